# Optimizing an MI355X kernel written in HIP

```python
import math
import jax, jax.numpy as jnp
from jax import lax
import numpy as np

D_MODEL = 1024
BATCH = 4
SEQ = 4096
DEPTH = 4

f32 = jnp.float32
N_EVEN = (DEPTH + 1) // 2
N_ODD = DEPTH // 2
D_FF = 4 * D_MODEL
MIX_WIDTH = D_MODEL
CONV_W = 4
NORM_EPS = 1e-6

LRU_WIDTH = MIX_WIDTH // 2
LRU_BLOCKS = 8
LRU_BW = LRU_WIDTH // LRU_BLOCKS
LRU_C = 8.0
LRU_COLS = 2 * LRU_WIDTH

RWKV_WIDTH = MIX_WIDTH // 2
RWKV_HEAD = 64
RWKV_HEADS = RWKV_WIDTH // RWKV_HEAD
RWKV_DECAY_RANK = 64
RWKV_A_RANK = 64
RWKV_GATE_RANK = 128
RWKV_COLS = 3 * RWKV_WIDTH + RWKV_DECAY_RANK + RWKV_A_RANK + RWKV_GATE_RANK
RWKV_LN_EPS = 64e-5
EVEN_IN_COLS = LRU_COLS + RWKV_COLS

GDN_HEADS = 4
GDN_DK = 128
GDN_DV = 128
GDN_WIDTH = GDN_HEADS * GDN_DV
GDN_QKV = GDN_HEADS * (2 * GDN_DK + GDN_DV)
GDN_COLS = GDN_QKV + GDN_WIDTH + 2 * GDN_HEADS
GDN_CHUNK = 64

MLSTM_HEADS = 4
MLSTM_DK = 64
MLSTM_DV = 128
MLSTM_WIDTH = MLSTM_HEADS * MLSTM_DV
MLSTM_QK = 2 * MLSTM_HEADS * MLSTM_DK
MLSTM_COLS = MLSTM_QK + 2 * MLSTM_WIDTH + 2 * MLSTM_HEADS
MLSTM_CHUNK = 64
ODD_IN_COLS = GDN_COLS + MLSTM_COLS

kernel_name = 'hybrid_rglru_rwkv7_gdn_mlstm_trunk'


def rms_norm(x, g, eps=NORM_EPS):
    xf = x.astype(f32)
    y = xf * lax.rsqrt(jnp.mean(jnp.square(xf), axis=-1, keepdims=True) + eps)
    return (y * g.astype(f32)).astype(x.dtype)


def l2_normalize(x, eps=1e-6):
    xf = x.astype(f32)
    return xf * lax.rsqrt(jnp.sum(jnp.square(xf), axis=-1, keepdims=True) + eps)


def causal_dwconv(x, w):
    K, T = w.shape[0], x.shape[1]
    xp = jnp.pad(x, ((0, 0), (K - 1, 0), (0, 0)))
    return sum(xp[:, k:k + T] * w[k] for k in range(K))


def token_shift(x):
    return jnp.pad(x, ((0, 0), (1, 0), (0, 0)))[:, :-1]


def to_chunks(x, c):
    B, T, H = x.shape[:3]
    x = x.reshape((B, T // c, c, H) + x.shape[3:])
    return jnp.moveaxis(x, 3, 1)


def from_chunks(x):
    B, H, N, C, d = x.shape
    return jnp.moveaxis(x, 1, 3).reshape(B, N * C, H, d)


def chunk_major(x):
    return jnp.moveaxis(x, 2, 0)


def _lin_combine(left, right):
    a_l, b_l = left
    a_r, b_r = right
    return a_l * a_r, a_r * b_l + b_r


def griffin_recurrent(p, conv_w, conv_b, wa, ba, wx, bx, lam):
    gate_in, rec_in = p[..., :LRU_WIDTH], p[..., LRU_WIDTH:]
    xc = (causal_dwconv(rec_in, conv_w) + conv_b).astype(f32)
    B, T, _ = xc.shape
    xb = xc.reshape(B, T, LRU_BLOCKS, LRU_BW)
    r_gate = jax.nn.sigmoid(jnp.einsum('btnd,nde->btne', xb, wa).reshape(B, T, LRU_WIDTH) + ba)
    i_gate = jax.nn.sigmoid(jnp.einsum('btnd,nde->btne', xb, wx).reshape(B, T, LRU_WIDTH) + bx)
    log_a = -LRU_C * r_gate * jax.nn.softplus(-lam.astype(f32))
    a = jnp.exp(log_a)
    mult = jnp.sqrt(-jnp.expm1(2.0 * log_a))
    mult = jnp.where(jnp.arange(T)[None, :, None] == 0, 1.0, mult)
    u = i_gate * xc * mult
    _, h = lax.associative_scan(_lin_combine, (a, u), axis=1)
    return (h * jax.nn.gelu(gate_in.astype(f32), approximate=True)).astype(p.dtype)


def rwkv7_mix(p, mu, w0, w2, a0, a2, g2, k_k, k_a, r_k, ln_w, ln_b):
    W, RD, RA = RWKV_WIDTH, RWKV_DECAY_RANK, RWKV_A_RANK
    pf = p.astype(f32)
    pf = pf + mu * (token_shift(pf) - pf)
    r, k, v = pf[..., :W], pf[..., W:2 * W], pf[..., 2 * W:3 * W]
    xw = pf[..., 3 * W:3 * W + RD]
    xa = pf[..., 3 * W + RD:3 * W + RD + RA]
    xg = pf[..., 3 * W + RD + RA:]
    w_log = -jax.nn.softplus(-(w0 + jnp.tanh(xw) @ w2)) - 0.5
    decay = jnp.exp(-jnp.exp(w_log))
    a = jax.nn.sigmoid(a0 + xa @ a2)
    g = jax.nn.sigmoid(xg) @ g2
    B, T, _ = pf.shape
    heads = lambda t: t.reshape(B, T, RWKV_HEADS, RWKV_HEAD)
    kk = l2_normalize(heads(k * k_k))
    k = k * (1.0 + (a - 1.0) * k_a)
    r_h, k_h, v_h, a_h, w_h = heads(r), heads(k), heads(v), heads(a), heads(decay)

    def step(S, inp):
        rt, wt, kt, vt, kkt, at = inp
        sk = jnp.einsum('bhvk,bhk->bhv', S, kkt)
        S = (S * wt[:, :, None, :] - sk[..., None] * (kkt * at)[:, :, None, :]
             + vt[..., None] * kt[:, :, None, :])
        return S, jnp.einsum('bhvk,bhk->bhv', S, rt)

    tm = lambda t: jnp.moveaxis(t, 1, 0)
    S0 = jnp.zeros((B, RWKV_HEADS, RWKV_HEAD, RWKV_HEAD), f32)
    _, y = lax.scan(step, S0, (tm(r_h), tm(w_h), tm(k_h), tm(v_h), tm(kk), tm(a_h)))
    y = jnp.moveaxis(y, 0, 1)
    mean = jnp.mean(y, axis=-1, keepdims=True)
    var = jnp.mean(jnp.square(y - mean), axis=-1, keepdims=True)
    y = ((y - mean) * lax.rsqrt(var + RWKV_LN_EPS)).reshape(B, T, W) * ln_w + ln_b
    bonus = jnp.sum(r_h * k_h * r_k, axis=-1, keepdims=True) * v_h
    y = (y + bonus.reshape(B, T, W)) * g
    return y.astype(p.dtype)


def gated_delta_chunked(q, k, v, g, beta):
    B, T, H, DK = q.shape
    DV = v.shape[-1]
    C = GDN_CHUNK
    q = q * DK ** -0.5
    qc, kc, vc = to_chunks(q, C), to_chunks(k, C), to_chunks(v, C)
    gc = jnp.cumsum(to_chunks(g, C), axis=-1)
    bc = to_chunks(beta, C)
    causal = jnp.tril(jnp.ones((C, C), bool))
    strict = jnp.tril(jnp.ones((C, C), bool), -1)
    decay = jnp.exp(jnp.where(causal, gc[..., :, None] - gc[..., None, :], -jnp.inf))
    kb = kc * bc[..., None]
    A = jnp.where(strict, jnp.einsum('bhnik,bhnjk->bhnij', kb, kc) * decay, 0.0)
    u = lax.linalg.triangular_solve(A, vc * bc[..., None], left_side=True, lower=True, unit_diagonal=True)
    w = lax.linalg.triangular_solve(A, kb * jnp.exp(gc)[..., None], left_side=True, lower=True, unit_diagonal=True)
    qk = jnp.einsum('bhnik,bhnjk->bhnij', qc, kc) * decay
    q_dec = qc * jnp.exp(gc)[..., None]
    k_dec = kc * jnp.exp(gc[..., -1:] - gc)[..., None]
    g_last = jnp.exp(gc[..., -1])

    def step(S, inp):
        q_d, k_d, u_c, w_c, qk_c, gl = inp
        v_new = u_c - jnp.einsum('bhck,bhkv->bhcv', w_c, S)
        o = jnp.einsum('bhck,bhkv->bhcv', q_d, S) + jnp.einsum('bhij,bhjv->bhiv', qk_c, v_new)
        S = S * gl[..., None, None] + jnp.einsum('bhck,bhcv->bhkv', k_d, v_new)
        return S, o

    S0 = jnp.zeros((B, H, DK, DV), f32)
    _, o = lax.scan(step, S0, (chunk_major(q_dec), chunk_major(k_dec), chunk_major(u),
                               chunk_major(w), chunk_major(qk), chunk_major(g_last)))
    return from_chunks(jnp.moveaxis(o, 0, 2))


def gdn_mix(p, conv_w, a_log, dt_bias, norm_g):
    B, T, _ = p.shape
    H = GDN_HEADS
    hk = H * GDN_DK
    qkv = jax.nn.silu(causal_dwconv(p[..., :GDN_QKV], conv_w))
    q = l2_normalize(qkv[..., :hk].reshape(B, T, H, GDN_DK))
    k = l2_normalize(qkv[..., hk:2 * hk].reshape(B, T, H, GDN_DK))
    v = qkv[..., 2 * hk:].reshape(B, T, H, GDN_DV).astype(f32)
    o0 = GDN_QKV
    z = p[..., o0:o0 + GDN_WIDTH].reshape(B, T, H, GDN_DV).astype(f32)
    b_raw = p[..., o0 + GDN_WIDTH:o0 + GDN_WIDTH + H].astype(f32)
    a_raw = p[..., o0 + GDN_WIDTH + H:].astype(f32)
    beta = jax.nn.sigmoid(b_raw)
    g = -jnp.exp(a_log.astype(f32)) * jax.nn.softplus(a_raw + dt_bias)
    o = gated_delta_chunked(q, k, v, g, beta)
    o = rms_norm(o, norm_g) * jax.nn.silu(z)
    return o.reshape(B, T, GDN_WIDTH).astype(p.dtype)


def mlstm_chunked(q, k, v, i_pre, f_pre):
    B, T, H, DK = q.shape
    DV = v.shape[-1]
    C = MLSTM_CHUNK
    q = q * DK ** -0.5
    qc, kc, vc = to_chunks(q, C), to_chunks(k, C), to_chunks(v, C)
    b = jnp.cumsum(to_chunks(jax.nn.log_sigmoid(f_pre), C), axis=-1)
    ic = to_chunks(i_pre, C)
    causal = jnp.tril(jnp.ones((C, C), bool))
    D = jnp.where(causal, b[..., :, None] - b[..., None, :] + ic[..., None, :], -jnp.inf)
    d_max = jnp.max(D, axis=-1)
    to_end = b[..., -1:] - b + ic
    qk = jnp.einsum('bhnik,bhnjk->bhnij', qc, kc)

    def step(carry, inp):
        Cs, ns, m = carry
        q_c, k_c, v_c, b_c, D_c, dmax_c, te_c, qk_c = inp
        inter = b_c + m[..., None]
        m_row = jnp.maximum(inter, dmax_c)
        w_inter = jnp.exp(inter - m_row)
        Wm = jnp.exp(D_c - m_row[..., None]) * qk_c
        num = (w_inter[..., None] * jnp.einsum('bhck,bhkv->bhcv', q_c, Cs)
               + jnp.einsum('bhij,bhjv->bhiv', Wm, v_c))
        den = w_inter * jnp.einsum('bhck,bhk->bhc', q_c, ns) + jnp.sum(Wm, axis=-1)
        h = num / jnp.maximum(jnp.abs(den), jnp.exp(-m_row))[..., None]
        m_new = jnp.maximum(b_c[..., -1] + m, jnp.max(te_c, axis=-1))
        decay_prev = jnp.exp(b_c[..., -1] + m - m_new)
        wk = k_c * jnp.exp(te_c - m_new[..., None])[..., None]
        Cs = decay_prev[..., None, None] * Cs + jnp.einsum('bhck,bhcv->bhkv', wk, v_c)
        ns = decay_prev[..., None] * ns + jnp.sum(wk, axis=-2)
        return (Cs, ns, m_new), h

    init = (jnp.zeros((B, H, DK, DV), f32), jnp.zeros((B, H, DK), f32), jnp.zeros((B, H), f32))
    _, h = lax.scan(step, init, (chunk_major(qc), chunk_major(kc), chunk_major(vc), chunk_major(b),
                                 chunk_major(D), chunk_major(d_max), chunk_major(to_end), chunk_major(qk)))
    return from_chunks(jnp.moveaxis(h, 0, 2))


def mlstm_mix(p, conv_w, ig_b, fg_b, norm_g):
    B, T, _ = p.shape
    H, W = MLSTM_HEADS, MLSTM_WIDTH
    hk = H * MLSTM_DK
    qk = jax.nn.silu(causal_dwconv(p[..., :MLSTM_QK], conv_w))
    q = qk[..., :hk].reshape(B, T, H, MLSTM_DK).astype(f32)
    k = qk[..., hk:].reshape(B, T, H, MLSTM_DK).astype(f32)
    o0 = MLSTM_QK
    v = p[..., o0:o0 + W].reshape(B, T, H, MLSTM_DV).astype(f32)
    og = p[..., o0 + W:o0 + 2 * W].astype(f32)
    i_pre = p[..., o0 + 2 * W:o0 + 2 * W + H].astype(f32) + ig_b
    f_pre = p[..., o0 + 2 * W + H:].astype(f32) + fg_b
    h = mlstm_chunked(q, k, v, i_pre, f_pre)
    h = rms_norm(h, norm_g).reshape(B, T, W) * jax.nn.sigmoid(og)
    return h.astype(p.dtype)


def setup_inputs(seed: int = 0) -> dict:
    key = jax.random.key(seed)
    ks = iter(jax.random.split(key, 48))

    def nrm(shape, scale):
        return jax.random.normal(next(ks), shape, f32) * scale

    def uni(shape, lo, hi):
        return jax.random.uniform(next(ks), shape, f32, lo, hi)

    E, O, D = N_EVEN, N_ODD, D_MODEL
    x = nrm((BATCH, SEQ, D), 1.0)
    norm_mix_g = 1.0 + nrm((DEPTH, D), 0.02)
    norm_mlp_g = 1.0 + nrm((DEPTH, D), 0.02)
    mlp_up = nrm((DEPTH, D, D_FF), D ** -0.5)
    mlp_down = nrm((DEPTH, D_FF, D), D_FF ** -0.5)
    final_g = 1.0 + nrm((D,), 0.02)
    ev_w_in = nrm((E, D, EVEN_IN_COLS), D ** -0.5)
    ev_w_out = nrm((E, MIX_WIDTH, D), MIX_WIDTH ** -0.5)
    lru_conv_w = nrm((E, CONV_W, LRU_WIDTH), CONV_W ** -0.5)
    lru_conv_b = nrm((E, LRU_WIDTH), 0.02)
    lru_wa = nrm((E, LRU_BLOCKS, LRU_BW, LRU_BW), LRU_BW ** -0.5)
    lru_ba = nrm((E, LRU_WIDTH), 0.02)
    lru_wx = nrm((E, LRU_BLOCKS, LRU_BW, LRU_BW), LRU_BW ** -0.5)
    lru_bx = nrm((E, LRU_WIDTH), 0.02)
    a_base = uni((E, LRU_WIDTH), 0.9, 0.999) ** (1.0 / LRU_C)
    lru_lambda = jnp.log(a_base) - jnp.log1p(-a_base)
    rwkv_mu = uni((E, RWKV_COLS), 0.0, 1.0)
    rwkv_w0 = uni((E, RWKV_WIDTH), -6.0, -1.0)
    rwkv_w2 = nrm((E, RWKV_DECAY_RANK, RWKV_WIDTH), 0.1 * RWKV_DECAY_RANK ** -0.5)
    rwkv_a0 = nrm((E, RWKV_WIDTH), 0.1)
    rwkv_a2 = nrm((E, RWKV_A_RANK, RWKV_WIDTH), RWKV_A_RANK ** -0.5)
    rwkv_g2 = nrm((E, RWKV_GATE_RANK, RWKV_WIDTH), RWKV_GATE_RANK ** -0.5)
    rwkv_kk = 0.85 + nrm((E, RWKV_WIDTH), 0.05)
    rwkv_ka = 1.0 + nrm((E, RWKV_WIDTH), 0.05)
    rwkv_rk = nrm((E, RWKV_HEADS, RWKV_HEAD), 0.1)
    rwkv_lnw = 1.0 + nrm((E, RWKV_WIDTH), 0.02)
    rwkv_lnb = nrm((E, RWKV_WIDTH), 0.02)
    od_w_in = nrm((O, D, ODD_IN_COLS), D ** -0.5)
    od_w_out = nrm((O, MIX_WIDTH, D), MIX_WIDTH ** -0.5)
    gdn_conv_w = nrm((O, CONV_W, GDN_QKV), CONV_W ** -0.5)
    gdn_a_log = jnp.log(uni((O, GDN_HEADS), 1.0, 16.0))
    dt = jnp.exp(uni((O, GDN_HEADS), math.log(1e-3), math.log(1e-1)))
    gdn_dt_bias = dt + jnp.log(-jnp.expm1(-dt))
    gdn_norm_g = 1.0 + nrm((O, GDN_DV), 0.02)
    mlstm_conv_w = nrm((O, CONV_W, MLSTM_QK), CONV_W ** -0.5)
    mlstm_ig_b = nrm((O, MLSTM_HEADS), 0.1)
    mlstm_fg_b = jnp.linspace(3.0, 6.0, MLSTM_HEADS, dtype=f32)[None, :] + nrm((O, MLSTM_HEADS), 0.1)
    mlstm_norm_g = 1.0 + nrm((O, MLSTM_DV), 0.02)
    return {
        'x': x, 'norm_mix_g': norm_mix_g, 'norm_mlp_g': norm_mlp_g,
        'mlp_up': mlp_up, 'mlp_down': mlp_down, 'final_g': final_g,
        'ev_w_in': ev_w_in, 'ev_w_out': ev_w_out,
        'lru_conv_w': lru_conv_w, 'lru_conv_b': lru_conv_b,
        'lru_wa': lru_wa, 'lru_ba': lru_ba, 'lru_wx': lru_wx, 'lru_bx': lru_bx,
        'lru_lambda': lru_lambda,
        'rwkv_mu': rwkv_mu, 'rwkv_w0': rwkv_w0, 'rwkv_w2': rwkv_w2,
        'rwkv_a0': rwkv_a0, 'rwkv_a2': rwkv_a2, 'rwkv_g2': rwkv_g2,
        'rwkv_kk': rwkv_kk, 'rwkv_ka': rwkv_ka, 'rwkv_rk': rwkv_rk,
        'rwkv_lnw': rwkv_lnw, 'rwkv_lnb': rwkv_lnb,
        'od_w_in': od_w_in, 'od_w_out': od_w_out,
        'gdn_conv_w': gdn_conv_w, 'gdn_a_log': gdn_a_log, 'gdn_dt_bias': gdn_dt_bias,
        'gdn_norm_g': gdn_norm_g,
        'mlstm_conv_w': mlstm_conv_w, 'mlstm_ig_b': mlstm_ig_b, 'mlstm_fg_b': mlstm_fg_b,
        'mlstm_norm_g': mlstm_norm_g,
    }


def reference(x, norm_mix_g, norm_mlp_g, mlp_up, mlp_down, final_g,
              ev_w_in, ev_w_out, lru_conv_w, lru_conv_b, lru_wa, lru_ba, lru_wx, lru_bx,
              lru_lambda, rwkv_mu, rwkv_w0, rwkv_w2, rwkv_a0, rwkv_a2, rwkv_g2,
              rwkv_kk, rwkv_ka, rwkv_rk, rwkv_lnw, rwkv_lnb,
              od_w_in, od_w_out, gdn_conv_w, gdn_a_log, gdn_dt_bias, gdn_norm_g,
              mlstm_conv_w, mlstm_ig_b, mlstm_fg_b, mlstm_norm_g):
    for l in range(DEPTH):
        h = rms_norm(x, norm_mix_g[l])
        if l % 2 == 0:
            e = l // 2
            p = h @ ev_w_in[e]
            ya = griffin_recurrent(p[..., :LRU_COLS], lru_conv_w[e], lru_conv_b[e],
                                   lru_wa[e], lru_ba[e], lru_wx[e], lru_bx[e], lru_lambda[e])
            yb = rwkv7_mix(p[..., LRU_COLS:], rwkv_mu[e], rwkv_w0[e], rwkv_w2[e], rwkv_a0[e],
                           rwkv_a2[e], rwkv_g2[e], rwkv_kk[e], rwkv_ka[e], rwkv_rk[e],
                           rwkv_lnw[e], rwkv_lnb[e])
            y = jnp.concatenate([ya, yb], axis=-1) @ ev_w_out[e]
        else:
            o = l // 2
            p = h @ od_w_in[o]
            yc = gdn_mix(p[..., :GDN_COLS], gdn_conv_w[o], gdn_a_log[o], gdn_dt_bias[o], gdn_norm_g[o])
            yd = mlstm_mix(p[..., GDN_COLS:], mlstm_conv_w[o], mlstm_ig_b[o], mlstm_fg_b[o], mlstm_norm_g[o])
            y = jnp.concatenate([yc, yd], axis=-1) @ od_w_out[o]
        x = x + y
        h = rms_norm(x, norm_mlp_g[l])
        x = x + jnp.square(jax.nn.relu(h @ mlp_up[l])) @ mlp_down[l]
    return rms_norm(x, final_g)
```

```cpp
#include <hip/hip_runtime.h>
#include <hip/hip_cooperative_groups.h>
#include <cstdio>
#include <cstdint>
namespace cg = cooperative_groups;
namespace pg8 {
#define PG8_LAS __attribute__((address_space(3)))
typedef unsigned short bf16_t;
typedef short bf16x8 __attribute__((ext_vector_type(8)));
typedef float f32x4 __attribute__((ext_vector_type(4)));
typedef unsigned u32x4 __attribute__((ext_vector_type(4)));
constexpr int BM = 256, BK = 64, HALF = 128, HTB = HALF * BK * 2  , STAGE_BYTES = 8 * HTB, NXCD = 8, WGM = 8;

__host__ __device__ __forceinline__ int lds_byte(int r, int c) { const int st = (r >> 4) * 2 + (c >> 5), rr = r & 15, cc = c & 31, ob = rr * 64 + cc * 2; return st * 1024 + (ob ^ (((ob >> 9) & 1) << 5)); }
__host__ __device__ __forceinline__ void stage_rc(int b, int& R, int& C) { const int st = b / 1024, sb = b % 1024, swz = sb ^ (((sb >> 9) & 1) << 5); R = (st >> 1) * 16 + swz / 64; C = (st & 1) * 32 + (swz % 64) / 2; }
__host__ __device__ __forceinline__ int perm32(int rho) { const int n = rho >> 4, i = rho & 15; return 8 * (i >> 2) + 4 * n + (i & 3); }

struct Unit { int pm, pn; };
struct Gemm { const bf16_t* A; const bf16_t* Bt; int M, N, K; };

struct StaticOrder {
    int nM, nN, nwg, G, c;
    __host__ __device__ void init(int M, int N, int G_, int c_) { nM = M / BM; nN = N / BM; nwg = nM * nN; G = G_; c = c_; }
    __host__ __device__ bool next(int i, Unit& u) const {
        const long L = (long)i * G + c; if (L >= nwg) return false;
        int wgid = (int)L; { const int q = nwg / NXCD, r = nwg % NXCD, xcd = wgid % NXCD, off = wgid / NXCD; wgid = (xcd < r ? xcd * (q + 1) : r * (q + 1) + (xcd - r) * q) + off; }
        const int nig = WGM * nN, gid = wgid / nig, fm = gid * WGM, gsz = (nM - fm) < WGM ? (nM - fm) : WGM;
        u.pm = fm + ((wgid % nig) % gsz); u.pn = (wgid % nig) / gsz; return true;
    }
    __device__ __forceinline__ void a_ready(const Unit&) const {}
    __device__ __forceinline__ void done(const Unit&) const {}
};

__device__ __forceinline__ unsigned cvt_pk_bf16(float lo, float hi) { unsigned r; asm volatile("v_cvt_pk_bf16_f32 %0, %1, %2" : "=v"(r) : "v"(lo), "v"(hi)); return r; }
__device__ __forceinline__ float row_rstd(const float* slots, int row) {
    const f32x4* s = (const f32x4*)(slots + (size_t)row * 16);
    const f32x4 a = s[0], b = s[1], c = s[2], d = s[3];
    const float t = ((a[0] + a[1]) + (a[2] + a[3])) + ((b[0] + b[1]) + (b[2] + b[3])) + ((c[0] + c[1]) + (c[2] + c[3])) + ((d[0] + d[1]) + (d[2] + d[3]));
    return 1.0f / sqrtf(t * (1.0f / 1024.0f) + 1e-6f);
}
__device__ __forceinline__ float row_rstd_q(const float* slots, int row, int fq) {
    const f32x4 a = *(const f32x4*)(slots + (size_t)row * 16 + 4 * fq);
    float t = (a[0] + a[1]) + (a[2] + a[3]);
    t += __shfl_xor(t, 16); t += __shfl_xor(t, 32);
    return 1.0f / sqrtf(t * (1.0f / 1024.0f) + 1e-6f);
}
template <int ACT> struct EpiScaleBf16 {
    static constexpr bool PERM = true, AFTER_DRAIN = false, WIDE = true;
    bf16_t* O; int ldc; const float* slots; bf16_t* halo = nullptr; int probe = 0;
    __device__ __forceinline__ void operator()(const f32x4 (&acc)[2][2][4][2], const Unit& u, int wr, int wc, int fr, int fq) const {
        const int row0 = u.pm * BM + wr * 64 + fr, col0 = u.pn * BM + wc * 64 + 8 * fq;
#pragma unroll
        for (int ai = 0; ai < 2; ++ai)
#pragma unroll
            for (int m = 0; m < 4; ++m) {
                const int row = row0 + ai * HALF + m * 16;
                const float rs = (probe & 2) ? 1.0f : row_rstd_q(slots, row, fq);
                bf16_t* rowp = O + (size_t)row * ldc + col0;
#pragma unroll
                for (int bj = 0; bj < 2; ++bj) {
                    f32x4 v0 = acc[ai][bj][m][0] * rs, v1 = acc[ai][bj][m][1] * rs;
                    if (ACT == 1) {
#pragma unroll
                        for (int q = 0; q < 4; ++q) { float a = fmaxf(v0[q], 0.f), b = fmaxf(v1[q], 0.f); v0[q] = a * a; v1[q] = b * b; }
                    }
                    u32x4 w; w.x = cvt_pk_bf16(v0[0], v0[1]); w.y = cvt_pk_bf16(v0[2], v0[3]); w.z = cvt_pk_bf16(v1[0], v1[1]); w.w = cvt_pk_bf16(v1[2], v1[3]);
                    if (!(probe & 1)) *(u32x4*)(rowp + bj * 32) = w;
                    if (halo && m == 3 && fr >= 13) *(u32x4*)(halo + ((size_t)(row >> 6) * 3 + (row & 63) - 61) * ldc + col0 + bj * 32) = w;
                }
            }
    }
};
struct EpiRes {
    static constexpr bool PERM = true, AFTER_DRAIN = false, WIDE = true;
    const bf16_t* XI; bf16_t* XO; float* slots; bool noslots = false;
    __device__ __forceinline__ void operator()(const f32x4 (&acc)[2][2][4][2], const Unit& u, int wr, int wc, int fr, int fq) const {
        const int col0 = u.pn * BM + wc * 64 + 8 * fq;
#pragma unroll
        for (int ai = 0; ai < 2; ++ai)
#pragma unroll
            for (int m = 0; m < 4; ++m) {
                const int row = u.pm * BM + ai * HALF + wr * 64 + m * 16 + fr;
                const size_t off = (size_t)row * 1024 + col0;
                u32x4 xin[2];
#pragma unroll
                for (int bj = 0; bj < 2; ++bj) xin[bj] = *(const u32x4*)(XI + off + bj * 32);
                float ss = 0.f;
#pragma unroll
                for (int bj = 0; bj < 2; ++bj) {
                    const u32x4 xi = xin[bj];
                    f32x4 v0, v1;
                    v0[0] = __uint_as_float(xi.x << 16); v0[1] = __uint_as_float(xi.x & 0xffff0000u); v0[2] = __uint_as_float(xi.y << 16); v0[3] = __uint_as_float(xi.y & 0xffff0000u);
                    v1[0] = __uint_as_float(xi.z << 16); v1[1] = __uint_as_float(xi.z & 0xffff0000u); v1[2] = __uint_as_float(xi.w << 16); v1[3] = __uint_as_float(xi.w & 0xffff0000u);
                    v0 = v0 + acc[ai][bj][m][0]; v1 = v1 + acc[ai][bj][m][1];
                    u32x4 w; w.x = cvt_pk_bf16(v0[0], v0[1]); w.y = cvt_pk_bf16(v0[2], v0[3]); w.z = cvt_pk_bf16(v1[0], v1[1]); w.w = cvt_pk_bf16(v1[2], v1[3]);
                    *(u32x4*)(XO + off + bj * 32) = w;
                    const float r0 = __uint_as_float(w.x << 16), r1 = __uint_as_float(w.x & 0xffff0000u), r2 = __uint_as_float(w.y << 16), r3 = __uint_as_float(w.y & 0xffff0000u);
                    const float r4 = __uint_as_float(w.z << 16), r5 = __uint_as_float(w.z & 0xffff0000u), r6 = __uint_as_float(w.w << 16), r7 = __uint_as_float(w.w & 0xffff0000u);
                    ss += ((r0 * r0 + r1 * r1) + (r2 * r2 + r3 * r3)) + ((r4 * r4 + r5 * r5) + (r6 * r6 + r7 * r7));
                }
                ss += __shfl_xor(ss, 16); ss += __shfl_xor(ss, 32);
                if (fq == 0 && !noslots) slots[(size_t)row * 16 + u.pn * 4 + wc] = ss;
            }
    }
};
template <class Epi, class Sched, bool ALIGN_EPI = false, bool SP2 = false>
__device__ __forceinline__ void gemm_phase(PG8_LAS unsigned char* lds, const Gemm g, const Sched& S, const Epi& E, int tid_in) {
    int tid_ = tid_in; asm volatile("" : "+v"(tid_));
    const int tid = tid_, wid = __builtin_amdgcn_readfirstlane(tid >> 6), lane = tid & 63, wr = wid >> 2, wc = wid & 3, fr = lane & 15, fq = lane >> 4;
    const int K = g.K, nt = K / BK;
    unsigned voffA[2], voffB[2];
#pragma unroll
    for (int i = 0; i < 2; ++i) { int R, C; stage_rc(tid * 16 + i * 8192, R, C); const int Rb = Epi::WIDE ? (64 * (R >> 5) + perm32(R & 31)) : (Epi::PERM ? ((R & ~31) + perm32(R & 31)) : R);
        voffA[i] = (unsigned)(R * K + C) * 2u; voffB[i] = (unsigned)(Rb * K + C) * 2u; }
    const size_t kstep = (size_t)(BK * 2);
    const size_t hstep = (size_t)HALF * K * 2;
    const size_t hstepB = Epi::WIDE ? (size_t)32 * K * 2 : hstep;
    const size_t tstep = 2 * hstep;
    const unsigned ldsw = (unsigned)wid * 1024u;
    const int aoff = lds_byte(wr * 64 + fr, fq * 8), boff = lds_byte(wc * 32 + fr, fq * 8);
#define PG8_SA(b, h) (((b) * 2 + (h)) * HTB)
#define PG8_SB(b, h) ((4 + (b) * 2 + (h)) * HTB)
#define PG8_STAGE(bufoff, gbase, voff) do { _Pragma("unroll") for (int _i = 0; _i < 2; ++_i) \
        __builtin_amdgcn_global_load_lds((const unsigned*)((const char*)(gbase) + (voff)[_i]), (PG8_LAS unsigned*)(lds + (bufoff) + ldsw + _i * 8192), 16, 0, 0); } while (0)
#define PG8_LDA(dst, b, h) do { _Pragma("unroll") for (int m = 0; m < 4; ++m) _Pragma("unroll") for (int k = 0; k < 2; ++k) dst[m][k] = *(const PG8_LAS bf16x8*)(lds + PG8_SA(b, h) + aoff + m * 2048 + k * 1024); } while (0)
#define PG8_LDB(dst, b, h) do { _Pragma("unroll") for (int n = 0; n < 2; ++n) _Pragma("unroll") for (int k = 0; k < 2; ++k) dst[n][k] = *(const PG8_LAS bf16x8*)(lds + PG8_SB(b, h) + boff + n * 2048 + k * 1024); } while (0)
#define PG8_MMA(ai, bj, At, Bt) do { __builtin_amdgcn_s_setprio(1); _Pragma("unroll") for (int m = 0; m < 4; ++m) _Pragma("unroll") for (int n = 0; n < 2; ++n) _Pragma("unroll") for (int k = 0; k < 2; ++k) \
        acc[ai][bj][m][n] = __builtin_amdgcn_mfma_f32_16x16x32_bf16(Bt[n][k], At[m][k], acc[ai][bj][m][n], 0, 0, 0); __builtin_amdgcn_s_setprio(0); } while (0)
#define PG8_WAIT_V(n) asm volatile("s_waitcnt vmcnt(" #n ")" ::: "memory")
#define PG8_WAIT_L(n) asm volatile("s_waitcnt lgkmcnt(" #n ")" ::: "memory")
#define PG8_BAR __builtin_amdgcn_s_barrier()
#define PG8_SCHED __builtin_amdgcn_sched_barrier(0)
    Unit cur, nxt; int ui = 0;
    if (!S.next(0, cur)) return;
    f32x4 acc[2][2][4][2];
#pragma unroll
    for (int a = 0; a < 2; ++a)
#pragma unroll
        for (int b = 0; b < 2; ++b)
#pragma unroll
            for (int m = 0; m < 4; ++m)
#pragma unroll
                for (int n = 0; n < 2; ++n) acc[a][b][m][n] = (f32x4){0.f, 0.f, 0.f, 0.f};
    bf16x8 At[4][2], B0[2][2], B1[2][2];
    const char* cA = (const char*)g.A + (size_t)cur.pm * tstep; const char* cB = (const char*)g.Bt + (size_t)cur.pn * tstep;
    S.a_ready(cur);
    if constexpr (SP2) {
        PG8_STAGE(PG8_SB(0, 0), cB, voffB); PG8_STAGE(PG8_SB(0, 1), cB + hstepB, voffB); PG8_STAGE(PG8_SA(0, 0), cA, voffA); PG8_STAGE(PG8_SA(0, 1), cA + hstep, voffA);
        if (wr == 1) PG8_BAR;
        PG8_WAIT_V(2); PG8_BAR;
        PG8_STAGE(PG8_SB(1, 0), cB + kstep, voffB); PG8_STAGE(PG8_SA(1, 0), cA + kstep, voffA); PG8_STAGE(PG8_SB(1, 1), cB + hstepB + kstep, voffB);
        PG8_WAIT_V(6); PG8_BAR;
    } else {
        PG8_STAGE(PG8_SB(0, 0), cB, voffB); PG8_STAGE(PG8_SA(0, 0), cA, voffA); PG8_STAGE(PG8_SB(0, 1), cB + hstepB, voffB); PG8_STAGE(PG8_SA(0, 1), cA + hstep, voffA);
        if (wr == 1) PG8_BAR;
        PG8_WAIT_V(4); PG8_BAR;
        PG8_STAGE(PG8_SB(1, 0), cB + kstep, voffB); PG8_STAGE(PG8_SA(1, 0), cA + kstep, voffA); PG8_STAGE(PG8_SB(1, 1), cB + hstepB + kstep, voffB);
        PG8_WAIT_V(6); PG8_BAR;
    }
    for (;;) {
        const bool has_next = S.next(ui + 1, nxt);
        const char* nA = has_next ? (const char*)g.A + (size_t)nxt.pm * tstep : cA; const char* nB = has_next ? (const char*)g.Bt + (size_t)nxt.pn * tstep : cB;
        for (int t = 0; t < nt; t += 2) {
            const bool last = (t == nt - 2);
            const char* a1 = cA + (size_t)(t + 1) * kstep;
            const char* a2 = last ? nA : cA + (size_t)(t + 2) * kstep; const char* b2 = last ? nB : cB + (size_t)(t + 2) * kstep;
            const char* a3 = a2 + kstep; const char* b3 = b2 + kstep;
            if (last && has_next) S.a_ready(nxt);
            if constexpr (SP2) {
            PG8_LDB(B0, 0, 0); PG8_LDB(B1, 0, 1); PG8_SCHED; PG8_LDA(At, 0, 0); PG8_STAGE(PG8_SA(1, 1), a1 + hstep, voffA);
            PG8_WAIT_V(8); PG8_WAIT_L(0); PG8_BAR; PG8_MMA(0, 0, At, B0); PG8_MMA(0, 1, At, B1); PG8_BAR; PG8_SCHED;
            PG8_LDA(At, 0, 1); PG8_STAGE(PG8_SB(0, 0), b2, voffB); PG8_STAGE(PG8_SB(0, 1), b2 + hstepB, voffB); PG8_STAGE(PG8_SA(0, 0), a2, voffA);
            PG8_WAIT_V(8); PG8_WAIT_L(0); PG8_BAR; PG8_MMA(1, 0, At, B0); PG8_MMA(1, 1, At, B1); PG8_BAR; PG8_SCHED;
            PG8_LDB(B0, 1, 0); PG8_LDB(B1, 1, 1); PG8_SCHED; PG8_LDA(At, 1, 0); PG8_STAGE(PG8_SA(0, 1), a2 + hstep, voffA);
            PG8_WAIT_V(8); PG8_WAIT_L(0); PG8_BAR; PG8_MMA(0, 0, At, B0); PG8_MMA(0, 1, At, B1); PG8_BAR; PG8_SCHED;
            PG8_LDA(At, 1, 1); PG8_STAGE(PG8_SB(1, 0), b3, voffB); PG8_STAGE(PG8_SB(1, 1), b3 + hstepB, voffB); PG8_STAGE(PG8_SA(1, 0), a3, voffA);
            PG8_WAIT_V(8); PG8_WAIT_L(0); PG8_BAR; PG8_MMA(1, 0, At, B0); PG8_MMA(1, 1, At, B1); PG8_BAR; PG8_SCHED;
            } else {
            PG8_LDB(B0, 0, 0); PG8_SCHED; PG8_LDA(At, 0, 0); PG8_STAGE(PG8_SA(1, 1), a1 + hstep, voffA);
            PG8_WAIT_L(8); PG8_BAR; PG8_WAIT_L(0); PG8_MMA(0, 0, At, B0); PG8_BAR; PG8_SCHED;
            PG8_LDB(B1, 0, 1); PG8_STAGE(PG8_SB(0, 0), b2, voffB);
            PG8_BAR; PG8_WAIT_L(0); PG8_MMA(0, 1, At, B1); PG8_BAR;
            PG8_LDA(At, 0, 1); PG8_STAGE(PG8_SA(0, 0), a2, voffA);
            PG8_BAR; PG8_WAIT_L(0); PG8_MMA(1, 0, At, B0); PG8_BAR; PG8_SCHED;
            PG8_STAGE(PG8_SB(0, 1), b2 + hstepB, voffB);
            PG8_WAIT_V(6); PG8_BAR; PG8_MMA(1, 1, At, B1); PG8_BAR;
            PG8_LDB(B0, 1, 0); PG8_SCHED; PG8_LDA(At, 1, 0); PG8_STAGE(PG8_SA(0, 1), a2 + hstep, voffA);
            PG8_WAIT_L(8); PG8_BAR; PG8_WAIT_L(0); PG8_MMA(0, 0, At, B0); PG8_BAR; PG8_SCHED;
            PG8_LDB(B1, 1, 1); PG8_STAGE(PG8_SB(1, 0), b3, voffB);
            PG8_BAR; PG8_WAIT_L(0); PG8_MMA(0, 1, At, B1); PG8_BAR;
            PG8_LDA(At, 1, 1); PG8_STAGE(PG8_SA(1, 0), a3, voffA);
            PG8_BAR; PG8_WAIT_L(0); PG8_MMA(1, 0, At, B0); PG8_BAR; PG8_SCHED;
            PG8_STAGE(PG8_SB(1, 1), b3 + hstepB, voffB);
            PG8_WAIT_V(6); PG8_BAR; PG8_MMA(1, 1, At, B1); PG8_BAR;
            }
        }
        if constexpr (ALIGN_EPI) { if (wr == 0) PG8_BAR; }
        if constexpr (!Epi::AFTER_DRAIN) { E(acc, cur, wr, wc, fr, fq); S.done(cur); }
        if (!has_next) break;
#pragma unroll
        for (int a = 0; a < 2; ++a)
#pragma unroll
            for (int b = 0; b < 2; ++b)
#pragma unroll
                for (int m = 0; m < 4; ++m)
#pragma unroll
                    for (int n = 0; n < 2; ++n) acc[a][b][m][n] = (f32x4){0.f, 0.f, 0.f, 0.f};
        cur = nxt; cA = nA; cB = nB; ++ui;
        if constexpr (ALIGN_EPI) { if (wr == 1) PG8_BAR; }
    }
    PG8_WAIT_V(0);
    if constexpr (!ALIGN_EPI) { if (wr == 0) PG8_BAR; }
    PG8_BAR;
    if constexpr (Epi::AFTER_DRAIN) { E.fused(acc, cur, wr, wc, fr, fq, lds, wid, lane); S.done(cur); }
#undef PG8_SA
#undef PG8_SB
#undef PG8_STAGE
#undef PG8_LDA
#undef PG8_LDB
#undef PG8_MMA
#undef PG8_WAIT_V
#undef PG8_WAIT_L
#undef PG8_BAR
#undef PG8_SCHED
}
}

typedef unsigned short bf16;
typedef float f32x4 __attribute__((ext_vector_type(4)));
typedef unsigned u32x4 __attribute__((ext_vector_type(4)));
typedef unsigned u32x2 __attribute__((ext_vector_type(2)));
#define LAS __attribute__((address_space(3)))
#define GAS __attribute__((address_space(1)))
constexpr int NWAVES = 8, NTHREADS = 512;
constexpr int BATCH = 4, SEQ = 4096, DM = 1024, DFF = 4096, DEPTH = 4, M = BATCH * SEQ;
constexpr int EV_COLS = 2816, OD_COLS = 3600, OD_PAD = 3840;
constexpr int OC_Z = 1536, OC_MQK = 2048, OC_MV = 2560, OC_MOG = 3072, OC_GB = 3584, OC_GA = 3588, OC_MI = 3592, OC_MF = 3596;
constexpr int EC_R = 1024, EC_K = 1536, EC_V = 2048, EC_XW = 2560, EC_XA = 2624, EC_XG = 2688;
constexpr int LDS_BYTES = 151552;
constexpr int N_PHASES = 2 + 7 * DEPTH;

constexpr size_t MiB = 1u << 20;
constexpr size_t WS_CTL = 0, CTL_BYTES = 1 * MiB;
constexpr size_t WS_TBL = 512 * 1024;
constexpr size_t WSET_BYTES = 26 * MiB;
constexpr size_t WS_WSET0 = 1 * MiB, WS_WSET1 = WS_WSET0 + WSET_BYTES;
constexpr size_t WOFF_IN = 0, WOFF_OUT = (size_t)OD_PAD * DM * 2, WOFF_UP = WOFF_OUT + (size_t)DM * DM * 2, WOFF_DOWN = WOFF_UP + (size_t)DFF * DM * 2, WOFF_G2 = WOFF_DOWN + (size_t)DM * DFF * 2;
static_assert(WOFF_G2 + (size_t)512 * 128 * 2 <= WSET_BYTES, "weight set");
constexpr size_t WS_SLOTS = WS_WSET1 + WSET_BYTES;
constexpr size_t WS_DEN = WS_SLOTS + 1 * MiB;
constexpr size_t WS_BONUS = WS_DEN + 1 * MiB;
constexpr size_t WS_XB = WS_BONUS + 1 * MiB;
constexpr size_t WS_Y = WS_XB + 32 * MiB;
constexpr size_t WS_R1 = WS_Y + 32 * MiB;
constexpr size_t WS_END = WS_R1 + 128 * MiB;
constexpr size_t WS_HALO = WS_END;
static_assert(WS_END <= 256 * MiB, "d_ws budget");

#ifndef REP_SKIP
#define REP_SKIP 0
#endif
struct Args {
    const float* in[36];
    float* out; unsigned char* ws;
    int ph_lo, ph_hi;
};

__device__ __forceinline__ float bf2f(unsigned h) { return __uint_as_float(h << 16); }
__device__ __forceinline__ unsigned f2bf(float f) { unsigned u = __float_as_uint(f); return (u + 0x7fffu + ((u >> 16) & 1u)) >> 16; }
__device__ __forceinline__ unsigned pk2(float lo, float hi) { typedef float f2_t __attribute__((ext_vector_type(2))); typedef __bf16 b2_t __attribute__((ext_vector_type(2)));
    const f2_t v = {lo, hi}; const b2_t c = __builtin_convertvector(v, b2_t); return __builtin_bit_cast(unsigned, c); }
__device__ __forceinline__ float fexp(float x) { return __builtin_amdgcn_exp2f(x * 1.4426950408889634f); }
__device__ __forceinline__ float flog(float x) { return __builtin_amdgcn_logf(x) * 0.6931471805599453f; }
__device__ __forceinline__ float frcp(float x) { return __builtin_amdgcn_rcpf(x); }
__device__ __forceinline__ float frsq(float x) { return __builtin_amdgcn_rsqf(x); }
__device__ __forceinline__ float sigm(float x) { return frcp(1.0f + fexp(-x)); }
__device__ __forceinline__ float softplusf(float x) { return fmaxf(x, 0.f) + flog(1.0f + fexp(-fabsf(x))); }
__device__ __forceinline__ float siluf(float x) { return x * sigm(x); }
__device__ __forceinline__ float ftanh(float x) { const float e = fexp(-2.0f * fabsf(x)); const float t = (1.0f - e) * frcp(1.0f + e); return x < 0.f ? -t : t; }
__device__ __forceinline__ float gelu_tanh(float x) { const float u = 0.7978845608028654f * (x + 0.044715f * x * x * x); return 0.5f * x * (1.0f + ftanh(u)); }
template <int CTRL> __device__ __forceinline__ float dpp_mov(float v) { return __int_as_float(__builtin_amdgcn_update_dpp(0, __float_as_int(v), CTRL, 0xF, 0xF, true)); }
__device__ __forceinline__ float row_sum16(float v) {
    v += dpp_mov<0x128>(v); v += dpp_mov<0x124>(v); v += dpp_mov<0x122>(v); v += dpp_mov<0x121>(v); return v;
}
__device__ __forceinline__ float wave_sum(float v) {
    v = row_sum16(v); v += __shfl_xor(v, 16); v += __shfl_xor(v, 32); return v;
}
__device__ __forceinline__ void ld4(const bf16* p, float* o) { const u32x2 w = *(const u32x2*)p; o[0] = bf2f(w.x & 0xffffu); o[1] = bf2f(w.x >> 16); o[2] = bf2f(w.y & 0xffffu); o[3] = bf2f(w.y >> 16); }
__device__ __forceinline__ void ld8(const bf16* p, float* o) { const u32x4 w = *(const u32x4*)p;
    o[0] = bf2f(w.x & 0xffffu); o[1] = bf2f(w.x >> 16); o[2] = bf2f(w.y & 0xffffu); o[3] = bf2f(w.y >> 16); o[4] = bf2f(w.z & 0xffffu); o[5] = bf2f(w.z >> 16); o[6] = bf2f(w.w & 0xffffu); o[7] = bf2f(w.w >> 16); }
__device__ __forceinline__ void ld2(const bf16* p, float* o) { const unsigned w = *(const unsigned*)p; o[0] = bf2f(w & 0xffffu); o[1] = bf2f(w >> 16); }

__device__ __forceinline__ void lds_barrier() { asm volatile("s_waitcnt lgkmcnt(0)" ::: "memory"); __builtin_amdgcn_s_barrier(); asm volatile("" ::: "memory"); }
#define GPTR(T, p) ((T*)(GAS T*)(unsigned long long)(p))
#define RING_FENCE asm volatile("" ::: "memory")
struct Ctx {
    const unsigned long long* tbl; float* out; unsigned char* ws;
    int wave, vcu, G, bid; unsigned z0;
    __device__ __forceinline__ int lane() const { return (int)__builtin_amdgcn_mbcnt_hi(~0u, __builtin_amdgcn_mbcnt_lo(~0u, z0)); }
    __device__ __forceinline__ int tid() const { return wave * 64 + lane(); }
    __device__ __forceinline__ float zf() const { return __uint_as_float(z0); }
    __device__ __forceinline__ const float* in(int i) const {
        const unsigned long long v = tbl[i];
        const unsigned lo = __builtin_amdgcn_readfirstlane((unsigned)v), hi = __builtin_amdgcn_readfirstlane((unsigned)(v >> 32));
        return (const float*)(const GAS float*)(((unsigned long long)hi << 32) | lo);
    }
    __device__ __forceinline__ bf16* wset(int l, size_t off) const { return (bf16*)(ws + ((l & 1) ? WS_WSET1 : WS_WSET0) + off); }
};

__device__ __forceinline__ void transpose_item(const float* W, int ldw, int K, int src_col0, bf16* WT, int dst_row0, const float* g, int kb, float* scr, int lane) {
    const int k0 = 64 * kb;
    float wv[32];
#pragma unroll
    for (int i = 0; i < 32; ++i) wv[i] = W[(size_t)(k0 + 2 * i + (lane >> 5)) * ldw + src_col0 + (lane & 31)];
#pragma unroll
    for (int i = 0; i < 32; ++i) { const int kk = 2 * i + (lane >> 5); float v = wv[i]; if (g) v *= g[k0 + kk]; scr[kk * 33 + (lane & 31)] = v; }
    asm volatile("s_waitcnt lgkmcnt(0)" ::: "memory");
    const int c = lane & 7;
#pragma unroll
    for (int j = 0; j < 4; ++j) { const int n = (lane >> 3) + 8 * j; const float* s = scr + (8 * c) * 33 + n;
        u32x4 o; o.x = pk2(s[0 * 33], s[1 * 33]); o.y = pk2(s[2 * 33], s[3 * 33]); o.z = pk2(s[4 * 33], s[5 * 33]); o.w = pk2(s[6 * 33], s[7 * 33]);
        *(u32x4*)(WT + (size_t)(dst_row0 + n) * K + k0 + 8 * c) = o; }
    asm volatile("s_waitcnt lgkmcnt(0)" ::: "memory");
}
__device__ __forceinline__ void convert_layer(const Ctx& C, int l, float* sm, int first_blk, int nblk) {
    float* scr = sm + C.wave * (64 * 33 + 16);
    const int gw = (C.bid - first_blk) * NWAVES + C.wave, NGW = nblk * NWAVES;
    const bool even = (l & 1) == 0; const int li = l >> 1;
    const float* Win = even ? C.in(6) + (size_t)li * DM * EV_COLS : C.in(26) + (size_t)li * DM * OD_COLS;
    const float* Wout = even ? C.in(7) + (size_t)li * DM * DM : C.in(27) + (size_t)li * DM * DM;
    const float* Wup = C.in(3) + (size_t)l * DM * DFF; const float* Wdn = C.in(4) + (size_t)l * DFF * DM;
    const float* gmix = C.in(1) + (size_t)l * DM; const float* gmlp = C.in(2) + (size_t)l * DM;
    bf16* Tin = C.wset(l, WOFF_IN); bf16* Tout = C.wset(l, WOFF_OUT); bf16* Tup = C.wset(l, WOFF_UP); bf16* Tdn = C.wset(l, WOFF_DOWN);
    const int ldin = even ? EV_COLS : OD_COLS;
    const int nb_in = even ? EV_COLS / 32 : 3584 / 32;
    const int I_IN = 16 * nb_in, I_OUT = 16 * 32, I_UP = 16 * 128, I_DN = 64 * 32;
    const int I_G2 = even ? 32 : 0;
    const int NIT = I_IN + I_OUT + I_UP + I_DN + I_G2;
    for (int it = gw; it < NIT; it += NGW) {
        int r = it;
        if (r < I_IN) { const int kb = r / nb_in, nb = r % nb_in; const int dst = 32 * nb; int src = dst; if (!even && dst >= 2048) src = dst + 8;
            transpose_item(Win, ldin, DM, src, Tin, dst, gmix, kb, scr, C.lane()); continue; } r -= I_IN;
        if (r < I_OUT) { transpose_item(Wout, DM, DM, 32 * (r % 32), Tout, 32 * (r % 32), nullptr, r / 32, scr, C.lane()); continue; } r -= I_OUT;
        if (r < I_UP) { transpose_item(Wup, DFF, DM, 32 * (r % 128), Tup, 32 * (r % 128), gmlp, r / 128, scr, C.lane()); continue; } r -= I_UP;
        if (r < I_DN) { transpose_item(Wdn, DM, DFF, 32 * (r % 32), Tdn, 32 * (r % 32), nullptr, r / 32, scr, C.lane()); continue; } r -= I_DN;
        transpose_item(C.in(20) + (size_t)li * 128 * 512, 512, 128, 32 * (r % 16), C.wset(l, WOFF_G2), 32 * (r % 16), nullptr, r / 16, scr, C.lane());
    }
    if (!even) {
        const int gt = (C.bid - first_blk) * NTHREADS + C.tid(), NGT = nblk * NTHREADS;
        for (int i = gt; i < 16 * DM; i += NGT) { const int n = i >> 10, k = i & 1023; const int src = n < 8 ? 2048 + n : 3592 + (n - 8);
            Tin[(size_t)(3584 + n) * DM + k] = (bf16)f2bf(Win[(size_t)k * OD_COLS + src] * gmix[k]); }
        u32x4* z = (u32x4*)(Tin + (size_t)3600 * DM); const int nz = 240 * DM / 8;
        for (int i = gt; i < nz; i += NGT) z[i] = (u32x4){C.z0, C.z0, C.z0, C.z0};
    }
}

__device__ __forceinline__ void prologue_rows(const Ctx& C) {
    const int gw = C.vcu * NWAVES + C.wave, NGW = C.G * NWAVES;
    const float* x = C.in(0); bf16* XB = (bf16*)C.out; float* slots = GPTR(float, C.ws + WS_SLOTS);
    for (int m = gw; m < M; m += NGW) {
        const f32x4* xr = (const f32x4*)(x + (size_t)m * DM) + C.lane();
        u32x2* brow = (u32x2*)(XB + (size_t)m * DM) + C.lane(); float s = 0.f;
#pragma unroll
        for (int j = 0; j < 4; ++j) { const f32x4 v = xr[64 * j]; u32x2 w; w.x = pk2(v[0], v[1]); w.y = pk2(v[2], v[3]); brow[64 * j] = w;
            const float r0 = __uint_as_float(w.x << 16), r1 = __uint_as_float(w.x & 0xffff0000u), r2 = __uint_as_float(w.y << 16), r3 = __uint_as_float(w.y & 0xffff0000u); s += (r0 * r0 + r1 * r1) + (r2 * r2 + r3 * r3); }
        s = wave_sum(s);
        if (C.lane() < 16) slots[(size_t)m * 16 + C.lane()] = (C.lane() == 0) ? s : 0.f;
    }
}
__device__ __forceinline__ void final_rows(const Ctx& C) {
    const int gw = C.vcu * NWAVES + C.wave, NGW = C.G * NWAVES;
    const float* slots = GPTR(const float, C.ws + WS_SLOTS); const f32x4* g = (const f32x4*)C.in(5) + C.lane();
    for (int m = gw; m < M; m += NGW) {
        const float rs = pg8::row_rstd(slots, m);
        f32x4* orow = (f32x4*)(C.out + (size_t)m * DM) + C.lane(); const u32x2* brow = (const u32x2*)(GPTR(const bf16, C.ws + WS_XB) + (size_t)m * DM) + C.lane();
#pragma unroll
        for (int j = 0; j < 4; ++j) { const u32x2 w = brow[64 * j]; f32x4 v; v[0] = __uint_as_float(w.x << 16); v[1] = __uint_as_float(w.x & 0xffff0000u); v[2] = __uint_as_float(w.y << 16); v[3] = __uint_as_float(w.y & 0xffff0000u);
            v = v * rs * g[64 * j]; orow[64 * j] = v; }
    }
}

__device__ __forceinline__ void lru_block(const Ctx& C, int e, int lb, float* sm) {
    const int tid = C.tid(), lane = C.lane(), wave = C.wave;
    const int b = lb >> 3, n = lb & 7;
    const bf16* P = GPTR(const bf16, C.ws + WS_R1); bf16* Y = GPTR(bf16, C.ws + WS_Y);
    const float* convw = C.in(8) + (size_t)e * 4 * 512; const float* convb = C.in(9) + (size_t)e * 512;
    const float* wa = C.in(10) + ((size_t)e * 8 + n) * 4096; const float* ba = C.in(11) + (size_t)e * 512;
    const float* wx = C.in(12) + ((size_t)e * 8 + n) * 4096; const float* bx = C.in(13) + (size_t)e * 512;
    const float* lam = C.in(14) + (size_t)e * 512;
    float* sWA = sm; float* sWX = sWA + 4096; float* sXC = sWX + 4096; float* sA = sXC + 4096; float* sU = sA + 4096; float* sH = sU + 4096;
    for (int i = tid; i < 4096; i += NTHREADS) { sWA[i] = wa[i]; sWX[i] = wx[i]; }
    float hc = 0.f;
    const int ct = tid >> 3, l8 = tid & 7;
    float cw[4][8], cb[8];
#pragma unroll
    for (int j = 0; j < 8; ++j) { const int c = n * 64 + 8 * l8 + j; cb[j] = convb[c];
#pragma unroll
        for (int k = 0; k < 4; ++k) cw[k][j] = convw[k * 512 + c]; }
    const int ce = n * 64 + lane;
    const float g_ba = ba[ce], g_bx = bx[ce], g_sp = softplusf(-lam[ce]);
    __syncthreads();
    for (int ch = 0; ch < SEQ / 64; ++ch) {
        const int t0 = ch * 64; const size_t m0 = (size_t)b * SEQ + t0;
        {
            float acc[8];
#pragma unroll
            for (int j = 0; j < 8; ++j) acc[j] = cb[j];
#pragma unroll
            for (int k = 0; k < 4; ++k) { const int t = t0 + ct - 3 + k;
                if (t >= 0) { float v[8]; ld8(P + ((size_t)b * SEQ + t) * EV_COLS + 512 + n * 64 + 8 * l8, v);
#pragma unroll
                    for (int j = 0; j < 8; ++j) acc[j] += cw[k][j] * v[j]; } }
            *(f32x4*)(sXC + ct * 64 + 8 * l8) = (f32x4){acc[0], acc[1], acc[2], acc[3]};
            *(f32x4*)(sXC + ct * 64 + 8 * l8 + 4) = (f32x4){acc[4], acc[5], acc[6], acc[7]};
        }
        __syncthreads();
        {
            float ar[8], ai[8];
#pragma unroll
            for (int q = 0; q < 8; ++q) { ar[q] = 0.f; ai[q] = 0.f; }
#pragma unroll 1
            for (int d = 0; d < 64; d += 4) {
                float war[4], wxr[4];
#pragma unroll
                for (int dd = 0; dd < 4; ++dd) { war[dd] = sWA[(d + dd) * 64 + lane]; wxr[dd] = sWX[(d + dd) * 64 + lane]; }
#pragma unroll
                for (int q = 0; q < 8; ++q) { const f32x4 xv = *(const f32x4*)(sXC + (wave * 8 + q) * 64 + d);
#pragma unroll
                    for (int dd = 0; dd < 4; ++dd) { ar[q] += xv[dd] * war[dd]; ai[q] += xv[dd] * wxr[dd]; } }
            }
#pragma unroll
            for (int q = 0; q < 8; ++q) { const int t = wave * 8 + q;
                const float r = sigm(ar[q] + g_ba), ig = sigm(ai[q] + g_bx);
                const float log_a = -8.0f * r * g_sp; const float a = fexp(log_a);
                float mult = sqrtf(-expm1f(2.0f * log_a)); if (t0 + t == 0) mult = 1.0f;
                sA[t * 64 + lane] = a; sU[t * 64 + lane] = ig * sXC[t * 64 + lane] * mult; }
        }
        __syncthreads();
        if (wave == 0) {
#pragma unroll 8
            for (int t = 0; t < 64; ++t) { hc = sA[t * 64 + lane] * hc + sU[t * 64 + lane]; sH[t * 64 + lane] = hc; }
        }
        __syncthreads();
        {
            float gv[8]; ld8(P + (m0 + ct) * EV_COLS + n * 64 + 8 * l8, gv);
            const f32x4 h0 = *(const f32x4*)(sH + ct * 64 + 8 * l8), h1 = *(const f32x4*)(sH + ct * 64 + 8 * l8 + 4);
            u32x4 w; w.x = pk2(h0[0] * gelu_tanh(gv[0]), h0[1] * gelu_tanh(gv[1])); w.y = pk2(h0[2] * gelu_tanh(gv[2]), h0[3] * gelu_tanh(gv[3]));
            w.z = pk2(h1[0] * gelu_tanh(gv[4]), h1[1] * gelu_tanh(gv[5])); w.w = pk2(h1[2] * gelu_tanh(gv[6]), h1[3] * gelu_tanh(gv[7]));
            *(u32x4*)(Y + (m0 + ct) * DM + n * 64 + 8 * l8) = w;
        }
    }
}

constexpr int RW_TC = 32;
__device__ __forceinline__ void rwkv_block(const Ctx& C, int e, int rb, float* sm) {
    const int tid = C.tid(), lane = C.lane(), wave = C.wave;
    const int bh = rb >> 1, half = rb & 1, b = bh >> 3, h = bh & 7;
    const bf16* P = GPTR(const bf16, C.ws + WS_R1); float* yraw = GPTR(float, C.ws + WS_XB); float* bonus = GPTR(float, C.ws + WS_BONUS);
    const float* mu = C.in(15) + (size_t)e * 1792; const float* w0 = C.in(16) + (size_t)e * 512; const float* w2 = C.in(17) + (size_t)e * 64 * 512;
    const float* a0 = C.in(18) + (size_t)e * 512; const float* a2 = C.in(19) + (size_t)e * 64 * 512;
    const float* kkp = C.in(21) + (size_t)e * 512; const float* kap = C.in(22) + (size_t)e * 512; const float* rkp = C.in(23) + (size_t)e * 512;
    float* sW2 = sm; float* sA2 = sW2 + 4096; float* sXW = sA2 + 4096; float* sXA = sXW + 2048;
    float* cW = sXA + 2048; float* cKK = cW + 2048; float* cB = cKK + 2048; float* cK = cB + 2048; float* cR = cK + 2048;
    float* cV = cR + 2048; float* sY = cV + 1024;
    for (int i = tid; i < 4096; i += NTHREADS) { const int j = i >> 6, c = i & 63; sW2[i] = w2[(size_t)j * 512 + h * 64 + c]; sA2[i] = a2[(size_t)j * 512 + h * 64 + c]; }
    const int tt = tid >> 4, l16 = tid & 15;
    float mur[4], muk[4], muv[4], muw[4], mua[4];
#pragma unroll
    for (int j = 0; j < 4; ++j) { const int c = 4 * l16 + j; mur[j] = mu[h * 64 + c]; muk[j] = mu[512 + h * 64 + c]; muv[j] = mu[1024 + h * 64 + c]; muw[j] = mu[1536 + c]; mua[j] = mu[1600 + c]; }
    const int hc = h * 64 + lane;
    const float p_w0 = w0[hc], p_a0 = a0[hc], p_kk = kkp[hc], p_ka = kap[hc], p_rk = rkp[hc];
    float S[4] = {0.f, 0.f, 0.f, 0.f};
    __syncthreads();
    for (int ch = 0; ch < SEQ / RW_TC; ++ch) {
        const int t0 = ch * RW_TC; const size_t m0 = (size_t)b * SEQ + t0;
        {
            const bf16* row = P + (m0 + tt) * EV_COLS; const bool hp = (t0 + tt) > 0; const bf16* prow = row - EV_COLS;
            float c4[4], p4[4], o[4];
#define SHIFT4(col, muv_) do { ld4(row + (col), c4); if (hp) ld4(prow + (col), p4); else { p4[0] = p4[1] = p4[2] = p4[3] = 0.f; } \
            _Pragma("unroll") for (int j = 0; j < 4; ++j) o[j] = c4[j] + muv_[j] * (p4[j] - c4[j]); } while (0)
            SHIFT4(EC_R + h * 64 + 4 * l16, mur); *(f32x4*)(cR + tt * 64 + 4 * l16) = (f32x4){o[0], o[1], o[2], o[3]};
            SHIFT4(EC_K + h * 64 + 4 * l16, muk); *(f32x4*)(cK + tt * 64 + 4 * l16) = (f32x4){o[0], o[1], o[2], o[3]};
            SHIFT4(EC_V + h * 64 + 4 * l16, muv); if ((l16 >> 3) == half) *(f32x4*)(cV + tt * 32 + 4 * (l16 & 7)) = (f32x4){o[0], o[1], o[2], o[3]};
            SHIFT4(EC_XW + 4 * l16, muw); *(f32x4*)(sXW + tt * 64 + 4 * l16) = (f32x4){ftanh(o[0]), ftanh(o[1]), ftanh(o[2]), ftanh(o[3])};
            SHIFT4(EC_XA + 4 * l16, mua); *(f32x4*)(sXA + tt * 64 + 4 * l16) = (f32x4){o[0], o[1], o[2], o[3]};
#undef SHIFT4
        }
        __syncthreads();
        {
            float zw[4] = {0.f, 0.f, 0.f, 0.f}, za[4] = {0.f, 0.f, 0.f, 0.f};
#pragma unroll 1
            for (int j = 0; j < 64; j += 4) {
                float w2v[4], a2v[4];
#pragma unroll
                for (int jj = 0; jj < 4; ++jj) { w2v[jj] = sW2[(j + jj) * 64 + lane]; a2v[jj] = sA2[(j + jj) * 64 + lane]; }
#pragma unroll
                for (int q = 0; q < 4; ++q) { const f32x4 xw = *(const f32x4*)(sXW + (wave * 4 + q) * 64 + j), xa = *(const f32x4*)(sXA + (wave * 4 + q) * 64 + j);
#pragma unroll
                    for (int jj = 0; jj < 4; ++jj) { zw[q] += xw[jj] * w2v[jj]; za[q] += xa[jj] * a2v[jj]; } }
            }
#pragma unroll
            for (int q = 0; q < 4; ++q) { const int t = wave * 4 + q;
                const float wlog = -softplusf(-(p_w0 + zw[q])) - 0.5f; const float dec = fexp(-fexp(wlog));
                const float a = sigm(p_a0 + za[q]);
                const float kraw = cK[t * 64 + lane], r = cR[t * 64 + lane];
                const float kkv = kraw * p_kk; const float ss = wave_sum(kkv * kkv); const float kkn = kkv * (frsq(ss + 1e-6f));
                const float kp = kraw * (1.0f + (a - 1.0f) * p_ka);
                const float bon = wave_sum(r * kp * p_rk);
                if (half == 0 && lane == 0) bonus[(m0 + t) * 8 + h] = bon;
                cW[t * 64 + lane] = dec; cKK[t * 64 + lane] = kkn; cB[t * 64 + lane] = kkn * a; cK[t * 64 + lane] = kp; }
        }
        __syncthreads();
        {
            const int row = tid >> 4;
#pragma unroll 4
            for (int t = 0; t < RW_TC; ++t) {
                const f32x4 w4 = *(const f32x4*)(cW + t * 64 + 4 * l16), kk4 = *(const f32x4*)(cKK + t * 64 + 4 * l16), b4 = *(const f32x4*)(cB + t * 64 + 4 * l16);
                const f32x4 k4 = *(const f32x4*)(cK + t * 64 + 4 * l16), r4 = *(const f32x4*)(cR + t * 64 + 4 * l16);
                const float v = cV[t * 32 + row];
                float sk = (S[0] * kk4[0] + S[1] * kk4[1]) + (S[2] * kk4[2] + S[3] * kk4[3]);
                sk = row_sum16(sk);
#pragma unroll
                for (int j = 0; j < 4; ++j) S[j] = (S[j] * w4[j] + v * k4[j]) - sk * b4[j];
                float y = (S[0] * r4[0] + S[1] * r4[1]) + (S[2] * r4[2] + S[3] * r4[3]);
                y = row_sum16(y);
                if (l16 == 0) sY[t * 32 + row] = y;
            }
        }
        __syncthreads();
#pragma unroll
        for (int i = 0; i < 2; ++i) { const int idx = tid + i * NTHREADS, t = idx >> 5, rr = idx & 31; yraw[(m0 + t) * 512 + h * 64 + 32 * half + rr] = sY[idx]; }
    }
}

__device__ __forceinline__ void rwkv_post_tile(const Ctx& C, int e, int tile, float* sm) {
    const int tid = C.tid(), lane = C.lane(), wave = C.wave;
    const bf16* P = GPTR(const bf16, C.ws + WS_R1); const float* yraw = GPTR(const float, C.ws + WS_XB); const float* bonus = GPTR(const float, C.ws + WS_BONUS); bf16* Y = GPTR(bf16, C.ws + WS_Y);
    const float* mu = C.in(15) + (size_t)e * 1792; const float* g2 = C.in(20) + (size_t)e * 128 * 512;
    const float* lnw = C.in(24) + (size_t)e * 512; const float* lnb = C.in(25) + (size_t)e * 512;
    const size_t m0 = (size_t)tile * 64; const int t0 = (int)(m0 % SEQ);
    float* sG = sm;
    __syncthreads();
    for (int i = 0; i < 16; ++i) { const int idx = tid + i * NTHREADS, t = idx >> 7, j = idx & 127;
        const float p = bf2f(P[(m0 + t) * EV_COLS + EC_XG + j]); const float pp = (t0 + t) > 0 ? bf2f(P[(m0 + t - 1) * EV_COLS + EC_XG + j]) : 0.f;
        sG[idx] = sigm(p + mu[1664 + j] * (pp - p)); }
    __syncthreads();
    const int c = tid;
    float acc[64];
#pragma unroll
    for (int t = 0; t < 64; ++t) acc[t] = 0.f;
#pragma unroll 1
    for (int j = 0; j < 128; j += 4) {
        const float g0 = g2[(size_t)(j + 0) * 512 + c], g1 = g2[(size_t)(j + 1) * 512 + c], g2v = g2[(size_t)(j + 2) * 512 + c], g3 = g2[(size_t)(j + 3) * 512 + c];
#pragma unroll
        for (int t = 0; t < 64; ++t) { const f32x4 s = *(const f32x4*)(sG + t * 128 + j); acc[t] += (s[0] * g0 + s[1] * g1) + (s[2] * g2v + s[3] * g3); }
    }
    __syncthreads();
#pragma unroll
    for (int t = 0; t < 64; ++t) sm[t * 512 + c] = acc[t];
    const float p_lnw = lnw[c], p_lnb = lnb[c], p_muv = mu[1024 + c];
#pragma unroll 2
    for (int t = 0; t < 64; ++t) { const size_t m = m0 + t;
        const float y = yraw[m * 512 + c]; const float mean = wave_sum(y) * (1.0f / 64.0f); const float d = y - mean; const float var = wave_sum(d * d) * (1.0f / 64.0f);
        const float yn = d * (frsq(var + 64e-5f)) * p_lnw + p_lnb;
        const float pv = bf2f(P[m * EV_COLS + EC_V + c]); const float pvp = (t0 + t) > 0 ? bf2f(P[(m - 1) * EV_COLS + EC_V + c]) : 0.f; const float vs = pv + p_muv * (pvp - pv);
        Y[m * DM + 512 + c] = (bf16)f2bf((yn + bonus[m * 8 + wave] * vs) * sm[t * 512 + c]); }
}

constexpr int OD_TC = 32;
__device__ __forceinline__ void gdn_block(const Ctx& C, int o, int gb, float* sm) {
    const int tid = C.tid();
    const int bh = gb >> 2, cgp = gb & 3, b = bh >> 2, h = bh & 3;
    const bf16* P = GPTR(const bf16, C.ws + WS_R1); bf16* oraw = GPTR(bf16, C.ws + WS_Y);
    const float* convw = C.in(28) + (size_t)o * 4 * 1536;
    const float nA = -fexp(C.in(29)[o * 4 + h]); const float dtb = C.in(30)[o * 4 + h];
    float* cQ = sm; float* cK = cQ + 4096; float* cV = cK + 4096; float* cAl = cV + 1024; float* cBe = cAl + 32; float* cQK = cBe + 32; float* sO = cQK + 32;
    const int tt = tid >> 4, l16 = tid & 15;
    const int qc = h * 128 + 8 * l16, kc = 512 + h * 128 + 8 * l16, vc = 1024 + h * 128 + 32 * cgp + 2 * l16;
    float wq[4][8], wk[4][8], wv[4][2];
#pragma unroll
    for (int k = 0; k < 4; ++k) {
#pragma unroll
        for (int j = 0; j < 8; ++j) { wq[k][j] = convw[k * 1536 + qc + j]; wk[k][j] = convw[k * 1536 + kc + j]; }
        wv[k][0] = convw[k * 1536 + vc]; wv[k][1] = convw[k * 1536 + vc + 1]; }
    float S[8];
#pragma unroll
    for (int j = 0; j < 8; ++j) S[j] = 0.f;
    for (int ch = 0; ch < SEQ / OD_TC; ++ch) {
        const int t0 = ch * OD_TC; const size_t m0 = (size_t)b * SEQ + t0;
        __syncthreads();
        {
            float q[8], kx[8], v2[2] = {0.f, 0.f};
#pragma unroll
            for (int j = 0; j < 8; ++j) { q[j] = 0.f; kx[j] = 0.f; }
#pragma unroll
            for (int k = 0; k < 4; ++k) { const int t = t0 + tt - 3 + k;
                if (t >= 0) { const bf16* row = P + ((size_t)b * SEQ + t) * OD_PAD; float a8[8], b8[8], c2[2]; ld8(row + qc, a8); ld8(row + kc, b8); ld2(row + vc, c2);
#pragma unroll
                    for (int j = 0; j < 8; ++j) { q[j] += wq[k][j] * a8[j]; kx[j] += wk[k][j] * b8[j]; }
                    v2[0] += wv[k][0] * c2[0]; v2[1] += wv[k][1] * c2[1]; } }
            float sq = 0.f, sk = 0.f;
#pragma unroll
            for (int j = 0; j < 8; ++j) { q[j] = siluf(q[j]); kx[j] = siluf(kx[j]); sq += q[j] * q[j]; sk += kx[j] * kx[j]; }
            sq = row_sum16(sq); sk = row_sum16(sk);
            const float rq = (frsq(sq + 1e-6f)) * 0.08838834764831845f, rk = frsq(sk + 1e-6f);
            float qk = 0.f;
#pragma unroll
            for (int j = 0; j < 8; ++j) { q[j] *= rq; kx[j] *= rk; qk += q[j] * kx[j]; }
            qk = row_sum16(qk);
            *(f32x4*)(cQ + tt * 128 + 8 * l16) = (f32x4){q[0], q[1], q[2], q[3]}; *(f32x4*)(cQ + tt * 128 + 8 * l16 + 4) = (f32x4){q[4], q[5], q[6], q[7]};
            *(f32x4*)(cK + tt * 128 + 8 * l16) = (f32x4){kx[0], kx[1], kx[2], kx[3]}; *(f32x4*)(cK + tt * 128 + 8 * l16 + 4) = (f32x4){kx[4], kx[5], kx[6], kx[7]};
            cV[tt * 32 + 2 * l16] = siluf(v2[0]); cV[tt * 32 + 2 * l16 + 1] = siluf(v2[1]);
            if (l16 == 0) { const bf16* row = P + (m0 + tt) * OD_PAD; const float braw = bf2f(row[OC_GB + h]), araw = bf2f(row[OC_GA + h]);
                cBe[tt] = sigm(braw); cAl[tt] = fexp(nA * softplusf(araw + dtb)); cQK[tt] = qk; }
        }
        __syncthreads();
        {
            const int col = tid >> 4;
#pragma unroll 2
            for (int t = 0; t < OD_TC; ++t) {
                const f32x4 k0 = *(const f32x4*)(cK + t * 128 + 8 * l16), k1 = *(const f32x4*)(cK + t * 128 + 8 * l16 + 4);
                const f32x4 q0 = *(const f32x4*)(cQ + t * 128 + 8 * l16), q1 = *(const f32x4*)(cQ + t * 128 + 8 * l16 + 4);
                const float v = cV[t * 32 + col], al = cAl[t], be = cBe[t], qk = cQK[t];
                float kS = ((S[0] * k0[0] + S[1] * k0[1]) + (S[2] * k0[2] + S[3] * k0[3])) + ((S[4] * k1[0] + S[5] * k1[1]) + (S[6] * k1[2] + S[7] * k1[3]));
                float qS = ((S[0] * q0[0] + S[1] * q0[1]) + (S[2] * q0[2] + S[3] * q0[3])) + ((S[4] * q1[0] + S[5] * q1[1]) + (S[6] * q1[2] + S[7] * q1[3]));
                kS = row_sum16(kS); qS = row_sum16(qS);
                const float delta = be * (v - al * kS);
#pragma unroll
                for (int j = 0; j < 4; ++j) { S[j] = al * S[j] + k0[j] * delta; S[4 + j] = al * S[4 + j] + k1[j] * delta; }
                if (l16 == 0) sO[t * 32 + col] = al * qS + qk * delta;
            }
        }
        __syncthreads();
#pragma unroll
        for (int i = 0; i < 2; ++i) { const int idx = tid + i * NTHREADS, t = idx >> 5, cc = idx & 31; oraw[(m0 + t) * DM + h * 128 + 32 * cgp + cc] = (bf16)f2bf(sO[idx]); }
    }
}

__device__ __forceinline__ void mlstm_block(const Ctx& C, int o, int mb, float* sm) {
    const int tid = C.tid();
    const int bh = mb / 5, cgp = mb % 5, b = bh >> 2, h = bh & 3;
    const bf16* P = GPTR(const bf16, C.ws + WS_R1); float* nraw = GPTR(float, C.ws + WS_XB); float* den = GPTR(float, C.ws + WS_DEN);
    const float* convw = C.in(32) + (size_t)o * 4 * 512;
    const float igb = C.in(33)[o * 4 + h], fgb = C.in(34)[o * 4 + h];
    float* cQ = sm; float* cIK = cQ + 2048; float* cV = cIK + 2048; float* cF = cV + 1024; float* sO = cF + 32;
    const int tt = tid >> 4, l16 = tid & 15;
    const int qc = h * 64 + 4 * l16, kc = 256 + h * 64 + 4 * l16;
    float wq[4][4], wk[4][4];
#pragma unroll
    for (int k = 0; k < 4; ++k)
#pragma unroll
        for (int j = 0; j < 4; ++j) { wq[k][j] = convw[k * 512 + qc + j]; wk[k][j] = convw[k * 512 + kc + j]; }
    float Cs[4] = {0.f, 0.f, 0.f, 0.f};
    for (int ch = 0; ch < SEQ / OD_TC; ++ch) {
        const int t0 = ch * OD_TC; const size_t m0 = (size_t)b * SEQ + t0;
        __syncthreads();
        {
            float q[4] = {0.f, 0.f, 0.f, 0.f}, kx[4] = {0.f, 0.f, 0.f, 0.f};
#pragma unroll
            for (int k = 0; k < 4; ++k) { const int t = t0 + tt - 3 + k;
                if (t >= 0) { const bf16* row = P + ((size_t)b * SEQ + t) * OD_PAD + OC_MQK; float a4[4], b4[4]; ld4(row + qc, a4); ld4(row + kc, b4);
#pragma unroll
                    for (int j = 0; j < 4; ++j) { q[j] += wq[k][j] * a4[j]; kx[j] += wk[k][j] * b4[j]; } } }
            const bf16* row = P + (m0 + tt) * OD_PAD;
            const float ei = fexp(bf2f(row[OC_MI + h]) + igb);
            *(f32x4*)(cQ + tt * 64 + 4 * l16) = (f32x4){siluf(q[0]) * 0.125f, siluf(q[1]) * 0.125f, siluf(q[2]) * 0.125f, siluf(q[3]) * 0.125f};
            *(f32x4*)(cIK + tt * 64 + 4 * l16) = (f32x4){siluf(kx[0]) * ei, siluf(kx[1]) * ei, siluf(kx[2]) * ei, siluf(kx[3]) * ei};
            if (cgp < 4) { float c2[2]; ld2(row + OC_MV + h * 128 + 32 * cgp + 2 * l16, c2); cV[tt * 32 + 2 * l16] = c2[0]; cV[tt * 32 + 2 * l16 + 1] = c2[1]; }
            else { cV[tt * 32 + 2 * l16] = 1.0f; cV[tt * 32 + 2 * l16 + 1] = 1.0f; }
            if (l16 == 0) cF[tt] = sigm(bf2f(row[OC_MF + h]) + fgb);
        }
        __syncthreads();
        {
            const int col = tid >> 4;
#pragma unroll 4
            for (int t = 0; t < OD_TC; ++t) {
                const f32x4 ik = *(const f32x4*)(cIK + t * 64 + 4 * l16), q4 = *(const f32x4*)(cQ + t * 64 + 4 * l16);
                const float v = cV[t * 32 + col], f = cF[t];
#pragma unroll
                for (int j = 0; j < 4; ++j) Cs[j] = f * Cs[j] + v * ik[j];
                float nm = (Cs[0] * q4[0] + Cs[1] * q4[1]) + (Cs[2] * q4[2] + Cs[3] * q4[3]);
                nm = row_sum16(nm);
                if (l16 == 0) sO[t * 32 + col] = nm;
            }
        }
        __syncthreads();
        if (cgp < 4) {
#pragma unroll
            for (int i = 0; i < 2; ++i) { const int idx = tid + i * NTHREADS, t = idx >> 5, cc = idx & 31; nraw[(m0 + t) * 512 + h * 128 + 32 * cgp + cc] = sO[idx]; }
        } else if (tid < OD_TC) den[(m0 + tid) * 4 + h] = sO[tid * 32];
    }
}

__device__ __forceinline__ void odd_post(const Ctx& C, int o, bool rep = false) {
    const int gw = C.vcu * NWAVES + C.wave, NGW = C.G * NWAVES, lane = C.lane();
    const bf16* P = GPTR(const bf16, C.ws + WS_R1); const float* den = GPTR(const float, C.ws + WS_BONUS);
    bf16* Y = GPTR(bf16, C.ws + WS_Y); bf16* Yo = rep ? GPTR(bf16, C.ws + WS_XB) : Y;
    const float* gng = C.in(31) + (size_t)o * 128; const float* mng = C.in(35) + (size_t)o * 128;
    float gg[8], mg[8];
#pragma unroll
    for (int j = 0; j < 8; ++j) { gg[j] = gng[(8 * lane + j) & 127]; mg[j] = mng[(8 * lane + j) & 127]; }
    for (int m = gw; m < M; m += NGW) {
        float ov[8], nv[8], z8[8], og8[8];
        ld8(Y + (size_t)m * DM + 8 * lane, ov); ld8(Y + (size_t)m * DM + 512 + 8 * lane, nv);
        const float dn = den[(size_t)m * 4 + (lane >> 4)];
        ld8(P + (size_t)m * OD_PAD + OC_Z + 8 * lane, z8); ld8(P + (size_t)m * OD_PAD + OC_MOG + 8 * lane, og8);
        const float inv = 1.0f / fmaxf(fabsf(dn), 1.0f);
        float s1 = 0.f, s2 = 0.f;
#pragma unroll
        for (int j = 0; j < 8; ++j) { nv[j] *= inv; s1 += ov[j] * ov[j]; s2 += nv[j] * nv[j]; }
        s1 = row_sum16(s1); s2 = row_sum16(s2);
        const float r1 = frsq(s1 * (1.0f / 128.0f) + 1e-6f), r2 = frsq(s2 * (1.0f / 128.0f) + 1e-6f);
        float y1[8], y2[8];
#pragma unroll
        for (int j = 0; j < 8; ++j) { y1[j] = ov[j] * r1 * gg[j] * siluf(z8[j]); y2[j] = nv[j] * r2 * mg[j] * sigm(og8[j]); }
        u32x4 w1, w2; w1.x = pk2(y1[0], y1[1]); w1.y = pk2(y1[2], y1[3]); w1.z = pk2(y1[4], y1[5]); w1.w = pk2(y1[6], y1[7]);
        w2.x = pk2(y2[0], y2[1]); w2.y = pk2(y2[2], y2[3]); w2.z = pk2(y2[4], y2[5]); w2.w = pk2(y2[6], y2[7]);
        *(u32x4*)(Yo + (size_t)m * DM + 8 * lane) = w1; *(u32x4*)(Yo + (size_t)m * DM + 512 + 8 * lane) = w2;
    }
}

typedef short bf16x8 __attribute__((ext_vector_type(8)));
typedef short bf16x4 __attribute__((ext_vector_type(4)));
typedef float f32x16 __attribute__((ext_vector_type(16)));
__device__ __forceinline__ f32x16 mfma32(bf16x8 a, bf16x8 b, f32x16 c) { return __builtin_amdgcn_mfma_f32_32x32x16_bf16(a, b, c, 0, 0, 0); }
__device__ __forceinline__ bf16x8 ldfrag(const bf16* p) { return *(const bf16x8*)p; }
__device__ __forceinline__ int drow(int g, int hh) { return (g & 3) + 8 * (g >> 2) + 4 * hh; }
__device__ __forceinline__ float logsigm(float x) { return -softplusf(-x); }
constexpr int LD64 = 72, LD128 = 136;

__device__ __forceinline__ void mlstm_chunk_block(const Ctx& C, int o, int mb, unsigned char* lds) {
    const int tid = C.tid(), lane = C.lane(), w = C.wave, r = lane & 31, hh = lane >> 5;
    const int b = mb >> 2, h = mb & 3;
    const bf16* P = GPTR(const bf16, C.ws + WS_R1); bf16* Y = GPTR(bf16, C.ws + WS_Y); float* den = GPTR(float, C.ws + WS_DEN);
    const float* convw = C.in(32) + (size_t)o * 4 * 512;
    const float igb = C.in(33)[o * 4 + h], fgb = C.in(34)[o * 4 + h];
    bf16* Qh = (bf16*)lds; bf16* Kh = Qh + 64 * LD64; bf16* QD = Kh + 64 * LD64; bf16* KTT = QD + 64 * LD64; bf16* Wm = KTT + 64 * LD64;
    bf16* VT = Wm + 64 * LD64; bf16* CT0 = VT + 160 * LD64; bf16* CT1 = CT0 + 160 * LD64;
    float* sB = (float*)(CT1 + 160 * LD64); float* sI = sB + 64;
    for (int i = tid; i < 2 * 160 * LD64 / 2; i += NTHREADS) ((unsigned*)CT0)[i] = 0u;
    for (int i = tid; i < 32 * LD64; i += NTHREADS) VT[128 * LD64 + i] = (i < 64) ? (bf16)0x3F80 : (bf16)0;
    const int l16 = tid & 15, typ = (tid >> 4) & 1, tg = tid >> 5;
    const int pc = OC_MQK + (typ ? 256 : 0) + h * 64 + 4 * l16;
    float cw[4][4];
#pragma unroll
    for (int k = 0; k < 4; ++k)
#pragma unroll
        for (int j = 0; j < 4; ++j) cw[k][j] = convw[k * 512 + (typ ? 256 : 0) + h * 64 + 4 * l16 + j];
    const int th = w >> 2, vj = w & 3; const bool two = (vj == 0);
    f32x16 Ca, Cb;
#pragma unroll
    for (int g = 0; g < 16; ++g) { Ca[g] = C.zf(); Cb[g] = C.zf(); }
    int cur = 0;
    u32x2 px[7]; u32x4 pva, pvb; unsigned pgi = 0, pgf = 0;
    const int vt = tid & 63, vg = tid >> 6;
#define ML_PF(ch_) do { _Pragma("unroll") for (int i = 0; i < 7; ++i) { const int t_ = 64 * (ch_) + 4 * tg - 3 + i; \
            if (t_ >= 0) px[i] = *(const u32x2*)(P + ((size_t)b * SEQ + t_) * OD_PAD + pc); else px[i] = (u32x2){C.z0, C.z0}; } \
        { const bf16* vr_ = P + ((size_t)b * SEQ + 64 * (ch_) + vt) * OD_PAD; pva = *(const u32x4*)(vr_ + OC_MV + h * 128 + 16 * vg); pvb = *(const u32x4*)(vr_ + OC_MV + h * 128 + 16 * vg + 8); pgi = vr_[OC_MI + h]; pgf = vr_[OC_MF + h]; } } while (0)
    ML_PF(0);
    __syncthreads();
    for (int ch = 0; ch < SEQ / 64; ++ch) {
        const int t0 = ch * 64; const size_t m0 = (size_t)b * SEQ + t0;
        {
            float x[7][4];
#pragma unroll
            for (int i = 0; i < 7; ++i) { x[i][0] = bf2f(px[i].x & 0xffffu); x[i][1] = bf2f(px[i].x >> 16); x[i][2] = bf2f(px[i].y & 0xffffu); x[i][3] = bf2f(px[i].y >> 16); }
#pragma unroll
            for (int tt = 0; tt < 4; ++tt) { float o4[4];
#pragma unroll
                for (int j = 0; j < 4; ++j) { float a = 0.f;
#pragma unroll
                    for (int k = 0; k < 4; ++k) a += cw[k][j] * x[tt + k][j];
                    a = siluf(a); o4[j] = typ ? a : a * 0.125f; }
                u32x2 pk; pk.x = pk2(o4[0], o4[1]); pk.y = pk2(o4[2], o4[3]);
                *(u32x2*)((typ ? Kh : Qh) + (4 * tg + tt) * LD64 + 4 * l16) = pk; }
            {   const int t = vt; const unsigned wv[8] = {pva.x, pva.y, pva.z, pva.w, pvb.x, pvb.y, pvb.z, pvb.w};
#pragma unroll
                for (int q = 0; q < 8; ++q) { VT[(16 * vg + 2 * q) * LD64 + t] = (bf16)(wv[q] & 0xffffu); VT[(16 * vg + 2 * q + 1) * LD64 + t] = (bf16)(wv[q] >> 16); } }
            if (tid < 64) { const float ip = bf2f(pgi) + igb; float lf = logsigm(bf2f(pgf) + fgb);
#pragma unroll
                for (int d = 1; d < 64; d <<= 1) { const float up = __shfl_up(lf, d); if (lane >= d) lf += up; }
                sB[tid] = lf; sI[tid] = ip; }
            if (ch + 1 < SEQ / 64) ML_PF(ch + 1);
        }
        lds_barrier();
        if (w < 4) {
            const int ti = w >> 1, tj = w & 1;
            f32x16 acc;
#pragma unroll
            for (int g = 0; g < 16; ++g) acc[g] = C.zf();
            if (tj <= ti) {
#pragma unroll
                for (int s = 0; s < 4; ++s) acc = mfma32(ldfrag(Kh + (32 * tj + r) * LD64 + 16 * s + 8 * hh), ldfrag(Qh + (32 * ti + r) * LD64 + 16 * s + 8 * hh), acc);
            }
            const int i = 32 * ti + r; const float bi = sB[i];
#pragma unroll
            for (int g4 = 0; g4 < 4; ++g4) { float v4[4];
#pragma unroll
                for (int q = 0; q < 4; ++q) { const int j = 32 * tj + 8 * g4 + 4 * hh + q; v4[q] = (j <= i) ? acc[4 * g4 + q] * fexp(bi - sB[j] + sI[j]) : 0.f; }
                u32x2 pk; pk.x = pk2(v4[0], v4[1]); pk.y = pk2(v4[2], v4[3]);
                *(u32x2*)(Wm + i * LD64 + 32 * tj + 8 * g4 + 4 * hh) = pk; }
        } else {
            const int lt = tid - 256;
            {   const int t = lt >> 2, kq = lt & 3; const float eb = fexp(sB[t]);
#pragma unroll
                for (int q = 0; q < 2; ++q) { float v8[8]; ld8(Qh + t * LD64 + 16 * kq + 8 * q, v8);
                    u32x4 pk; pk.x = pk2(v8[0] * eb, v8[1] * eb); pk.y = pk2(v8[2] * eb, v8[3] * eb); pk.z = pk2(v8[4] * eb, v8[5] * eb); pk.w = pk2(v8[6] * eb, v8[7] * eb);
                    *(u32x4*)(QD + t * LD64 + 16 * kq + 8 * q) = pk; } }
            {   const int k = lt & 63, tq = lt >> 6; const float bl = sB[63];
                float v16[16];
#pragma unroll
                for (int q = 0; q < 16; ++q) { const int t = 16 * tq + q; v16[q] = bf2f(Kh[t * LD64 + k]) * fexp(bl - sB[t] + sI[t]); }
                u32x4 p0, p1; p0.x = pk2(v16[0], v16[1]); p0.y = pk2(v16[2], v16[3]); p0.z = pk2(v16[4], v16[5]); p0.w = pk2(v16[6], v16[7]);
                p1.x = pk2(v16[8], v16[9]); p1.y = pk2(v16[10], v16[11]); p1.z = pk2(v16[12], v16[13]); p1.w = pk2(v16[14], v16[15]);
                *(u32x4*)(KTT + k * LD64 + 16 * tq) = p0; *(u32x4*)(KTT + k * LD64 + 16 * tq + 8) = p1; }
        }
        lds_barrier();
        {
            const bf16* CTc = cur ? CT1 : CT0; bf16* CTn = cur ? CT0 : CT1;
            const float F = fexp(sB[63]);
#pragma unroll
            for (int q = 0; q < 2; ++q) {
                if (q == 1 && !two) break;
                const int vjj = q == 0 ? vj : 4;
                bf16x8 vf[4];
                f32x16 num;
#pragma unroll
                for (int g = 0; g < 16; ++g) num[g] = C.zf();
#pragma unroll
                for (int s = 0; s < 4; ++s) { vf[s] = ldfrag(VT + (32 * vjj + r) * LD64 + 16 * s + 8 * hh);
                    num = mfma32(ldfrag(QD + (32 * th + r) * LD64 + 16 * s + 8 * hh), ldfrag(CTc + (32 * vjj + r) * LD64 + 16 * s + 8 * hh), num); }
#pragma unroll
                for (int s = 0; s < 4; ++s) num = mfma32(ldfrag(Wm + (32 * th + r) * LD64 + 16 * s + 8 * hh), vf[s], num);
                if (vjj < 4) {
#pragma unroll
                    for (int g = 0; g < 16; ++g) Y[(m0 + 32 * th + drow(g, hh)) * DM + 512 + h * 128 + 32 * vjj + r] = (bf16)f2bf(num[g]);
                } else if (r == 0) {
#pragma unroll
                    for (int g = 0; g < 16; ++g) den[(m0 + 32 * th + drow(g, hh)) * 4 + h] = num[g];
                }
                f32x16 cacc = q == 0 ? Ca : Cb;
#pragma unroll
                for (int g = 0; g < 16; ++g) cacc[g] *= F;
#pragma unroll
                for (int s = 0; s < 4; ++s) cacc = mfma32(ldfrag(KTT + (32 * th + r) * LD64 + 16 * s + 8 * hh), vf[s], cacc);
                if (q == 0) Ca = cacc; else Cb = cacc;
#pragma unroll
                for (int g4 = 0; g4 < 4; ++g4) { u32x2 pk; pk.x = pk2(cacc[4 * g4], cacc[4 * g4 + 1]); pk.y = pk2(cacc[4 * g4 + 2], cacc[4 * g4 + 3]);
                    *(u32x2*)(CTn + (32 * vjj + r) * LD64 + 32 * th + 8 * g4 + 4 * hh) = pk; }
            }
        }
        cur ^= 1;
        lds_barrier();
    }
}
#undef ML_PF

constexpr size_t GDN_UNIT_BYTES = 32768;
__device__ __forceinline__ void gdn_pre(const Ctx& C, int o, unsigned char* lds) {
    const int tid = C.tid(), half = tid >> 8, lt = tid & 255, lw = lt >> 6, lane = C.lane(), r = lane & 31, hh = lane >> 5;
    const bf16* P = GPTR(const bf16, C.ws + WS_R1);
    const float* convw = C.in(28) + (size_t)o * 4 * 1536;
    unsigned char* base = lds + half * 53248;
    bf16* KhB = (bf16*)base; bf16* VhB = KhB + 64 * LD128; float* Amat = (float*)(VhB + 64 * LD128); float* sGC = Amat + 64 * 68; float* sBe = sGC + 64; float* sEg = sBe + 64;
    const int l16 = lt & 15, typ = (lt >> 4) & 1, tg = lt >> 5;
    for (int up = C.bid; up < 512; up += C.G) {
        const int unit = 2 * up + half, bh = unit >> 6, n = unit & 63, b = bh >> 2, h = bh & 3, t0 = n * 64;
        const size_t m0 = (size_t)b * SEQ + t0;
        {
            const int pc = (typ ? 1024 : 512) + h * 128 + 8 * l16;
            float cw[4][8];
#pragma unroll
            for (int k = 0; k < 4; ++k)
#pragma unroll
                for (int j = 0; j < 8; ++j) cw[k][j] = convw[k * 1536 + pc + j];
            float x[4][8];
#pragma unroll
            for (int i = 0; i < 3; ++i) { const int t = t0 + 8 * tg - 3 + i;
                if (t >= 0) ld8(P + ((size_t)b * SEQ + t) * OD_PAD + pc, x[i]); else {
#pragma unroll
                    for (int j = 0; j < 8; ++j) x[i][j] = 0.f; } }
#pragma unroll
            for (int tt = 0; tt < 8; ++tt) {
                ld8(P + (m0 + 8 * tg + tt) * OD_PAD + pc, x[(tt + 3) & 3]);
                float o8[8]; float ss = 0.f;
#pragma unroll
                for (int j = 0; j < 8; ++j) { float a = 0.f;
#pragma unroll
                    for (int k = 0; k < 4; ++k) a += cw[k][j] * x[(tt + k) & 3][j];
                    a = siluf(a); o8[j] = a; ss += a * a; }
                ss = row_sum16(ss);
                const float sc = typ ? 1.0f : frsq(ss + 1e-6f);
                u32x4 pk; pk.x = pk2(o8[0] * sc, o8[1] * sc); pk.y = pk2(o8[2] * sc, o8[3] * sc); pk.z = pk2(o8[4] * sc, o8[5] * sc); pk.w = pk2(o8[6] * sc, o8[7] * sc);
                *(u32x4*)((typ ? VhB : KhB) + (8 * tg + tt) * LD128 + 8 * l16) = pk;
            }
            if (lt < 64) { const bf16* row = P + (m0 + lt) * OD_PAD; const float be = sigm(bf2f(row[OC_GB + h]));
                float g = -fexp(C.in(29)[o * 4 + h]) * softplusf(bf2f(row[OC_GA + h]) + C.in(30)[o * 4 + h]);
#pragma unroll
                for (int d = 1; d < 64; d <<= 1) { const float upv = __shfl_up(g, d); if (lane >= d) g += upv; }
                sGC[lt] = g; sBe[lt] = be; sEg[lt] = be * fexp(g); }
        }
        __syncthreads();
        {
            const int ti = lw >> 1, tj = lw & 1;
            f32x16 acc;
#pragma unroll
            for (int g = 0; g < 16; ++g) acc[g] = C.zf();
            if (tj <= ti) {
#pragma unroll
                for (int s = 0; s < 8; ++s) acc = mfma32(ldfrag(KhB + (32 * ti + r) * LD128 + 16 * s + 8 * hh), ldfrag(KhB + (32 * tj + r) * LD128 + 16 * s + 8 * hh), acc);
            }
            const int j = 32 * tj + r; const float gj = sGC[j];
#pragma unroll
            for (int g = 0; g < 16; ++g) { const int i = 32 * ti + drow(g, hh);
                Amat[i * 68 + j] = (j < i) ? sBe[i] * acc[g] * fexp(sGC[i] - gj) : 0.f; }
        }
        __syncthreads();
        {
            const bool isw = lt < 128; const bf16* src = isw ? (KhB + lt) : (VhB + lt - 128);
            float X[64];
#pragma unroll
            for (int i = 0; i < 64; ++i) X[i] = 0.f;
#pragma unroll
            for (int i = 0; i < 64; ++i) {
                const float zz = C.zf(); float p[8] = {zz, zz, zz, zz, zz, zz, zz, zz};
#pragma unroll
                for (int j4 = 0; j4 < (i + 3) / 4; ++j4) { const f32x4 av = *(const f32x4*)(Amat + i * 68 + 4 * j4); const int o = (j4 & 1) * 4;
                    p[o] += av[0] * X[4 * j4]; p[o + 1] += av[1] * X[4 * j4 + 1]; p[o + 2] += av[2] * X[4 * j4 + 2]; p[o + 3] += av[3] * X[4 * j4 + 3]; }
                X[i] = (isw ? sEg[i] : sBe[i]) * bf2f(src[i * LD128]) - (((p[0] + p[1]) + (p[2] + p[3])) + ((p[4] + p[5]) + (p[6] + p[7])));
            }
            bf16* dst = isw ? (KhB + lt) : (VhB + lt - 128);
#pragma unroll
            for (int i = 0; i < 64; ++i) dst[i * LD128] = (bf16)f2bf(isw ? -X[i] : X[i]);
        }
        __syncthreads();
        {
            bf16* Wg = (bf16*)(C.ws + WS_XB + (size_t)unit * GDN_UNIT_BYTES); bf16* Ug = Wg + 64 * 128;
#pragma unroll
            for (int q = 0; q < 4; ++q) { const int p = lt + 256 * q, t = p >> 4, cp = (p & 15) * 8;
                *(u32x4*)(Wg + t * 128 + cp) = *(const u32x4*)(KhB + t * LD128 + cp); }
#pragma unroll
            for (int q = 0; q < 4; ++q) { const int p = lt + 256 * q, tile = p >> 7, ln = (p >> 1) & 63, q8 = p & 1;
                const int v = 32 * (tile & 3) + (ln & 31), hq = ln >> 5, thh = tile >> 2;
                unsigned e[8];
#pragma unroll
                for (int gg = 0; gg < 8; ++gg) e[gg] = VhB[(32 * thh + drow(8 * q8 + gg, hq)) * LD128 + v];
                u32x4 pk; pk.x = e[0] | (e[1] << 16); pk.y = e[2] | (e[3] << 16); pk.z = e[4] | (e[5] << 16); pk.w = e[6] | (e[7] << 16);
                *(u32x4*)(Ug + p * 8) = pk; }
        }
        __syncthreads();
    }
}

__device__ __forceinline__ void gdn_chunk_block(const Ctx& C, int o, int gb, unsigned char* lds) {
    const int tid = C.tid(), lane = C.lane(), w = C.wave, r = lane & 31, hh = lane >> 5;
    const int b = gb >> 2, h = gb & 3;
    const bf16* P = GPTR(const bf16, C.ws + WS_R1); bf16* Y = GPTR(bf16, C.ws + WS_Y);
    const float* convw = C.in(28) + (size_t)o * 4 * 1536;
    const float nA = -fexp(C.in(29)[o * 4 + h]); const float dtb = C.in(30)[o * 4 + h];
    bf16* Qh = (bf16*)lds; bf16* Kh = Qh + 64 * LD128; bf16* QD = Kh + 64 * LD128; bf16* KDT = QD + 64 * LD128; bf16* QKd = KDT + 128 * LD64; bf16* VNT = QKd + 64 * LD64; bf16* ST = VNT + 128 * LD64;
    float* sGC = (float*)(ST + 128 * LD128);
    for (int i = tid; i < 128 * LD128 / 2; i += NTHREADS) ((unsigned*)ST)[i] = 0u;
    const int l16 = tid & 15, typ = (tid >> 4) & 1, tg = tid >> 5;
    const int pc = (typ ? 512 : 0) + h * 128 + 8 * l16;
    float* sCW = sGC + 64;
    for (int i = tid; i < 1024; i += NTHREADS) { const int k = i >> 8, c = i & 255; sCW[i] = convw[k * 1536 + (c >> 7) * 512 + h * 128 + (c & 127)]; }
    const int th = w >> 2, vj = w & 3;
    f32x16 S0, S1;
#pragma unroll
    for (int g = 0; g < 16; ++g) { S0[g] = C.zf(); S1[g] = C.zf(); }
    u32x4 px[7]; unsigned ar_raw = 0; bf16x8 wf[8]; u32x4 u0, u1;
#define GDN_PF(ch_) do { _Pragma("unroll") for (int i = 0; i < 7; ++i) { const int t_ = 64 * (ch_) + 4 * tg - 3 + i; \
            if (t_ >= 0) px[i] = *(const u32x4*)(P + ((size_t)b * SEQ + t_) * OD_PAD + pc); else px[i] = (u32x4){C.z0, C.z0, C.z0, C.z0}; } \
        ar_raw = P[((size_t)b * SEQ + 64 * (ch_) + (tid & 63)) * OD_PAD + OC_GA + h]; } while (0)
#define GDN_WU(ch_) do { const bf16* Wg_ = (const bf16*)(C.ws + WS_XB + (size_t)((gb * 64) + (ch_)) * GDN_UNIT_BYTES); const bf16* Ug_ = Wg_ + 64 * 128; \
        _Pragma("unroll") for (int s = 0; s < 8; ++s) wf[s] = *(const bf16x8*)(Wg_ + (32 * th + r) * 128 + 16 * s + 8 * hh); \
        u0 = *(const u32x4*)(Ug_ + ((th * 4 + vj) * 64 + lane) * 16); u1 = *(const u32x4*)(Ug_ + ((th * 4 + vj) * 64 + lane) * 16 + 8); } while (0)
#define UNPK8(v_, o_) do { o_[0] = bf2f(v_.x & 0xffffu); o_[1] = bf2f(v_.x >> 16); o_[2] = bf2f(v_.y & 0xffffu); o_[3] = bf2f(v_.y >> 16); o_[4] = bf2f(v_.z & 0xffffu); o_[5] = bf2f(v_.z >> 16); o_[6] = bf2f(v_.w & 0xffffu); o_[7] = bf2f(v_.w >> 16); } while (0)
    GDN_PF(0); GDN_WU(0);
    __syncthreads();
    for (int ch = 0; ch < SEQ / 64; ++ch) {
        const int t0 = ch * 64; const size_t m0 = (size_t)b * SEQ + t0;
        {
            float cw[4][8];
#pragma unroll
            for (int k = 0; k < 4; ++k) { const f32x4 a = *(const f32x4*)(sCW + k * 256 + typ * 128 + 8 * l16), c2 = *(const f32x4*)(sCW + k * 256 + typ * 128 + 8 * l16 + 4);
                cw[k][0] = a[0]; cw[k][1] = a[1]; cw[k][2] = a[2]; cw[k][3] = a[3]; cw[k][4] = c2[0]; cw[k][5] = c2[1]; cw[k][6] = c2[2]; cw[k][7] = c2[3]; }
            float x[4][8];
            UNPK8(px[0], x[0]); UNPK8(px[1], x[1]); UNPK8(px[2], x[2]);
#pragma unroll
            for (int tt = 0; tt < 4; ++tt) { float o8[8]; float ss = 0.f;
                UNPK8(px[tt + 3], x[(tt + 3) & 3]);
#pragma unroll
                for (int j = 0; j < 8; ++j) { float a = 0.f;
#pragma unroll
                    for (int k = 0; k < 4; ++k) a += cw[k][j] * x[(tt + k) & 3][j];
                    a = siluf(a); o8[j] = a; ss += a * a; }
                ss = row_sum16(ss);
                const float sc = (frsq(ss + 1e-6f)) * (typ ? 1.0f : 0.08838834764831845f);
                u32x4 pk; pk.x = pk2(o8[0] * sc, o8[1] * sc); pk.y = pk2(o8[2] * sc, o8[3] * sc); pk.z = pk2(o8[4] * sc, o8[5] * sc); pk.w = pk2(o8[6] * sc, o8[7] * sc);
                *(u32x4*)((typ ? Kh : Qh) + (4 * tg + tt) * LD128 + 8 * l16) = pk; }
            if (tid < 64) { float g = nA * softplusf(bf2f(ar_raw) + dtb);
#pragma unroll
                for (int d = 1; d < 64; d <<= 1) { const float upv = __shfl_up(g, d); if (lane >= d) g += upv; }
                sGC[tid] = g; }
            if (ch + 1 < SEQ / 64) GDN_PF(ch + 1);
        }
        lds_barrier();
        if (w < 4) {
            const int ti = w >> 1, tj = w & 1;
            f32x16 acc;
#pragma unroll
            for (int g = 0; g < 16; ++g) acc[g] = C.zf();
            if (tj <= ti) {
#pragma unroll
                for (int s = 0; s < 8; ++s) acc = mfma32(ldfrag(Kh + (32 * tj + r) * LD128 + 16 * s + 8 * hh), ldfrag(Qh + (32 * ti + r) * LD128 + 16 * s + 8 * hh), acc);
            }
            const int i = 32 * ti + r; const float gi = sGC[i];
#pragma unroll
            for (int g4 = 0; g4 < 4; ++g4) { float v4[4];
#pragma unroll
                for (int q = 0; q < 4; ++q) { const int j = 32 * tj + 8 * g4 + 4 * hh + q; v4[q] = (j <= i) ? acc[4 * g4 + q] * fexp(gi - sGC[j]) : 0.f; }
                u32x2 pk; pk.x = pk2(v4[0], v4[1]); pk.y = pk2(v4[2], v4[3]);
                *(u32x2*)(QKd + i * LD64 + 32 * tj + 8 * g4 + 4 * hh) = pk; }
        } else {
            const int lt = tid - 256;
            {   const int t = lt >> 2, kq = lt & 3; const float eg = fexp(sGC[t]);
#pragma unroll
                for (int q = 0; q < 4; ++q) { float v8[8]; ld8(Qh + t * LD128 + 32 * kq + 8 * q, v8);
                    u32x4 pk; pk.x = pk2(v8[0] * eg, v8[1] * eg); pk.y = pk2(v8[2] * eg, v8[3] * eg); pk.z = pk2(v8[4] * eg, v8[5] * eg); pk.w = pk2(v8[6] * eg, v8[7] * eg);
                    *(u32x4*)(QD + t * LD128 + 32 * kq + 8 * q) = pk; } }
            {   const int k = lt & 127, tq = lt >> 7; const float gl_ = sGC[63];
#pragma unroll
                for (int q4 = 0; q4 < 4; ++q4) { float v8[8];
#pragma unroll
                    for (int q = 0; q < 8; ++q) { const int t = 32 * tq + 8 * q4 + q; v8[q] = bf2f(Kh[t * LD128 + k]) * fexp(gl_ - sGC[t]); }
                    u32x4 pk; pk.x = pk2(v8[0], v8[1]); pk.y = pk2(v8[2], v8[3]); pk.z = pk2(v8[4], v8[5]); pk.w = pk2(v8[6], v8[7]);
                    *(u32x4*)(KDT + k * LD64 + 32 * tq + 8 * q4) = pk; } }
        }
        lds_barrier();
        bf16x8 sf[8];
        {
            f32x16 acc;
            acc[0] = bf2f(u0.x & 0xffffu); acc[1] = bf2f(u0.x >> 16); acc[2] = bf2f(u0.y & 0xffffu); acc[3] = bf2f(u0.y >> 16);
            acc[4] = bf2f(u0.z & 0xffffu); acc[5] = bf2f(u0.z >> 16); acc[6] = bf2f(u0.w & 0xffffu); acc[7] = bf2f(u0.w >> 16);
            acc[8] = bf2f(u1.x & 0xffffu); acc[9] = bf2f(u1.x >> 16); acc[10] = bf2f(u1.y & 0xffffu); acc[11] = bf2f(u1.y >> 16);
            acc[12] = bf2f(u1.z & 0xffffu); acc[13] = bf2f(u1.z >> 16); acc[14] = bf2f(u1.w & 0xffffu); acc[15] = bf2f(u1.w >> 16);
#pragma unroll
            for (int s = 0; s < 8; ++s) { sf[s] = ldfrag(ST + (32 * vj + r) * LD128 + 16 * s + 8 * hh); acc = mfma32(wf[s], sf[s], acc); }
#pragma unroll
            for (int g4 = 0; g4 < 4; ++g4) { u32x2 pk; pk.x = pk2(acc[4 * g4], acc[4 * g4 + 1]); pk.y = pk2(acc[4 * g4 + 2], acc[4 * g4 + 3]);
                *(u32x2*)(VNT + (32 * vj + r) * LD64 + 32 * th + 8 * g4 + 4 * hh) = pk; }
            if (ch + 1 < SEQ / 64) GDN_WU(ch + 1);
        }
        lds_barrier();
        {
            f32x16 acc;
#pragma unroll
            for (int g = 0; g < 16; ++g) acc[g] = C.zf();
#pragma unroll
            for (int s = 0; s < 8; ++s) acc = mfma32(ldfrag(QD + (32 * th + r) * LD128 + 16 * s + 8 * hh), sf[s], acc);
            bf16x8 vf[4];
#pragma unroll
            for (int s = 0; s < 4; ++s) { vf[s] = ldfrag(VNT + (32 * vj + r) * LD64 + 16 * s + 8 * hh); acc = mfma32(ldfrag(QKd + (32 * th + r) * LD64 + 16 * s + 8 * hh), vf[s], acc); }
#pragma unroll
            for (int g = 0; g < 16; ++g) Y[(m0 + 32 * th + drow(g, hh)) * DM + h * 128 + 32 * vj + r] = (bf16)f2bf(acc[g]);
            const float gl_ = fexp(sGC[63]);
#pragma unroll
            for (int q = 0; q < 2; ++q) { const int kt = 2 * th + q;
                f32x16 sa = q == 0 ? S0 : S1;
#pragma unroll
                for (int g = 0; g < 16; ++g) sa[g] *= gl_;
#pragma unroll
                for (int s = 0; s < 4; ++s) sa = mfma32(ldfrag(KDT + (32 * kt + r) * LD64 + 16 * s + 8 * hh), vf[s], sa);
                if (q == 0) S0 = sa; else S1 = sa;
#pragma unroll
                for (int g4 = 0; g4 < 4; ++g4) { u32x2 pk; pk.x = pk2(sa[4 * g4], sa[4 * g4 + 1]); pk.y = pk2(sa[4 * g4 + 2], sa[4 * g4 + 3]);
                    *(u32x2*)(ST + (32 * vj + r) * LD128 + 32 * kt + 8 * g4 + 4 * hh) = pk; }
            }
        }
        lds_barrier();
    }
}
#undef GDN_PF
#undef GDN_WU

constexpr size_t WS_LW = WS_R1 + (size_t)M * EV_COLS * 2, WS_AA = WS_LW + (size_t)M * 512 * 2, WS_KK = WS_XB, WS_ACUM = WS_XB + (size_t)M * 512 * 2;
static_assert(WS_AA + (size_t)M * 512 * 2 <= WS_END, "even-layer scratch");

__device__ __forceinline__ void even_pre_tile(const Ctx& C, int e_in, int tile_in, unsigned char* lds) {
    int e = e_in, tile = tile_in; asm volatile("" : "+s"(e), "+s"(tile));
    int tid_ = C.tid(); asm volatile("" : "+v"(tid_));
    const int tid = tid_, lane = tid & 63, w = __builtin_amdgcn_readfirstlane(tid >> 6), r = lane & 31, hh = lane >> 5;
    const size_t m0 = (size_t)tile * 64; const int b = tile >> 6, t0 = (tile & 63) * 64;
    const bf16* P = GPTR(const bf16, C.ws + WS_R1); bf16* Y = GPTR(bf16, C.ws + WS_Y);
    bf16* ACUM = GPTR(bf16, C.ws + WS_ACUM); float* SUMS = GPTR(float, C.ws + WS_DEN);
    bf16* LW = GPTR(bf16, C.ws + WS_LW); bf16* AA = GPTR(bf16, C.ws + WS_AA); bf16* KK = GPTR(bf16, C.ws + WS_KK);
    {
        const int n = w;
        bf16* sXCb = (bf16*)(lds + w * 18432);
        bf16* sWT = sXCb + 64 * LD64; float* sZ = (float*)sWT;
        const float* convw = C.in(8) + (size_t)e * 4 * 512; const float* convb = C.in(9) + (size_t)e * 512;
        {   const int tq = lane >> 3, c8 = lane & 7; const int pc = 512 + n * 64 + 8 * c8;
            float cw[4][8], cb[8];
#pragma unroll
            for (int j = 0; j < 8; ++j) { cb[j] = convb[n * 64 + 8 * c8 + j];
#pragma unroll
                for (int k = 0; k < 4; ++k) cw[k][j] = convw[k * 512 + n * 64 + 8 * c8 + j]; }
            float x[4][8];
#pragma unroll
            for (int i = 0; i < 3; ++i) { const int t = t0 + 8 * tq - 3 + i;
                if (t >= 0) ld8(P + ((size_t)b * SEQ + t) * EV_COLS + pc, x[i]); else {
#pragma unroll
                    for (int j = 0; j < 8; ++j) x[i][j] = 0.f; } }
#pragma unroll
            for (int tt = 0; tt < 8; ++tt) {
                ld8(P + (m0 + 8 * tq + tt) * EV_COLS + pc, x[(tt + 3) & 3]);
                float o8[8];
#pragma unroll
                for (int j = 0; j < 8; ++j) { float a = cb[j];
#pragma unroll
                    for (int k = 0; k < 4; ++k) a += cw[k][j] * x[(tt + k) & 3][j];
                    o8[j] = a; }
                u32x4 pk; pk.x = pk2(o8[0], o8[1]); pk.y = pk2(o8[2], o8[3]); pk.z = pk2(o8[4], o8[5]); pk.w = pk2(o8[6], o8[7]);
                *(u32x4*)(sXCb + (8 * tq + tt) * LD64 + 8 * c8) = pk;
            }
        }
        bf16x8 bwa[2][4], bwx[2][4];
#pragma unroll 1
        for (int mat = 0; mat < 2; ++mat) { const float* src = (mat ? C.in(12) : C.in(10)) + ((size_t)e * 8 + n) * 4096;
#pragma unroll 8
            for (int d = 0; d < 64; d += 2) *(unsigned*)(sWT + lane * LD64 + d) = pk2(src[d * 64 + lane], src[(d + 1) * 64 + lane]);
            asm volatile("s_waitcnt lgkmcnt(0)" ::: "memory");
#pragma unroll
            for (int nt = 0; nt < 2; ++nt)
#pragma unroll
                for (int s = 0; s < 4; ++s) { const bf16x8 f = ldfrag(sWT + (32 * nt + r) * LD64 + 16 * s + 8 * hh); if (mat) bwx[nt][s] = f; else bwa[nt][s] = f; }
            asm volatile("s_waitcnt lgkmcnt(0)" ::: "memory");
        }
        const int ce = n * 64 + lane;
        const float g_ba = C.in(11)[(size_t)e * 512 + ce], g_bx = C.in(13)[(size_t)e * 512 + ce], g_sp = softplusf(-C.in(14)[(size_t)e * 512 + ce]);
        float hloc = 0.f, acum = 1.f;
#pragma unroll 1
        for (int tt = 0; tt < 2; ++tt) {
            float av[32];
#pragma unroll
            for (int nt = 0; nt < 2; ++nt) { f32x16 z;
#pragma unroll
                for (int g = 0; g < 16; ++g) z[g] = C.zf();
#pragma unroll
                for (int s = 0; s < 4; ++s) z = mfma32(ldfrag(sXCb + (32 * tt + r) * LD64 + 16 * s + 8 * hh), bwa[nt][s], z);
#pragma unroll
                for (int g = 0; g < 16; ++g) sZ[drow(g, hh) * 64 + 32 * nt + r] = z[g]; }
            asm volatile("s_waitcnt lgkmcnt(0)" ::: "memory");
#pragma unroll
            for (int t = 0; t < 32; ++t) av[t] = fexp(-8.0f * sigm(sZ[t * 64 + lane] + g_ba) * g_sp);
            asm volatile("s_waitcnt lgkmcnt(0)" ::: "memory");
#pragma unroll
            for (int nt = 0; nt < 2; ++nt) { f32x16 z;
#pragma unroll
                for (int g = 0; g < 16; ++g) z[g] = C.zf();
#pragma unroll
                for (int s = 0; s < 4; ++s) z = mfma32(ldfrag(sXCb + (32 * tt + r) * LD64 + 16 * s + 8 * hh), bwx[nt][s], z);
#pragma unroll
                for (int g = 0; g < 16; ++g) sZ[drow(g, hh) * 64 + 32 * nt + r] = z[g]; }
            asm volatile("s_waitcnt lgkmcnt(0)" ::: "memory");
            float zx[32];
#pragma unroll
            for (int t = 0; t < 32; ++t) zx[t] = sZ[t * 64 + lane];
            asm volatile("s_waitcnt lgkmcnt(0)" ::: "memory");
            bf16* hb = (bf16*)sZ; bf16* ab = hb + 32 * 64;
#pragma unroll
            for (int t = 0; t < 32; ++t) { const int tl = 32 * tt + t; const float a = av[t];
                float mult = sqrtf(fmaxf(1.0f - a * a, 0.f)); if (t0 + tl == 0) mult = 1.0f;
                const float u = sigm(zx[t] + g_bx) * bf2f(sXCb[tl * LD64 + lane]) * mult;
                hloc = a * hloc + u; acum *= a;
                hb[t * 64 + lane] = (bf16)f2bf(hloc); ab[t * 64 + lane] = (bf16)f2bf(acum); }
            asm volatile("s_waitcnt lgkmcnt(0)" ::: "memory");
#pragma unroll
            for (int i = 0; i < 4; ++i) { const int rw = 8 * i + (lane >> 3), pc8 = 8 * (lane & 7);
                const u32x4 hv = *(const u32x4*)(hb + rw * 64 + pc8), cv = *(const u32x4*)(ab + rw * 64 + pc8);
                *(u32x4*)(Y + (m0 + 32 * tt + rw) * DM + n * 64 + pc8) = hv; *(u32x4*)(ACUM + (m0 + 32 * tt + rw) * 512 + n * 64 + pc8) = cv; }
            asm volatile("s_waitcnt lgkmcnt(0)" ::: "memory");
        }
        SUMS[((size_t)tile * 2 + 0) * 512 + ce] = acum; SUMS[((size_t)tile * 2 + 1) * 512 + ce] = hloc;
    }
}

__device__ __forceinline__ void rwkv_chain_block(const Ctx& C, int e, int rb, unsigned char* lds) {
    const int tid = C.tid(), w = C.wave;
    const int bh = rb >> 2, q = rb & 3, b = bh >> 3, h = bh & 7;
    const bf16* P = GPTR(const bf16, C.ws + WS_R1); bf16* Y = GPTR(bf16, C.ws + WS_Y);
    const bf16* LW = GPTR(const bf16, C.ws + WS_LW); const bf16* AA = GPTR(const bf16, C.ws + WS_AA); const bf16* KK = GPTR(const bf16, C.ws + WS_KK);
    float* buf0 = (float*)lds; float* buf1 = buf0 + 10752; float* sY = buf1 + 10752;
    if (w >= 4) {
        const int pt = tid - 256, t = pt >> 3, c8 = pt & 7, hc = h * 64 + 8 * c8;
        const float* mu = C.in(15) + (size_t)e * 1792; const float* kap = C.in(22) + (size_t)e * 512;
        float mur[8], muk[8], muv[8], ka[8];
#pragma unroll
        for (int j = 0; j < 8; ++j) { mur[j] = mu[hc + j]; muk[j] = mu[512 + hc + j]; muv[j] = mu[1024 + hc + j]; ka[j] = kap[hc + j]; }
        u32x4 rc, rp, kc, kp, vc, vp, lwv, aav, kkv;
#define RW_LOAD(ch_) do { const size_t m_ = (size_t)b * SEQ + 32 * (ch_) + t; const bf16* row_ = P + m_ * EV_COLS; const bool hp_ = (32 * (ch_) + t) > 0; const bf16* prow_ = hp_ ? row_ - EV_COLS : row_; \
            rc = *(const u32x4*)(row_ + EC_R + hc); kc = *(const u32x4*)(row_ + EC_K + hc); vc = *(const u32x4*)(row_ + EC_V + hc); \
            rp = *(const u32x4*)(prow_ + EC_R + hc); kp = *(const u32x4*)(prow_ + EC_K + hc); vp = *(const u32x4*)(prow_ + EC_V + hc); \
            lwv = *(const u32x4*)(LW + m_ * 512 + hc); aav = *(const u32x4*)(AA + m_ * 512 + hc); kkv = *(const u32x4*)(KK + m_ * 512 + hc); } while (0)
#define RW_UNPK(v_, o_) do { o_[0] = bf2f(v_.x & 0xffffu); o_[1] = bf2f(v_.x >> 16); o_[2] = bf2f(v_.y & 0xffffu); o_[3] = bf2f(v_.y >> 16); o_[4] = bf2f(v_.z & 0xffffu); o_[5] = bf2f(v_.z >> 16); o_[6] = bf2f(v_.w & 0xffffu); o_[7] = bf2f(v_.w >> 16); } while (0)
#define RW_STAGE(ch_, dst_) do { const float pm_ = (32 * (ch_) + t) > 0 ? 1.0f : 0.0f; float a_[8], b_[8], o1_[8], o2_[8], o3_[8], o4_[8], o5_[8]; \
            RW_UNPK(rc, a_); RW_UNPK(rp, b_); _Pragma("unroll") for (int j = 0; j < 8; ++j) o5_[j] = a_[j] + mur[j] * (b_[j] * pm_ - a_[j]); \
            RW_UNPK(kc, a_); RW_UNPK(kp, b_); _Pragma("unroll") for (int j = 0; j < 8; ++j) o4_[j] = a_[j] + muk[j] * (b_[j] * pm_ - a_[j]); \
            RW_UNPK(aav, a_); RW_UNPK(kkv, b_); _Pragma("unroll") for (int j = 0; j < 8; ++j) { o4_[j] = o4_[j] * (1.0f + (a_[j] - 1.0f) * ka[j]); o2_[j] = b_[j]; o3_[j] = b_[j] * a_[j]; } \
            RW_UNPK(lwv, a_); _Pragma("unroll") for (int j = 0; j < 8; ++j) o1_[j] = fexp(a_[j]); \
            float* d_ = (dst_) + t * 64 + 8 * c8; \
            *(f32x4*)(d_) = (f32x4){o1_[0], o1_[1], o1_[2], o1_[3]}; *(f32x4*)(d_ + 4) = (f32x4){o1_[4], o1_[5], o1_[6], o1_[7]}; \
            *(f32x4*)(d_ + 2048) = (f32x4){o2_[0], o2_[1], o2_[2], o2_[3]}; *(f32x4*)(d_ + 2052) = (f32x4){o2_[4], o2_[5], o2_[6], o2_[7]}; \
            *(f32x4*)(d_ + 4096) = (f32x4){o3_[0], o3_[1], o3_[2], o3_[3]}; *(f32x4*)(d_ + 4100) = (f32x4){o3_[4], o3_[5], o3_[6], o3_[7]}; \
            *(f32x4*)(d_ + 6144) = (f32x4){o4_[0], o4_[1], o4_[2], o4_[3]}; *(f32x4*)(d_ + 6148) = (f32x4){o4_[4], o4_[5], o4_[6], o4_[7]}; \
            *(f32x4*)(d_ + 8192) = (f32x4){o5_[0], o5_[1], o5_[2], o5_[3]}; *(f32x4*)(d_ + 8196) = (f32x4){o5_[4], o5_[5], o5_[6], o5_[7]}; \
            if ((c8 >> 1) == q) { RW_UNPK(vc, a_); RW_UNPK(vp, b_); float* dv_ = (dst_) + 10240 + t * 16 + 8 * (c8 & 1); \
                *(f32x4*)(dv_) = (f32x4){a_[0] + muv[0] * (b_[0] * pm_ - a_[0]), a_[1] + muv[1] * (b_[1] * pm_ - a_[1]), a_[2] + muv[2] * (b_[2] * pm_ - a_[2]), a_[3] + muv[3] * (b_[3] * pm_ - a_[3])}; \
                *(f32x4*)(dv_ + 4) = (f32x4){a_[4] + muv[4] * (b_[4] * pm_ - a_[4]), a_[5] + muv[5] * (b_[5] * pm_ - a_[5]), a_[6] + muv[6] * (b_[6] * pm_ - a_[6]), a_[7] + muv[7] * (b_[7] * pm_ - a_[7])}; } } while (0)
        RW_LOAD(0); RW_STAGE(0, buf0); RW_LOAD(1);
        lds_barrier();
        for (int ch = 0; ch < SEQ / 32; ++ch) {
            if (ch + 1 < SEQ / 32) { RW_STAGE(ch + 1, ((ch + 1) & 1) ? buf1 : buf0); if (ch + 2 < SEQ / 32) RW_LOAD(ch + 2); }
            if (ch >= 1) { const float* sy = sY + ((ch - 1) & 1) * 512; const int pr = pt & 7; const size_t m = (size_t)b * SEQ + 32 * (ch - 1) + t;
                *(unsigned*)(Y + m * DM + 512 + h * 64 + 16 * q + 2 * pr) = pk2(sy[t * 16 + 2 * pr], sy[t * 16 + 2 * pr + 1]); }
            lds_barrier();
        }
        {   const float* sy = sY + ((SEQ / 32 - 1) & 1) * 512; const int pr = pt & 7; const size_t m = (size_t)b * SEQ + 32 * (SEQ / 32 - 1) + t;
            *(unsigned*)(Y + m * DM + 512 + h * 64 + 16 * q + 2 * pr) = pk2(sy[t * 16 + 2 * pr], sy[t * 16 + 2 * pr + 1]); }
#undef RW_LOAD
#undef RW_UNPK
#undef RW_STAGE
    } else {
        __builtin_amdgcn_s_setprio(3);
        const int row = tid >> 4, l16 = tid & 15;
        float S0 = 0.f, S1 = 0.f, S2 = 0.f, S3 = 0.f;
        lds_barrier();
        for (int ch = 0; ch < SEQ / 32; ++ch) {
            const float* bf = (ch & 1) ? buf1 : buf0; float* sy = sY + (ch & 1) * 512;
            const float* pw = bf + 4 * l16; const float* pv = bf + 10240 + row;
            f32x4 w4 = *(const f32x4*)(pw), kk4 = *(const f32x4*)(pw + 2048), b4 = *(const f32x4*)(pw + 4096), k4 = *(const f32x4*)(pw + 6144), r4 = *(const f32x4*)(pw + 8192);
            float v = pv[0];
#pragma unroll 8
            for (int t = 0; t < 32; ++t) {
                const int tn = t < 31 ? t + 1 : 31;
                const f32x4 w4n = *(const f32x4*)(pw + tn * 64), kk4n = *(const f32x4*)(pw + 2048 + tn * 64), b4n = *(const f32x4*)(pw + 4096 + tn * 64);
                const f32x4 k4n = *(const f32x4*)(pw + 6144 + tn * 64), r4n = *(const f32x4*)(pw + 8192 + tn * 64);
                const float vn = pv[tn * 16];
                float sk = (S0 * kk4[0] + S1 * kk4[1]) + (S2 * kk4[2] + S3 * kk4[3]);
                sk = row_sum16(sk);
                S0 = (S0 * w4[0] + v * k4[0]) - sk * b4[0]; S1 = (S1 * w4[1] + v * k4[1]) - sk * b4[1];
                S2 = (S2 * w4[2] + v * k4[2]) - sk * b4[2]; S3 = (S3 * w4[3] + v * k4[3]) - sk * b4[3];
                float y = (S0 * r4[0] + S1 * r4[1]) + (S2 * r4[2] + S3 * r4[3]);
                y = row_sum16(y);
                sy[t * 16 + row] = y;
                w4 = w4n; kk4 = kk4n; b4 = b4n; k4 = k4n; r4 = r4n; v = vn;
            }
            lds_barrier();
        }
        __builtin_amdgcn_s_setprio(0);
    }
}

#ifndef LRUPROBE
#define LRUPROBE 0
#endif
__device__ __forceinline__ void lru_pass2_tile(const Ctx& C, int tile, float* sm, bool rep = false) {
    const int tid = C.tid(); const int c = 4 * (tid & 127), part = __builtin_amdgcn_readfirstlane(tid >> 7); const int b = tile >> 6, jt = tile & 63;
    const bf16* P = GPTR(const bf16, C.ws + WS_R1); bf16* Y = GPTR(bf16, C.ws + WS_Y); const bf16* ACUM = GPTR(const bf16, C.ws + WS_ACUM); const float* SUMS = GPTR(const float, C.ws + WS_DEN);
    const int j0 = (jt * part) >> 2, j1 = (jt * (part + 1)) >> 2;
    const float z_ = C.zf(), o_ = z_ + 1.0f;
    f32x4 A = {o_, o_, o_, o_}, B = {z_, z_, z_, z_};
#pragma unroll 8
    for (int j = j0; j < ((rep && (LRUPROBE & 2)) ? j0 : j1); ++j) { const size_t tl = (size_t)b * 64 + j; const f32x4 a = *(const f32x4*)(SUMS + (tl * 2) * 512 + c), bb = *(const f32x4*)(SUMS + (tl * 2 + 1) * 512 + c); B = a * B + bb; A = a * A; }
    __syncthreads();
    *(f32x4*)(sm + part * 1024 + c) = A; *(f32x4*)(sm + part * 1024 + 512 + c) = B;
    __syncthreads();
    f32x4 carry = {z_, z_, z_, z_};
#pragma unroll
    for (int q = 0; q < 4; ++q) { const f32x4 a = *(const f32x4*)(sm + q * 1024 + c), bb = *(const f32x4*)(sm + q * 1024 + 512 + c); carry = a * carry + bb; }
#pragma unroll 1
    for (int t0_ = 0; t0_ < ((rep && (LRUPROBE & 4)) ? 0 : 16); t0_ += 8) {
        u32x2 rh[8], ra[8], rg[8];
#pragma unroll
        for (int t = 0; t < 8; ++t) { const size_t m = (size_t)tile * 64 + 16 * part + t0_ + t; rh[t] = *(const u32x2*)(Y + m * DM + c); ra[t] = *(const u32x2*)(ACUM + m * 512 + c); rg[t] = *(const u32x2*)(P + m * EV_COLS + c); }
#pragma unroll
        for (int t = 0; t < 8; ++t) { const size_t m = (size_t)tile * 64 + 16 * part + t0_ + t;
            const float hl[4] = {bf2f(rh[t].x & 0xffffu), bf2f(rh[t].x >> 16), bf2f(rh[t].y & 0xffffu), bf2f(rh[t].y >> 16)};
            const float ac[4] = {bf2f(ra[t].x & 0xffffu), bf2f(ra[t].x >> 16), bf2f(ra[t].y & 0xffffu), bf2f(ra[t].y >> 16)};
            const float g[4] = {bf2f(rg[t].x & 0xffffu), bf2f(rg[t].x >> 16), bf2f(rg[t].y & 0xffffu), bf2f(rg[t].y >> 16)};
            u32x2 pk; pk.x = pk2((hl[0] + ac[0] * carry[0]) * gelu_tanh(g[0]), (hl[1] + ac[1] * carry[1]) * gelu_tanh(g[1])); pk.y = pk2((hl[2] + ac[2] * carry[2]) * gelu_tanh(g[2]), (hl[3] + ac[3] * carry[3]) * gelu_tanh(g[3]));
            if (rep) *(u32x2*)(GPTR(bf16, C.ws + WS_XB + 16 * MiB) + m * 512 + c) = pk; else *(u32x2*)(Y + m * DM + c) = pk; }
    }
}

__device__ __forceinline__ void rwkv_post_tile2(const Ctx& C, int e, int tile, float* sm, bool rep = false) {
    const int tid = C.tid();
    const bf16* P = GPTR(const bf16, C.ws + WS_R1); bf16* Y = GPTR(bf16, C.ws + WS_Y); bf16* Yo = rep ? GPTR(bf16, C.ws + WS_XB + 16 * MiB) : Y; const float* bonus = GPTR(const float, C.ws + WS_BONUS);
    const float* mu = C.in(15) + (size_t)e * 1792; const float* g2 = C.in(20) + (size_t)e * 128 * 512;
    const size_t m0 = (size_t)tile * 64; const int t0 = (int)(m0 % SEQ);
    bf16* sGb = (bf16*)((unsigned char*)sm + 131072);
    __syncthreads();
#pragma unroll
    for (int i = 0; i < 2; ++i) { const int idx = tid + i * NTHREADS, t = idx >> 4, j0 = 8 * (idx & 15);
        float p8[8], q8[8]; ld8(P + (m0 + t) * EV_COLS + EC_XG + j0, p8);
        if ((t0 + t) > 0) ld8(P + (m0 + t - 1) * EV_COLS + EC_XG + j0, q8); else {
#pragma unroll
            for (int q = 0; q < 8; ++q) q8[q] = C.zf(); }
        const f32x4 ma = *(const f32x4*)(mu + 1664 + j0), mb = *(const f32x4*)(mu + 1664 + j0 + 4); float o8[8];
#pragma unroll
        for (int q = 0; q < 8; ++q) o8[q] = sigm(p8[q] + (q < 4 ? ma[q] : mb[q - 4]) * (q8[q] - p8[q]));
        u32x4 pk; pk.x = pk2(o8[0], o8[1]); pk.y = pk2(o8[2], o8[3]); pk.z = pk2(o8[4], o8[5]); pk.w = pk2(o8[6], o8[7]);
        *(u32x4*)(sGb + t * LD128 + j0) = pk; }
    __syncthreads();
    {   const int lane = tid & 63, r = lane & 31, hh = lane >> 5; const bf16* g2t = C.wset(2 * e, WOFF_G2);
#pragma unroll 1
        for (int cc = 0; cc < 2; ++cc) { const int ct = 2 * C.wave + cc;
            bf16x8 bfr[8];
#pragma unroll
            for (int s = 0; s < 8; ++s) bfr[s] = *(const bf16x8*)(g2t + (size_t)(32 * ct + r) * 128 + 16 * s + 8 * hh);
#pragma unroll
            for (int th = 0; th < 2; ++th) { f32x16 acc;
#pragma unroll
                for (int g = 0; g < 16; ++g) acc[g] = C.zf();
#pragma unroll
                for (int s = 0; s < 8; ++s) acc = mfma32(ldfrag(sGb + (32 * th + r) * LD128 + 16 * s + 8 * hh), bfr[s], acc);
#pragma unroll
                for (int g = 0; g < 16; ++g) sm[(32 * th + drow(g, hh)) * 512 + 32 * ct + r] = acc[g]; } }
    }
    asm volatile("s_waitcnt lgkmcnt(0)" ::: "memory");
    {
        const int lane = tid & 63, l8 = lane & 7, ts = lane >> 3, cb = 64 * C.wave + 8 * l8;
        float lnw[8], lnb[8], muv[8];
        {   const f32x4 a0 = *(const f32x4*)(C.in(24) + (size_t)e * 512 + cb), a1 = *(const f32x4*)(C.in(24) + (size_t)e * 512 + cb + 4);
            const f32x4 b0 = *(const f32x4*)(C.in(25) + (size_t)e * 512 + cb), b1 = *(const f32x4*)(C.in(25) + (size_t)e * 512 + cb + 4);
            const f32x4 c0 = *(const f32x4*)(mu + 1024 + cb), c1 = *(const f32x4*)(mu + 1024 + cb + 4);
#pragma unroll
            for (int j = 0; j < 4; ++j) { lnw[j] = a0[j]; lnw[4 + j] = a1[j]; lnb[j] = b0[j]; lnb[4 + j] = b1[j]; muv[j] = c0[j]; muv[4 + j] = c1[j]; } }
#pragma unroll 2
        for (int it = 0; it < 8; ++it) { const int t = 8 * it + ts; const size_t m = m0 + t; const bool hp = (t0 + t) > 0; const bf16* row = P + m * EV_COLS;
            float y8[8], v8[8], p8[8];
            ld8(Y + m * DM + 512 + cb, y8); ld8(row + EC_V + cb, v8);
            if (hp) ld8(row - EV_COLS + EC_V + cb, p8); else {
#pragma unroll
                for (int j = 0; j < 8; ++j) p8[j] = C.zf(); }
            const float bon = bonus[m * 8 + C.wave];
            const f32x4 g0 = *(const f32x4*)(sm + t * 512 + cb), g1 = *(const f32x4*)(sm + t * 512 + cb + 4);
            float sy = ((y8[0] + y8[1]) + (y8[2] + y8[3])) + ((y8[4] + y8[5]) + (y8[6] + y8[7]));
            sy += __shfl_xor(sy, 1); sy += __shfl_xor(sy, 2); sy += __shfl_xor(sy, 4);
            const float mean = sy * (1.0f / 64.0f);
            float d8[8], sq = C.zf();
#pragma unroll
            for (int j = 0; j < 8; ++j) { d8[j] = y8[j] - mean; sq += d8[j] * d8[j]; }
            sq += __shfl_xor(sq, 1); sq += __shfl_xor(sq, 2); sq += __shfl_xor(sq, 4);
            const float rs = frsq(sq * (1.0f / 64.0f) + 64e-5f);
            float o8[8];
#pragma unroll
            for (int j = 0; j < 8; ++j) { const float vs = v8[j] + muv[j] * (p8[j] - v8[j]); o8[j] = ((d8[j] * rs * lnw[j] + lnb[j]) + bon * vs) * (j < 4 ? g0[j] : g1[j - 4]); }
            u32x4 pk; pk.x = pk2(o8[0], o8[1]); pk.y = pk2(o8[2], o8[3]); pk.z = pk2(o8[4], o8[5]); pk.w = pk2(o8[6], o8[7]);
            *(u32x4*)(Yo + m * DM + 512 + cb) = pk; }
    }
}

__device__ __forceinline__ void gdn_chunk_block2(const Ctx& C, int o, int gb, unsigned char* lds) {
    const int tid = C.tid(), lane = C.lane(), w = C.wave, r = lane & 31, hh = lane >> 5;
    const int b = gb >> 2, h = gb & 3;
    const bf16* P = GPTR(const bf16, C.ws + WS_R1); bf16* Y = GPTR(bf16, C.ws + WS_Y);
    const float* convw = C.in(28) + (size_t)o * 4 * 1536;
    const float nA = -fexp(C.in(29)[o * 4 + h]); const float dtb = C.in(30)[o * 4 + h];
    bf16* Qh = (bf16*)lds; bf16* Kh = Qh + 64 * LD128; bf16* KT = Kh + 64 * LD128; bf16* QKd = KT + 128 * LD64; bf16* VNT = QKd + 64 * LD64; bf16* VNS = VNT + 128 * LD64; bf16* ST = VNS + 128 * LD64;
    float* sT = (float*)(ST + 128 * LD128);
    float* sCW = sT + 512;
    for (int i = tid; i < 128 * LD128 / 2; i += NTHREADS) ((unsigned*)ST)[i] = 0u;
    for (int i = tid; i < 64 * LD64 / 2; i += NTHREADS) ((unsigned*)QKd)[i] = 0u;
    for (int i = tid; i < 1024; i += NTHREADS) { const int k = i >> 8, c = i & 255; sCW[i] = convw[k * 1536 + (c >> 7) * 512 + h * 128 + (c & 127)]; }
    const int l16 = tid & 15, typ = (tid >> 4) & 1, tg = tid >> 5;
    const int pc = (typ ? 512 : 0) + h * 128 + 8 * l16;
    const int th = w >> 2, vj = w & 3;
    f32x16 S0, S1;
#pragma unroll
    for (int g = 0; g < 16; ++g) { S0[g] = C.zf(); S1[g] = C.zf(); }
    u32x4 px[7]; unsigned ar_next = 0; bf16x8 wf[8]; u32x4 u0, u1;
#define G2_PF(ch_) do { _Pragma("unroll") for (int i = 0; i < 7; ++i) { const int t_ = 64 * (ch_) + 4 * tg - 3 + i; \
            if (t_ >= 0) px[i] = *(const u32x4*)(P + ((size_t)b * SEQ + t_) * OD_PAD + pc); else px[i] = (u32x4){C.z0, C.z0, C.z0, C.z0}; } } while (0)
#define G2_AR(ch_) do { ar_next = P[((size_t)b * SEQ + 64 * (ch_) + (tid & 63)) * OD_PAD + OC_GA + h]; } while (0)
#define G2_WU(ch_) do { const bf16* Wg_ = GPTR(const bf16, C.ws + WS_XB + (size_t)((gb * 64) + (ch_)) * GDN_UNIT_BYTES); const bf16* Ug_ = Wg_ + 64 * 128; \
        _Pragma("unroll") for (int s = 0; s < 8; ++s) wf[s] = *(const bf16x8*)(Wg_ + (32 * th + r) * 128 + 16 * s + 8 * hh); \
        u0 = *(const u32x4*)(Ug_ + ((th * 4 + vj) * 64 + lane) * 16); u1 = *(const u32x4*)(Ug_ + ((th * 4 + vj) * 64 + lane) * 16 + 8); } while (0)
#define G2_GATES(buf_) do { if (tid < 64) { float g_ = nA * softplusf(bf2f(ar_next) + dtb); \
            _Pragma("unroll") for (int d = 1; d < 64; d <<= 1) { const float up_ = __shfl_up(g_, d); if (lane >= d) g_ += up_; } \
            const float gl_ = __shfl(g_, 63); float* tb_ = sT + (buf_) * 256; tb_[tid] = g_; tb_[64 + tid] = fexp(g_); tb_[128 + tid] = fexp(gl_ - g_); if (tid == 0) tb_[192] = fexp(gl_); } } while (0)
    G2_AR(0); G2_PF(0); G2_WU(0);
    G2_GATES(0);
    G2_AR(1);
    __syncthreads();
    for (int ch = 0; ch < SEQ / 64; ++ch) {
        const size_t m0 = (size_t)b * SEQ + ch * 64;
        const float* tb = sT + (ch & 1) * 256;
#ifndef GPROBE
#define GPROBE 0
#endif
        for (int rp1 = 0; rp1 < (GPROBE == 1 ? 2 : 1); ++rp1)
        {
            f32x16 acc;
            acc[0] = bf2f(u0.x & 0xffffu); acc[1] = bf2f(u0.x >> 16); acc[2] = bf2f(u0.y & 0xffffu); acc[3] = bf2f(u0.y >> 16);
            acc[4] = bf2f(u0.z & 0xffffu); acc[5] = bf2f(u0.z >> 16); acc[6] = bf2f(u0.w & 0xffffu); acc[7] = bf2f(u0.w >> 16);
            acc[8] = bf2f(u1.x & 0xffffu); acc[9] = bf2f(u1.x >> 16); acc[10] = bf2f(u1.y & 0xffffu); acc[11] = bf2f(u1.y >> 16);
            acc[12] = bf2f(u1.z & 0xffffu); acc[13] = bf2f(u1.z >> 16); acc[14] = bf2f(u1.w & 0xffffu); acc[15] = bf2f(u1.w >> 16);
#pragma unroll
            for (int s = 0; s < 8; ++s) acc = mfma32(wf[s], ldfrag(ST + (32 * vj + r) * LD128 + 16 * s + 8 * hh), acc);
#pragma unroll
            for (int g4 = 0; g4 < 4; ++g4) { const f32x4 ek = *(const f32x4*)(tb + 128 + 32 * th + 8 * g4 + 4 * hh);
                u32x2 pk; pk.x = pk2(acc[4 * g4], acc[4 * g4 + 1]); pk.y = pk2(acc[4 * g4 + 2], acc[4 * g4 + 3]);
                *(u32x2*)(VNT + (32 * vj + r) * LD64 + 32 * th + 8 * g4 + 4 * hh) = pk;
                pk.x = pk2(acc[4 * g4] * ek[0], acc[4 * g4 + 1] * ek[1]); pk.y = pk2(acc[4 * g4 + 2] * ek[2], acc[4 * g4 + 3] * ek[3]);
                *(u32x2*)(VNS + (32 * vj + r) * LD64 + 32 * th + 8 * g4 + 4 * hh) = pk; }
        }
        for (int rp2 = 0; rp2 < (GPROBE == 2 ? 2 : 1); ++rp2)
        {
            float cw[4][8];
#pragma unroll
            for (int k = 0; k < 4; ++k) { const f32x4 a = *(const f32x4*)(sCW + k * 256 + typ * 128 + 8 * l16), c2 = *(const f32x4*)(sCW + k * 256 + typ * 128 + 8 * l16 + 4);
                cw[k][0] = a[0]; cw[k][1] = a[1]; cw[k][2] = a[2]; cw[k][3] = a[3]; cw[k][4] = c2[0]; cw[k][5] = c2[1]; cw[k][6] = c2[2]; cw[k][7] = c2[3]; }
            float x[4][8], kprev[8];
            UNPK8(px[0], x[0]); UNPK8(px[1], x[1]); UNPK8(px[2], x[2]);
#pragma unroll
            for (int tt = 0; tt < 4; ++tt) { float o8[8]; float ss = 0.f;
                UNPK8(px[tt + 3], x[(tt + 3) & 3]);
#pragma unroll
                for (int j = 0; j < 8; ++j) { float a = 0.f;
#pragma unroll
                    for (int k = 0; k < 4; ++k) a += cw[k][j] * x[(tt + k) & 3][j];
                    a = siluf(a); o8[j] = a; ss += a * a; }
                ss = row_sum16(ss);
                const float sc = frsq(ss + 1e-6f) * (typ ? 1.0f : 0.08838834764831845f);
#pragma unroll
                for (int j = 0; j < 8; ++j) o8[j] *= sc;
                u32x4 pk; pk.x = pk2(o8[0], o8[1]); pk.y = pk2(o8[2], o8[3]); pk.z = pk2(o8[4], o8[5]); pk.w = pk2(o8[6], o8[7]);
                *(u32x4*)((typ ? Kh : Qh) + (4 * tg + tt) * LD128 + 8 * l16) = pk;
                if (typ) {
                    if (tt & 1) {
#pragma unroll
                        for (int j = 0; j < 8; ++j) *(unsigned*)(KT + (8 * l16 + j) * LD64 + 4 * tg + tt - 1) = pk2(kprev[j], o8[j]);
                    } else {
#pragma unroll
                        for (int j = 0; j < 8; ++j) kprev[j] = o8[j]; } } }
        }
        if (ch + 1 < SEQ / 64) { G2_PF(ch + 1); G2_WU(ch + 1); G2_GATES((ch + 1) & 1); if (ch + 2 < SEQ / 64) G2_AR(ch + 2); }
        lds_barrier();
        f32x16 oacc;
        for (int rp3 = 0; rp3 < (GPROBE == 3 ? 2 : 1); ++rp3) {
#pragma unroll
        for (int g = 0; g < 16; ++g) oacc[g] = C.zf();
#pragma unroll
        for (int s = 0; s < 8; ++s) oacc = mfma32(ldfrag(Qh + (32 * th + r) * LD128 + 16 * s + 8 * hh), ldfrag(ST + (32 * vj + r) * LD128 + 16 * s + 8 * hh), oacc);
#pragma unroll
        for (int g4 = 0; g4 < 4; ++g4) { const f32x4 eg = *(const f32x4*)(tb + 64 + 32 * th + 8 * g4 + 4 * hh);
            oacc[4 * g4] *= eg[0]; oacc[4 * g4 + 1] *= eg[1]; oacc[4 * g4 + 2] *= eg[2]; oacc[4 * g4 + 3] *= eg[3]; }
        if (w < 3) {
            const int ti = w > 0 ? 1 : 0, tj = w > 1 ? 1 : 0;
            f32x16 acc;
#pragma unroll
            for (int g = 0; g < 16; ++g) acc[g] = C.zf();
#pragma unroll
            for (int s = 0; s < 8; ++s) acc = mfma32(ldfrag(Kh + (32 * tj + r) * LD128 + 16 * s + 8 * hh), ldfrag(Qh + (32 * ti + r) * LD128 + 16 * s + 8 * hh), acc);
            const int i = 32 * ti + r; const float gi = tb[i];
#pragma unroll
            for (int g4 = 0; g4 < 4; ++g4) { const f32x4 gj = *(const f32x4*)(tb + 32 * tj + 8 * g4 + 4 * hh); float v4[4];
#pragma unroll
                for (int q = 0; q < 4; ++q) { const int j = 32 * tj + 8 * g4 + 4 * hh + q; v4[q] = (j <= i) ? acc[4 * g4 + q] * fexp(gi - gj[q]) : 0.f; }
                u32x2 pk; pk.x = pk2(v4[0], v4[1]); pk.y = pk2(v4[2], v4[3]);
                *(u32x2*)(QKd + i * LD64 + 32 * tj + 8 * g4 + 4 * hh) = pk; }
        }
        }
        lds_barrier();
        {
            f32x16 acc = oacc;
            for (int rp4 = 0; rp4 < (GPROBE == 4 ? 2 : 1); ++rp4) { acc = oacc;
#pragma unroll
            for (int s = 0; s < 4; ++s) acc = mfma32(ldfrag(QKd + (32 * th + r) * LD64 + 16 * s + 8 * hh), ldfrag(VNT + (32 * vj + r) * LD64 + 16 * s + 8 * hh), acc);
#pragma unroll
            for (int g = 0; g < 16; ++g) Y[(m0 + 32 * th + drow(g, hh)) * DM + h * 128 + 32 * vj + r] = (bf16)f2bf(acc[g]);
            }
            const float gl_ = tb[192];
            bf16x8 vs[4];
#pragma unroll
            for (int s = 0; s < 4; ++s) vs[s] = ldfrag(VNS + (32 * vj + r) * LD64 + 16 * s + 8 * hh);
#pragma unroll
            for (int q = 0; q < 2; ++q) { const int kt = 2 * th + q;
                f32x16 sa = q == 0 ? S0 : S1;
#pragma unroll
                for (int g = 0; g < 16; ++g) sa[g] *= gl_;
#pragma unroll
                for (int s = 0; s < 4; ++s) sa = mfma32(ldfrag(KT + (32 * kt + r) * LD64 + 16 * s + 8 * hh), vs[s], sa);
                if (q == 0) S0 = sa; else S1 = sa;
#pragma unroll
                for (int g4 = 0; g4 < 4; ++g4) { u32x2 pk; pk.x = pk2(sa[4 * g4], sa[4 * g4 + 1]); pk.y = pk2(sa[4 * g4 + 2], sa[4 * g4 + 3]);
                    *(u32x2*)(ST + (32 * vj + r) * LD128 + 32 * kt + 8 * g4 + 4 * hh) = pk; }
            }
        }
        lds_barrier();
    }
#undef G2_PF
#undef G2_AR
#undef G2_WU
#undef G2_GATES
}

__device__ __forceinline__ void mlstm_chunk_block2(const Ctx& C, int o, int mb, unsigned char* lds) {
    const int tid = C.tid(), lane = C.lane(), w = C.wave, r = lane & 31, hh = lane >> 5;
    const int b = mb >> 2, h = mb & 3;
    const bf16* P = GPTR(const bf16, C.ws + WS_R1); bf16* Y = GPTR(bf16, C.ws + WS_Y); float* den = GPTR(float, C.ws + WS_BONUS);
    const float* convw = C.in(32) + (size_t)o * 4 * 512;
    const float igb = C.in(33)[o * 4 + h], fgb = C.in(34)[o * 4 + h];
    bf16* Qh = (bf16*)lds; bf16* Kh = Qh + 64 * LD64; bf16* KT = Kh + 64 * LD64; bf16* Wm = KT + 64 * LD64;
    bf16* VT = Wm + 64 * LD64; bf16* VS = VT + 160 * LD64; bf16* CT0 = VS + 160 * LD64; bf16* CT1 = CT0 + 160 * LD64;
    float* sT = (float*)(CT1 + 160 * LD64);
    for (int i = tid; i < 2 * 160 * LD64 / 2; i += NTHREADS) ((unsigned*)CT0)[i] = 0u;
    for (int i = tid; i < 64 * LD64 / 2; i += NTHREADS) ((unsigned*)Wm)[i] = 0u;
    for (int i = tid; i < 32 * LD64; i += NTHREADS) { VT[128 * LD64 + i] = (i < 64) ? (bf16)0x3F80 : (bf16)0; VS[128 * LD64 + i] = (bf16)0; }
    const int l16 = tid & 15, typ = (tid >> 4) & 1, tg = tid >> 5;
    const int pc = OC_MQK + (typ ? 256 : 0) + h * 64 + 4 * l16;
    float cw[4][4];
#pragma unroll
    for (int k = 0; k < 4; ++k)
#pragma unroll
        for (int j = 0; j < 4; ++j) cw[k][j] = convw[k * 512 + (typ ? 256 : 0) + h * 64 + 4 * l16 + j];
    const int th = w >> 2, vj = w & 3; const bool two = (vj == 0);
    f32x16 Ca, Cb;
#pragma unroll
    for (int g = 0; g < 16; ++g) { Ca[g] = C.zf(); Cb[g] = C.zf(); }
    int cur = 0;
    u32x2 px[7]; u32x4 pva, pvb; unsigned pgi = 0, pgf = 0;
    const int vt = tid & 63, vg = tid >> 6;
#define M2_PF(ch_) do { _Pragma("unroll") for (int i = 0; i < 7; ++i) { const int t_ = 64 * (ch_) + 4 * tg - 3 + i; \
            if (t_ >= 0) px[i] = *(const u32x2*)(P + ((size_t)b * SEQ + t_) * OD_PAD + pc); else px[i] = (u32x2){C.z0, C.z0}; } \
        { const bf16* vr_ = P + ((size_t)b * SEQ + 64 * (ch_) + vt) * OD_PAD; pva = *(const u32x4*)(vr_ + OC_MV + h * 128 + 16 * vg); pvb = *(const u32x4*)(vr_ + OC_MV + h * 128 + 16 * vg + 8); } } while (0)
#define M2_GPF(ch_) do { const bf16* vr_ = P + ((size_t)b * SEQ + 64 * (ch_) + vt) * OD_PAD; pgi = vr_[OC_MI + h]; pgf = vr_[OC_MF + h]; } while (0)
#define M2_GATES(buf_) do { if (tid < 64) { const float ip_ = bf2f(pgi) + igb; float lf_ = logsigm(bf2f(pgf) + fgb); \
            _Pragma("unroll") for (int d = 1; d < 64; d <<= 1) { const float up_ = __shfl_up(lf_, d); if (lane >= d) lf_ += up_; } \
            const float bl_ = __shfl(lf_, 63); float* tb_ = sT + (buf_) * 256; tb_[tid] = lf_; tb_[64 + tid] = ip_; tb_[128 + tid] = fexp(lf_); tb_[192 + tid] = fexp(bl_ - lf_ + ip_); } } while (0)
    M2_GPF(0); M2_PF(0);
    M2_GATES(0);
    M2_GPF(1);
    __syncthreads();
    for (int ch = 0; ch < SEQ / 64; ++ch) {
        const size_t m0 = (size_t)b * SEQ + ch * 64;
        const float* tb = sT + (ch & 1) * 256;
        {
            float x[7][4], ko[4][4];
#pragma unroll
            for (int i = 0; i < 7; ++i) { x[i][0] = bf2f(px[i].x & 0xffffu); x[i][1] = bf2f(px[i].x >> 16); x[i][2] = bf2f(px[i].y & 0xffffu); x[i][3] = bf2f(px[i].y >> 16); }
#pragma unroll
            for (int tt = 0; tt < 4; ++tt) {
#pragma unroll
                for (int j = 0; j < 4; ++j) { float a = 0.f;
#pragma unroll
                    for (int k = 0; k < 4; ++k) a += cw[k][j] * x[tt + k][j];
                    a = siluf(a); ko[tt][j] = typ ? a : a * 0.125f; }
                u32x2 pk; pk.x = pk2(ko[tt][0], ko[tt][1]); pk.y = pk2(ko[tt][2], ko[tt][3]);
                *(u32x2*)((typ ? Kh : Qh) + (4 * tg + tt) * LD64 + 4 * l16) = pk; }
            if (typ) {
#pragma unroll
                for (int j = 0; j < 4; ++j) { u32x2 pk; pk.x = pk2(ko[0][j], ko[1][j]); pk.y = pk2(ko[2][j], ko[3][j]); *(u32x2*)(KT + (4 * l16 + j) * LD64 + 4 * tg) = pk; } }
            {   const float ek = tb[192 + vt]; const unsigned wv[8] = {pva.x, pva.y, pva.z, pva.w, pvb.x, pvb.y, pvb.z, pvb.w};
#pragma unroll
                for (int q = 0; q < 8; ++q) { const unsigned lo = wv[q] & 0xffffu, hi = wv[q] >> 16;
                    VT[(16 * vg + 2 * q) * LD64 + vt] = (bf16)lo; VT[(16 * vg + 2 * q + 1) * LD64 + vt] = (bf16)hi;
                    VS[(16 * vg + 2 * q) * LD64 + vt] = (bf16)f2bf(bf2f(lo) * ek); VS[(16 * vg + 2 * q + 1) * LD64 + vt] = (bf16)f2bf(bf2f(hi) * ek); }
                if (tid < 64) VS[128 * LD64 + tid] = (bf16)f2bf(ek); }
        }
        if (ch + 1 < SEQ / 64) { M2_PF(ch + 1); M2_GATES((ch + 1) & 1); if (ch + 2 < SEQ / 64) M2_GPF(ch + 2); }
        lds_barrier();
        if (w < 3) {
            const int ti = w > 0 ? 1 : 0, tj = w > 1 ? 1 : 0;
            f32x16 acc;
#pragma unroll
            for (int g = 0; g < 16; ++g) acc[g] = C.zf();
#pragma unroll
            for (int s = 0; s < 4; ++s) acc = mfma32(ldfrag(Kh + (32 * tj + r) * LD64 + 16 * s + 8 * hh), ldfrag(Qh + (32 * ti + r) * LD64 + 16 * s + 8 * hh), acc);
            const int i = 32 * ti + r; const float bi = tb[i];
#pragma unroll
            for (int g4 = 0; g4 < 4; ++g4) { const f32x4 bj = *(const f32x4*)(tb + 32 * tj + 8 * g4 + 4 * hh), ij = *(const f32x4*)(tb + 64 + 32 * tj + 8 * g4 + 4 * hh); float v4[4];
#pragma unroll
                for (int q = 0; q < 4; ++q) { const int j = 32 * tj + 8 * g4 + 4 * hh + q; v4[q] = (j <= i) ? acc[4 * g4 + q] * fexp(bi - bj[q] + ij[q]) : 0.f; }
                u32x2 pk; pk.x = pk2(v4[0], v4[1]); pk.y = pk2(v4[2], v4[3]);
                *(u32x2*)(Wm + i * LD64 + 32 * tj + 8 * g4 + 4 * hh) = pk; }
        }
        lds_barrier();
        {
            const bf16* CTc = cur ? CT1 : CT0; bf16* CTn = cur ? CT0 : CT1;
            const float F = tb[128 + 63];
#pragma unroll
            for (int q = 0; q < 2; ++q) {
                if (q == 1 && !two) break;
                const int vjj = q == 0 ? vj : 4;
                f32x16 num;
#pragma unroll
                for (int g = 0; g < 16; ++g) num[g] = C.zf();
#pragma unroll
                for (int s = 0; s < 4; ++s) num = mfma32(ldfrag(Qh + (32 * th + r) * LD64 + 16 * s + 8 * hh), ldfrag(CTc + (32 * vjj + r) * LD64 + 16 * s + 8 * hh), num);
#pragma unroll
                for (int g4 = 0; g4 < 4; ++g4) { const f32x4 eb = *(const f32x4*)(tb + 128 + 32 * th + 8 * g4 + 4 * hh);
                    num[4 * g4] *= eb[0]; num[4 * g4 + 1] *= eb[1]; num[4 * g4 + 2] *= eb[2]; num[4 * g4 + 3] *= eb[3]; }
#pragma unroll
                for (int s = 0; s < 4; ++s) num = mfma32(ldfrag(Wm + (32 * th + r) * LD64 + 16 * s + 8 * hh), ldfrag(VT + (32 * vjj + r) * LD64 + 16 * s + 8 * hh), num);
                if (vjj < 4) {
#pragma unroll
                    for (int g = 0; g < 16; ++g) Y[(m0 + 32 * th + drow(g, hh)) * DM + 512 + h * 128 + 32 * vjj + r] = (bf16)f2bf(num[g]);
                } else if (r == 0) {
#pragma unroll
                    for (int g = 0; g < 16; ++g) den[(m0 + 32 * th + drow(g, hh)) * 4 + h] = num[g];
                }
                f32x16 cacc = q == 0 ? Ca : Cb;
#pragma unroll
                for (int g = 0; g < 16; ++g) cacc[g] *= F;
#pragma unroll
                for (int s = 0; s < 4; ++s) cacc = mfma32(ldfrag(KT + (32 * th + r) * LD64 + 16 * s + 8 * hh), ldfrag(VS + (32 * vjj + r) * LD64 + 16 * s + 8 * hh), cacc);
                if (q == 0) Ca = cacc; else Cb = cacc;
#pragma unroll
                for (int g4 = 0; g4 < 4; ++g4) { u32x2 pk; pk.x = pk2(cacc[4 * g4], cacc[4 * g4 + 1]); pk.y = pk2(cacc[4 * g4 + 2], cacc[4 * g4 + 3]);
                    *(u32x2*)(CTn + (32 * vjj + r) * LD64 + 32 * th + 8 * g4 + 4 * hh) = pk; }
            }
        }
        cur ^= 1;
        lds_barrier();
    }
#undef M2_PF
#undef M2_GPF
#undef M2_GATES
}

constexpr size_t WS_RP = WS_R1 + (size_t)M * EV_COLS * 2, WS_YP = WS_RP + 16 * MiB, WS_ZP0 = WS_YP + 16 * MiB, WS_MM = WS_XB, WS_ZP1 = WS_END;
static_assert(WS_ZP0 + 8 * MiB == WS_R1 + 128 * MiB && WS_ZP1 + 8 * MiB <= 256 * MiB, "rwkv chunk operand map");
__device__ __forceinline__ unsigned char* rwkv_zp(const Ctx& C, int u) { return C.ws + (u < 1024 ? WS_ZP0 + (size_t)u * 8192 : WS_ZP1 + (size_t)(u - 1024) * 8192); }

#ifndef RPHEADS
#define RPHEADS 8
#endif
__device__ __forceinline__ void rwkv_pre_tile(const Ctx& C, int e_in, int tile_in, unsigned char* lds, int nheads = 8) {
    int e = e_in, tile = tile_in; asm volatile("" : "+s"(e), "+s"(tile));
    const size_t m0 = (size_t)tile * 64; const int b = tile >> 6, n = tile & 63, t0 = n * 64;
    const bf16* P = GPTR(const bf16, C.ws + WS_R1); float* bonus = GPTR(float, C.ws + WS_BONUS);
    const float* mu = C.in(15) + (size_t)e * 1792;
    const float* p_w2 = C.in(17) + (size_t)e * 64 * 512; const float* p_a2 = C.in(19) + (size_t)e * 64 * 512; const float* pw0 = C.in(16) + (size_t)e * 512;
    const float* pkk = C.in(21) + (size_t)e * 512; const float* pa0 = C.in(18) + (size_t)e * 512; const float* pka = C.in(22) + (size_t)e * 512; const float* prk = C.in(23) + (size_t)e * 512;
    float* Ab = (float*)lds; float* Rh = Ab + 64 * 68;
    bf16* KKt = (bf16*)(Rh + 64 * 68); bf16* Bh = KKt + 64 * LD64; bf16* Kh = Bh + 64 * LD64; bf16* Rt = Kh + 64 * LD64; bf16* VT = Rt + 64 * LD64;
    bf16* Ak = VT + 64 * LD64; bf16* Ark = Ak + 64 * LD64; bf16* ArbN = Ark + 64 * LD64; bf16* WT = ArbN + 64 * LD64; bf16* UT = WT + 64 * LD64; bf16* BbTN = UT + 64 * LD64; bf16* KbT = BbTN + 64 * LD64;
    float* sGL = (float*)(KbT + 64 * LD64);
    u32x4 gxw, gxwp, gxa, gxap, gr, grp, gk, gkp, gv, gvp; f32x4 gw0, gw1, ga0, ga1;
    {   const int tq = C.tid() >> 3, cq = C.tid() & 7; const bf16* row = P + (m0 + tq) * EV_COLS; const bf16* prow = (t0 + tq) > 0 ? row - EV_COLS : row;
        gxw = *(const u32x4*)(row + EC_XW + 8 * cq); gxwp = *(const u32x4*)(prow + EC_XW + 8 * cq); gxa = *(const u32x4*)(row + EC_XA + 8 * cq); gxap = *(const u32x4*)(prow + EC_XA + 8 * cq); }
#define RP_LOAD(h_) do { const int tq_ = C.tid() >> 3, cq_ = C.tid() & 7; const bf16* row_ = P + (m0 + tq_) * EV_COLS; const bf16* prow_ = (t0 + tq_) > 0 ? row_ - EV_COLS : row_; const int hc_ = (h_) * 64 + 8 * cq_; \
        gr = *(const u32x4*)(row_ + EC_R + hc_); grp = *(const u32x4*)(prow_ + EC_R + hc_); gk = *(const u32x4*)(row_ + EC_K + hc_); gkp = *(const u32x4*)(prow_ + EC_K + hc_); gv = *(const u32x4*)(row_ + EC_V + hc_); gvp = *(const u32x4*)(prow_ + EC_V + hc_); \
        const float* w2_ = p_w2 + (size_t)tq_ * 512 + hc_; const float* a2_ = p_a2 + (size_t)tq_ * 512 + hc_; \
        gw0 = *(const f32x4*)w2_; gw1 = *(const f32x4*)(w2_ + 4); ga0 = *(const f32x4*)a2_; ga1 = *(const f32x4*)(a2_ + 4); } while (0)
    RP_LOAD(0);
#pragma unroll 1
    for (int h = 0; h < nheads; ++h) {
        int tid_ = C.tid(); asm volatile("" : "+v"(tid_));
        const int tid = tid_, lane = tid & 63, w = __builtin_amdgcn_readfirstlane(tid >> 6), r = lane & 31, hh = lane >> 5;
        const int u = (b * 8 + h) * 64 + n;
        float q_mur[8], q_muk[8], q_muv[8], q_kk[8], q_a0[8], q_ka[8], q_rk[8];
        {   const int hc_ = h * 64 + 8 * (tid & 7);
#define RP_P8(dst_, src_) do { const f32x4 a_ = *(const f32x4*)((src_) + hc_), b_ = *(const f32x4*)((src_) + hc_ + 4); dst_[0] = a_[0]; dst_[1] = a_[1]; dst_[2] = a_[2]; dst_[3] = a_[3]; dst_[4] = b_[0]; dst_[5] = b_[1]; dst_[6] = b_[2]; dst_[7] = b_[3]; } while (0)
            RP_P8(q_mur, mu); RP_P8(q_muk, mu + 512); RP_P8(q_muv, mu + 1024); RP_P8(q_kk, pkk); RP_P8(q_a0, pa0); RP_P8(q_ka, pka); RP_P8(q_rk, prk);
#undef RP_P8
        }
        lds_barrier();
#ifndef RPROBE
#define RPROBE 0
#endif
        for (int rp = 0; rp < (RPROBE == 1 ? 2 : 1); ++rp) { if (rp) lds_barrier();
        {
            const int t = tid >> 3, c8 = tid & 7; const float pm0 = (t0 + t) > 0 ? 1.0f : 0.0f;
            float c[8], p[8], o[8];
            UNPK8(gxw, c); UNPK8(gxwp, p);
#pragma unroll
            for (int j = 0; j < 8; ++j) o[j] = ftanh(c[j] + mu[1536 + 8 * c8 + j] * (p[j] * pm0 - c[j]));
            u32x4 pk; pk.x = pk2(o[0], o[1]); pk.y = pk2(o[2], o[3]); pk.z = pk2(o[4], o[5]); pk.w = pk2(o[6], o[7]);
            *(u32x4*)(Ak + t * LD64 + 8 * c8) = pk;
            UNPK8(gxa, c); UNPK8(gxap, p);
#pragma unroll
            for (int j = 0; j < 8; ++j) o[j] = c[j] + mu[1600 + 8 * c8 + j] * (p[j] * pm0 - c[j]);
            pk.x = pk2(o[0], o[1]); pk.y = pk2(o[2], o[3]); pk.z = pk2(o[4], o[5]); pk.w = pk2(o[6], o[7]);
            *(u32x4*)(Ark + t * LD64 + 8 * c8) = pk;
            const f32x4 wa0 = gw0, wa1 = gw1, aa0 = ga0, aa1 = ga1;
#pragma unroll
            for (int j = 0; j < 4; ++j) { WT[(8 * c8 + j) * LD64 + t] = (bf16)f2bf(wa0[j]); WT[(8 * c8 + 4 + j) * LD64 + t] = (bf16)f2bf(wa1[j]);
                UT[(8 * c8 + j) * LD64 + t] = (bf16)f2bf(aa0[j]); UT[(8 * c8 + 4 + j) * LD64 + t] = (bf16)f2bf(aa1[j]); }
        }
        lds_barrier();
        {
            const int mat = w >> 2, tt = (w >> 1) & 1, nt = w & 1;
            f32x16 z;
#pragma unroll
            for (int g = 0; g < 16; ++g) z[g] = C.zf();
#pragma unroll
            for (int s = 0; s < 4; ++s) z = mfma32(ldfrag((mat ? Ark : Ak) + (32 * tt + r) * LD64 + 16 * s + 8 * hh), ldfrag((mat ? UT : WT) + (32 * nt + r) * LD64 + 16 * s + 8 * hh), z);
            float* dst = mat ? Rh : Ab;
            if (!mat) {
                const float p_w0 = pw0[h * 64 + 32 * nt + r];
#pragma unroll
                for (int g = 0; g < 16; ++g) z[g] = -fexp(-softplusf(-(p_w0 + z[g])) - 0.5f);
            }
#pragma unroll
            for (int g = 0; g < 16; ++g) dst[(32 * tt + drow(g, hh)) * 68 + 32 * nt + r] = z[g];
        }
        }
        lds_barrier();
        for (int rp = 0; rp < (RPROBE == 2 ? 2 : 1); ++rp)
        if (w == 0) {
            float cl = 0.f;
#pragma unroll 16
            for (int t = 0; t < 64; ++t) { cl += Ab[t * 68 + lane]; Ab[t * 68 + lane] = cl; }
            sGL[lane] = fexp(cl);
        }
        lds_barrier();
        {
            const int t = tid >> 3, c8 = tid & 7, hc = h * 64 + 8 * c8; const size_t m = m0 + t; const float pm = (t0 + t) > 0 ? 1.0f : 0.0f;
            float rs[8], ks[8], vs[8], tmp[8];
            UNPK8(gr, rs); UNPK8(grp, tmp);
#pragma unroll
            for (int j = 0; j < 8; ++j) rs[j] += q_mur[j] * (tmp[j] * pm - rs[j]);
            UNPK8(gk, ks); UNPK8(gkp, tmp);
#pragma unroll
            for (int j = 0; j < 8; ++j) ks[j] += q_muk[j] * (tmp[j] * pm - ks[j]);
            UNPK8(gv, vs); UNPK8(gvp, tmp);
#pragma unroll
            for (int j = 0; j < 8; ++j) vs[j] += q_muv[j] * (tmp[j] * pm - vs[j]);
            if (h + 1 < nheads) RP_LOAD(h + 1);
            float kkv[8], ss = 0.f;
#pragma unroll
            for (int j = 0; j < 8; ++j) { kkv[j] = ks[j] * q_kk[j]; ss += kkv[j] * kkv[j]; }
            ss += __shfl_xor(ss, 1); ss += __shfl_xor(ss, 2); ss += __shfl_xor(ss, 4);
            const float rn = frsq(ss + 1e-6f);
            const f32x4 cl0 = *(const f32x4*)(Ab + t * 68 + 8 * c8), cl1 = *(const f32x4*)(Ab + t * 68 + 8 * c8 + 4);
            const f32x4 za0 = *(const f32x4*)(Rh + t * 68 + 8 * c8), za1 = *(const f32x4*)(Rh + t * 68 + 8 * c8 + 4);
            const f32x4 cL0 = *(const f32x4*)(Ab + 63 * 68 + 8 * c8), cL1 = *(const f32x4*)(Ab + 63 * 68 + 8 * c8 + 4);
            f32x4 cp0 = {C.zf(), C.zf(), C.zf(), C.zf()}, cp1 = cp0;
            if (t > 0) { cp0 = *(const f32x4*)(Ab + (t - 1) * 68 + 8 * c8); cp1 = *(const f32x4*)(Ab + (t - 1) * 68 + 8 * c8 + 4); }
            float o1[8], o2[8], o3[8], o4[8], bon = 0.f;
#pragma unroll
            for (int j = 0; j < 8; ++j) { const float cl = j < 4 ? cl0[j] : cl1[j - 4], cp = j < 4 ? cp0[j] : cp1[j - 4], cL = j < 4 ? cL0[j] : cL1[j - 4], za = j < 4 ? za0[j] : za1[j - 4];
                const float a = sigm(q_a0[j] + za);
                const float kk = kkv[j] * rn, bb = kk * a, kp = ks[j] * (1.0f + (a - 1.0f) * q_ka[j]);
                bon += rs[j] * kp * q_rk[j];
                const float ig = fexp(-cl), eg = fexp(cl), el = fexp(cL - cl);
                o1[j] = kk * fexp(cp); o2[j] = bb * ig; o3[j] = kp * ig; o4[j] = rs[j] * eg;
                BbTN[(8 * c8 + j) * LD64 + t] = (bf16)f2bf(-bb * el); KbT[(8 * c8 + j) * LD64 + t] = (bf16)f2bf(kp * el); VT[(8 * c8 + j) * LD64 + t] = (bf16)f2bf(vs[j]); WT[(8 * c8 + j) * LD64 + t] = (bf16)f2bf(o1[j]); }
            bon += __shfl_xor(bon, 1); bon += __shfl_xor(bon, 2); bon += __shfl_xor(bon, 4);
            if (c8 == 0) bonus[m * 8 + h] = bon;
            u32x4 pk; pk.x = pk2(o1[0], o1[1]); pk.y = pk2(o1[2], o1[3]); pk.z = pk2(o1[4], o1[5]); pk.w = pk2(o1[6], o1[7]); *(u32x4*)(KKt + t * LD64 + 8 * c8) = pk;
            pk.x = pk2(o2[0], o2[1]); pk.y = pk2(o2[2], o2[3]); pk.z = pk2(o2[4], o2[5]); pk.w = pk2(o2[6], o2[7]); *(u32x4*)(Bh + t * LD64 + 8 * c8) = pk;
            pk.x = pk2(o3[0], o3[1]); pk.y = pk2(o3[2], o3[3]); pk.z = pk2(o3[4], o3[5]); pk.w = pk2(o3[6], o3[7]); *(u32x4*)(Kh + t * LD64 + 8 * c8) = pk;
            pk.x = pk2(o4[0], o4[1]); pk.y = pk2(o4[2], o4[3]); pk.z = pk2(o4[4], o4[5]); pk.w = pk2(o4[6], o4[7]); *(u32x4*)(Rt + t * LD64 + 8 * c8) = pk;
        }
        lds_barrier();
        bf16* AbI = (bf16*)Ab; bf16* AbT = AbI + 64 * LD64;
        bf16* WK0 = AbT + 64 * LD64; bf16* WK1 = Bh;
        {
#pragma unroll 1
            for (int job = w; job < 18; job += 8) {
                const bool tr = job >= 16; const int mat = tr ? 0 : (job >> 2), ti = tr ? (job - 16) : ((job >> 1) & 1), tj = tr ? ti : (job & 1);
                const bf16* first = mat < 2 ? KKt : Rt; const bf16* second = (mat == 0 || mat == 3) ? Bh : Kh;
                f32x16 acc;
#pragma unroll
                for (int g = 0; g < 16; ++g) acc[g] = C.zf();
                const bf16* opA = tr ? first + (32 * ti + r) * LD64 : second + (32 * tj + r) * LD64; const bf16* opB = tr ? second + (32 * tj + r) * LD64 : first + (32 * ti + r) * LD64;
                if (tj <= ti) {
#pragma unroll
                    for (int s4 = 0; s4 < 4; ++s4) acc = mfma32(ldfrag(opA + 16 * s4 + 8 * hh), ldfrag(opB + 16 * s4 + 8 * hh), acc);
                }
                const int fx = 32 * (tr ? tj : ti) + r; const bool incl = mat >= 2; const float sg = mat == 3 ? -1.0f : 1.0f;
                bf16* dstI = tr ? AbT : (mat == 0 ? AbI : (mat == 1 ? Ak : (mat == 2 ? Ark : ArbN)));
#pragma unroll
                for (int g4 = 0; g4 < 4; ++g4) { float v4[4];
#pragma unroll
                    for (int q = 0; q < 4; ++q) { const int y = 32 * (tr ? ti : tj) + 8 * g4 + 4 * hh + q; const int tt_ = tr ? y : fx, ii_ = tr ? fx : y;
                        v4[q] = (incl ? ii_ <= tt_ : ii_ < tt_) ? acc[4 * g4 + q] * sg : 0.f; }
                    u32x2 pk; pk.x = pk2(v4[0], v4[1]); pk.y = pk2(v4[2], v4[3]);
                    *(u32x2*)(dstI + fx * LD64 + 32 * (tr ? ti : tj) + 8 * g4 + 4 * hh) = pk; }
            }
        }
        lds_barrier();
        for (int rp = 0; rp < (RPROBE == 8 ? 2 : 1); ++rp)
        if (w < 2) {
            const int d = w; bf16* wk = d ? WK1 : WK0;
            bf16* PA = wk; bf16* PAT = wk + 1280; bf16* PB = wk + 2560; bf16* PBT = wk + 3840; bf16* TA = wk + 5120; bf16* TB = wk + 6400;
            const bf16* Pc = AbI + (32 * d) * LD64 + 32 * d; const bf16* PTc = AbT + (32 * d) * LD64 + 32 * d; int ldp = LD64;
            {   float v8[8], o8[8];
#pragma unroll
                for (int q = 0; q < 2; ++q) { ld8(Pc + r * LD64 + 16 * hh + 8 * q, v8);
#pragma unroll
                    for (int j = 0; j < 8; ++j) o8[j] = ((16 * hh + 8 * q + j) == r ? 1.0f : 0.0f) - v8[j];
                    u32x4 pk; pk.x = pk2(o8[0], o8[1]); pk.y = pk2(o8[2], o8[3]); pk.z = pk2(o8[4], o8[5]); pk.w = pk2(o8[6], o8[7]); *(u32x4*)(TA + r * 40 + 16 * hh + 8 * q) = pk; } }
            asm volatile("s_waitcnt lgkmcnt(0)" ::: "memory");
#pragma unroll
            for (int k = 0; k < 4; ++k) {
                bf16* Pn = (k & 1) ? PA : PB; bf16* PnT = (k & 1) ? PAT : PBT; const bf16* Tc = (k & 1) ? TB : TA; bf16* Tn = (k & 1) ? TA : TB;
                f32x16 a1, a2;
#pragma unroll
                for (int g = 0; g < 16; ++g) { a1[g] = C.zf(); a2[g] = C.zf(); }
#pragma unroll
                for (int s2 = 0; s2 < 2; ++s2) { const bf16x8 fp = ldfrag(Pc + r * ldp + 16 * s2 + 8 * hh), ft = ldfrag(PTc + r * ldp + 16 * s2 + 8 * hh);
                    a1 = mfma32(ft, fp, a1);
                    a2 = mfma32(fp, ft, a2); }
#pragma unroll
                for (int g4 = 0; g4 < 4; ++g4) { u32x2 pk; pk.x = pk2(a1[4 * g4], a1[4 * g4 + 1]); pk.y = pk2(a1[4 * g4 + 2], a1[4 * g4 + 3]); *(u32x2*)(Pn + r * 40 + 8 * g4 + 4 * hh) = pk;
                    pk.x = pk2(a2[4 * g4], a2[4 * g4 + 1]); pk.y = pk2(a2[4 * g4 + 2], a2[4 * g4 + 3]); *(u32x2*)(PnT + r * 40 + 8 * g4 + 4 * hh) = pk; }
                asm volatile("s_waitcnt lgkmcnt(0)" ::: "memory");
#pragma unroll
                for (int g = 0; g < 16; ++g) a1[g] = C.zf();
#pragma unroll
                for (int s2 = 0; s2 < 2; ++s2) a1 = mfma32(ldfrag(PnT + r * 40 + 16 * s2 + 8 * hh), ldfrag(Tc + r * 40 + 16 * s2 + 8 * hh), a1);
#pragma unroll
                for (int g4 = 0; g4 < 4; ++g4) { float t4[4]; ld4(Tc + r * 40 + 8 * g4 + 4 * hh, t4);
                    u32x2 pk; pk.x = pk2(t4[0] + a1[4 * g4], t4[1] + a1[4 * g4 + 1]); pk.y = pk2(t4[2] + a1[4 * g4 + 2], t4[3] + a1[4 * g4 + 3]); *(u32x2*)(Tn + r * 40 + 8 * g4 + 4 * hh) = pk; }
                asm volatile("s_waitcnt lgkmcnt(0)" ::: "memory");
                Pc = Pn; PTc = PnT; ldp = 40;
            }
        } else if (w >= 4) {
            const int ti = (w >> 1) & 1, vj = w & 1;
            f32x16 acc;
#pragma unroll
            for (int g = 0; g < 16; ++g) acc[g] = C.zf();
#pragma unroll
            for (int s4 = 0; s4 < 4; ++s4) acc = mfma32(ldfrag(Ak + (32 * ti + r) * LD64 + 16 * s4 + 8 * hh), ldfrag(VT + (32 * vj + r) * LD64 + 16 * s4 + 8 * hh), acc);
#pragma unroll
            for (int g4 = 0; g4 < 4; ++g4) { u32x2 pk; pk.x = pk2(acc[4 * g4], acc[4 * g4 + 1]); pk.y = pk2(acc[4 * g4 + 2], acc[4 * g4 + 3]); *(u32x2*)(UT + (32 * vj + r) * LD64 + 32 * ti + 8 * g4 + 4 * hh) = pk; }
        }
        lds_barrier();
        for (int rp = 0; rp < (RPROBE == 9 ? 2 : 1); ++rp)
        if (w < 4) {
            bf16* XT = (w < 2 ? WT : UT) + (32 * (w & 1) + r) * LD64;
            const bf16* T00 = WK0 + 5120; const bf16* T11 = WK1 + 5120;
            f32x16 acc;
#pragma unroll
            for (int g = 0; g < 16; ++g) acc[g] = C.zf();
#pragma unroll
            for (int s2 = 0; s2 < 2; ++s2) acc = mfma32(ldfrag(T00 + r * 40 + 16 * s2 + 8 * hh), ldfrag(XT + 16 * s2 + 8 * hh), acc);
#pragma unroll
            for (int g4 = 0; g4 < 4; ++g4) { u32x2 pk; pk.x = pk2(acc[4 * g4], acc[4 * g4 + 1]); pk.y = pk2(acc[4 * g4 + 2], acc[4 * g4 + 3]); *(u32x2*)(XT + 8 * g4 + 4 * hh) = pk; }
            asm volatile("s_waitcnt lgkmcnt(0)" ::: "memory");
#pragma unroll
            for (int g = 0; g < 16; ++g) acc[g] = C.zf();
#pragma unroll
            for (int s2 = 0; s2 < 2; ++s2) acc = mfma32(ldfrag(AbI + (32 + r) * LD64 + 16 * s2 + 8 * hh), ldfrag(XT + 16 * s2 + 8 * hh), acc);
#pragma unroll
            for (int g4 = 0; g4 < 4; ++g4) { float r4[4]; ld4(XT + 32 + 8 * g4 + 4 * hh, r4);
                u32x2 pk; pk.x = pk2(r4[0] - acc[4 * g4], r4[1] - acc[4 * g4 + 1]); pk.y = pk2(r4[2] - acc[4 * g4 + 2], r4[3] - acc[4 * g4 + 3]); *(u32x2*)(XT + 32 + 8 * g4 + 4 * hh) = pk; }
            asm volatile("s_waitcnt lgkmcnt(0)" ::: "memory");
#pragma unroll
            for (int g = 0; g < 16; ++g) acc[g] = C.zf();
#pragma unroll
            for (int s2 = 0; s2 < 2; ++s2) acc = mfma32(ldfrag(T11 + r * 40 + 16 * s2 + 8 * hh), ldfrag(XT + 32 + 16 * s2 + 8 * hh), acc);
#pragma unroll
            for (int g4 = 0; g4 < 4; ++g4) { u32x2 pk; pk.x = pk2(acc[4 * g4], acc[4 * g4 + 1]); pk.y = pk2(acc[4 * g4 + 2], acc[4 * g4 + 3]); *(u32x2*)(XT + 32 + 8 * g4 + 4 * hh) = pk; }
        }
        lds_barrier();
        {
            int t7 = tid; asm volatile("" : "+v"(t7));
            const int lane = t7 & 63, r = lane & 31, hh = lane >> 5;
            const int p2 = (w >> 1) & 1, xj = w & 1; const bool lo = w < 4;
            const bf16* A1 = lo ? Ark : KbT; const bf16* A2 = lo ? ArbN : BbTN;
            f32x16 acc;
#pragma unroll
            for (int g = 0; g < 16; ++g) acc[g] = C.zf();
#pragma unroll
            for (int s = 0; s < 4; ++s) acc = mfma32(ldfrag(A1 + (32 * p2 + r) * LD64 + 16 * s + 8 * hh), ldfrag(VT + (32 * xj + r) * LD64 + 16 * s + 8 * hh), acc);
#pragma unroll
            for (int s = 0; s < 4; ++s) acc = mfma32(ldfrag(A2 + (32 * p2 + r) * LD64 + 16 * s + 8 * hh), ldfrag(UT + (32 * xj + r) * LD64 + 16 * s + 8 * hh), acc);
            {   bf16* dst = lo ? GPTR(bf16, C.ws + WS_YP + (size_t)u * 8192) : (bf16*)GPTR(bf16, rwkv_zp(C, u));
                u32x4 q0, q1; q0.x = pk2(acc[0], acc[1]); q0.y = pk2(acc[2], acc[3]); q0.z = pk2(acc[4], acc[5]); q0.w = pk2(acc[6], acc[7]);
                q1.x = pk2(acc[8], acc[9]); q1.y = pk2(acc[10], acc[11]); q1.z = pk2(acc[12], acc[13]); q1.w = pk2(acc[14], acc[15]);
                *(u32x4*)(dst + ((p2 * 2 + xj) * 64 + lane) * 16) = q0; *(u32x4*)(dst + ((p2 * 2 + xj) * 64 + lane) * 16 + 8) = q1; }
#pragma unroll
            for (int g = 0; g < 16; ++g) acc[g] = C.zf();
#pragma unroll
            for (int s = 0; s < 4; ++s) acc = mfma32(ldfrag(WT + (32 * xj + r) * LD64 + 16 * s + 8 * hh), ldfrag(A2 + (32 * p2 + r) * LD64 + 16 * s + 8 * hh), acc);
            const int x = 32 * p2 + r;
            bf16* dst = lo ? GPTR(bf16, C.ws + WS_RP + (size_t)u * 8192) : GPTR(bf16, C.ws + WS_MM + (size_t)u * 8192);
#pragma unroll
            for (int g4 = 0; g4 < 4; ++g4) { const int c0 = 32 * xj + 8 * g4 + 4 * hh; float v4[4];
                if (lo) { float rt4[4]; ld4(Rt + x * LD64 + c0, rt4);
#pragma unroll
                    for (int q = 0; q < 4; ++q) v4[q] = acc[4 * g4 + q] + rt4[q]; }
                else {
#pragma unroll
                    for (int q = 0; q < 4; ++q) v4[q] = acc[4 * g4 + q] + ((c0 + q) == x ? sGL[x] : 0.f); }
                u32x2 pk; pk.x = pk2(v4[0], v4[1]); pk.y = pk2(v4[2], v4[3]);
                *(u32x2*)(dst + ((((x >> 5) * 4 + (c0 >> 4)) * 64 + (x & 31) + 32 * ((c0 >> 3) & 1)) * 8) + (c0 & 7)) = pk; }
        }
    }
}

#undef RP_LOAD
__device__ __forceinline__ void rwkv_chain3_block(const Ctx& C, int e, int rb, unsigned char* lds) {
    const int tid = C.tid(), lane = C.lane(), w = C.wave, r = lane & 31, hh = lane >> 5;
    const int b = rb >> 3, h = rb & 7;
    bf16* Y = GPTR(bf16, C.ws + WS_Y);
    bf16* ZT0 = (bf16*)lds; bf16* ZT1 = ZT0 + 64 * LD64;
    for (int i = tid; i < 2 * 64 * LD64 / 2; i += NTHREADS) ((unsigned*)ZT0)[i] = 0u;
    const bool lo = w < 4; const int p2 = (w >> 1) & 1, xj = w & 1;
    bf16x8 af[4][4]; u32x4 i0[4], i1[4];
#define R3_LOAD(j_, ch_) do { const int u_ = (rb * 64) + (ch_); const bf16* A_ = lo ? GPTR(const bf16, C.ws + WS_RP + (size_t)u_ * 8192) : GPTR(const bf16, C.ws + WS_MM + (size_t)u_ * 8192); \
        const bf16* I_ = lo ? GPTR(const bf16, C.ws + WS_YP + (size_t)u_ * 8192) : (const bf16*)GPTR(const bf16, rwkv_zp(C, u_)); \
        _Pragma("unroll") for (int s = 0; s < 4; ++s) af[j_][s] = *(const bf16x8*)(A_ + ((p2 * 4 + s) * 64 + lane) * 8); \
        i0[j_] = *(const u32x4*)(I_ + ((p2 * 2 + xj) * 64 + lane) * 16); i1[j_] = *(const u32x4*)(I_ + ((p2 * 2 + xj) * 64 + lane) * 16 + 8); } while (0)
    R3_LOAD(0, 0); RING_FENCE; R3_LOAD(1, 1); RING_FENCE; R3_LOAD(2, 2); RING_FENCE; R3_LOAD(3, 3); RING_FENCE;
    __syncthreads();
#pragma unroll 1
    for (int ch0 = 0; ch0 < SEQ / 64; ch0 += 4) {
#pragma unroll
        for (int j = 0; j < 4; ++j) {
            const int ch = ch0 + j;
            const bf16* ZTc = (j & 1) ? ZT1 : ZT0; bf16* ZTn = (j & 1) ? ZT0 : ZT1;
            f32x16 acc;
            acc[0] = bf2f(i0[j].x & 0xffffu); acc[1] = bf2f(i0[j].x >> 16); acc[2] = bf2f(i0[j].y & 0xffffu); acc[3] = bf2f(i0[j].y >> 16);
            acc[4] = bf2f(i0[j].z & 0xffffu); acc[5] = bf2f(i0[j].z >> 16); acc[6] = bf2f(i0[j].w & 0xffffu); acc[7] = bf2f(i0[j].w >> 16);
            acc[8] = bf2f(i1[j].x & 0xffffu); acc[9] = bf2f(i1[j].x >> 16); acc[10] = bf2f(i1[j].y & 0xffffu); acc[11] = bf2f(i1[j].y >> 16);
            acc[12] = bf2f(i1[j].z & 0xffffu); acc[13] = bf2f(i1[j].z >> 16); acc[14] = bf2f(i1[j].w & 0xffffu); acc[15] = bf2f(i1[j].w >> 16);
#pragma unroll
            for (int s = 0; s < 4; ++s) acc = mfma32(af[j][s], ldfrag(ZTc + (32 * xj + r) * LD64 + 16 * s + 8 * hh), acc);
            R3_LOAD(j, (ch + 4 < SEQ / 64 ? ch + 4 : SEQ / 64 - 1));
            if (lo) {
                const size_t m0 = (size_t)b * SEQ + 64 * ch;
#pragma unroll
                for (int g = 0; g < 16; ++g) Y[(m0 + 32 * p2 + drow(g, hh)) * DM + 512 + h * 64 + 32 * xj + r] = (bf16)f2bf(acc[g]);
            } else {
#pragma unroll
                for (int g4 = 0; g4 < 4; ++g4) { u32x2 pk; pk.x = pk2(acc[4 * g4], acc[4 * g4 + 1]); pk.y = pk2(acc[4 * g4 + 2], acc[4 * g4 + 3]);
                    *(u32x2*)(ZTn + (32 * xj + r) * LD64 + 32 * p2 + 8 * g4 + 4 * hh) = pk; }
            }
            lds_barrier();
        }
    }
#undef R3_LOAD
}

constexpr size_t WS_QKD = WS_R1 + (size_t)M * OD_PAD * 2;
static_assert(WS_QKD + 8 * MiB == WS_R1 + 128 * MiB, "odd-layer map");
constexpr size_t P_PITCH = (size_t)OD_PAD * 2;

__device__ __forceinline__ void gdn_pre3(const Ctx& C, int o_in, int unit_in, unsigned char* lds, bool dummy = false) {
    int o = o_in, unit = unit_in; asm volatile("" : "+s"(o), "+s"(unit));
    int tid_ = C.tid(); asm volatile("" : "+v"(tid_));
    const int tid = tid_, lane = tid & 63, w = __builtin_amdgcn_readfirstlane(tid >> 6), r = lane & 31, hh = lane >> 5;
    const int bh = unit >> 6, n = unit & 63, b = bh >> 2, h = bh & 3, t0 = n * 64;
    const size_t m0 = (size_t)b * SEQ + t0;
    const bf16* P = GPTR(const bf16, C.ws + WS_R1); const bf16* HALO = GPTR(const bf16, C.ws + WS_HALO);
    const float* convw = C.in(28) + (size_t)o * 4 * 1536;
    bf16* QhB = (bf16*)lds; bf16* KhB = QhB + 64 * LD128; bf16* XW = KhB + 64 * LD128; bf16* XU = XW + 128 * LD64;
    bf16* AbI = XU + 128 * LD64; bf16* AbT = AbI + 64 * LD64; bf16* QKdI = AbT + 64 * LD64; bf16* WK0 = QKdI + 64 * LD64; bf16* WK1 = WK0 + 7680;
    float* sGC = (float*)(WK1 + 7680); float* sBe = sGC + 64; float* sEg = sBe + 64; float* sBE = sEg + 64; float* sEk = sBE + 64;
    lds_barrier();
    if (w == 0) {
        const bf16* row = P + (m0 + lane) * OD_PAD; const float be = sigm(bf2f(row[OC_GB + h]));
        float g = -fexp(C.in(29)[o * 4 + h]) * softplusf(bf2f(row[OC_GA + h]) + C.in(30)[o * 4 + h]);
#pragma unroll
        for (int d = 1; d < 64; d <<= 1) { const float upv = __shfl_up(g, d); if (lane >= d) g += upv; }
        const float gl = __shfl(g, 63); const float eg = fexp(g);
        sGC[lane] = g; sBe[lane] = be; sEg[lane] = eg; sBE[lane] = be * eg;
        sEk[lane] = fexp(gl - g);
        if (lane == 0) (GPTR(float, C.ws + WS_DEN) + (size_t)unit * 256)[128] = fexp(gl);
    }
    const int l16 = tid & 15, typ = (tid >> 4) & 1, tg = tid >> 5;
    float ko[4][8];
#define G3_ROW(t_) ((t_) >= t0 ? P + ((size_t)b * SEQ + (t_)) * OD_PAD : HALO + ((size_t)((b * 64 + n - 1) * 3 + ((t_) - (t0 - 3)))) * OD_PAD)
    lds_barrier();
    {
#pragma unroll
        for (int pass = 0; pass < 2; ++pass) {
            if (pass == 1 && typ) break;
            const int pc = (pass ? 1024 : (typ ? 512 : 0)) + h * 128 + 8 * l16;
            float cw[4][8];
#pragma unroll
            for (int k = 0; k < 4; ++k) { const f32x4 a = *(const f32x4*)(convw + k * 1536 + pc), c2 = *(const f32x4*)(convw + k * 1536 + pc + 4);
                cw[k][0] = a[0]; cw[k][1] = a[1]; cw[k][2] = a[2]; cw[k][3] = a[3]; cw[k][4] = c2[0]; cw[k][5] = c2[1]; cw[k][6] = c2[2]; cw[k][7] = c2[3]; }
            float x[4][8];
#pragma unroll
            for (int i = 0; i < 3; ++i) { const int t = t0 + 4 * tg - 3 + i;
                if (t >= 0) ld8(G3_ROW(t) + pc, x[i]); else {
#pragma unroll
                    for (int j = 0; j < 8; ++j) x[i][j] = C.zf(); } }
            float vv[4][8];
#pragma unroll
            for (int tt = 0; tt < 4; ++tt) { const int tl = 4 * tg + tt; float o8[8]; float ss = C.zf();
                ld8(P + (m0 + tl) * OD_PAD + pc, x[(tt + 3) & 3]);
#pragma unroll
                for (int j = 0; j < 8; ++j) { float a = C.zf();
#pragma unroll
                    for (int k = 0; k < 4; ++k) a += cw[k][j] * x[(tt + k) & 3][j];
                    a = siluf(a); o8[j] = a; ss += a * a; }
                if (pass == 0) {
                    ss = row_sum16(ss);
                    const float sc = frsq(ss + 1e-6f) * (typ ? 1.0f : 0.08838834764831845f);
#pragma unroll
                    for (int j = 0; j < 8; ++j) o8[j] *= sc;
                    u32x4 pk; pk.x = pk2(o8[0], o8[1]); pk.y = pk2(o8[2], o8[3]); pk.z = pk2(o8[4], o8[5]); pk.w = pk2(o8[6], o8[7]);
                    *(u32x4*)((typ ? KhB : QhB) + tl * LD128 + 8 * l16) = pk;
                    if (typ) {
#pragma unroll
                        for (int j = 0; j < 8; ++j) ko[tt][j] = o8[j];
                    }
                } else {
#pragma unroll
                    for (int j = 0; j < 8; ++j) vv[tt][j] = o8[j] * sBe[tl];
                }
            }
            if (pass == 0 && typ) {
#pragma unroll
                for (int j = 0; j < 8; ++j) { u32x2 pk; pk.x = pk2(ko[0][j] * sBE[4 * tg], ko[1][j] * sBE[4 * tg + 1]); pk.y = pk2(ko[2][j] * sBE[4 * tg + 2], ko[3][j] * sBE[4 * tg + 3]); *(u32x2*)(XW + (8 * l16 + j) * LD64 + 4 * tg) = pk; }
            }
            if (pass == 1) {
#pragma unroll
                for (int j = 0; j < 8; ++j) { u32x2 pk; pk.x = pk2(vv[0][j], vv[1][j]); pk.y = pk2(vv[2][j], vv[3][j]); *(u32x2*)(XU + (8 * l16 + j) * LD64 + 4 * tg) = pk; }
            }
        }
    }
    lds_barrier();
    {
        bf16* Pw = GPTR(bf16, C.ws + WS_R1);
#pragma unroll
        for (int q = 0; q < 2; ++q) { const int p = tid + 512 * q, ln = p & 63, s8 = (p >> 6) & 7, R = p >> 9;
            float v8[8]; ld8(QhB + (32 * R + (ln & 31)) * LD128 + 16 * s8 + 8 * (ln >> 5), v8); const float eg = sEg[32 * R + (ln & 31)];
            u32x4 pk; pk.x = pk2(v8[0] * eg, v8[1] * eg); pk.y = pk2(v8[2] * eg, v8[3] * eg); pk.z = pk2(v8[4] * eg, v8[5] * eg); pk.w = pk2(v8[6] * eg, v8[7] * eg);
            if (!dummy) *(u32x4*)(Pw + (m0 + (p >> 4)) * OD_PAD + h * 128 + (p & 15) * 8) = pk; }
#pragma unroll
        for (int q = 0; q < 2; ++q) { const int p = tid + 512 * q, ln = p & 63, s4 = (p >> 6) & 3, kt = p >> 8;
            const int k = 32 * kt + (ln & 31), tq = 16 * s4 + 8 * (ln >> 5);
            float e[8];
#pragma unroll
            for (int j = 0; j < 8; ++j) e[j] = bf2f((unsigned)(unsigned short)KhB[(tq + j) * LD128 + k]) * sEk[tq + j];
            u32x4 pk; pk.x = pk2(e[0], e[1]); pk.y = pk2(e[2], e[3]); pk.z = pk2(e[4], e[5]); pk.w = pk2(e[6], e[7]);
            if (!dummy) *(u32x4*)(Pw + (m0 + (p >> 4)) * OD_PAD + 512 + h * 128 + (p & 15) * 8) = pk; }
#pragma unroll 1
        for (int job = w; job < 10; job += 8) {
            const bool tr = job == 4 || job == 5, isq = job >= 6; const int jj = isq ? job - 6 : job; const int ti = tr ? job - 4 : ((jj >> 1) & 1), tj = tr ? ti : (jj & 1);
            const bf16* first = isq ? QhB : KhB;
            f32x16 acc;
#pragma unroll
            for (int g = 0; g < 16; ++g) acc[g] = C.zf();
            const bf16* opA = tr ? first + (32 * ti + r) * LD128 : KhB + (32 * tj + r) * LD128; const bf16* opB = tr ? KhB + (32 * tj + r) * LD128 : first + (32 * ti + r) * LD128;
            if (tj <= ti) {
#pragma unroll
                for (int s8 = 0; s8 < 8; ++s8) acc = mfma32(ldfrag(opA + 16 * s8 + 8 * hh), ldfrag(opB + 16 * s8 + 8 * hh), acc);
            }
            const int fx = 32 * (tr ? tj : ti) + r;
            bf16* dstI = tr ? AbT : (isq ? QKdI : AbI);
#pragma unroll
            for (int g4 = 0; g4 < 4; ++g4) { float v4[4];
#pragma unroll
                for (int q = 0; q < 4; ++q) { const int y = 32 * (tr ? ti : tj) + 8 * g4 + 4 * hh + q; const int tt_ = tr ? y : fx, ii_ = tr ? fx : y;
                    const float dec = fexp(sGC[tt_] - sGC[ii_]);
                    v4[q] = isq ? (ii_ <= tt_ ? acc[4 * g4 + q] * dec : 0.f) : (ii_ < tt_ ? acc[4 * g4 + q] * dec * sBe[tt_] : 0.f); }
                u32x2 pk; pk.x = pk2(v4[0], v4[1]); pk.y = pk2(v4[2], v4[3]);
                *(u32x2*)(dstI + fx * LD64 + 32 * (tr ? ti : tj) + 8 * g4 + 4 * hh) = pk; }
        }
    }
    lds_barrier();
    if (w < 2) {
        const int d = w; bf16* wk = d ? WK1 : WK0;
        bf16* PA = wk; bf16* PAT = wk + 1280; bf16* PB = wk + 2560; bf16* PBT = wk + 3840; bf16* TA = wk + 5120; bf16* TB = wk + 6400;
        const bf16* Pc = AbI + (32 * d) * LD64 + 32 * d; const bf16* PTc = AbT + (32 * d) * LD64 + 32 * d; int ldp = LD64;
        {   float v8[8], o8[8];
#pragma unroll
            for (int q = 0; q < 2; ++q) { ld8(Pc + r * LD64 + 16 * hh + 8 * q, v8);
#pragma unroll
                for (int j = 0; j < 8; ++j) o8[j] = ((16 * hh + 8 * q + j) == r ? 1.0f : 0.0f) - v8[j];
                u32x4 pk; pk.x = pk2(o8[0], o8[1]); pk.y = pk2(o8[2], o8[3]); pk.z = pk2(o8[4], o8[5]); pk.w = pk2(o8[6], o8[7]); *(u32x4*)(TA + r * 40 + 16 * hh + 8 * q) = pk; } }
        asm volatile("s_waitcnt lgkmcnt(0)" ::: "memory");
#pragma unroll
        for (int k = 0; k < 4; ++k) {
            bf16* Pn = (k & 1) ? PA : PB; bf16* PnT = (k & 1) ? PAT : PBT; const bf16* Tc = (k & 1) ? TB : TA; bf16* Tn = (k & 1) ? TA : TB;
            f32x16 a1, a2;
#pragma unroll
            for (int g = 0; g < 16; ++g) { a1[g] = C.zf(); a2[g] = C.zf(); }
#pragma unroll
            for (int s2 = 0; s2 < 2; ++s2) { const bf16x8 fp = ldfrag(Pc + r * ldp + 16 * s2 + 8 * hh), ft = ldfrag(PTc + r * ldp + 16 * s2 + 8 * hh);
                a1 = mfma32(ft, fp, a1); a2 = mfma32(fp, ft, a2); }
#pragma unroll
            for (int g4 = 0; g4 < 4; ++g4) { u32x2 pk; pk.x = pk2(a1[4 * g4], a1[4 * g4 + 1]); pk.y = pk2(a1[4 * g4 + 2], a1[4 * g4 + 3]); *(u32x2*)(Pn + r * 40 + 8 * g4 + 4 * hh) = pk;
                pk.x = pk2(a2[4 * g4], a2[4 * g4 + 1]); pk.y = pk2(a2[4 * g4 + 2], a2[4 * g4 + 3]); *(u32x2*)(PnT + r * 40 + 8 * g4 + 4 * hh) = pk; }
            asm volatile("s_waitcnt lgkmcnt(0)" ::: "memory");
#pragma unroll
            for (int g = 0; g < 16; ++g) a1[g] = C.zf();
#pragma unroll
            for (int s2 = 0; s2 < 2; ++s2) a1 = mfma32(ldfrag(PnT + r * 40 + 16 * s2 + 8 * hh), ldfrag(Tc + r * 40 + 16 * s2 + 8 * hh), a1);
#pragma unroll
            for (int g4 = 0; g4 < 4; ++g4) { float t4[4]; ld4(Tc + r * 40 + 8 * g4 + 4 * hh, t4);
                u32x2 pk; pk.x = pk2(t4[0] + a1[4 * g4], t4[1] + a1[4 * g4 + 1]); pk.y = pk2(t4[2] + a1[4 * g4 + 2], t4[3] + a1[4 * g4 + 3]); *(u32x2*)(Tn + r * 40 + 8 * g4 + 4 * hh) = pk; }
            asm volatile("s_waitcnt lgkmcnt(0)" ::: "memory");
            Pc = Pn; PTc = PnT; ldp = 40;
        }
    }
    lds_barrier();
    {
        bf16* XT = (w < 4 ? XW : XU) + (32 * (w & 3) + r) * LD64;
        const bf16* T00 = WK0 + 5120; const bf16* T11 = WK1 + 5120;
        f32x16 acc;
#pragma unroll
        for (int g = 0; g < 16; ++g) acc[g] = C.zf();
#pragma unroll
        for (int s2 = 0; s2 < 2; ++s2) acc = mfma32(ldfrag(T00 + r * 40 + 16 * s2 + 8 * hh), ldfrag(XT + 16 * s2 + 8 * hh), acc);
#pragma unroll
        for (int g4 = 0; g4 < 4; ++g4) { u32x2 pk; pk.x = pk2(acc[4 * g4], acc[4 * g4 + 1]); pk.y = pk2(acc[4 * g4 + 2], acc[4 * g4 + 3]); *(u32x2*)(XT + 8 * g4 + 4 * hh) = pk; }
        asm volatile("s_waitcnt lgkmcnt(0)" ::: "memory");
#pragma unroll
        for (int g = 0; g < 16; ++g) acc[g] = C.zf();
#pragma unroll
        for (int s2 = 0; s2 < 2; ++s2) acc = mfma32(ldfrag(AbI + (32 + r) * LD64 + 16 * s2 + 8 * hh), ldfrag(XT + 16 * s2 + 8 * hh), acc);
#pragma unroll
        for (int g4 = 0; g4 < 4; ++g4) { float r4[4]; ld4(XT + 32 + 8 * g4 + 4 * hh, r4);
            u32x2 pk; pk.x = pk2(r4[0] - acc[4 * g4], r4[1] - acc[4 * g4 + 1]); pk.y = pk2(r4[2] - acc[4 * g4 + 2], r4[3] - acc[4 * g4 + 3]); *(u32x2*)(XT + 32 + 8 * g4 + 4 * hh) = pk; }
        asm volatile("s_waitcnt lgkmcnt(0)" ::: "memory");
#pragma unroll
        for (int g = 0; g < 16; ++g) acc[g] = C.zf();
#pragma unroll
        for (int s2 = 0; s2 < 2; ++s2) acc = mfma32(ldfrag(T11 + r * 40 + 16 * s2 + 8 * hh), ldfrag(XT + 32 + 16 * s2 + 8 * hh), acc);
#pragma unroll
        for (int g4 = 0; g4 < 4; ++g4) { u32x2 pk; pk.x = pk2(acc[4 * g4], acc[4 * g4 + 1]); pk.y = pk2(acc[4 * g4 + 2], acc[4 * g4 + 3]); *(u32x2*)(XT + 32 + 8 * g4 + 4 * hh) = pk; }
    }
    lds_barrier();
    {
        bf16* Wg = GPTR(bf16, C.ws + WS_XB + (size_t)unit * GDN_UNIT_BYTES); bf16* Ug = Wg + 64 * 128; bf16* Qg = GPTR(bf16, C.ws + WS_QKD + (size_t)unit * 8192);
#pragma unroll
        for (int q = 0; q < 2; ++q) { const int p = tid + 512 * q, ln = p & 63, s8 = (p >> 6) & 7, R = p >> 9; const int t = 32 * R + (ln & 31), c0 = 16 * s8 + 8 * (ln >> 5);
            unsigned e[8];
#pragma unroll
            for (int j = 0; j < 8; ++j) e[j] = XW[(c0 + j) * LD64 + t] ^ 0x8000u;
            u32x4 pk; pk.x = e[0] | (e[1] << 16); pk.y = e[2] | (e[3] << 16); pk.z = e[4] | (e[5] << 16); pk.w = e[6] | (e[7] << 16);
            *(u32x4*)(Wg + p * 8) = pk; }
#pragma unroll
        for (int q = 0; q < 2; ++q) { const int p = tid + 512 * q, tile = p >> 7, ln = (p >> 1) & 63, q8 = p & 1;
            const int v = 32 * (tile & 3) + (ln & 31), hq = ln >> 5, thh = tile >> 2;
            const u32x2 a = *(const u32x2*)(XU + v * LD64 + 32 * thh + 8 * (2 * q8) + 4 * hq), c2 = *(const u32x2*)(XU + v * LD64 + 32 * thh + 8 * (2 * q8 + 1) + 4 * hq);
            u32x4 pk; pk.x = a.x; pk.y = a.y; pk.z = c2.x; pk.w = c2.y;
            *(u32x4*)(Ug + p * 8) = pk; }
        {   const int p = tid, ln = p & 63, s4 = (p >> 6) & 3, R = p >> 8;
            *(u32x4*)(Qg + p * 8) = *(const u32x4*)(QKdI + (32 * R + (ln & 31)) * LD64 + 16 * s4 + 8 * (ln >> 5)); }
    }
#undef G3_ROW
}

__device__ __forceinline__ void gdn_chain4_block(const Ctx& C, int gb, int c, unsigned char* lds) {
    const int w = C.wave;
    const int b = gb >> 2, h = gb & 3;
    const bf16* P = GPTR(const bf16, C.ws + WS_R1); bf16* Y = GPTR(bf16, C.ws + WS_Y);
    bf16* VNT = (bf16*)lds; bf16* ST = VNT + 32 * LD64;
    for (int i = C.tid(); i < 32 * LD128 / 2; i += NTHREADS) ((unsigned*)ST)[i] = 0u;
#define G4_LANE int ln_ = C.lane(); asm volatile("" : "+v"(ln_)); const int lane = ln_, r = lane & 31, hh = lane >> 5;
    if (w < 2) {
        const int th = w; G4_LANE
        bf16x8 wf[4][8]; u32x4 u0[4], u1[4];
#define G4_LV(j_, ch_) do { const int u_ = gb * 64 + (ch_); const bf16* Wg_ = GPTR(const bf16, C.ws + WS_XB + (size_t)u_ * GDN_UNIT_BYTES); const bf16* Ug_ = Wg_ + 64 * 128; \
        _Pragma("unroll") for (int s = 0; s < 8; ++s) wf[j_][s] = *(const bf16x8*)(Wg_ + ((th * 8 + s) * 64 + lane) * 8); \
        u0[j_] = *(const u32x4*)(Ug_ + ((th * 4 + c) * 64 + lane) * 16); u1[j_] = *(const u32x4*)(Ug_ + ((th * 4 + c) * 64 + lane) * 16 + 8); } while (0)
        G4_LV(0, 0); RING_FENCE; G4_LV(1, 1); RING_FENCE; G4_LV(2, 2); RING_FENCE; G4_LV(3, 3); RING_FENCE;
        __syncthreads();
#pragma unroll 1
        for (int ch0 = 0; ch0 < SEQ / 64; ch0 += 4) {
#pragma unroll
            for (int j = 0; j < 4; ++j) {
                const int ch = ch0 + j;
                f32x16 acc;
                acc[0] = bf2f(u0[j].x & 0xffffu); acc[1] = bf2f(u0[j].x >> 16); acc[2] = bf2f(u0[j].y & 0xffffu); acc[3] = bf2f(u0[j].y >> 16);
                acc[4] = bf2f(u0[j].z & 0xffffu); acc[5] = bf2f(u0[j].z >> 16); acc[6] = bf2f(u0[j].w & 0xffffu); acc[7] = bf2f(u0[j].w >> 16);
                acc[8] = bf2f(u1[j].x & 0xffffu); acc[9] = bf2f(u1[j].x >> 16); acc[10] = bf2f(u1[j].y & 0xffffu); acc[11] = bf2f(u1[j].y >> 16);
                acc[12] = bf2f(u1[j].z & 0xffffu); acc[13] = bf2f(u1[j].z >> 16); acc[14] = bf2f(u1[j].w & 0xffffu); acc[15] = bf2f(u1[j].w >> 16);
#pragma unroll
                for (int s = 0; s < 8; ++s) acc = mfma32(wf[j][s], ldfrag(ST + r * LD128 + 16 * s + 8 * hh), acc);
#pragma unroll
                for (int g4 = 0; g4 < 4; ++g4) { u32x2 pk; pk.x = pk2(acc[4 * g4], acc[4 * g4 + 1]); pk.y = pk2(acc[4 * g4 + 2], acc[4 * g4 + 3]);
                    *(u32x2*)(VNT + r * LD64 + 32 * th + 8 * g4 + 4 * hh) = pk; }
                G4_LV(j, (ch + 4 < SEQ / 64 ? ch + 4 : SEQ / 64 - 1));
                lds_barrier();
                lds_barrier();
            }
        }
#undef G4_LV
    } else if (w < 4) {
        const int th = w - 2; G4_LANE
        bf16x8 qf[4][8], kq[2][4];
#define G4_LO(j_, ch_) do { const int u_ = gb * 64 + (ch_); const bf16* qsec_ = P + ((size_t)b * SEQ + 64 * (ch_)) * OD_PAD + h * 128; (void)u_; \
        _Pragma("unroll") for (int s = 0; s < 8; ++s) { const int p_ = (th * 8 + s) * 64 + lane; qf[j_][s] = *(const bf16x8*)(qsec_ + (size_t)(p_ >> 4) * OD_PAD + (p_ & 15) * 8); } \
        } while (0)
#define G4_LK(j_, ch_) do { const bf16* Qg_ = GPTR(const bf16, C.ws + WS_QKD + (size_t)(gb * 64 + (ch_)) * 8192); \
        _Pragma("unroll") for (int s = 0; s < 4; ++s) kq[j_][s] = *(const bf16x8*)(Qg_ + ((th * 4 + s) * 64 + lane) * 8); } while (0)
        G4_LO(0, 0); G4_LK(0, 0); RING_FENCE; G4_LO(1, 1); G4_LK(1, 1); RING_FENCE; G4_LO(2, 2); RING_FENCE; G4_LO(3, 3); RING_FENCE;
        __syncthreads();
#pragma unroll 1
        for (int ch0 = 0; ch0 < SEQ / 64; ch0 += 4) {
#pragma unroll
            for (int j = 0; j < 4; ++j) {
                const int ch = ch0 + j; const size_t m0 = (size_t)b * SEQ + 64 * ch;
                f32x16 oacc;
#pragma unroll
                for (int g = 0; g < 16; ++g) oacc[g] = C.zf();
#pragma unroll
                for (int s = 0; s < 8; ++s) oacc = mfma32(ldfrag(ST + r * LD128 + 16 * s + 8 * hh), qf[j][s], oacc);
                lds_barrier();
#pragma unroll
                for (int s = 0; s < 4; ++s) oacc = mfma32(ldfrag(VNT + r * LD64 + 16 * s + 8 * hh), kq[j & 1][s], oacc);
                G4_LK(j & 1, (ch + 2 < SEQ / 64 ? ch + 2 : SEQ / 64 - 1)); G4_LO(j, (ch + 4 < SEQ / 64 ? ch + 4 : SEQ / 64 - 1));
#pragma unroll
                for (int g4 = 0; g4 < 4; ++g4) { u32x2 pk; pk.x = pk2(oacc[4 * g4], oacc[4 * g4 + 1]); pk.y = pk2(oacc[4 * g4 + 2], oacc[4 * g4 + 3]);
                    *(u32x2*)(Y + (m0 + 32 * th + r) * DM + h * 128 + 32 * c + 8 * g4 + 4 * hh) = pk; }
                lds_barrier();
            }
        }
#undef G4_LO
#undef G4_LK
    } else {
        const int kt = w - 4; G4_LANE
        int lz = 0; asm volatile("" : "+v"(lz));
        bf16x8 kf[4][4]; float glv[4];
        f32x16 S;
#pragma unroll
        for (int g = 0; g < 16; ++g) S[g] = C.zf();
#define G4_LS(j_, ch_) do { const int u_ = gb * 64 + (ch_); const bf16* ksec_ = P + ((size_t)b * SEQ + 64 * (ch_)) * OD_PAD + 512 + h * 128; \
        _Pragma("unroll") for (int s = 0; s < 4; ++s) { const int p_ = (kt * 4 + s) * 64 + lane; kf[j_][s] = *(const bf16x8*)(ksec_ + (size_t)(p_ >> 4) * OD_PAD + (p_ & 15) * 8); } \
        glv[j_] = (GPTR(const float, C.ws + WS_DEN) + (size_t)u_ * 256)[128 + lz]; } while (0)
        G4_LS(0, 0); RING_FENCE; G4_LS(1, 1); RING_FENCE; G4_LS(2, 2); RING_FENCE; G4_LS(3, 3); RING_FENCE;
        __syncthreads();
#pragma unroll 1
        for (int ch0 = 0; ch0 < SEQ / 64; ch0 += 4) {
#pragma unroll
            for (int j = 0; j < 4; ++j) {
                const int ch = ch0 + j;
                const float gl_ = glv[j];
#pragma unroll
                for (int g = 0; g < 16; ++g) S[g] *= gl_;
                lds_barrier();
#pragma unroll
                for (int s = 0; s < 4; ++s) S = mfma32(kf[j][s], ldfrag(VNT + r * LD64 + 16 * s + 8 * hh), S);
#pragma unroll
                for (int g4 = 0; g4 < 4; ++g4) { u32x2 pk; pk.x = pk2(S[4 * g4], S[4 * g4 + 1]); pk.y = pk2(S[4 * g4 + 2], S[4 * g4 + 3]);
                    *(u32x2*)(ST + r * LD128 + 32 * kt + 8 * g4 + 4 * hh) = pk; }
                G4_LS(j, (ch + 4 < SEQ / 64 ? ch + 4 : SEQ / 64 - 1));
                lds_barrier();
            }
        }
#undef G4_LS
    }
#undef G4_LANE
}

__device__ __forceinline__ bf16* ml_dc_piece(bf16* Pw, size_t m0, int h, int p) {
    const int pr = p & 15; return Pw + (m0 + (p >> 4)) * OD_PAD + OC_MQK + (pr < 8 ? h * 64 + pr * 8 : 256 + h * 64 + (pr - 8) * 8); }
__device__ __forceinline__ void mlstm_pre3(const Ctx& C, int o_in, int unit_in, unsigned char* lds, bool dummy = false) {
    int o = o_in, unit = unit_in; asm volatile("" : "+s"(o), "+s"(unit));
    int tid_ = C.tid(); asm volatile("" : "+v"(tid_));
    const int tid = tid_, lane = tid & 63, w = __builtin_amdgcn_readfirstlane(tid >> 6), r = lane & 31, hh = lane >> 5;
    const int bh = unit >> 6, n = unit & 63, b = bh >> 2, h = bh & 3, t0 = n * 64;
    const size_t m0 = (size_t)b * SEQ + t0;
    const bf16* P = GPTR(const bf16, C.ws + WS_R1); const bf16* HALO = GPTR(const bf16, C.ws + WS_HALO);
    const float* convw = C.in(32) + (size_t)o * 4 * 512;
    bf16* Qh = (bf16*)lds; bf16* Kh = Qh + 64 * LD64; bf16* KTs = Kh + 64 * LD64; bf16* Wm = KTs + 64 * LD64; bf16* VT = Wm + 64 * LD64;
    float* sB = (float*)(VT + 160 * LD64); float* sI = sB + 64; float* sEB = sI + 64; float* sEK = sEB + 64;
    float* tab = GPTR(float, C.ws + WS_DEN) + (size_t)unit * 256; float* tab2 = GPTR(float, C.ws + WS_BONUS + 512 * 1024) + (size_t)unit * 128;
    lds_barrier();
    if (w == 0) {
        const bf16* row = P + (m0 + lane) * OD_PAD; const float ip = bf2f(row[OC_MI + h]) + C.in(33)[o * 4 + h]; float lf = logsigm(bf2f(row[OC_MF + h]) + C.in(34)[o * 4 + h]);
#pragma unroll
        for (int d = 1; d < 64; d <<= 1) { const float up = __shfl_up(lf, d); if (lane >= d) lf += up; }
        const float bl = __shfl(lf, 63);
        sB[lane] = lf; sI[lane] = ip; sEB[lane] = fexp(lf); sEK[lane] = fexp(bl - lf + ip); if (lane == 0) tab[129] = fexp(bl);
    }
    for (int i = tid; i < 32 * LD64; i += NTHREADS) VT[128 * LD64 + i] = (i < 64) ? (bf16)0x3F80 : (bf16)0;
    for (int i = tid; i < 64 * LD64 / 2; i += NTHREADS) ((unsigned*)Wm)[i] = C.z0;
    const int l16 = tid & 15, typ = (tid >> 4) & 1, tg = tid >> 5;
    const int pc = OC_MQK + (typ ? 256 : 0) + h * 64 + 4 * l16;
    lds_barrier();
    {
        float cw[4][4], x[7][4], ko[4][4];
#pragma unroll
        for (int k = 0; k < 4; ++k)
#pragma unroll
            for (int j = 0; j < 4; ++j) cw[k][j] = convw[k * 512 + (typ ? 256 : 0) + h * 64 + 4 * l16 + j];
#pragma unroll
        for (int i = 0; i < 7; ++i) { const int t = t0 + 4 * tg - 3 + i;
            if (t >= 0) ld4((t >= t0 ? P + ((size_t)b * SEQ + t) * OD_PAD : HALO + ((size_t)((b * 64 + n - 1) * 3 + (t - (t0 - 3)))) * OD_PAD) + pc, x[i]);
            else { x[i][0] = x[i][1] = x[i][2] = x[i][3] = C.zf(); } }
#pragma unroll
        for (int tt = 0; tt < 4; ++tt) {
#pragma unroll
            for (int j = 0; j < 4; ++j) { float a = C.zf();
#pragma unroll
                for (int k = 0; k < 4; ++k) a += cw[k][j] * x[tt + k][j];
                a = siluf(a); ko[tt][j] = typ ? a : a * 0.125f; }
            u32x2 pk; pk.x = pk2(ko[tt][0], ko[tt][1]); pk.y = pk2(ko[tt][2], ko[tt][3]);
            *(u32x2*)((typ ? Kh : Qh) + (4 * tg + tt) * LD64 + 4 * l16) = pk; }
        if (typ) {
#pragma unroll
            for (int j = 0; j < 4; ++j) { u32x2 pk; pk.x = pk2(ko[0][j] * sEK[4 * tg], ko[1][j] * sEK[4 * tg + 1]); pk.y = pk2(ko[2][j] * sEK[4 * tg + 2], ko[3][j] * sEK[4 * tg + 3]); *(u32x2*)(KTs + (4 * l16 + j) * LD64 + 4 * tg) = pk; } }
        {   const int vt = tid & 63, vg = tid >> 6; const bf16* vr = P + (m0 + vt) * OD_PAD + OC_MV + h * 128 + 16 * vg; const u32x4 a = *(const u32x4*)vr, c2 = *(const u32x4*)(vr + 8);
            const unsigned wv[8] = {a.x, a.y, a.z, a.w, c2.x, c2.y, c2.z, c2.w};
#pragma unroll
            for (int q = 0; q < 8; ++q) { VT[(16 * vg + 2 * q) * LD64 + vt] = (bf16)(wv[q] & 0xffffu); VT[(16 * vg + 2 * q + 1) * LD64 + vt] = (bf16)(wv[q] >> 16); } }
    }
    lds_barrier();
    if (w < 3) {
        const int ti = w > 0 ? 1 : 0, tj = w > 1 ? 1 : 0;
        f32x16 acc;
#pragma unroll
        for (int g = 0; g < 16; ++g) acc[g] = C.zf();
#pragma unroll
        for (int s = 0; s < 4; ++s) acc = mfma32(ldfrag(Kh + (32 * tj + r) * LD64 + 16 * s + 8 * hh), ldfrag(Qh + (32 * ti + r) * LD64 + 16 * s + 8 * hh), acc);
        const int i = 32 * ti + r; const float bi = sB[i];
#pragma unroll
        for (int g4 = 0; g4 < 4; ++g4) { const f32x4 bj = *(const f32x4*)(sB + 32 * tj + 8 * g4 + 4 * hh), ij = *(const f32x4*)(sI + 32 * tj + 8 * g4 + 4 * hh); float v4[4];
#pragma unroll
            for (int q = 0; q < 4; ++q) { const int j = 32 * tj + 8 * g4 + 4 * hh + q; v4[q] = (j <= i) ? acc[4 * g4 + q] * fexp(bi - bj[q] + ij[q]) : 0.f; }
            u32x2 pk; pk.x = pk2(v4[0], v4[1]); pk.y = pk2(v4[2], v4[3]);
            *(u32x2*)(Wm + i * LD64 + 32 * tj + 8 * g4 + 4 * hh) = pk; }
    } else if (w >= 4) {
        bf16* Pw = GPTR(bf16, C.ws + WS_R1);
#pragma unroll
        for (int q = 0; q < 2; ++q) { const int p = (tid - 256) + 256 * q, ln = p & 63, s4 = (p >> 6) & 3, R = p >> 8; const int t = 32 * R + (ln & 31);
            float v8[8]; ld8(Qh + t * LD64 + 16 * s4 + 8 * (ln >> 5), v8); const float eb = sEB[t];
            u32x4 pk; pk.x = pk2(v8[0] * eb, v8[1] * eb); pk.y = pk2(v8[2] * eb, v8[3] * eb); pk.z = pk2(v8[4] * eb, v8[5] * eb); pk.w = pk2(v8[6] * eb, v8[7] * eb);
            if (!dummy) *(u32x4*)(Pw + (m0 + (p >> 4)) * OD_PAD + 1024 + h * 128 + (p & 15) * 8) = pk; }
    }
    lds_barrier();
    {
        bf16* Pw = GPTR(bf16, C.ws + WS_R1);
#pragma unroll 1
        for (int job = w; job < 20; job += 8) {
            const bool isc = job >= 10; const int jj = isc ? job - 10 : job, rt = jj / 5, vjj = jj % 5;
            const bf16* A = (isc ? KTs : Wm) + (32 * rt + r) * LD64;
            f32x16 acc;
#pragma unroll
            for (int g = 0; g < 16; ++g) acc[g] = C.zf();
#pragma unroll
            for (int s = 0; s < 4; ++s) acc = mfma32(ldfrag(A + 16 * s + 8 * hh), ldfrag(VT + (32 * vjj + r) * LD64 + 16 * s + 8 * hh), acc);
            if (vjj < 4) {
                u32x4 q0, q1; q0.x = pk2(acc[0], acc[1]); q0.y = pk2(acc[2], acc[3]); q0.z = pk2(acc[4], acc[5]); q0.w = pk2(acc[6], acc[7]);
                q1.x = pk2(acc[8], acc[9]); q1.y = pk2(acc[10], acc[11]); q1.z = pk2(acc[12], acc[13]); q1.w = pk2(acc[14], acc[15]);
                const int p0 = ((rt * 4 + vjj) * 64 + lane) * 2;
                if (dummy) {} else if (isc) { *(u32x4*)ml_dc_piece(Pw, m0, h, p0) = q0; *(u32x4*)ml_dc_piece(Pw, m0, h, p0 + 1) = q1; }
                else { *(u32x4*)(Pw + (m0 + (p0 >> 4)) * OD_PAD + OC_MV + h * 128 + (p0 & 15) * 8) = q0; *(u32x4*)(Pw + (m0 + ((p0 + 1) >> 4)) * OD_PAD + OC_MV + h * 128 + ((p0 + 1) & 15) * 8) = q1; }
            } else if (r == 0) {
#pragma unroll
                for (int g = 0; g < 16; ++g) tab2[(isc ? 64 : 0) + 32 * rt + drow(g, hh)] = acc[g];
            }
        }
    }
}

__device__ __forceinline__ void mlstm_chain4_block(const Ctx& C, int mb, int c, unsigned char* lds) {
    const int w = C.wave;
    const int b = mb >> 2, h = mb & 3;
    const bf16* P = GPTR(const bf16, C.ws + WS_R1); bf16* Y = GPTR(bf16, C.ws + WS_Y); float* den = GPTR(float, C.ws + WS_BONUS);
    bf16* CT0 = (bf16*)lds; bf16* CT1 = CT0 + 32 * LD64; float* sN = (float*)(CT1 + 32 * LD64);
    for (int i = C.tid(); i < 2 * 32 * LD64 / 2; i += NTHREADS) ((unsigned*)CT0)[i] = 0u;
    if (C.tid() < 128) sN[C.tid()] = 0.f;
#define M4_LANE int ln_ = C.lane(); asm volatile("" : "+v"(ln_)); const int lane = ln_, r = lane & 31, hh = lane >> 5; int lz = 0; asm volatile("" : "+v"(lz));
#define M4_QD(j_, mm_) _Pragma("unroll") for (int s = 0; s < 4; ++s) { const int p_ = (th * 4 + s) * 64 + lane; qd[j_][s] = *(const bf16x8*)(P + ((mm_) + (p_ >> 4)) * OD_PAD + 1024 + h * 128 + (p_ & 15) * 8); }
    if (w < 2) {
        const int th = w; M4_LANE
        f32x16 Cacc;
#pragma unroll
        for (int g = 0; g < 16; ++g) Cacc[g] = C.zf();
        bf16x8 qd[4][4]; u32x4 n0[4], n1[4], d0[4], d1[4]; float Fv[4];
#define M4_LT(j_, ch_) do { const size_t mm_ = (size_t)b * SEQ + 64 * (ch_); const int u_ = mb * 64 + (ch_); M4_QD(j_, mm_) \
        const int p0_ = ((th * 4 + c) * 64 + lane) * 2; \
        n0[j_] = *(const u32x4*)(P + (mm_ + (p0_ >> 4)) * OD_PAD + OC_MV + h * 128 + (p0_ & 15) * 8); n1[j_] = *(const u32x4*)(P + (mm_ + ((p0_ + 1) >> 4)) * OD_PAD + OC_MV + h * 128 + ((p0_ + 1) & 15) * 8); \
        d0[j_] = *(const u32x4*)ml_dc_piece((bf16*)P, mm_, h, p0_); d1[j_] = *(const u32x4*)ml_dc_piece((bf16*)P, mm_, h, p0_ + 1); \
        Fv[j_] = (GPTR(const float, C.ws + WS_DEN) + (size_t)u_ * 256)[129 + lz]; } while (0)
        M4_LT(0, 0); RING_FENCE; M4_LT(1, 1); RING_FENCE; M4_LT(2, 2); RING_FENCE; M4_LT(3, 3); RING_FENCE;
        __syncthreads();
#pragma unroll 1
        for (int ch0 = 0; ch0 < SEQ / 64; ch0 += 4) {
#pragma unroll
            for (int j = 0; j < 4; ++j) {
                const int ch = ch0 + j; const size_t m0 = (size_t)b * SEQ + 64 * ch;
                const bf16* CTc = (j & 1) ? CT1 : CT0; bf16* CTn = (j & 1) ? CT0 : CT1;
                const float F = Fv[j];
                f32x16 num;
                num[0] = bf2f(n0[j].x & 0xffffu); num[1] = bf2f(n0[j].x >> 16); num[2] = bf2f(n0[j].y & 0xffffu); num[3] = bf2f(n0[j].y >> 16); num[4] = bf2f(n0[j].z & 0xffffu); num[5] = bf2f(n0[j].z >> 16); num[6] = bf2f(n0[j].w & 0xffffu); num[7] = bf2f(n0[j].w >> 16);
                num[8] = bf2f(n1[j].x & 0xffffu); num[9] = bf2f(n1[j].x >> 16); num[10] = bf2f(n1[j].y & 0xffffu); num[11] = bf2f(n1[j].y >> 16); num[12] = bf2f(n1[j].z & 0xffffu); num[13] = bf2f(n1[j].z >> 16); num[14] = bf2f(n1[j].w & 0xffffu); num[15] = bf2f(n1[j].w >> 16);
#pragma unroll
                for (int s = 0; s < 4; ++s) num = mfma32(qd[j][s], ldfrag(CTc + r * LD64 + 16 * s + 8 * hh), num);
                {   float dc[16];
                    dc[0] = bf2f(d0[j].x & 0xffffu); dc[1] = bf2f(d0[j].x >> 16); dc[2] = bf2f(d0[j].y & 0xffffu); dc[3] = bf2f(d0[j].y >> 16); dc[4] = bf2f(d0[j].z & 0xffffu); dc[5] = bf2f(d0[j].z >> 16); dc[6] = bf2f(d0[j].w & 0xffffu); dc[7] = bf2f(d0[j].w >> 16);
                    dc[8] = bf2f(d1[j].x & 0xffffu); dc[9] = bf2f(d1[j].x >> 16); dc[10] = bf2f(d1[j].y & 0xffffu); dc[11] = bf2f(d1[j].y >> 16); dc[12] = bf2f(d1[j].z & 0xffffu); dc[13] = bf2f(d1[j].z >> 16); dc[14] = bf2f(d1[j].w & 0xffffu); dc[15] = bf2f(d1[j].w >> 16);
#pragma unroll
                    for (int g = 0; g < 16; ++g) Cacc[g] = F * Cacc[g] + dc[g]; }
#pragma unroll
                for (int g4 = 0; g4 < 4; ++g4) { u32x2 pk; pk.x = pk2(Cacc[4 * g4], Cacc[4 * g4 + 1]); pk.y = pk2(Cacc[4 * g4 + 2], Cacc[4 * g4 + 3]);
                    *(u32x2*)(CTn + r * LD64 + 32 * th + 8 * g4 + 4 * hh) = pk; }
                M4_LT(j, (ch + 4 < SEQ / 64 ? ch + 4 : SEQ / 64 - 1));
#pragma unroll
                for (int g = 0; g < 16; ++g) Y[(m0 + 32 * th + drow(g, hh)) * DM + 512 + h * 128 + 32 * c + r] = (bf16)f2bf(num[g]);
                lds_barrier();
            }
        }
#undef M4_LT
    } else if (w < 4 && c == 0) {
        const int th = w - 2; M4_LANE
        bf16x8 qd[4][4]; float Fv[4], dpv[4], dnv[4];
#define M4_LD(j_, ch_) do { const size_t mm_ = (size_t)b * SEQ + 64 * (ch_); const int u_ = mb * 64 + (ch_); M4_QD(j_, mm_) \
        Fv[j_] = (GPTR(const float, C.ws + WS_DEN) + (size_t)u_ * 256)[129 + lz]; \
        { const float* t2_ = GPTR(const float, C.ws + WS_BONUS + 512 * 1024) + (size_t)u_ * 128; dpv[j_] = t2_[32 * th + r]; dnv[j_] = t2_[64 + lane]; } } while (0)
        M4_LD(0, 0); RING_FENCE; M4_LD(1, 1); RING_FENCE; M4_LD(2, 2); RING_FENCE; M4_LD(3, 3); RING_FENCE;
        __syncthreads();
#pragma unroll 1
        for (int ch0 = 0; ch0 < SEQ / 64; ch0 += 4) {
#pragma unroll
            for (int j = 0; j < 4; ++j) {
                const int ch = ch0 + j; const size_t m0 = (size_t)b * SEQ + 64 * ch;
                const float F = Fv[j];
                const float* nc = sN + (j & 1) * 64; float* nn = sN + ((j + 1) & 1) * 64;
                float dsum = C.zf();
#pragma unroll
                for (int s = 0; s < 4; ++s) { const f32x4 na = *(const f32x4*)(nc + 16 * s + 8 * hh), nb = *(const f32x4*)(nc + 16 * s + 8 * hh + 4); float q8[8]; const u32x4 qq = __builtin_bit_cast(u32x4, qd[j][s]); UNPK8(qq, q8);
                    dsum += (q8[0] * na[0] + q8[1] * na[1]) + (q8[2] * na[2] + q8[3] * na[3]) + (q8[4] * nb[0] + q8[5] * nb[1]) + (q8[6] * nb[2] + q8[7] * nb[3]); }
                dsum += __shfl_xor(dsum, 32);
                if (hh == 0) den[(m0 + 32 * th + r) * 4 + h] = dsum + dpv[j];
                if (th == 1) nn[lane] = F * nc[lane] + dnv[j];
                M4_LD(j, (ch + 4 < SEQ / 64 ? ch + 4 : SEQ / 64 - 1));
                lds_barrier();
            }
        }
#undef M4_LD
    } else {
        __syncthreads();
#pragma unroll 1
        for (int ch = 0; ch < SEQ / 64; ++ch) lds_barrier();
    }
#undef M4_QD
#undef M4_LANE
}

#ifndef MLX
#define MLX 0
#endif
__device__ __forceinline__ void mlstm_chain3_block(const Ctx& C, int mb, unsigned char* lds, bool rep = false) {
    const int tid = C.tid(), lane = tid & 63, w = C.wave, r = lane & 31, hh = lane >> 5;
    const int b = mb >> 2, h = mb & 3;
    const bf16* P = GPTR(const bf16, C.ws + WS_R1); bf16* Y = GPTR(bf16, C.ws + WS_Y); float* den = GPTR(float, C.ws + WS_BONUS);
    bf16* CT0 = (bf16*)lds; bf16* CT1 = CT0 + 128 * LD64; float* sN = (float*)(CT1 + 128 * LD64);
    for (int i = tid; i < 2 * 128 * LD64 / 2; i += NTHREADS) ((unsigned*)CT0)[i] = 0u;
    if (tid < 128) sN[tid] = 0.f;
    const int th = w >> 2, vj = w & 3;
    f32x16 Cacc;
#pragma unroll
    for (int g = 0; g < 16; ++g) Cacc[g] = C.zf();
    int lz = 0; asm volatile("" : "+v"(lz));
    bf16x8 qd[4][4]; u32x4 n0[4], n1[4], d0[4], d1[4]; float Fv[4], dpv[4], dnv[4];
#define M3_LOAD(j_, ch_) do { const size_t mm_ = (size_t)b * SEQ + 64 * (ch_); const int u_ = mb * 64 + (ch_); \
        _Pragma("unroll") for (int s = 0; s < 4; ++s) { const int p_ = (th * 4 + s) * 64 + lane; qd[j_][s] = *(const bf16x8*)(P + (mm_ + (p_ >> 4)) * OD_PAD + 1024 + h * 128 + (p_ & 15) * 8); } \
        const int p0_ = ((th * 4 + vj) * 64 + lane) * 2; \
        n0[j_] = *(const u32x4*)(P + (mm_ + (p0_ >> 4)) * OD_PAD + OC_MV + h * 128 + (p0_ & 15) * 8); n1[j_] = *(const u32x4*)(P + (mm_ + ((p0_ + 1) >> 4)) * OD_PAD + OC_MV + h * 128 + ((p0_ + 1) & 15) * 8); \
        d0[j_] = *(const u32x4*)ml_dc_piece((bf16*)P, mm_, h, p0_); d1[j_] = *(const u32x4*)ml_dc_piece((bf16*)P, mm_, h, p0_ + 1); \
        Fv[j_] = (GPTR(const float, C.ws + WS_DEN) + (size_t)u_ * 256)[129 + lz]; \
        { const float* t2_ = GPTR(const float, C.ws + WS_BONUS + 512 * 1024) + (size_t)u_ * 128; dpv[j_] = t2_[32 * th + r]; dnv[j_] = t2_[64 + lane]; } } while (0)
#pragma unroll
    for (int j = 0; j < 4; ++j) { dpv[j] = C.zf(); dnv[j] = C.zf(); }
    M3_LOAD(0, 0); RING_FENCE; M3_LOAD(1, 1); RING_FENCE; M3_LOAD(2, 2); RING_FENCE; M3_LOAD(3, 3); RING_FENCE;
    __syncthreads();
#pragma unroll 1
    for (int ch0 = 0; ch0 < SEQ / 64; ch0 += 4) {
#pragma unroll
        for (int j = 0; j < 4; ++j) {
            const int ch = ch0 + j;
            const size_t m0 = (size_t)b * SEQ + 64 * ch;
            const bf16* CTc = (j & 1) ? CT1 : CT0; bf16* CTn = (j & 1) ? CT0 : CT1;
            const float F = Fv[j];
            f32x16 num;
            num[0] = bf2f(n0[j].x & 0xffffu); num[1] = bf2f(n0[j].x >> 16); num[2] = bf2f(n0[j].y & 0xffffu); num[3] = bf2f(n0[j].y >> 16); num[4] = bf2f(n0[j].z & 0xffffu); num[5] = bf2f(n0[j].z >> 16); num[6] = bf2f(n0[j].w & 0xffffu); num[7] = bf2f(n0[j].w >> 16);
            num[8] = bf2f(n1[j].x & 0xffffu); num[9] = bf2f(n1[j].x >> 16); num[10] = bf2f(n1[j].y & 0xffffu); num[11] = bf2f(n1[j].y >> 16); num[12] = bf2f(n1[j].z & 0xffffu); num[13] = bf2f(n1[j].z >> 16); num[14] = bf2f(n1[j].w & 0xffffu); num[15] = bf2f(n1[j].w >> 16);
#pragma unroll
            for (int s = 0; s < 4; ++s) num = mfma32(qd[j][s], ldfrag(CTc + (32 * vj + r) * LD64 + 16 * s + 8 * hh), num);
            {   float dc[16];
                dc[0] = bf2f(d0[j].x & 0xffffu); dc[1] = bf2f(d0[j].x >> 16); dc[2] = bf2f(d0[j].y & 0xffffu); dc[3] = bf2f(d0[j].y >> 16); dc[4] = bf2f(d0[j].z & 0xffffu); dc[5] = bf2f(d0[j].z >> 16); dc[6] = bf2f(d0[j].w & 0xffffu); dc[7] = bf2f(d0[j].w >> 16);
                dc[8] = bf2f(d1[j].x & 0xffffu); dc[9] = bf2f(d1[j].x >> 16); dc[10] = bf2f(d1[j].y & 0xffffu); dc[11] = bf2f(d1[j].y >> 16); dc[12] = bf2f(d1[j].z & 0xffffu); dc[13] = bf2f(d1[j].z >> 16); dc[14] = bf2f(d1[j].w & 0xffffu); dc[15] = bf2f(d1[j].w >> 16);
#pragma unroll
                for (int g = 0; g < 16; ++g) Cacc[g] = F * Cacc[g] + dc[g]; }
#pragma unroll
            for (int g4 = 0; g4 < 4; ++g4) { u32x2 pk; pk.x = pk2(Cacc[4 * g4], Cacc[4 * g4 + 1]); pk.y = pk2(Cacc[4 * g4 + 2], Cacc[4 * g4 + 3]);
                *(u32x2*)(CTn + (32 * vj + r) * LD64 + 32 * th + 8 * g4 + 4 * hh) = pk; }
            if (vj == 3 && !((MLX & 2) && rep)) {
                const float* nc = sN + (j & 1) * 64; float* nn = sN + ((j + 1) & 1) * 64;
                float dsum = C.zf();
#pragma unroll
                for (int s = 0; s < 4; ++s) { const f32x4 na = *(const f32x4*)(nc + 16 * s + 8 * hh), nb = *(const f32x4*)(nc + 16 * s + 8 * hh + 4); float q8[8]; const u32x4 qq = __builtin_bit_cast(u32x4, qd[j][s]); UNPK8(qq, q8);
                    dsum += (q8[0] * na[0] + q8[1] * na[1]) + (q8[2] * na[2] + q8[3] * na[3]) + (q8[4] * nb[0] + q8[5] * nb[1]) + (q8[6] * nb[2] + q8[7] * nb[3]); }
                dsum += __shfl_xor(dsum, 32);
                if (hh == 0) den[(m0 + 32 * th + r) * 4 + h] = dsum + dpv[j];
                if (th == 1) nn[lane] = F * nc[lane] + dnv[j];
            }
            M3_LOAD(j, (ch + 4 < SEQ / 64 ? ch + 4 : SEQ / 64 - 1));
            if (!((MLX & 1) && rep)) {
#pragma unroll
            for (int g = 0; g < 16; ++g) Y[(m0 + 32 * th + drow(g, hh)) * DM + 512 + h * 128 + 32 * vj + r] = (bf16)f2bf(num[g]); }
            lds_barrier();
        }
    }
#undef M3_LOAD
}

__device__ __forceinline__ void run_phase(const Ctx& C, int ph, unsigned char* lds, bool rep = false) {
    float* sm = (float*)lds;
    const int bid = C.bid;
    bf16* XB = (bf16*)C.out; bf16* Y = GPTR(bf16, C.ws + WS_Y); bf16* R1 = GPTR(bf16, C.ws + WS_R1); float* slots = GPTR(float, C.ws + WS_SLOTS);
#ifndef ONLY
#define ONLY -1
#endif
#define ON(x) (ONLY < 0 || ONLY == (x))
#ifndef CONVPROBE
#define CONVPROBE 0
#endif
#ifndef PREO_PROBE
#define PREO_PROBE 0
#endif
#ifndef G3PROBE
#define G3PROBE 0
#endif
#ifndef PREPART
#define PREPART 3
#endif
    if (ph == 0) { if (ON(10)) { prologue_rows(C); convert_layer(C, 0, sm, 0, C.G); } return; }
    if (ph == N_PHASES - 1) { if (ON(11)) final_rows(C); return; }
    const int l = (ph - 1) / 7, k7 = (ph - 1) % 7; const bool even = (l & 1) == 0; const int li = l >> 1;
    const int k = k7 == 0 ? 0 : (k7 == 1 ? 6 : k7 - 1);
    if (k == 6) {
        if (even) { if (ON(20)) { for (int tile = bid; tile < M / 64; tile += C.G) { if ((PREPART & 1) && !(rep && REP_SKIP == 2)) even_pre_tile(C, li, tile, lds); }
                                   for (int tile = bid; tile < M / 64; tile += C.G) { if ((PREPART & 2) && !(rep && REP_SKIP == 1)) rwkv_pre_tile(C, li, tile, lds, rep ? RPHEADS : 8); } } }
        else { if (ON(19)) for (int unit = bid; unit < 1024; unit += C.G) { const bool dummy = PREO_PROBE && !rep; if (!(PREO_PROBE & 2) || !dummy) gdn_pre3(C, li, unit, lds, dummy); if (!(PREO_PROBE & 4) || !dummy) mlstm_pre3(C, li, unit, lds, dummy); } }
        return; }
    if (k == 0 && ON(0)) {
        const int N = even ? EV_COLS : OD_PAD;
        pg8::Gemm g{XB, C.wset(l, WOFF_IN), M, N, DM}; pg8::StaticOrder S; S.init(M, N, C.G, bid);
        pg8::EpiScaleBf16<0> E{R1, N, slots, even ? nullptr : GPTR(bf16, C.ws + WS_HALO)};
        pg8::gemm_phase<pg8::EpiScaleBf16<0>, pg8::StaticOrder, true, true>((PG8_LAS unsigned char*)lds, g, S, E, C.tid());
    } else if (k == 1 && (ON(1) || ON(12) || ON(13) || ON(14) || ON(15))) {
        if (even) { if (bid < 32) { if (ON(1) || ON(12)) rwkv_chain3_block(C, li, bid, lds); } else if (rep && LRUPROBE) { for (int tile = bid - 32; tile < M / 64; tile += C.G - 32) lru_pass2_tile(C, tile, sm, true); }
                    else if (!rep && (ON(1) || ON(13))) { for (int tile = bid - 32; tile < M / 64; tile += C.G - 32) lru_pass2_tile(C, tile, sm); __syncthreads(); if (l + 1 < DEPTH) { convert_layer(C, l + 1, sm, 32, C.G - 32); if (CONVPROBE) { __syncthreads(); convert_layer(C, l + 1, sm, 32, C.G - 32); } } } }
        else { if (bid < 64) { if ((ON(1) || ON(14)) && !(rep && (REP_SKIP & 1))) gdn_chain4_block(C, bid & 15, bid >> 4, lds); } else if (bid < 128) { if ((ON(1) || ON(15)) && !(rep && (REP_SKIP & 2))) mlstm_chain4_block(C, (bid - 64) & 15, (bid - 64) >> 4, lds); }
               else if (!rep && l + 1 < DEPTH) convert_layer(C, l + 1, sm, 128, C.G - 128); }
    } else if (k == 2 && (ON(2) || ON(16) || ON(17) || ON(18))) {
        if (even) { if (ON(2) || ON(16)) for (int tile = bid; tile < M / 64; tile += C.G) rwkv_post_tile2(C, li, tile, sm, rep); }
        else { if (ON(2) || ON(17)) odd_post(C, li, rep); }
    } else if (k == 3 && ON(3)) {
        pg8::Gemm g{Y, C.wset(l, WOFF_OUT), M, DM, DM}; pg8::StaticOrder S; S.init(M, DM, C.G, bid);
        pg8::EpiRes E{XB, rep ? GPTR(bf16, C.ws + WS_XB) : XB, slots, rep};
        pg8::gemm_phase<pg8::EpiRes, pg8::StaticOrder, true, true>((PG8_LAS unsigned char*)lds, g, S, E, C.tid());
    } else if (k == 4 && ON(4)) {
        pg8::Gemm g{XB, C.wset(l, WOFF_UP), M, DFF, DM}; pg8::StaticOrder S; S.init(M, DFF, C.G, bid);
        pg8::EpiScaleBf16<1> E{R1, DFF, slots, nullptr, rep ? G3PROBE : 0};
        pg8::gemm_phase<pg8::EpiScaleBf16<1>, pg8::StaticOrder, true, true>((PG8_LAS unsigned char*)lds, g, S, E, C.tid());
    } else if (k == 5 && ON(5)) {
        pg8::Gemm g{R1, C.wset(l, WOFF_DOWN), M, DM, DFF}; pg8::StaticOrder S; S.init(M, DM, C.G, bid);
        pg8::EpiRes E{XB, (l + 1 < DEPTH && !rep) ? XB : GPTR(bf16, C.ws + WS_XB), slots, rep};
        pg8::gemm_phase<pg8::EpiRes, pg8::StaticOrder, true, true>((PG8_LAS unsigned char*)lds, g, S, E, C.tid());
    }
}

#ifndef MK_SINGLE
#define MK_SINGLE 1
#endif
#ifndef REP_SKIP
#define REP_SKIP 0
#endif
#ifndef MK_XCDBAR
#define MK_XCDBAR 1
#endif
constexpr int CW_BAR = 4096;
#define XB_TMO      128
#define XB_XCNT(j)  (256  + 64 * (j))
#define XB_XSUB(j)  (1280 + 64 * (j))
#define XB_XGEN(j)  (2304 + 64 * (j))
#define XB_TOP      3328
#define XB_TOPGEN   3392
#define XCD_BAR_WORDS 3456
#define XB_SPIN_CAP (1u << 18)

__device__ __forceinline__ unsigned xb_ld(unsigned* p)              { return __hip_atomic_load(p, __ATOMIC_RELAXED, __HIP_MEMORY_SCOPE_AGENT); }
__device__ __forceinline__ unsigned xb_add(unsigned* p, unsigned v) { return __hip_atomic_fetch_add(p, v, __ATOMIC_RELAXED, __HIP_MEMORY_SCOPE_AGENT); }
__device__ __forceinline__ unsigned xb_xcc_id() { return (unsigned)__builtin_amdgcn_s_getreg((3 << 11) | 20) & 0xFu; }
#define XB_SPIN(cond, bar) do { unsigned _sp = 0; while (cond) { __builtin_amdgcn_s_sleep(1); \
    if ((++_sp & 255u) == 0u) { if (xb_ld(&(bar)[XB_TMO])) break; if (_sp > XB_SPIN_CAP) { atomicAdd(&(bar)[XB_TMO], 1u); break; } } } } while (0)

struct XcdBarrier {
    unsigned* bar; unsigned x;
    volatile LAS unsigned* st;
};

__device__ __forceinline__ XcdBarrier xcd_barrier_post(unsigned* bar, volatile LAS unsigned* st) {
    XcdBarrier b; b.bar = bar; b.x = xb_xcc_id(); b.st = st;
    if (threadIdx.x == 0) (void)xb_add(&bar[XB_XCNT(b.x)], 1u);
    return b;
}
__device__ __forceinline__ void xcd_barrier_complete(unsigned* bar, unsigned x, unsigned& nloc, unsigned& nx) {
    const unsigned G = gridDim.x * gridDim.y * gridDim.z;
    unsigned sum, cnt, mine, sp = 0u;
    for (;;) {
        sum = 0u; cnt = 0u; mine = 0u;
#pragma unroll
        for (unsigned j = 0; j < 16; ++j) { const unsigned c = xb_ld(&bar[XB_XCNT(j)]); sum += c; cnt += (c > 0u) ? 1u : 0u; mine = (j == x) ? c : mine; }
        if (sum == G) break;
        __builtin_amdgcn_s_sleep(1);
        if ((++sp & 255u) == 0u) { if (xb_ld(&bar[XB_TMO])) break; if (sp > XB_SPIN_CAP) { atomicAdd(&bar[XB_TMO], 1u); break; } }
    }
    nloc = mine > 0u ? mine : 1u; nx = cnt > 0u ? cnt : 1u;
}

__device__ __forceinline__ void xcd_barrier(const XcdBarrier& b, bool lead  ) {
    asm volatile("s_waitcnt vmcnt(0)" ::: "memory");
    __syncthreads();
    if (lead) {
        unsigned* bar = b.bar;
        __builtin_amdgcn_s_waitcnt(0);
        unsigned nloc = b.st[0], nx = b.st[1];
        if (nloc == 0u) { xcd_barrier_complete(bar, b.x, nloc, nx); b.st[0] = nloc; b.st[1] = nx; }
        const unsigned old = xb_add(&bar[XB_XSUB(b.x)], 1u);
        const unsigned gen = old / nloc;
        if (old + 1u == (gen + 1u) * nloc) {
            __builtin_amdgcn_fence(__ATOMIC_RELEASE, "agent");
            asm volatile("s_waitcnt vmcnt(0)" ::: "memory");
            const unsigned og = xb_add(&bar[XB_TOP], 1u);
            const unsigned tg = og / nx;
            if (og + 1u == (tg + 1u) * nx) xb_add(&bar[XB_TOPGEN], 1u);
            else XB_SPIN(xb_ld(&bar[XB_TOPGEN]) == tg, bar);
            __builtin_amdgcn_fence(__ATOMIC_ACQUIRE, "agent");
            xb_add(&bar[XB_XGEN(b.x)], 1u);
            asm volatile("s_waitcnt vmcnt(0)" ::: "memory");
        } else {
            XB_SPIN(xb_ld(&bar[XB_XGEN(b.x)]) == gen, bar);
            __builtin_amdgcn_fence(__ATOMIC_ACQUIRE, "agent");
            asm volatile("s_waitcnt vmcnt(0)" ::: "memory");
        }
    }
    __syncthreads();
}


__global__ void __launch_bounds__(NTHREADS, 2) mega(Args args) {
    extern __shared__ __attribute__((aligned(16))) unsigned char lds[];
    {   unsigned long long* t = (unsigned long long*)(args.ws + WS_TBL + (size_t)blockIdx.x * 512);
        if (threadIdx.x == 0) {
#pragma unroll
            for (int i = 0; i < 36; ++i) t[i] = (unsigned long long)args.in[i];
        }
    }
#if MK_SINGLE && MK_XCDBAR
    volatile LAS unsigned* bst = (volatile LAS unsigned*)((LAS unsigned char*)lds + (LDS_BYTES - 64));
    if (threadIdx.x < 2) bst[threadIdx.x] = 0u;
    __syncthreads();
    const XcdBarrier xbar = xcd_barrier_post((unsigned*)(args.ws + WS_CTL) + CW_BAR, bst);
#endif
    __syncthreads();
    const int wave_s = __builtin_amdgcn_readfirstlane((int)threadIdx.x >> 6);
#ifdef REPEAT_MASK
    for (int ph2 = args.ph_lo * 2; ph2 < args.ph_hi * 2; ++ph2) {
        const int ph = ph2 >> 1; const bool rep = (ph2 & 1) != 0;
        if (rep) { const int l_ = (ph - 1) / 7, k7_ = (ph - 1) % 7; const bool ev_ = (l_ & 1) == 0; const int k_ = (ph == 0 || ph == N_PHASES - 1) ? -1 : (k7_ == 0 ? 0 : (k7_ == 1 ? 6 : k7_ - 1));
                   const int code_ = ph == 0 ? 16 : (k_ < 0 ? -1 : (k_ + (ev_ ? 0 : 8)));
                   if (!(code_ >= 0 && ((REPEAT_MASK >> code_) & 1))) continue; }
#else
    for (int ph = args.ph_lo; ph < args.ph_hi; ++ph) { const bool rep = false;
#endif
        Ctx C;
        int wv_ = wave_s; unsigned z0_ = 0u; asm volatile("" : "+s"(wv_), "+s"(z0_));
        int bx = blockIdx.x, G = gridDim.x; unsigned char* ws = args.ws; float* out = args.out;
        asm volatile("" : "+s"(bx)); asm volatile("" : "+s"(G)); asm volatile("" : "+s"(ws)); asm volatile("" : "+s"(out));
        ws = GPTR(unsigned char, ws); out = GPTR(float, out);
        C.tbl = (const unsigned long long*)(ws + WS_TBL + (size_t)bx * 512); C.out = out; C.ws = ws;
        C.wave = wv_; C.z0 = z0_;
        C.G = G; C.vcu = (G % 8 == 0) ? (bx % 8) * (G / 8) + bx / 8 : bx; C.bid = bx;
        int zoff = 0; asm volatile("" : "+s"(zoff));
        run_phase(C, ph, lds + zoff, rep);
#if MK_SINGLE
#if MK_XCDBAR
#ifdef REPEAT_MASK
        xcd_barrier(xbar, C.tid() == 0);
#else
        if (ph + 1 < args.ph_hi) xcd_barrier(xbar, C.tid() == 0);
#endif
#else
        if (ph + 1 < args.ph_hi) cg::this_grid().sync();
#endif
#endif
    }
#ifdef BARPROBE
    for (int i = 0; i < BARPROBE; ++i) xcd_barrier(xbar, threadIdx.x == 0);
#endif
}

extern "C" void kernel_launch(void* const* d_in, const int* in_sizes, int n_in, void* d_out, int out_size, void* d_ws, size_t ws_size, hipStream_t stream) {
    static int grid = 0;
    if (grid == 0) {
        if (n_in != 36 || out_size != M * DM || ws_size < 256 * MiB) { fprintf(stderr, "kernel_launch: unexpected shapes (n_in %d, out %d, ws %zu); nothing launched\n", n_in, out_size, ws_size); grid = -1; return; }
        int dev = 0, cus = 0, per_cu = 0;
        (void)hipGetDevice(&dev); (void)hipDeviceGetAttribute(&cus, hipDeviceAttributeMultiprocessorCount, dev);
        if (hipFuncSetAttribute((const void*)mega, hipFuncAttributeMaxDynamicSharedMemorySize, LDS_BYTES) != hipSuccess) { fprintf(stderr, "kernel_launch: hipFuncSetAttribute failed\n"); grid = -1; return; }
        if (hipOccupancyMaxActiveBlocksPerMultiprocessor(&per_cu, (const void*)mega, NTHREADS, LDS_BYTES) != hipSuccess || per_cu < 1) { fprintf(stderr, "kernel_launch: occupancy query says %d\n", per_cu); per_cu = 1; }
        (void)hipGetLastError();
        grid = cus > 0 ? cus : 256;
        fprintf(stderr, "kernel_launch: cus %d per_cu %d grid %d ws %zu\n", cus, per_cu, grid, ws_size);
    }
    if (grid < 0) return;
    Args a{};
    for (int i = 0; i < 36; ++i) a.in[i] = (const float*)d_in[i];
    a.out = (float*)d_out; a.ws = (unsigned char*)d_ws;
#if MK_SINGLE
    a.ph_lo = 0; a.ph_hi = N_PHASES;
#if MK_XCDBAR
    if (hipMemsetAsync((char*)d_ws + WS_CTL, 0, 65536, stream) != hipSuccess) { fprintf(stderr, "kernel_launch: hipMemsetAsync failed\n"); return; }
    hipLaunchKernelGGL(mega, dim3(grid), dim3(NTHREADS), LDS_BYTES, stream, a);
#else
    void* kargs[] = {&a};
    hipError_t e = hipLaunchCooperativeKernel((const void*)mega, dim3(grid), dim3(NTHREADS), kargs, LDS_BYTES, stream);
    if (e != hipSuccess) fprintf(stderr, "kernel_launch: cooperative launch failed: %s\n", hipGetErrorString(e));
#endif
#else
    for (int ph = 0; ph < N_PHASES; ++ph) {
        a.ph_lo = ph; a.ph_hi = ph + 1;
        hipLaunchKernelGGL(mega, dim3(grid), dim3(NTHREADS), LDS_BYTES, stream, a);
    }
#endif
}
```

```cpp
#include <hip/hip_runtime.h>
#include <hip/hip_cooperative_groups.h>
#include <cstdio>
#include <cstdint>
namespace cg = cooperative_groups;
namespace pg8 {
#define PG8_LAS __attribute__((address_space(3)))
typedef unsigned short bf16_t;
typedef short bf16x8 __attribute__((ext_vector_type(8)));
typedef float f32x4 __attribute__((ext_vector_type(4)));
typedef unsigned u32x4 __attribute__((ext_vector_type(4)));
constexpr int BM = 256, BK = 64, HALF = 128, HTB = HALF * BK * 2  , STAGE_BYTES = 8 * HTB, NXCD = 8, WGM = 8;

__host__ __device__ __forceinline__ int lds_byte(int r, int c) { const int st = (r >> 4) * 2 + (c >> 5), rr = r & 15, cc = c & 31, ob = rr * 64 + cc * 2; return st * 1024 + (ob ^ (((ob >> 9) & 1) << 5)); }
__host__ __device__ __forceinline__ void stage_rc(int b, int& R, int& C) { const int st = b / 1024, sb = b % 1024, swz = sb ^ (((sb >> 9) & 1) << 5); R = (st >> 1) * 16 + swz / 64; C = (st & 1) * 32 + (swz % 64) / 2; }
__host__ __device__ __forceinline__ int perm32(int rho) { const int n = rho >> 4, i = rho & 15; return 8 * (i >> 2) + 4 * n + (i & 3); }

struct Unit { int pm, pn; };
struct Gemm { const bf16_t* A; const bf16_t* Bt; int M, N, K; };

struct StaticOrder {
    int nM, nN, nwg, G, c;
    __host__ __device__ void init(int M, int N, int G_, int c_) { nM = M / BM; nN = N / BM; nwg = nM * nN; G = G_; c = c_; }
    __host__ __device__ bool next(int i, Unit& u) const {
        const long L = (long)i * G + c; if (L >= nwg) return false;
        int wgid = (int)L; { const int q = nwg / NXCD, r = nwg % NXCD, xcd = wgid % NXCD, off = wgid / NXCD; wgid = (xcd < r ? xcd * (q + 1) : r * (q + 1) + (xcd - r) * q) + off; }
        const int nig = WGM * nN, gid = wgid / nig, fm = gid * WGM, gsz = (nM - fm) < WGM ? (nM - fm) : WGM;
        u.pm = fm + ((wgid % nig) % gsz); u.pn = (wgid % nig) / gsz; return true;
    }
    __device__ __forceinline__ void a_ready(const Unit&) const {}
    __device__ __forceinline__ void done(const Unit&) const {}
};

__device__ __forceinline__ unsigned cvt_pk_bf16(float lo, float hi) { unsigned r; asm volatile("v_cvt_pk_bf16_f32 %0, %1, %2" : "=v"(r) : "v"(lo), "v"(hi)); return r; }
__device__ __forceinline__ float row_rstd(const float* slots, int row) {
    const f32x4* s = (const f32x4*)(slots + (size_t)row * 16);
    const f32x4 a = s[0], b = s[1], c = s[2], d = s[3];
    const float t = ((a[0] + a[1]) + (a[2] + a[3])) + ((b[0] + b[1]) + (b[2] + b[3])) + ((c[0] + c[1]) + (c[2] + c[3])) + ((d[0] + d[1]) + (d[2] + d[3]));
    return 1.0f / sqrtf(t * (1.0f / 1024.0f) + 1e-6f);
}
__device__ __forceinline__ float row_rstd_q(const float* slots, int row, int fq) {
    const f32x4 a = *(const f32x4*)(slots + (size_t)row * 16 + 4 * fq);
    float t = (a[0] + a[1]) + (a[2] + a[3]);
    t += __shfl_xor(t, 16); t += __shfl_xor(t, 32);
    return 1.0f / sqrtf(t * (1.0f / 1024.0f) + 1e-6f);
}
template <int ACT> struct EpiScaleBf16 {
    static constexpr bool PERM = true, AFTER_DRAIN = false, WIDE = true;
    bf16_t* O; int ldc; const float* slots; bf16_t* halo = nullptr; int probe = 0;
    __device__ __forceinline__ void operator()(const f32x4 (&acc)[2][2][4][2], const Unit& u, int wr, int wc, int fr, int fq) const {
        const int row0 = u.pm * BM + wr * 64 + fr, col0 = u.pn * BM + wc * 64 + 8 * fq;
#pragma unroll
        for (int ai = 0; ai < 2; ++ai)
#pragma unroll
            for (int m = 0; m < 4; ++m) {
                const int row = row0 + ai * HALF + m * 16;
                const float rs = (probe & 2) ? 1.0f : row_rstd_q(slots, row, fq);
                bf16_t* rowp = O + (size_t)row * ldc + col0;
#pragma unroll
                for (int bj = 0; bj < 2; ++bj) {
                    f32x4 v0 = acc[ai][bj][m][0] * rs, v1 = acc[ai][bj][m][1] * rs;
                    if (ACT == 1) {
#pragma unroll
                        for (int q = 0; q < 4; ++q) { float a = fmaxf(v0[q], 0.f), b = fmaxf(v1[q], 0.f); v0[q] = a * a; v1[q] = b * b; }
                    }
                    u32x4 w; w.x = cvt_pk_bf16(v0[0], v0[1]); w.y = cvt_pk_bf16(v0[2], v0[3]); w.z = cvt_pk_bf16(v1[0], v1[1]); w.w = cvt_pk_bf16(v1[2], v1[3]);
                    if (!(probe & 1)) *(u32x4*)(rowp + bj * 32) = w;
                    if (halo && m == 3 && fr >= 13) *(u32x4*)(halo + ((size_t)(row >> 6) * 3 + (row & 63) - 61) * ldc + col0 + bj * 32) = w;
                }
            }
    }
};
struct EpiRes {
    static constexpr bool PERM = true, AFTER_DRAIN = false, WIDE = true;
    const bf16_t* XI; bf16_t* XO; float* slots; bool noslots = false;
    __device__ __forceinline__ void operator()(const f32x4 (&acc)[2][2][4][2], const Unit& u, int wr, int wc, int fr, int fq) const {
        const int col0 = u.pn * BM + wc * 64 + 8 * fq;
#pragma unroll
        for (int ai = 0; ai < 2; ++ai)
#pragma unroll
            for (int m = 0; m < 4; ++m) {
                const int row = u.pm * BM + ai * HALF + wr * 64 + m * 16 + fr;
                const size_t off = (size_t)row * 1024 + col0;
                u32x4 xin[2];
#pragma unroll
                for (int bj = 0; bj < 2; ++bj) xin[bj] = *(const u32x4*)(XI + off + bj * 32);
                float ss = 0.f;
#pragma unroll
                for (int bj = 0; bj < 2; ++bj) {
                    const u32x4 xi = xin[bj];
                    f32x4 v0, v1;
                    v0[0] = __uint_as_float(xi.x << 16); v0[1] = __uint_as_float(xi.x & 0xffff0000u); v0[2] = __uint_as_float(xi.y << 16); v0[3] = __uint_as_float(xi.y & 0xffff0000u);
                    v1[0] = __uint_as_float(xi.z << 16); v1[1] = __uint_as_float(xi.z & 0xffff0000u); v1[2] = __uint_as_float(xi.w << 16); v1[3] = __uint_as_float(xi.w & 0xffff0000u);
                    v0 = v0 + acc[ai][bj][m][0]; v1 = v1 + acc[ai][bj][m][1];
                    u32x4 w; w.x = cvt_pk_bf16(v0[0], v0[1]); w.y = cvt_pk_bf16(v0[2], v0[3]); w.z = cvt_pk_bf16(v1[0], v1[1]); w.w = cvt_pk_bf16(v1[2], v1[3]);
                    *(u32x4*)(XO + off + bj * 32) = w;
                    const float r0 = __uint_as_float(w.x << 16), r1 = __uint_as_float(w.x & 0xffff0000u), r2 = __uint_as_float(w.y << 16), r3 = __uint_as_float(w.y & 0xffff0000u);
                    const float r4 = __uint_as_float(w.z << 16), r5 = __uint_as_float(w.z & 0xffff0000u), r6 = __uint_as_float(w.w << 16), r7 = __uint_as_float(w.w & 0xffff0000u);
                    ss += ((r0 * r0 + r1 * r1) + (r2 * r2 + r3 * r3)) + ((r4 * r4 + r5 * r5) + (r6 * r6 + r7 * r7));
                }
                ss += __shfl_xor(ss, 16); ss += __shfl_xor(ss, 32);
                if (fq == 0 && !noslots) slots[(size_t)row * 16 + u.pn * 4 + wc] = ss;
            }
    }
};
template <class Epi, class Sched, bool ALIGN_EPI = false, bool SP2 = false>
__device__ __forceinline__ void gemm_phase(PG8_LAS unsigned char* lds, const Gemm g, const Sched& S, const Epi& E, int tid_in) {
    int tid_ = tid_in; asm volatile("" : "+v"(tid_));
    const int tid = tid_, wid = __builtin_amdgcn_readfirstlane(tid >> 6), lane = tid & 63, wr = wid >> 2, wc = wid & 3, fr = lane & 15, fq = lane >> 4;
    const int K = g.K, nt = K / BK;
    unsigned voffA[2], voffB[2];
#pragma unroll
    for (int i = 0; i < 2; ++i) { int R, C; stage_rc(tid * 16 + i * 8192, R, C); const int Rb = Epi::WIDE ? (64 * (R >> 5) + perm32(R & 31)) : (Epi::PERM ? ((R & ~31) + perm32(R & 31)) : R);
        voffA[i] = (unsigned)(R * K + C) * 2u; voffB[i] = (unsigned)(Rb * K + C) * 2u; }
    const size_t kstep = (size_t)(BK * 2);
    const size_t hstep = (size_t)HALF * K * 2;
    const size_t hstepB = Epi::WIDE ? (size_t)32 * K * 2 : hstep;
    const size_t tstep = 2 * hstep;
    const unsigned ldsw = (unsigned)wid * 1024u;
    const int aoff = lds_byte(wr * 64 + fr, fq * 8), boff = lds_byte(wc * 32 + fr, fq * 8);
#define PG8_SA(b, h) (((b) * 2 + (h)) * HTB)
#define PG8_SB(b, h) ((4 + (b) * 2 + (h)) * HTB)
#define PG8_STAGE(bufoff, gbase, voff) do { _Pragma("unroll") for (int _i = 0; _i < 2; ++_i) \
        __builtin_amdgcn_global_load_lds((const unsigned*)((const char*)(gbase) + (voff)[_i]), (PG8_LAS unsigned*)(lds + (bufoff) + ldsw + _i * 8192), 16, 0, 0); } while (0)
#define PG8_LDA(dst, b, h) do { _Pragma("unroll") for (int m = 0; m < 4; ++m) _Pragma("unroll") for (int k = 0; k < 2; ++k) dst[m][k] = *(const PG8_LAS bf16x8*)(lds + PG8_SA(b, h) + aoff + m * 2048 + k * 1024); } while (0)
#define PG8_LDB(dst, b, h) do { _Pragma("unroll") for (int n = 0; n < 2; ++n) _Pragma("unroll") for (int k = 0; k < 2; ++k) dst[n][k] = *(const PG8_LAS bf16x8*)(lds + PG8_SB(b, h) + boff + n * 2048 + k * 1024); } while (0)
#define PG8_MMA(ai, bj, At, Bt) do { __builtin_amdgcn_s_setprio(1); _Pragma("unroll") for (int m = 0; m < 4; ++m) _Pragma("unroll") for (int n = 0; n < 2; ++n) _Pragma("unroll") for (int k = 0; k < 2; ++k) \
        acc[ai][bj][m][n] = __builtin_amdgcn_mfma_f32_16x16x32_bf16(Bt[n][k], At[m][k], acc[ai][bj][m][n], 0, 0, 0); __builtin_amdgcn_s_setprio(0); } while (0)
#define PG8_WAIT_V(n) asm volatile("s_waitcnt vmcnt(" #n ")" ::: "memory")
#define PG8_WAIT_L(n) asm volatile("s_waitcnt lgkmcnt(" #n ")" ::: "memory")
#define PG8_BAR __builtin_amdgcn_s_barrier()
#define PG8_SCHED __builtin_amdgcn_sched_barrier(0)
    Unit cur, nxt; int ui = 0;
    if (!S.next(0, cur)) return;
    f32x4 acc[2][2][4][2];
#pragma unroll
    for (int a = 0; a < 2; ++a)
#pragma unroll
        for (int b = 0; b < 2; ++b)
#pragma unroll
            for (int m = 0; m < 4; ++m)
#pragma unroll
                for (int n = 0; n < 2; ++n) acc[a][b][m][n] = (f32x4){0.f, 0.f, 0.f, 0.f};
    bf16x8 At[4][2], B0[2][2], B1[2][2];
    const char* cA = (const char*)g.A + (size_t)cur.pm * tstep; const char* cB = (const char*)g.Bt + (size_t)cur.pn * tstep;
    S.a_ready(cur);
    if constexpr (SP2) {
        PG8_STAGE(PG8_SB(0, 0), cB, voffB); PG8_STAGE(PG8_SB(0, 1), cB + hstepB, voffB); PG8_STAGE(PG8_SA(0, 0), cA, voffA); PG8_STAGE(PG8_SA(0, 1), cA + hstep, voffA);
        if (wr == 1) PG8_BAR;
        PG8_WAIT_V(2); PG8_BAR;
        PG8_STAGE(PG8_SB(1, 0), cB + kstep, voffB); PG8_STAGE(PG8_SA(1, 0), cA + kstep, voffA); PG8_STAGE(PG8_SB(1, 1), cB + hstepB + kstep, voffB);
        PG8_WAIT_V(6); PG8_BAR;
    } else {
        PG8_STAGE(PG8_SB(0, 0), cB, voffB); PG8_STAGE(PG8_SA(0, 0), cA, voffA); PG8_STAGE(PG8_SB(0, 1), cB + hstepB, voffB); PG8_STAGE(PG8_SA(0, 1), cA + hstep, voffA);
        if (wr == 1) PG8_BAR;
        PG8_WAIT_V(4); PG8_BAR;
        PG8_STAGE(PG8_SB(1, 0), cB + kstep, voffB); PG8_STAGE(PG8_SA(1, 0), cA + kstep, voffA); PG8_STAGE(PG8_SB(1, 1), cB + hstepB + kstep, voffB);
        PG8_WAIT_V(6); PG8_BAR;
    }
    for (;;) {
        const bool has_next = S.next(ui + 1, nxt);
        const char* nA = has_next ? (const char*)g.A + (size_t)nxt.pm * tstep : cA; const char* nB = has_next ? (const char*)g.Bt + (size_t)nxt.pn * tstep : cB;
        for (int t = 0; t < nt; t += 2) {
            const bool last = (t == nt - 2);
            const char* a1 = cA + (size_t)(t + 1) * kstep;
            const char* a2 = last ? nA : cA + (size_t)(t + 2) * kstep; const char* b2 = last ? nB : cB + (size_t)(t + 2) * kstep;
            const char* a3 = a2 + kstep; const char* b3 = b2 + kstep;
            if (last && has_next) S.a_ready(nxt);
            if constexpr (SP2) {
            PG8_LDB(B0, 0, 0); PG8_LDB(B1, 0, 1); PG8_SCHED; PG8_LDA(At, 0, 0); PG8_STAGE(PG8_SA(1, 1), a1 + hstep, voffA);
            PG8_WAIT_V(8); PG8_WAIT_L(0); PG8_BAR; PG8_MMA(0, 0, At, B0); PG8_MMA(0, 1, At, B1); PG8_BAR; PG8_SCHED;
            PG8_LDA(At, 0, 1); PG8_STAGE(PG8_SB(0, 0), b2, voffB); PG8_STAGE(PG8_SB(0, 1), b2 + hstepB, voffB); PG8_STAGE(PG8_SA(0, 0), a2, voffA);
            PG8_WAIT_V(8); PG8_WAIT_L(0); PG8_BAR; PG8_MMA(1, 0, At, B0); PG8_MMA(1, 1, At, B1); PG8_BAR; PG8_SCHED;
            PG8_LDB(B0, 1, 0); PG8_LDB(B1, 1, 1); PG8_SCHED; PG8_LDA(At, 1, 0); PG8_STAGE(PG8_SA(0, 1), a2 + hstep, voffA);
            PG8_WAIT_V(8); PG8_WAIT_L(0); PG8_BAR; PG8_MMA(0, 0, At, B0); PG8_MMA(0, 1, At, B1); PG8_BAR; PG8_SCHED;
            PG8_LDA(At, 1, 1); PG8_STAGE(PG8_SB(1, 0), b3, voffB); PG8_STAGE(PG8_SB(1, 1), b3 + hstepB, voffB); PG8_STAGE(PG8_SA(1, 0), a3, voffA);
            PG8_WAIT_V(8); PG8_WAIT_L(0); PG8_BAR; PG8_MMA(1, 0, At, B0); PG8_MMA(1, 1, At, B1); PG8_BAR; PG8_SCHED;
            } else {
            PG8_LDB(B0, 0, 0); PG8_SCHED; PG8_LDA(At, 0, 0); PG8_STAGE(PG8_SA(1, 1), a1 + hstep, voffA);
            PG8_WAIT_L(8); PG8_BAR; PG8_WAIT_L(0); PG8_MMA(0, 0, At, B0); PG8_BAR; PG8_SCHED;
            PG8_LDB(B1, 0, 1); PG8_STAGE(PG8_SB(0, 0), b2, voffB);
            PG8_BAR; PG8_WAIT_L(0); PG8_MMA(0, 1, At, B1); PG8_BAR;
            PG8_LDA(At, 0, 1); PG8_STAGE(PG8_SA(0, 0), a2, voffA);
            PG8_BAR; PG8_WAIT_L(0); PG8_MMA(1, 0, At, B0); PG8_BAR; PG8_SCHED;
            PG8_STAGE(PG8_SB(0, 1), b2 + hstepB, voffB);
            PG8_WAIT_V(6); PG8_BAR; PG8_MMA(1, 1, At, B1); PG8_BAR;
            PG8_LDB(B0, 1, 0); PG8_SCHED; PG8_LDA(At, 1, 0); PG8_STAGE(PG8_SA(0, 1), a2 + hstep, voffA);
            PG8_WAIT_L(8); PG8_BAR; PG8_WAIT_L(0); PG8_MMA(0, 0, At, B0); PG8_BAR; PG8_SCHED;
            PG8_LDB(B1, 1, 1); PG8_STAGE(PG8_SB(1, 0), b3, voffB);
            PG8_BAR; PG8_WAIT_L(0); PG8_MMA(0, 1, At, B1); PG8_BAR;
            PG8_LDA(At, 1, 1); PG8_STAGE(PG8_SA(1, 0), a3, voffA);
            PG8_BAR; PG8_WAIT_L(0); PG8_MMA(1, 0, At, B0); PG8_BAR; PG8_SCHED;
            PG8_STAGE(PG8_SB(1, 1), b3 + hstepB, voffB);
            PG8_WAIT_V(6); PG8_BAR; PG8_MMA(1, 1, At, B1); PG8_BAR;
            }
        }
        if constexpr (ALIGN_EPI) { if (wr == 0) PG8_BAR; }
        if constexpr (!Epi::AFTER_DRAIN) { E(acc, cur, wr, wc, fr, fq); S.done(cur); }
        if (!has_next) break;
#pragma unroll
        for (int a = 0; a < 2; ++a)
#pragma unroll
            for (int b = 0; b < 2; ++b)
#pragma unroll
                for (int m = 0; m < 4; ++m)
#pragma unroll
                    for (int n = 0; n < 2; ++n) acc[a][b][m][n] = (f32x4){0.f, 0.f, 0.f, 0.f};
        cur = nxt; cA = nA; cB = nB; ++ui;
        if constexpr (ALIGN_EPI) { if (wr == 1) PG8_BAR; }
    }
    PG8_WAIT_V(0);
    if constexpr (!ALIGN_EPI) { if (wr == 0) PG8_BAR; }
    PG8_BAR;
    if constexpr (Epi::AFTER_DRAIN) { E.fused(acc, cur, wr, wc, fr, fq, lds, wid, lane); S.done(cur); }
#undef PG8_SA
#undef PG8_SB
#undef PG8_STAGE
#undef PG8_LDA
#undef PG8_LDB
#undef PG8_MMA
#undef PG8_WAIT_V
#undef PG8_WAIT_L
#undef PG8_BAR
#undef PG8_SCHED
}
}

typedef unsigned short bf16;
typedef float f32x4 __attribute__((ext_vector_type(4)));
typedef unsigned u32x4 __attribute__((ext_vector_type(4)));
typedef unsigned u32x2 __attribute__((ext_vector_type(2)));
#define LAS __attribute__((address_space(3)))
#define GAS __attribute__((address_space(1)))
constexpr int NWAVES = 8, NTHREADS = 512;
constexpr int BATCH = 4, SEQ = 4096, DM = 1024, DFF = 4096, DEPTH = 4, M = BATCH * SEQ;
constexpr int EV_COLS = 2816, OD_COLS = 3600, OD_PAD = 3840;
constexpr int OC_Z = 1536, OC_MQK = 2048, OC_MV = 2560, OC_MOG = 3072, OC_GB = 3584, OC_GA = 3588, OC_MI = 3592, OC_MF = 3596;
constexpr int EC_R = 1024, EC_K = 1536, EC_V = 2048, EC_XW = 2560, EC_XA = 2624, EC_XG = 2688;
constexpr int LDS_BYTES = 151552;
constexpr int N_PHASES = 2 + 7 * DEPTH;

constexpr size_t MiB = 1u << 20;
constexpr size_t WS_CTL = 0, CTL_BYTES = 1 * MiB;
constexpr size_t WS_TBL = 512 * 1024;
constexpr size_t WSET_BYTES = 26 * MiB;
constexpr size_t WS_WSET0 = 1 * MiB, WS_WSET1 = WS_WSET0 + WSET_BYTES;
constexpr size_t WOFF_IN = 0, WOFF_OUT = (size_t)OD_PAD * DM * 2, WOFF_UP = WOFF_OUT + (size_t)DM * DM * 2, WOFF_DOWN = WOFF_UP + (size_t)DFF * DM * 2, WOFF_G2 = WOFF_DOWN + (size_t)DM * DFF * 2;
static_assert(WOFF_G2 + (size_t)512 * 128 * 2 <= WSET_BYTES, "weight set");
constexpr size_t WS_SLOTS = WS_WSET1 + WSET_BYTES;
constexpr size_t WS_DEN = WS_SLOTS + 1 * MiB;
constexpr size_t WS_BONUS = WS_DEN + 1 * MiB;
constexpr size_t WS_XB = WS_BONUS + 1 * MiB;
constexpr size_t WS_Y = WS_XB + 32 * MiB;
constexpr size_t WS_R1 = WS_Y + 32 * MiB;
constexpr size_t WS_END = WS_R1 + 128 * MiB;
constexpr size_t WS_HALO = WS_END;
static_assert(WS_END <= 256 * MiB, "d_ws budget");

#ifndef REP_SKIP
#define REP_SKIP 0
#endif
struct Args {
    const float* in[36];
    float* out; unsigned char* ws;
    int ph_lo, ph_hi;
};

__device__ __forceinline__ float bf2f(unsigned h) { return __uint_as_float(h << 16); }
__device__ __forceinline__ unsigned f2bf(float f) { unsigned u = __float_as_uint(f); return (u + 0x7fffu + ((u >> 16) & 1u)) >> 16; }
__device__ __forceinline__ unsigned pk2(float lo, float hi) { typedef float f2_t __attribute__((ext_vector_type(2))); typedef __bf16 b2_t __attribute__((ext_vector_type(2)));
    const f2_t v = {lo, hi}; const b2_t c = __builtin_convertvector(v, b2_t); return __builtin_bit_cast(unsigned, c); }
__device__ __forceinline__ float fexp(float x) { return __builtin_amdgcn_exp2f(x * 1.4426950408889634f); }
__device__ __forceinline__ float flog(float x) { return __builtin_amdgcn_logf(x) * 0.6931471805599453f; }
__device__ __forceinline__ float frcp(float x) { return __builtin_amdgcn_rcpf(x); }
__device__ __forceinline__ float frsq(float x) { return __builtin_amdgcn_rsqf(x); }
__device__ __forceinline__ float sigm(float x) { return frcp(1.0f + fexp(-x)); }
__device__ __forceinline__ float softplusf(float x) { return fmaxf(x, 0.f) + flog(1.0f + fexp(-fabsf(x))); }
__device__ __forceinline__ float siluf(float x) { return x * sigm(x); }
__device__ __forceinline__ float ftanh(float x) { const float e = fexp(-2.0f * fabsf(x)); const float t = (1.0f - e) * frcp(1.0f + e); return x < 0.f ? -t : t; }
__device__ __forceinline__ float gelu_tanh(float x) { const float u = 0.7978845608028654f * (x + 0.044715f * x * x * x); return 0.5f * x * (1.0f + ftanh(u)); }
template <int CTRL> __device__ __forceinline__ float dpp_mov(float v) { return __int_as_float(__builtin_amdgcn_update_dpp(0, __float_as_int(v), CTRL, 0xF, 0xF, true)); }
__device__ __forceinline__ float row_sum16(float v) {
    v += dpp_mov<0x128>(v); v += dpp_mov<0x124>(v); v += dpp_mov<0x122>(v); v += dpp_mov<0x121>(v); return v;
}
__device__ __forceinline__ float wave_sum(float v) {
    v = row_sum16(v); v += __shfl_xor(v, 16); v += __shfl_xor(v, 32); return v;
}
__device__ __forceinline__ void ld4(const bf16* p, float* o) { const u32x2 w = *(const u32x2*)p; o[0] = bf2f(w.x & 0xffffu); o[1] = bf2f(w.x >> 16); o[2] = bf2f(w.y & 0xffffu); o[3] = bf2f(w.y >> 16); }
__device__ __forceinline__ void ld8(const bf16* p, float* o) { const u32x4 w = *(const u32x4*)p;
    o[0] = bf2f(w.x & 0xffffu); o[1] = bf2f(w.x >> 16); o[2] = bf2f(w.y & 0xffffu); o[3] = bf2f(w.y >> 16); o[4] = bf2f(w.z & 0xffffu); o[5] = bf2f(w.z >> 16); o[6] = bf2f(w.w & 0xffffu); o[7] = bf2f(w.w >> 16); }
__device__ __forceinline__ void ld2(const bf16* p, float* o) { const unsigned w = *(const unsigned*)p; o[0] = bf2f(w & 0xffffu); o[1] = bf2f(w >> 16); }

__device__ __forceinline__ void lds_barrier() { asm volatile("s_waitcnt lgkmcnt(0)" ::: "memory"); __builtin_amdgcn_s_barrier(); asm volatile("" ::: "memory"); }
#define GPTR(T, p) ((T*)(GAS T*)(unsigned long long)(p))
#define RING_FENCE asm volatile("" ::: "memory")
struct Ctx {
    const unsigned long long* tbl; float* out; unsigned char* ws;
    int wave, vcu, G, bid; unsigned z0;
    __device__ __forceinline__ int lane() const { return (int)__builtin_amdgcn_mbcnt_hi(~0u, __builtin_amdgcn_mbcnt_lo(~0u, z0)); }
    __device__ __forceinline__ int tid() const { return wave * 64 + lane(); }
    __device__ __forceinline__ float zf() const { return __uint_as_float(z0); }
    __device__ __forceinline__ const float* in(int i) const {
        const unsigned long long v = tbl[i];
        const unsigned lo = __builtin_amdgcn_readfirstlane((unsigned)v), hi = __builtin_amdgcn_readfirstlane((unsigned)(v >> 32));
        return (const float*)(const GAS float*)(((unsigned long long)hi << 32) | lo);
    }
    __device__ __forceinline__ bf16* wset(int l, size_t off) const { return (bf16*)(ws + ((l & 1) ? WS_WSET1 : WS_WSET0) + off); }
};

__device__ __forceinline__ void transpose_item(const float* W, int ldw, int K, int src_col0, bf16* WT, int dst_row0, const float* g, int kb, float* scr, int lane) {
    const int k0 = 64 * kb;
    float wv[32];
#pragma unroll
    for (int i = 0; i < 32; ++i) wv[i] = W[(size_t)(k0 + 2 * i + (lane >> 5)) * ldw + src_col0 + (lane & 31)];
#pragma unroll
    for (int i = 0; i < 32; ++i) { const int kk = 2 * i + (lane >> 5); float v = wv[i]; if (g) v *= g[k0 + kk]; scr[kk * 33 + (lane & 31)] = v; }
    asm volatile("s_waitcnt lgkmcnt(0)" ::: "memory");
    const int c = lane & 7;
#pragma unroll
    for (int j = 0; j < 4; ++j) { const int n = (lane >> 3) + 8 * j; const float* s = scr + (8 * c) * 33 + n;
        u32x4 o; o.x = pk2(s[0 * 33], s[1 * 33]); o.y = pk2(s[2 * 33], s[3 * 33]); o.z = pk2(s[4 * 33], s[5 * 33]); o.w = pk2(s[6 * 33], s[7 * 33]);
        *(u32x4*)(WT + (size_t)(dst_row0 + n) * K + k0 + 8 * c) = o; }
    asm volatile("s_waitcnt lgkmcnt(0)" ::: "memory");
}
__device__ __forceinline__ void convert_layer(const Ctx& C, int l, float* sm, int first_blk, int nblk) {
    float* scr = sm + C.wave * (64 * 33 + 16);
    const int gw = (C.bid - first_blk) * NWAVES + C.wave, NGW = nblk * NWAVES;
    const bool even = (l & 1) == 0; const int li = l >> 1;
    const float* Win = even ? C.in(6) + (size_t)li * DM * EV_COLS : C.in(26) + (size_t)li * DM * OD_COLS;
    const float* Wout = even ? C.in(7) + (size_t)li * DM * DM : C.in(27) + (size_t)li * DM * DM;
    const float* Wup = C.in(3) + (size_t)l * DM * DFF; const float* Wdn = C.in(4) + (size_t)l * DFF * DM;
    const float* gmix = C.in(1) + (size_t)l * DM; const float* gmlp = C.in(2) + (size_t)l * DM;
    bf16* Tin = C.wset(l, WOFF_IN); bf16* Tout = C.wset(l, WOFF_OUT); bf16* Tup = C.wset(l, WOFF_UP); bf16* Tdn = C.wset(l, WOFF_DOWN);
    const int ldin = even ? EV_COLS : OD_COLS;
    const int nb_in = even ? EV_COLS / 32 : 3584 / 32;
    const int I_IN = 16 * nb_in, I_OUT = 16 * 32, I_UP = 16 * 128, I_DN = 64 * 32;
    const int I_G2 = even ? 32 : 0;
    const int NIT = I_IN + I_OUT + I_UP + I_DN + I_G2;
    for (int it = gw; it < NIT; it += NGW) {
        int r = it;
        if (r < I_IN) { const int kb = r / nb_in, nb = r % nb_in; const int dst = 32 * nb; int src = dst; if (!even && dst >= 2048) src = dst + 8;
            transpose_item(Win, ldin, DM, src, Tin, dst, gmix, kb, scr, C.lane()); continue; } r -= I_IN;
        if (r < I_OUT) { transpose_item(Wout, DM, DM, 32 * (r % 32), Tout, 32 * (r % 32), nullptr, r / 32, scr, C.lane()); continue; } r -= I_OUT;
        if (r < I_UP) { transpose_item(Wup, DFF, DM, 32 * (r % 128), Tup, 32 * (r % 128), gmlp, r / 128, scr, C.lane()); continue; } r -= I_UP;
        if (r < I_DN) { transpose_item(Wdn, DM, DFF, 32 * (r % 32), Tdn, 32 * (r % 32), nullptr, r / 32, scr, C.lane()); continue; } r -= I_DN;
        transpose_item(C.in(20) + (size_t)li * 128 * 512, 512, 128, 32 * (r % 16), C.wset(l, WOFF_G2), 32 * (r % 16), nullptr, r / 16, scr, C.lane());
    }
    if (!even) {
        const int gt = (C.bid - first_blk) * NTHREADS + C.tid(), NGT = nblk * NTHREADS;
        for (int i = gt; i < 16 * DM; i += NGT) { const int n = i >> 10, k = i & 1023; const int src = n < 8 ? 2048 + n : 3592 + (n - 8);
            Tin[(size_t)(3584 + n) * DM + k] = (bf16)f2bf(Win[(size_t)k * OD_COLS + src] * gmix[k]); }
        u32x4* z = (u32x4*)(Tin + (size_t)3600 * DM); const int nz = 240 * DM / 8;
        for (int i = gt; i < nz; i += NGT) z[i] = (u32x4){C.z0, C.z0, C.z0, C.z0};
    }
}

__device__ __forceinline__ void prologue_rows(const Ctx& C) {
    const int gw = C.vcu * NWAVES + C.wave, NGW = C.G * NWAVES;
    const float* x = C.in(0); bf16* XB = (bf16*)C.out; float* slots = GPTR(float, C.ws + WS_SLOTS);
    for (int m = gw; m < M; m += NGW) {
        const f32x4* xr = (const f32x4*)(x + (size_t)m * DM) + C.lane();
        u32x2* brow = (u32x2*)(XB + (size_t)m * DM) + C.lane(); float s = 0.f;
#pragma unroll
        for (int j = 0; j < 4; ++j) { const f32x4 v = xr[64 * j]; u32x2 w; w.x = pk2(v[0], v[1]); w.y = pk2(v[2], v[3]); brow[64 * j] = w;
            const float r0 = __uint_as_float(w.x << 16), r1 = __uint_as_float(w.x & 0xffff0000u), r2 = __uint_as_float(w.y << 16), r3 = __uint_as_float(w.y & 0xffff0000u); s += (r0 * r0 + r1 * r1) + (r2 * r2 + r3 * r3); }
        s = wave_sum(s);
        if (C.lane() < 16) slots[(size_t)m * 16 + C.lane()] = (C.lane() == 0) ? s : 0.f;
    }
}
__device__ __forceinline__ void final_rows(const Ctx& C) {
    const int gw = C.vcu * NWAVES + C.wave, NGW = C.G * NWAVES;
    const float* slots = GPTR(const float, C.ws + WS_SLOTS); const f32x4* g = (const f32x4*)C.in(5) + C.lane();
    for (int m = gw; m < M; m += NGW) {
        const float rs = pg8::row_rstd(slots, m);
        f32x4* orow = (f32x4*)(C.out + (size_t)m * DM) + C.lane(); const u32x2* brow = (const u32x2*)(GPTR(const bf16, C.ws + WS_XB) + (size_t)m * DM) + C.lane();
#pragma unroll
        for (int j = 0; j < 4; ++j) { const u32x2 w = brow[64 * j]; f32x4 v; v[0] = __uint_as_float(w.x << 16); v[1] = __uint_as_float(w.x & 0xffff0000u); v[2] = __uint_as_float(w.y << 16); v[3] = __uint_as_float(w.y & 0xffff0000u);
            v = v * rs * g[64 * j]; orow[64 * j] = v; }
    }
}

__device__ __forceinline__ void lru_block(const Ctx& C, int e, int lb, float* sm) {
    const int tid = C.tid(), lane = C.lane(), wave = C.wave;
    const int b = lb >> 3, n = lb & 7;
    const bf16* P = GPTR(const bf16, C.ws + WS_R1); bf16* Y = GPTR(bf16, C.ws + WS_Y);
    const float* convw = C.in(8) + (size_t)e * 4 * 512; const float* convb = C.in(9) + (size_t)e * 512;
    const float* wa = C.in(10) + ((size_t)e * 8 + n) * 4096; const float* ba = C.in(11) + (size_t)e * 512;
    const float* wx = C.in(12) + ((size_t)e * 8 + n) * 4096; const float* bx = C.in(13) + (size_t)e * 512;
    const float* lam = C.in(14) + (size_t)e * 512;
    float* sWA = sm; float* sWX = sWA + 4096; float* sXC = sWX + 4096; float* sA = sXC + 4096; float* sU = sA + 4096; float* sH = sU + 4096;
    for (int i = tid; i < 4096; i += NTHREADS) { sWA[i] = wa[i]; sWX[i] = wx[i]; }
    float hc = 0.f;
    const int ct = tid >> 3, l8 = tid & 7;
    float cw[4][8], cb[8];
#pragma unroll
    for (int j = 0; j < 8; ++j) { const int c = n * 64 + 8 * l8 + j; cb[j] = convb[c];
#pragma unroll
        for (int k = 0; k < 4; ++k) cw[k][j] = convw[k * 512 + c]; }
    const int ce = n * 64 + lane;
    const float g_ba = ba[ce], g_bx = bx[ce], g_sp = softplusf(-lam[ce]);
    __syncthreads();
    for (int ch = 0; ch < SEQ / 64; ++ch) {
        const int t0 = ch * 64; const size_t m0 = (size_t)b * SEQ + t0;
        {
            float acc[8];
#pragma unroll
            for (int j = 0; j < 8; ++j) acc[j] = cb[j];
#pragma unroll
            for (int k = 0; k < 4; ++k) { const int t = t0 + ct - 3 + k;
                if (t >= 0) { float v[8]; ld8(P + ((size_t)b * SEQ + t) * EV_COLS + 512 + n * 64 + 8 * l8, v);
#pragma unroll
                    for (int j = 0; j < 8; ++j) acc[j] += cw[k][j] * v[j]; } }
            *(f32x4*)(sXC + ct * 64 + 8 * l8) = (f32x4){acc[0], acc[1], acc[2], acc[3]};
            *(f32x4*)(sXC + ct * 64 + 8 * l8 + 4) = (f32x4){acc[4], acc[5], acc[6], acc[7]};
        }
        __syncthreads();
        {
            float ar[8], ai[8];
#pragma unroll
            for (int q = 0; q < 8; ++q) { ar[q] = 0.f; ai[q] = 0.f; }
#pragma unroll 1
            for (int d = 0; d < 64; d += 4) {
                float war[4], wxr[4];
#pragma unroll
                for (int dd = 0; dd < 4; ++dd) { war[dd] = sWA[(d + dd) * 64 + lane]; wxr[dd] = sWX[(d + dd) * 64 + lane]; }
#pragma unroll
                for (int q = 0; q < 8; ++q) { const f32x4 xv = *(const f32x4*)(sXC + (wave * 8 + q) * 64 + d);
#pragma unroll
                    for (int dd = 0; dd < 4; ++dd) { ar[q] += xv[dd] * war[dd]; ai[q] += xv[dd] * wxr[dd]; } }
            }
#pragma unroll
            for (int q = 0; q < 8; ++q) { const int t = wave * 8 + q;
                const float r = sigm(ar[q] + g_ba), ig = sigm(ai[q] + g_bx);
                const float log_a = -8.0f * r * g_sp; const float a = fexp(log_a);
                float mult = sqrtf(-expm1f(2.0f * log_a)); if (t0 + t == 0) mult = 1.0f;
                sA[t * 64 + lane] = a; sU[t * 64 + lane] = ig * sXC[t * 64 + lane] * mult; }
        }
        __syncthreads();
        if (wave == 0) {
#pragma unroll 8
            for (int t = 0; t < 64; ++t) { hc = sA[t * 64 + lane] * hc + sU[t * 64 + lane]; sH[t * 64 + lane] = hc; }
        }
        __syncthreads();
        {
            float gv[8]; ld8(P + (m0 + ct) * EV_COLS + n * 64 + 8 * l8, gv);
            const f32x4 h0 = *(const f32x4*)(sH + ct * 64 + 8 * l8), h1 = *(const f32x4*)(sH + ct * 64 + 8 * l8 + 4);
            u32x4 w; w.x = pk2(h0[0] * gelu_tanh(gv[0]), h0[1] * gelu_tanh(gv[1])); w.y = pk2(h0[2] * gelu_tanh(gv[2]), h0[3] * gelu_tanh(gv[3]));
            w.z = pk2(h1[0] * gelu_tanh(gv[4]), h1[1] * gelu_tanh(gv[5])); w.w = pk2(h1[2] * gelu_tanh(gv[6]), h1[3] * gelu_tanh(gv[7]));
            *(u32x4*)(Y + (m0 + ct) * DM + n * 64 + 8 * l8) = w;
        }
    }
}

constexpr int RW_TC = 32;
__device__ __forceinline__ void rwkv_block(const Ctx& C, int e, int rb, float* sm) {
    const int tid = C.tid(), lane = C.lane(), wave = C.wave;
    const int bh = rb >> 1, half = rb & 1, b = bh >> 3, h = bh & 7;
    const bf16* P = GPTR(const bf16, C.ws + WS_R1); float* yraw = GPTR(float, C.ws + WS_XB); float* bonus = GPTR(float, C.ws + WS_BONUS);
    const float* mu = C.in(15) + (size_t)e * 1792; const float* w0 = C.in(16) + (size_t)e * 512; const float* w2 = C.in(17) + (size_t)e * 64 * 512;
    const float* a0 = C.in(18) + (size_t)e * 512; const float* a2 = C.in(19) + (size_t)e * 64 * 512;
    const float* kkp = C.in(21) + (size_t)e * 512; const float* kap = C.in(22) + (size_t)e * 512; const float* rkp = C.in(23) + (size_t)e * 512;
    float* sW2 = sm; float* sA2 = sW2 + 4096; float* sXW = sA2 + 4096; float* sXA = sXW + 2048;
    float* cW = sXA + 2048; float* cKK = cW + 2048; float* cB = cKK + 2048; float* cK = cB + 2048; float* cR = cK + 2048;
    float* cV = cR + 2048; float* sY = cV + 1024;
    for (int i = tid; i < 4096; i += NTHREADS) { const int j = i >> 6, c = i & 63; sW2[i] = w2[(size_t)j * 512 + h * 64 + c]; sA2[i] = a2[(size_t)j * 512 + h * 64 + c]; }
    const int tt = tid >> 4, l16 = tid & 15;
    float mur[4], muk[4], muv[4], muw[4], mua[4];
#pragma unroll
    for (int j = 0; j < 4; ++j) { const int c = 4 * l16 + j; mur[j] = mu[h * 64 + c]; muk[j] = mu[512 + h * 64 + c]; muv[j] = mu[1024 + h * 64 + c]; muw[j] = mu[1536 + c]; mua[j] = mu[1600 + c]; }
    const int hc = h * 64 + lane;
    const float p_w0 = w0[hc], p_a0 = a0[hc], p_kk = kkp[hc], p_ka = kap[hc], p_rk = rkp[hc];
    float S[4] = {0.f, 0.f, 0.f, 0.f};
    __syncthreads();
    for (int ch = 0; ch < SEQ / RW_TC; ++ch) {
        const int t0 = ch * RW_TC; const size_t m0 = (size_t)b * SEQ + t0;
        {
            const bf16* row = P + (m0 + tt) * EV_COLS; const bool hp = (t0 + tt) > 0; const bf16* prow = row - EV_COLS;
            float c4[4], p4[4], o[4];
#define SHIFT4(col, muv_) do { ld4(row + (col), c4); if (hp) ld4(prow + (col), p4); else { p4[0] = p4[1] = p4[2] = p4[3] = 0.f; } \
            _Pragma("unroll") for (int j = 0; j < 4; ++j) o[j] = c4[j] + muv_[j] * (p4[j] - c4[j]); } while (0)
            SHIFT4(EC_R + h * 64 + 4 * l16, mur); *(f32x4*)(cR + tt * 64 + 4 * l16) = (f32x4){o[0], o[1], o[2], o[3]};
            SHIFT4(EC_K + h * 64 + 4 * l16, muk); *(f32x4*)(cK + tt * 64 + 4 * l16) = (f32x4){o[0], o[1], o[2], o[3]};
            SHIFT4(EC_V + h * 64 + 4 * l16, muv); if ((l16 >> 3) == half) *(f32x4*)(cV + tt * 32 + 4 * (l16 & 7)) = (f32x4){o[0], o[1], o[2], o[3]};
            SHIFT4(EC_XW + 4 * l16, muw); *(f32x4*)(sXW + tt * 64 + 4 * l16) = (f32x4){ftanh(o[0]), ftanh(o[1]), ftanh(o[2]), ftanh(o[3])};
            SHIFT4(EC_XA + 4 * l16, mua); *(f32x4*)(sXA + tt * 64 + 4 * l16) = (f32x4){o[0], o[1], o[2], o[3]};
#undef SHIFT4
        }
        __syncthreads();
        {
            float zw[4] = {0.f, 0.f, 0.f, 0.f}, za[4] = {0.f, 0.f, 0.f, 0.f};
#pragma unroll 1
            for (int j = 0; j < 64; j += 4) {
                float w2v[4], a2v[4];
#pragma unroll
                for (int jj = 0; jj < 4; ++jj) { w2v[jj] = sW2[(j + jj) * 64 + lane]; a2v[jj] = sA2[(j + jj) * 64 + lane]; }
#pragma unroll
                for (int q = 0; q < 4; ++q) { const f32x4 xw = *(const f32x4*)(sXW + (wave * 4 + q) * 64 + j), xa = *(const f32x4*)(sXA + (wave * 4 + q) * 64 + j);
#pragma unroll
                    for (int jj = 0; jj < 4; ++jj) { zw[q] += xw[jj] * w2v[jj]; za[q] += xa[jj] * a2v[jj]; } }
            }
#pragma unroll
            for (int q = 0; q < 4; ++q) { const int t = wave * 4 + q;
                const float wlog = -softplusf(-(p_w0 + zw[q])) - 0.5f; const float dec = fexp(-fexp(wlog));
                const float a = sigm(p_a0 + za[q]);
                const float kraw = cK[t * 64 + lane], r = cR[t * 64 + lane];
                const float kkv = kraw * p_kk; const float ss = wave_sum(kkv * kkv); const float kkn = kkv * (frsq(ss + 1e-6f));
                const float kp = kraw * (1.0f + (a - 1.0f) * p_ka);
                const float bon = wave_sum(r * kp * p_rk);
                if (half == 0 && lane == 0) bonus[(m0 + t) * 8 + h] = bon;
                cW[t * 64 + lane] = dec; cKK[t * 64 + lane] = kkn; cB[t * 64 + lane] = kkn * a; cK[t * 64 + lane] = kp; }
        }
        __syncthreads();
        {
            const int row = tid >> 4;
#pragma unroll 4
            for (int t = 0; t < RW_TC; ++t) {
                const f32x4 w4 = *(const f32x4*)(cW + t * 64 + 4 * l16), kk4 = *(const f32x4*)(cKK + t * 64 + 4 * l16), b4 = *(const f32x4*)(cB + t * 64 + 4 * l16);
                const f32x4 k4 = *(const f32x4*)(cK + t * 64 + 4 * l16), r4 = *(const f32x4*)(cR + t * 64 + 4 * l16);
                const float v = cV[t * 32 + row];
                float sk = (S[0] * kk4[0] + S[1] * kk4[1]) + (S[2] * kk4[2] + S[3] * kk4[3]);
                sk = row_sum16(sk);
#pragma unroll
                for (int j = 0; j < 4; ++j) S[j] = (S[j] * w4[j] + v * k4[j]) - sk * b4[j];
                float y = (S[0] * r4[0] + S[1] * r4[1]) + (S[2] * r4[2] + S[3] * r4[3]);
                y = row_sum16(y);
                if (l16 == 0) sY[t * 32 + row] = y;
            }
        }
        __syncthreads();
#pragma unroll
        for (int i = 0; i < 2; ++i) { const int idx = tid + i * NTHREADS, t = idx >> 5, rr = idx & 31; yraw[(m0 + t) * 512 + h * 64 + 32 * half + rr] = sY[idx]; }
    }
}

__device__ __forceinline__ void rwkv_post_tile(const Ctx& C, int e, int tile, float* sm) {
    const int tid = C.tid(), lane = C.lane(), wave = C.wave;
    const bf16* P = GPTR(const bf16, C.ws + WS_R1); const float* yraw = GPTR(const float, C.ws + WS_XB); const float* bonus = GPTR(const float, C.ws + WS_BONUS); bf16* Y = GPTR(bf16, C.ws + WS_Y);
    const float* mu = C.in(15) + (size_t)e * 1792; const float* g2 = C.in(20) + (size_t)e * 128 * 512;
    const float* lnw = C.in(24) + (size_t)e * 512; const float* lnb = C.in(25) + (size_t)e * 512;
    const size_t m0 = (size_t)tile * 64; const int t0 = (int)(m0 % SEQ);
    float* sG = sm;
    __syncthreads();
    for (int i = 0; i < 16; ++i) { const int idx = tid + i * NTHREADS, t = idx >> 7, j = idx & 127;
        const float p = bf2f(P[(m0 + t) * EV_COLS + EC_XG + j]); const float pp = (t0 + t) > 0 ? bf2f(P[(m0 + t - 1) * EV_COLS + EC_XG + j]) : 0.f;
        sG[idx] = sigm(p + mu[1664 + j] * (pp - p)); }
    __syncthreads();
    const int c = tid;
    float acc[64];
#pragma unroll
    for (int t = 0; t < 64; ++t) acc[t] = 0.f;
#pragma unroll 1
    for (int j = 0; j < 128; j += 4) {
        const float g0 = g2[(size_t)(j + 0) * 512 + c], g1 = g2[(size_t)(j + 1) * 512 + c], g2v = g2[(size_t)(j + 2) * 512 + c], g3 = g2[(size_t)(j + 3) * 512 + c];
#pragma unroll
        for (int t = 0; t < 64; ++t) { const f32x4 s = *(const f32x4*)(sG + t * 128 + j); acc[t] += (s[0] * g0 + s[1] * g1) + (s[2] * g2v + s[3] * g3); }
    }
    __syncthreads();
#pragma unroll
    for (int t = 0; t < 64; ++t) sm[t * 512 + c] = acc[t];
    const float p_lnw = lnw[c], p_lnb = lnb[c], p_muv = mu[1024 + c];
#pragma unroll 2
    for (int t = 0; t < 64; ++t) { const size_t m = m0 + t;
        const float y = yraw[m * 512 + c]; const float mean = wave_sum(y) * (1.0f / 64.0f); const float d = y - mean; const float var = wave_sum(d * d) * (1.0f / 64.0f);
        const float yn = d * (frsq(var + 64e-5f)) * p_lnw + p_lnb;
        const float pv = bf2f(P[m * EV_COLS + EC_V + c]); const float pvp = (t0 + t) > 0 ? bf2f(P[(m - 1) * EV_COLS + EC_V + c]) : 0.f; const float vs = pv + p_muv * (pvp - pv);
        Y[m * DM + 512 + c] = (bf16)f2bf((yn + bonus[m * 8 + wave] * vs) * sm[t * 512 + c]); }
}

constexpr int OD_TC = 32;
__device__ __forceinline__ void gdn_block(const Ctx& C, int o, int gb, float* sm) {
    const int tid = C.tid();
    const int bh = gb >> 2, cgp = gb & 3, b = bh >> 2, h = bh & 3;
    const bf16* P = GPTR(const bf16, C.ws + WS_R1); bf16* oraw = GPTR(bf16, C.ws + WS_Y);
    const float* convw = C.in(28) + (size_t)o * 4 * 1536;
    const float nA = -fexp(C.in(29)[o * 4 + h]); const float dtb = C.in(30)[o * 4 + h];
    float* cQ = sm; float* cK = cQ + 4096; float* cV = cK + 4096; float* cAl = cV + 1024; float* cBe = cAl + 32; float* cQK = cBe + 32; float* sO = cQK + 32;
    const int tt = tid >> 4, l16 = tid & 15;
    const int qc = h * 128 + 8 * l16, kc = 512 + h * 128 + 8 * l16, vc = 1024 + h * 128 + 32 * cgp + 2 * l16;
    float wq[4][8], wk[4][8], wv[4][2];
#pragma unroll
    for (int k = 0; k < 4; ++k) {
#pragma unroll
        for (int j = 0; j < 8; ++j) { wq[k][j] = convw[k * 1536 + qc + j]; wk[k][j] = convw[k * 1536 + kc + j]; }
        wv[k][0] = convw[k * 1536 + vc]; wv[k][1] = convw[k * 1536 + vc + 1]; }
    float S[8];
#pragma unroll
    for (int j = 0; j < 8; ++j) S[j] = 0.f;
    for (int ch = 0; ch < SEQ / OD_TC; ++ch) {
        const int t0 = ch * OD_TC; const size_t m0 = (size_t)b * SEQ + t0;
        __syncthreads();
        {
            float q[8], kx[8], v2[2] = {0.f, 0.f};
#pragma unroll
            for (int j = 0; j < 8; ++j) { q[j] = 0.f; kx[j] = 0.f; }
#pragma unroll
            for (int k = 0; k < 4; ++k) { const int t = t0 + tt - 3 + k;
                if (t >= 0) { const bf16* row = P + ((size_t)b * SEQ + t) * OD_PAD; float a8[8], b8[8], c2[2]; ld8(row + qc, a8); ld8(row + kc, b8); ld2(row + vc, c2);
#pragma unroll
                    for (int j = 0; j < 8; ++j) { q[j] += wq[k][j] * a8[j]; kx[j] += wk[k][j] * b8[j]; }
                    v2[0] += wv[k][0] * c2[0]; v2[1] += wv[k][1] * c2[1]; } }
            float sq = 0.f, sk = 0.f;
#pragma unroll
            for (int j = 0; j < 8; ++j) { q[j] = siluf(q[j]); kx[j] = siluf(kx[j]); sq += q[j] * q[j]; sk += kx[j] * kx[j]; }
            sq = row_sum16(sq); sk = row_sum16(sk);
            const float rq = (frsq(sq + 1e-6f)) * 0.08838834764831845f, rk = frsq(sk + 1e-6f);
            float qk = 0.f;
#pragma unroll
            for (int j = 0; j < 8; ++j) { q[j] *= rq; kx[j] *= rk; qk += q[j] * kx[j]; }
            qk = row_sum16(qk);
            *(f32x4*)(cQ + tt * 128 + 8 * l16) = (f32x4){q[0], q[1], q[2], q[3]}; *(f32x4*)(cQ + tt * 128 + 8 * l16 + 4) = (f32x4){q[4], q[5], q[6], q[7]};
            *(f32x4*)(cK + tt * 128 + 8 * l16) = (f32x4){kx[0], kx[1], kx[2], kx[3]}; *(f32x4*)(cK + tt * 128 + 8 * l16 + 4) = (f32x4){kx[4], kx[5], kx[6], kx[7]};
            cV[tt * 32 + 2 * l16] = siluf(v2[0]); cV[tt * 32 + 2 * l16 + 1] = siluf(v2[1]);
            if (l16 == 0) { const bf16* row = P + (m0 + tt) * OD_PAD; const float braw = bf2f(row[OC_GB + h]), araw = bf2f(row[OC_GA + h]);
                cBe[tt] = sigm(braw); cAl[tt] = fexp(nA * softplusf(araw + dtb)); cQK[tt] = qk; }
        }
        __syncthreads();
        {
            const int col = tid >> 4;
#pragma unroll 2
            for (int t = 0; t < OD_TC; ++t) {
                const f32x4 k0 = *(const f32x4*)(cK + t * 128 + 8 * l16), k1 = *(const f32x4*)(cK + t * 128 + 8 * l16 + 4);
                const f32x4 q0 = *(const f32x4*)(cQ + t * 128 + 8 * l16), q1 = *(const f32x4*)(cQ + t * 128 + 8 * l16 + 4);
                const float v = cV[t * 32 + col], al = cAl[t], be = cBe[t], qk = cQK[t];
                float kS = ((S[0] * k0[0] + S[1] * k0[1]) + (S[2] * k0[2] + S[3] * k0[3])) + ((S[4] * k1[0] + S[5] * k1[1]) + (S[6] * k1[2] + S[7] * k1[3]));
                float qS = ((S[0] * q0[0] + S[1] * q0[1]) + (S[2] * q0[2] + S[3] * q0[3])) + ((S[4] * q1[0] + S[5] * q1[1]) + (S[6] * q1[2] + S[7] * q1[3]));
                kS = row_sum16(kS); qS = row_sum16(qS);
                const float delta = be * (v - al * kS);
#pragma unroll
                for (int j = 0; j < 4; ++j) { S[j] = al * S[j] + k0[j] * delta; S[4 + j] = al * S[4 + j] + k1[j] * delta; }
                if (l16 == 0) sO[t * 32 + col] = al * qS + qk * delta;
            }
        }
        __syncthreads();
#pragma unroll
        for (int i = 0; i < 2; ++i) { const int idx = tid + i * NTHREADS, t = idx >> 5, cc = idx & 31; oraw[(m0 + t) * DM + h * 128 + 32 * cgp + cc] = (bf16)f2bf(sO[idx]); }
    }
}

__device__ __forceinline__ void mlstm_block(const Ctx& C, int o, int mb, float* sm) {
    const int tid = C.tid();
    const int bh = mb / 5, cgp = mb % 5, b = bh >> 2, h = bh & 3;
    const bf16* P = GPTR(const bf16, C.ws + WS_R1); float* nraw = GPTR(float, C.ws + WS_XB); float* den = GPTR(float, C.ws + WS_DEN);
    const float* convw = C.in(32) + (size_t)o * 4 * 512;
    const float igb = C.in(33)[o * 4 + h], fgb = C.in(34)[o * 4 + h];
    float* cQ = sm; float* cIK = cQ + 2048; float* cV = cIK + 2048; float* cF = cV + 1024; float* sO = cF + 32;
    const int tt = tid >> 4, l16 = tid & 15;
    const int qc = h * 64 + 4 * l16, kc = 256 + h * 64 + 4 * l16;
    float wq[4][4], wk[4][4];
#pragma unroll
    for (int k = 0; k < 4; ++k)
#pragma unroll
        for (int j = 0; j < 4; ++j) { wq[k][j] = convw[k * 512 + qc + j]; wk[k][j] = convw[k * 512 + kc + j]; }
    float Cs[4] = {0.f, 0.f, 0.f, 0.f};
    for (int ch = 0; ch < SEQ / OD_TC; ++ch) {
        const int t0 = ch * OD_TC; const size_t m0 = (size_t)b * SEQ + t0;
        __syncthreads();
        {
            float q[4] = {0.f, 0.f, 0.f, 0.f}, kx[4] = {0.f, 0.f, 0.f, 0.f};
#pragma unroll
            for (int k = 0; k < 4; ++k) { const int t = t0 + tt - 3 + k;
                if (t >= 0) { const bf16* row = P + ((size_t)b * SEQ + t) * OD_PAD + OC_MQK; float a4[4], b4[4]; ld4(row + qc, a4); ld4(row + kc, b4);
#pragma unroll
                    for (int j = 0; j < 4; ++j) { q[j] += wq[k][j] * a4[j]; kx[j] += wk[k][j] * b4[j]; } } }
            const bf16* row = P + (m0 + tt) * OD_PAD;
            const float ei = fexp(bf2f(row[OC_MI + h]) + igb);
            *(f32x4*)(cQ + tt * 64 + 4 * l16) = (f32x4){siluf(q[0]) * 0.125f, siluf(q[1]) * 0.125f, siluf(q[2]) * 0.125f, siluf(q[3]) * 0.125f};
            *(f32x4*)(cIK + tt * 64 + 4 * l16) = (f32x4){siluf(kx[0]) * ei, siluf(kx[1]) * ei, siluf(kx[2]) * ei, siluf(kx[3]) * ei};
            if (cgp < 4) { float c2[2]; ld2(row + OC_MV + h * 128 + 32 * cgp + 2 * l16, c2); cV[tt * 32 + 2 * l16] = c2[0]; cV[tt * 32 + 2 * l16 + 1] = c2[1]; }
            else { cV[tt * 32 + 2 * l16] = 1.0f; cV[tt * 32 + 2 * l16 + 1] = 1.0f; }
            if (l16 == 0) cF[tt] = sigm(bf2f(row[OC_MF + h]) + fgb);
        }
        __syncthreads();
        {
            const int col = tid >> 4;
#pragma unroll 4
            for (int t = 0; t < OD_TC; ++t) {
                const f32x4 ik = *(const f32x4*)(cIK + t * 64 + 4 * l16), q4 = *(const f32x4*)(cQ + t * 64 + 4 * l16);
                const float v = cV[t * 32 + col], f = cF[t];
#pragma unroll
                for (int j = 0; j < 4; ++j) Cs[j] = f * Cs[j] + v * ik[j];
                float nm = (Cs[0] * q4[0] + Cs[1] * q4[1]) + (Cs[2] * q4[2] + Cs[3] * q4[3]);
                nm = row_sum16(nm);
                if (l16 == 0) sO[t * 32 + col] = nm;
            }
        }
        __syncthreads();
        if (cgp < 4) {
#pragma unroll
            for (int i = 0; i < 2; ++i) { const int idx = tid + i * NTHREADS, t = idx >> 5, cc = idx & 31; nraw[(m0 + t) * 512 + h * 128 + 32 * cgp + cc] = sO[idx]; }
        } else if (tid < OD_TC) den[(m0 + tid) * 4 + h] = sO[tid * 32];
    }
}

__device__ __forceinline__ void odd_post(const Ctx& C, int o, bool rep = false) {
    const int gw = C.vcu * NWAVES + C.wave, NGW = C.G * NWAVES, lane = C.lane();
    const bf16* P = GPTR(const bf16, C.ws + WS_R1); const float* den = GPTR(const float, C.ws + WS_BONUS);
    bf16* Y = GPTR(bf16, C.ws + WS_Y); bf16* Yo = rep ? GPTR(bf16, C.ws + WS_XB) : Y;
    const float* gng = C.in(31) + (size_t)o * 128; const float* mng = C.in(35) + (size_t)o * 128;
    float gg[8], mg[8];
#pragma unroll
    for (int j = 0; j < 8; ++j) { gg[j] = gng[(8 * lane + j) & 127]; mg[j] = mng[(8 * lane + j) & 127]; }
    for (int m = gw; m < M; m += NGW) {
        float ov[8], nv[8], z8[8], og8[8];
        ld8(Y + (size_t)m * DM + 8 * lane, ov); ld8(Y + (size_t)m * DM + 512 + 8 * lane, nv);
        const float dn = den[(size_t)m * 4 + (lane >> 4)];
        ld8(P + (size_t)m * OD_PAD + OC_Z + 8 * lane, z8); ld8(P + (size_t)m * OD_PAD + OC_MOG + 8 * lane, og8);
        const float inv = 1.0f / fmaxf(fabsf(dn), 1.0f);
        float s1 = 0.f, s2 = 0.f;
#pragma unroll
        for (int j = 0; j < 8; ++j) { nv[j] *= inv; s1 += ov[j] * ov[j]; s2 += nv[j] * nv[j]; }
        s1 = row_sum16(s1); s2 = row_sum16(s2);
        const float r1 = frsq(s1 * (1.0f / 128.0f) + 1e-6f), r2 = frsq(s2 * (1.0f / 128.0f) + 1e-6f);
        float y1[8], y2[8];
#pragma unroll
        for (int j = 0; j < 8; ++j) { y1[j] = ov[j] * r1 * gg[j] * siluf(z8[j]); y2[j] = nv[j] * r2 * mg[j] * sigm(og8[j]); }
        u32x4 w1, w2; w1.x = pk2(y1[0], y1[1]); w1.y = pk2(y1[2], y1[3]); w1.z = pk2(y1[4], y1[5]); w1.w = pk2(y1[6], y1[7]);
        w2.x = pk2(y2[0], y2[1]); w2.y = pk2(y2[2], y2[3]); w2.z = pk2(y2[4], y2[5]); w2.w = pk2(y2[6], y2[7]);
        *(u32x4*)(Yo + (size_t)m * DM + 8 * lane) = w1; *(u32x4*)(Yo + (size_t)m * DM + 512 + 8 * lane) = w2;
    }
}

typedef short bf16x8 __attribute__((ext_vector_type(8)));
typedef short bf16x4 __attribute__((ext_vector_type(4)));
typedef float f32x16 __attribute__((ext_vector_type(16)));
__device__ __forceinline__ f32x16 mfma32(bf16x8 a, bf16x8 b, f32x16 c) { return __builtin_amdgcn_mfma_f32_32x32x16_bf16(a, b, c, 0, 0, 0); }
__device__ __forceinline__ bf16x8 ldfrag(const bf16* p) { return *(const bf16x8*)p; }
__device__ __forceinline__ int drow(int g, int hh) { return (g & 3) + 8 * (g >> 2) + 4 * hh; }
__device__ __forceinline__ float logsigm(float x) { return -softplusf(-x); }
constexpr int LD64 = 72, LD128 = 136;

__device__ __forceinline__ void mlstm_chunk_block(const Ctx& C, int o, int mb, unsigned char* lds) {
    const int tid = C.tid(), lane = C.lane(), w = C.wave, r = lane & 31, hh = lane >> 5;
    const int b = mb >> 2, h = mb & 3;
    const bf16* P = GPTR(const bf16, C.ws + WS_R1); bf16* Y = GPTR(bf16, C.ws + WS_Y); float* den = GPTR(float, C.ws + WS_DEN);
    const float* convw = C.in(32) + (size_t)o * 4 * 512;
    const float igb = C.in(33)[o * 4 + h], fgb = C.in(34)[o * 4 + h];
    bf16* Qh = (bf16*)lds; bf16* Kh = Qh + 64 * LD64; bf16* QD = Kh + 64 * LD64; bf16* KTT = QD + 64 * LD64; bf16* Wm = KTT + 64 * LD64;
    bf16* VT = Wm + 64 * LD64; bf16* CT0 = VT + 160 * LD64; bf16* CT1 = CT0 + 160 * LD64;
    float* sB = (float*)(CT1 + 160 * LD64); float* sI = sB + 64;
    for (int i = tid; i < 2 * 160 * LD64 / 2; i += NTHREADS) ((unsigned*)CT0)[i] = 0u;
    for (int i = tid; i < 32 * LD64; i += NTHREADS) VT[128 * LD64 + i] = (i < 64) ? (bf16)0x3F80 : (bf16)0;
    const int l16 = tid & 15, typ = (tid >> 4) & 1, tg = tid >> 5;
    const int pc = OC_MQK + (typ ? 256 : 0) + h * 64 + 4 * l16;
    float cw[4][4];
#pragma unroll
    for (int k = 0; k < 4; ++k)
#pragma unroll
        for (int j = 0; j < 4; ++j) cw[k][j] = convw[k * 512 + (typ ? 256 : 0) + h * 64 + 4 * l16 + j];
    const int th = w >> 2, vj = w & 3; const bool two = (vj == 0);
    f32x16 Ca, Cb;
#pragma unroll
    for (int g = 0; g < 16; ++g) { Ca[g] = C.zf(); Cb[g] = C.zf(); }
    int cur = 0;
    u32x2 px[7]; u32x4 pva, pvb; unsigned pgi = 0, pgf = 0;
    const int vt = tid & 63, vg = tid >> 6;
#define ML_PF(ch_) do { _Pragma("unroll") for (int i = 0; i < 7; ++i) { const int t_ = 64 * (ch_) + 4 * tg - 3 + i; \
            if (t_ >= 0) px[i] = *(const u32x2*)(P + ((size_t)b * SEQ + t_) * OD_PAD + pc); else px[i] = (u32x2){C.z0, C.z0}; } \
        { const bf16* vr_ = P + ((size_t)b * SEQ + 64 * (ch_) + vt) * OD_PAD; pva = *(const u32x4*)(vr_ + OC_MV + h * 128 + 16 * vg); pvb = *(const u32x4*)(vr_ + OC_MV + h * 128 + 16 * vg + 8); pgi = vr_[OC_MI + h]; pgf = vr_[OC_MF + h]; } } while (0)
    ML_PF(0);
    __syncthreads();
    for (int ch = 0; ch < SEQ / 64; ++ch) {
        const int t0 = ch * 64; const size_t m0 = (size_t)b * SEQ + t0;
        {
            float x[7][4];
#pragma unroll
            for (int i = 0; i < 7; ++i) { x[i][0] = bf2f(px[i].x & 0xffffu); x[i][1] = bf2f(px[i].x >> 16); x[i][2] = bf2f(px[i].y & 0xffffu); x[i][3] = bf2f(px[i].y >> 16); }
#pragma unroll
            for (int tt = 0; tt < 4; ++tt) { float o4[4];
#pragma unroll
                for (int j = 0; j < 4; ++j) { float a = 0.f;
#pragma unroll
                    for (int k = 0; k < 4; ++k) a += cw[k][j] * x[tt + k][j];
                    a = siluf(a); o4[j] = typ ? a : a * 0.125f; }
                u32x2 pk; pk.x = pk2(o4[0], o4[1]); pk.y = pk2(o4[2], o4[3]);
                *(u32x2*)((typ ? Kh : Qh) + (4 * tg + tt) * LD64 + 4 * l16) = pk; }
            {   const int t = vt; const unsigned wv[8] = {pva.x, pva.y, pva.z, pva.w, pvb.x, pvb.y, pvb.z, pvb.w};
#pragma unroll
                for (int q = 0; q < 8; ++q) { VT[(16 * vg + 2 * q) * LD64 + t] = (bf16)(wv[q] & 0xffffu); VT[(16 * vg + 2 * q + 1) * LD64 + t] = (bf16)(wv[q] >> 16); } }
            if (tid < 64) { const float ip = bf2f(pgi) + igb; float lf = logsigm(bf2f(pgf) + fgb);
#pragma unroll
                for (int d = 1; d < 64; d <<= 1) { const float up = __shfl_up(lf, d); if (lane >= d) lf += up; }
                sB[tid] = lf; sI[tid] = ip; }
            if (ch + 1 < SEQ / 64) ML_PF(ch + 1);
        }
        lds_barrier();
        if (w < 4) {
            const int ti = w >> 1, tj = w & 1;
            f32x16 acc;
#pragma unroll
            for (int g = 0; g < 16; ++g) acc[g] = C.zf();
            if (tj <= ti) {
#pragma unroll
                for (int s = 0; s < 4; ++s) acc = mfma32(ldfrag(Kh + (32 * tj + r) * LD64 + 16 * s + 8 * hh), ldfrag(Qh + (32 * ti + r) * LD64 + 16 * s + 8 * hh), acc);
            }
            const int i = 32 * ti + r; const float bi = sB[i];
#pragma unroll
            for (int g4 = 0; g4 < 4; ++g4) { float v4[4];
#pragma unroll
                for (int q = 0; q < 4; ++q) { const int j = 32 * tj + 8 * g4 + 4 * hh + q; v4[q] = (j <= i) ? acc[4 * g4 + q] * fexp(bi - sB[j] + sI[j]) : 0.f; }
                u32x2 pk; pk.x = pk2(v4[0], v4[1]); pk.y = pk2(v4[2], v4[3]);
                *(u32x2*)(Wm + i * LD64 + 32 * tj + 8 * g4 + 4 * hh) = pk; }
        } else {
            const int lt = tid - 256;
            {   const int t = lt >> 2, kq = lt & 3; const float eb = fexp(sB[t]);
#pragma unroll
                for (int q = 0; q < 2; ++q) { float v8[8]; ld8(Qh + t * LD64 + 16 * kq + 8 * q, v8);
                    u32x4 pk; pk.x = pk2(v8[0] * eb, v8[1] * eb); pk.y = pk2(v8[2] * eb, v8[3] * eb); pk.z = pk2(v8[4] * eb, v8[5] * eb); pk.w = pk2(v8[6] * eb, v8[7] * eb);
                    *(u32x4*)(QD + t * LD64 + 16 * kq + 8 * q) = pk; } }
            {   const int k = lt & 63, tq = lt >> 6; const float bl = sB[63];
                float v16[16];
#pragma unroll
                for (int q = 0; q < 16; ++q) { const int t = 16 * tq + q; v16[q] = bf2f(Kh[t * LD64 + k]) * fexp(bl - sB[t] + sI[t]); }
                u32x4 p0, p1; p0.x = pk2(v16[0], v16[1]); p0.y = pk2(v16[2], v16[3]); p0.z = pk2(v16[4], v16[5]); p0.w = pk2(v16[6], v16[7]);
                p1.x = pk2(v16[8], v16[9]); p1.y = pk2(v16[10], v16[11]); p1.z = pk2(v16[12], v16[13]); p1.w = pk2(v16[14], v16[15]);
                *(u32x4*)(KTT + k * LD64 + 16 * tq) = p0; *(u32x4*)(KTT + k * LD64 + 16 * tq + 8) = p1; }
        }
        lds_barrier();
        {
            const bf16* CTc = cur ? CT1 : CT0; bf16* CTn = cur ? CT0 : CT1;
            const float F = fexp(sB[63]);
#pragma unroll
            for (int q = 0; q < 2; ++q) {
                if (q == 1 && !two) break;
                const int vjj = q == 0 ? vj : 4;
                bf16x8 vf[4];
                f32x16 num;
#pragma unroll
                for (int g = 0; g < 16; ++g) num[g] = C.zf();
#pragma unroll
                for (int s = 0; s < 4; ++s) { vf[s] = ldfrag(VT + (32 * vjj + r) * LD64 + 16 * s + 8 * hh);
                    num = mfma32(ldfrag(QD + (32 * th + r) * LD64 + 16 * s + 8 * hh), ldfrag(CTc + (32 * vjj + r) * LD64 + 16 * s + 8 * hh), num); }
#pragma unroll
                for (int s = 0; s < 4; ++s) num = mfma32(ldfrag(Wm + (32 * th + r) * LD64 + 16 * s + 8 * hh), vf[s], num);
                if (vjj < 4) {
#pragma unroll
                    for (int g = 0; g < 16; ++g) Y[(m0 + 32 * th + drow(g, hh)) * DM + 512 + h * 128 + 32 * vjj + r] = (bf16)f2bf(num[g]);
                } else if (r == 0) {
#pragma unroll
                    for (int g = 0; g < 16; ++g) den[(m0 + 32 * th + drow(g, hh)) * 4 + h] = num[g];
                }
                f32x16 cacc = q == 0 ? Ca : Cb;
#pragma unroll
                for (int g = 0; g < 16; ++g) cacc[g] *= F;
#pragma unroll
                for (int s = 0; s < 4; ++s) cacc = mfma32(ldfrag(KTT + (32 * th + r) * LD64 + 16 * s + 8 * hh), vf[s], cacc);
                if (q == 0) Ca = cacc; else Cb = cacc;
#pragma unroll
                for (int g4 = 0; g4 < 4; ++g4) { u32x2 pk; pk.x = pk2(cacc[4 * g4], cacc[4 * g4 + 1]); pk.y = pk2(cacc[4 * g4 + 2], cacc[4 * g4 + 3]);
                    *(u32x2*)(CTn + (32 * vjj + r) * LD64 + 32 * th + 8 * g4 + 4 * hh) = pk; }
            }
        }
        cur ^= 1;
        lds_barrier();
    }
}
#undef ML_PF

constexpr size_t GDN_UNIT_BYTES = 32768;
__device__ __forceinline__ void gdn_pre(const Ctx& C, int o, unsigned char* lds) {
    const int tid = C.tid(), half = tid >> 8, lt = tid & 255, lw = lt >> 6, lane = C.lane(), r = lane & 31, hh = lane >> 5;
    const bf16* P = GPTR(const bf16, C.ws + WS_R1);
    const float* convw = C.in(28) + (size_t)o * 4 * 1536;
    unsigned char* base = lds + half * 53248;
    bf16* KhB = (bf16*)base; bf16* VhB = KhB + 64 * LD128; float* Amat = (float*)(VhB + 64 * LD128); float* sGC = Amat + 64 * 68; float* sBe = sGC + 64; float* sEg = sBe + 64;
    const int l16 = lt & 15, typ = (lt >> 4) & 1, tg = lt >> 5;
    for (int up = C.bid; up < 512; up += C.G) {
        const int unit = 2 * up + half, bh = unit >> 6, n = unit & 63, b = bh >> 2, h = bh & 3, t0 = n * 64;
        const size_t m0 = (size_t)b * SEQ + t0;
        {
            const int pc = (typ ? 1024 : 512) + h * 128 + 8 * l16;
            float cw[4][8];
#pragma unroll
            for (int k = 0; k < 4; ++k)
#pragma unroll
                for (int j = 0; j < 8; ++j) cw[k][j] = convw[k * 1536 + pc + j];
            float x[4][8];
#pragma unroll
            for (int i = 0; i < 3; ++i) { const int t = t0 + 8 * tg - 3 + i;
                if (t >= 0) ld8(P + ((size_t)b * SEQ + t) * OD_PAD + pc, x[i]); else {
#pragma unroll
                    for (int j = 0; j < 8; ++j) x[i][j] = 0.f; } }
#pragma unroll
            for (int tt = 0; tt < 8; ++tt) {
                ld8(P + (m0 + 8 * tg + tt) * OD_PAD + pc, x[(tt + 3) & 3]);
                float o8[8]; float ss = 0.f;
#pragma unroll
                for (int j = 0; j < 8; ++j) { float a = 0.f;
#pragma unroll
                    for (int k = 0; k < 4; ++k) a += cw[k][j] * x[(tt + k) & 3][j];
                    a = siluf(a); o8[j] = a; ss += a * a; }
                ss = row_sum16(ss);
                const float sc = typ ? 1.0f : frsq(ss + 1e-6f);
                u32x4 pk; pk.x = pk2(o8[0] * sc, o8[1] * sc); pk.y = pk2(o8[2] * sc, o8[3] * sc); pk.z = pk2(o8[4] * sc, o8[5] * sc); pk.w = pk2(o8[6] * sc, o8[7] * sc);
                *(u32x4*)((typ ? VhB : KhB) + (8 * tg + tt) * LD128 + 8 * l16) = pk;
            }
            if (lt < 64) { const bf16* row = P + (m0 + lt) * OD_PAD; const float be = sigm(bf2f(row[OC_GB + h]));
                float g = -fexp(C.in(29)[o * 4 + h]) * softplusf(bf2f(row[OC_GA + h]) + C.in(30)[o * 4 + h]);
#pragma unroll
                for (int d = 1; d < 64; d <<= 1) { const float upv = __shfl_up(g, d); if (lane >= d) g += upv; }
                sGC[lt] = g; sBe[lt] = be; sEg[lt] = be * fexp(g); }
        }
        __syncthreads();
        {
            const int ti = lw >> 1, tj = lw & 1;
            f32x16 acc;
#pragma unroll
            for (int g = 0; g < 16; ++g) acc[g] = C.zf();
            if (tj <= ti) {
#pragma unroll
                for (int s = 0; s < 8; ++s) acc = mfma32(ldfrag(KhB + (32 * ti + r) * LD128 + 16 * s + 8 * hh), ldfrag(KhB + (32 * tj + r) * LD128 + 16 * s + 8 * hh), acc);
            }
            const int j = 32 * tj + r; const float gj = sGC[j];
#pragma unroll
            for (int g = 0; g < 16; ++g) { const int i = 32 * ti + drow(g, hh);
                Amat[i * 68 + j] = (j < i) ? sBe[i] * acc[g] * fexp(sGC[i] - gj) : 0.f; }
        }
        __syncthreads();
        {
            const bool isw = lt < 128; const bf16* src = isw ? (KhB + lt) : (VhB + lt - 128);
            float X[64];
#pragma unroll
            for (int i = 0; i < 64; ++i) X[i] = 0.f;
#pragma unroll
            for (int i = 0; i < 64; ++i) {
                const float zz = C.zf(); float p[8] = {zz, zz, zz, zz, zz, zz, zz, zz};
#pragma unroll
                for (int j4 = 0; j4 < (i + 3) / 4; ++j4) { const f32x4 av = *(const f32x4*)(Amat + i * 68 + 4 * j4); const int o = (j4 & 1) * 4;
                    p[o] += av[0] * X[4 * j4]; p[o + 1] += av[1] * X[4 * j4 + 1]; p[o + 2] += av[2] * X[4 * j4 + 2]; p[o + 3] += av[3] * X[4 * j4 + 3]; }
                X[i] = (isw ? sEg[i] : sBe[i]) * bf2f(src[i * LD128]) - (((p[0] + p[1]) + (p[2] + p[3])) + ((p[4] + p[5]) + (p[6] + p[7])));
            }
            bf16* dst = isw ? (KhB + lt) : (VhB + lt - 128);
#pragma unroll
            for (int i = 0; i < 64; ++i) dst[i * LD128] = (bf16)f2bf(isw ? -X[i] : X[i]);
        }
        __syncthreads();
        {
            bf16* Wg = (bf16*)(C.ws + WS_XB + (size_t)unit * GDN_UNIT_BYTES); bf16* Ug = Wg + 64 * 128;
#pragma unroll
            for (int q = 0; q < 4; ++q) { const int p = lt + 256 * q, t = p >> 4, cp = (p & 15) * 8;
                *(u32x4*)(Wg + t * 128 + cp) = *(const u32x4*)(KhB + t * LD128 + cp); }
#pragma unroll
            for (int q = 0; q < 4; ++q) { const int p = lt + 256 * q, tile = p >> 7, ln = (p >> 1) & 63, q8 = p & 1;
                const int v = 32 * (tile & 3) + (ln & 31), hq = ln >> 5, thh = tile >> 2;
                unsigned e[8];
#pragma unroll
                for (int gg = 0; gg < 8; ++gg) e[gg] = VhB[(32 * thh + drow(8 * q8 + gg, hq)) * LD128 + v];
                u32x4 pk; pk.x = e[0] | (e[1] << 16); pk.y = e[2] | (e[3] << 16); pk.z = e[4] | (e[5] << 16); pk.w = e[6] | (e[7] << 16);
                *(u32x4*)(Ug + p * 8) = pk; }
        }
        __syncthreads();
    }
}

__device__ __forceinline__ void gdn_chunk_block(const Ctx& C, int o, int gb, unsigned char* lds) {
    const int tid = C.tid(), lane = C.lane(), w = C.wave, r = lane & 31, hh = lane >> 5;
    const int b = gb >> 2, h = gb & 3;
    const bf16* P = GPTR(const bf16, C.ws + WS_R1); bf16* Y = GPTR(bf16, C.ws + WS_Y);
    const float* convw = C.in(28) + (size_t)o * 4 * 1536;
    const float nA = -fexp(C.in(29)[o * 4 + h]); const float dtb = C.in(30)[o * 4 + h];
    bf16* Qh = (bf16*)lds; bf16* Kh = Qh + 64 * LD128; bf16* QD = Kh + 64 * LD128; bf16* KDT = QD + 64 * LD128; bf16* QKd = KDT + 128 * LD64; bf16* VNT = QKd + 64 * LD64; bf16* ST = VNT + 128 * LD64;
    float* sGC = (float*)(ST + 128 * LD128);
    for (int i = tid; i < 128 * LD128 / 2; i += NTHREADS) ((unsigned*)ST)[i] = 0u;
    const int l16 = tid & 15, typ = (tid >> 4) & 1, tg = tid >> 5;
    const int pc = (typ ? 512 : 0) + h * 128 + 8 * l16;
    float* sCW = sGC + 64;
    for (int i = tid; i < 1024; i += NTHREADS) { const int k = i >> 8, c = i & 255; sCW[i] = convw[k * 1536 + (c >> 7) * 512 + h * 128 + (c & 127)]; }
    const int th = w >> 2, vj = w & 3;
    f32x16 S0, S1;
#pragma unroll
    for (int g = 0; g < 16; ++g) { S0[g] = C.zf(); S1[g] = C.zf(); }
    u32x4 px[7]; unsigned ar_raw = 0; bf16x8 wf[8]; u32x4 u0, u1;
#define GDN_PF(ch_) do { _Pragma("unroll") for (int i = 0; i < 7; ++i) { const int t_ = 64 * (ch_) + 4 * tg - 3 + i; \
            if (t_ >= 0) px[i] = *(const u32x4*)(P + ((size_t)b * SEQ + t_) * OD_PAD + pc); else px[i] = (u32x4){C.z0, C.z0, C.z0, C.z0}; } \
        ar_raw = P[((size_t)b * SEQ + 64 * (ch_) + (tid & 63)) * OD_PAD + OC_GA + h]; } while (0)
#define GDN_WU(ch_) do { const bf16* Wg_ = (const bf16*)(C.ws + WS_XB + (size_t)((gb * 64) + (ch_)) * GDN_UNIT_BYTES); const bf16* Ug_ = Wg_ + 64 * 128; \
        _Pragma("unroll") for (int s = 0; s < 8; ++s) wf[s] = *(const bf16x8*)(Wg_ + (32 * th + r) * 128 + 16 * s + 8 * hh); \
        u0 = *(const u32x4*)(Ug_ + ((th * 4 + vj) * 64 + lane) * 16); u1 = *(const u32x4*)(Ug_ + ((th * 4 + vj) * 64 + lane) * 16 + 8); } while (0)
#define UNPK8(v_, o_) do { o_[0] = bf2f(v_.x & 0xffffu); o_[1] = bf2f(v_.x >> 16); o_[2] = bf2f(v_.y & 0xffffu); o_[3] = bf2f(v_.y >> 16); o_[4] = bf2f(v_.z & 0xffffu); o_[5] = bf2f(v_.z >> 16); o_[6] = bf2f(v_.w & 0xffffu); o_[7] = bf2f(v_.w >> 16); } while (0)
    GDN_PF(0); GDN_WU(0);
    __syncthreads();
    for (int ch = 0; ch < SEQ / 64; ++ch) {
        const int t0 = ch * 64; const size_t m0 = (size_t)b * SEQ + t0;
        {
            float cw[4][8];
#pragma unroll
            for (int k = 0; k < 4; ++k) { const f32x4 a = *(const f32x4*)(sCW + k * 256 + typ * 128 + 8 * l16), c2 = *(const f32x4*)(sCW + k * 256 + typ * 128 + 8 * l16 + 4);
                cw[k][0] = a[0]; cw[k][1] = a[1]; cw[k][2] = a[2]; cw[k][3] = a[3]; cw[k][4] = c2[0]; cw[k][5] = c2[1]; cw[k][6] = c2[2]; cw[k][7] = c2[3]; }
            float x[4][8];
            UNPK8(px[0], x[0]); UNPK8(px[1], x[1]); UNPK8(px[2], x[2]);
#pragma unroll
            for (int tt = 0; tt < 4; ++tt) { float o8[8]; float ss = 0.f;
                UNPK8(px[tt + 3], x[(tt + 3) & 3]);
#pragma unroll
                for (int j = 0; j < 8; ++j) { float a = 0.f;
#pragma unroll
                    for (int k = 0; k < 4; ++k) a += cw[k][j] * x[(tt + k) & 3][j];
                    a = siluf(a); o8[j] = a; ss += a * a; }
                ss = row_sum16(ss);
                const float sc = (frsq(ss + 1e-6f)) * (typ ? 1.0f : 0.08838834764831845f);
                u32x4 pk; pk.x = pk2(o8[0] * sc, o8[1] * sc); pk.y = pk2(o8[2] * sc, o8[3] * sc); pk.z = pk2(o8[4] * sc, o8[5] * sc); pk.w = pk2(o8[6] * sc, o8[7] * sc);
                *(u32x4*)((typ ? Kh : Qh) + (4 * tg + tt) * LD128 + 8 * l16) = pk; }
            if (tid < 64) { float g = nA * softplusf(bf2f(ar_raw) + dtb);
#pragma unroll
                for (int d = 1; d < 64; d <<= 1) { const float upv = __shfl_up(g, d); if (lane >= d) g += upv; }
                sGC[tid] = g; }
            if (ch + 1 < SEQ / 64) GDN_PF(ch + 1);
        }
        lds_barrier();
        if (w < 4) {
            const int ti = w >> 1, tj = w & 1;
            f32x16 acc;
#pragma unroll
            for (int g = 0; g < 16; ++g) acc[g] = C.zf();
            if (tj <= ti) {
#pragma unroll
                for (int s = 0; s < 8; ++s) acc = mfma32(ldfrag(Kh + (32 * tj + r) * LD128 + 16 * s + 8 * hh), ldfrag(Qh + (32 * ti + r) * LD128 + 16 * s + 8 * hh), acc);
            }
            const int i = 32 * ti + r; const float gi = sGC[i];
#pragma unroll
            for (int g4 = 0; g4 < 4; ++g4) { float v4[4];
#pragma unroll
                for (int q = 0; q < 4; ++q) { const int j = 32 * tj + 8 * g4 + 4 * hh + q; v4[q] = (j <= i) ? acc[4 * g4 + q] * fexp(gi - sGC[j]) : 0.f; }
                u32x2 pk; pk.x = pk2(v4[0], v4[1]); pk.y = pk2(v4[2], v4[3]);
                *(u32x2*)(QKd + i * LD64 + 32 * tj + 8 * g4 + 4 * hh) = pk; }
        } else {
            const int lt = tid - 256;
            {   const int t = lt >> 2, kq = lt & 3; const float eg = fexp(sGC[t]);
#pragma unroll
                for (int q = 0; q < 4; ++q) { float v8[8]; ld8(Qh + t * LD128 + 32 * kq + 8 * q, v8);
                    u32x4 pk; pk.x = pk2(v8[0] * eg, v8[1] * eg); pk.y = pk2(v8[2] * eg, v8[3] * eg); pk.z = pk2(v8[4] * eg, v8[5] * eg); pk.w = pk2(v8[6] * eg, v8[7] * eg);
                    *(u32x4*)(QD + t * LD128 + 32 * kq + 8 * q) = pk; } }
            {   const int k = lt & 127, tq = lt >> 7; const float gl_ = sGC[63];
#pragma unroll
                for (int q4 = 0; q4 < 4; ++q4) { float v8[8];
#pragma unroll
                    for (int q = 0; q < 8; ++q) { const int t = 32 * tq + 8 * q4 + q; v8[q] = bf2f(Kh[t * LD128 + k]) * fexp(gl_ - sGC[t]); }
                    u32x4 pk; pk.x = pk2(v8[0], v8[1]); pk.y = pk2(v8[2], v8[3]); pk.z = pk2(v8[4], v8[5]); pk.w = pk2(v8[6], v8[7]);
                    *(u32x4*)(KDT + k * LD64 + 32 * tq + 8 * q4) = pk; } }
        }
        lds_barrier();
        bf16x8 sf[8];
        {
            f32x16 acc;
            acc[0] = bf2f(u0.x & 0xffffu); acc[1] = bf2f(u0.x >> 16); acc[2] = bf2f(u0.y & 0xffffu); acc[3] = bf2f(u0.y >> 16);
            acc[4] = bf2f(u0.z & 0xffffu); acc[5] = bf2f(u0.z >> 16); acc[6] = bf2f(u0.w & 0xffffu); acc[7] = bf2f(u0.w >> 16);
            acc[8] = bf2f(u1.x & 0xffffu); acc[9] = bf2f(u1.x >> 16); acc[10] = bf2f(u1.y & 0xffffu); acc[11] = bf2f(u1.y >> 16);
            acc[12] = bf2f(u1.z & 0xffffu); acc[13] = bf2f(u1.z >> 16); acc[14] = bf2f(u1.w & 0xffffu); acc[15] = bf2f(u1.w >> 16);
#pragma unroll
            for (int s = 0; s < 8; ++s) { sf[s] = ldfrag(ST + (32 * vj + r) * LD128 + 16 * s + 8 * hh); acc = mfma32(wf[s], sf[s], acc); }
#pragma unroll
            for (int g4 = 0; g4 < 4; ++g4) { u32x2 pk; pk.x = pk2(acc[4 * g4], acc[4 * g4 + 1]); pk.y = pk2(acc[4 * g4 + 2], acc[4 * g4 + 3]);
                *(u32x2*)(VNT + (32 * vj + r) * LD64 + 32 * th + 8 * g4 + 4 * hh) = pk; }
            if (ch + 1 < SEQ / 64) GDN_WU(ch + 1);
        }
        lds_barrier();
        {
            f32x16 acc;
#pragma unroll
            for (int g = 0; g < 16; ++g) acc[g] = C.zf();
#pragma unroll
            for (int s = 0; s < 8; ++s) acc = mfma32(ldfrag(QD + (32 * th + r) * LD128 + 16 * s + 8 * hh), sf[s], acc);
            bf16x8 vf[4];
#pragma unroll
            for (int s = 0; s < 4; ++s) { vf[s] = ldfrag(VNT + (32 * vj + r) * LD64 + 16 * s + 8 * hh); acc = mfma32(ldfrag(QKd + (32 * th + r) * LD64 + 16 * s + 8 * hh), vf[s], acc); }
#pragma unroll
            for (int g = 0; g < 16; ++g) Y[(m0 + 32 * th + drow(g, hh)) * DM + h * 128 + 32 * vj + r] = (bf16)f2bf(acc[g]);
            const float gl_ = fexp(sGC[63]);
#pragma unroll
            for (int q = 0; q < 2; ++q) { const int kt = 2 * th + q;
                f32x16 sa = q == 0 ? S0 : S1;
#pragma unroll
                for (int g = 0; g < 16; ++g) sa[g] *= gl_;
#pragma unroll
                for (int s = 0; s < 4; ++s) sa = mfma32(ldfrag(KDT + (32 * kt + r) * LD64 + 16 * s + 8 * hh), vf[s], sa);
                if (q == 0) S0 = sa; else S1 = sa;
#pragma unroll
                for (int g4 = 0; g4 < 4; ++g4) { u32x2 pk; pk.x = pk2(sa[4 * g4], sa[4 * g4 + 1]); pk.y = pk2(sa[4 * g4 + 2], sa[4 * g4 + 3]);
                    *(u32x2*)(ST + (32 * vj + r) * LD128 + 32 * kt + 8 * g4 + 4 * hh) = pk; }
            }
        }
        lds_barrier();
    }
}
#undef GDN_PF
#undef GDN_WU

constexpr size_t WS_LW = WS_R1 + (size_t)M * EV_COLS * 2, WS_AA = WS_LW + (size_t)M * 512 * 2, WS_KK = WS_XB, WS_ACUM = WS_XB + (size_t)M * 512 * 2;
static_assert(WS_AA + (size_t)M * 512 * 2 <= WS_END, "even-layer scratch");

__device__ __forceinline__ void even_pre_tile(const Ctx& C, int e_in, int tile_in, unsigned char* lds) {
    int e = e_in, tile = tile_in; asm volatile("" : "+s"(e), "+s"(tile));
    int tid_ = C.tid(); asm volatile("" : "+v"(tid_));
    const int tid = tid_, lane = tid & 63, w = __builtin_amdgcn_readfirstlane(tid >> 6), r = lane & 31, hh = lane >> 5;
    const size_t m0 = (size_t)tile * 64; const int b = tile >> 6, t0 = (tile & 63) * 64;
    const bf16* P = GPTR(const bf16, C.ws + WS_R1); bf16* Y = GPTR(bf16, C.ws + WS_Y);
    bf16* ACUM = GPTR(bf16, C.ws + WS_ACUM); float* SUMS = GPTR(float, C.ws + WS_DEN);
    bf16* LW = GPTR(bf16, C.ws + WS_LW); bf16* AA = GPTR(bf16, C.ws + WS_AA); bf16* KK = GPTR(bf16, C.ws + WS_KK);
    {
        const int n = w;
        bf16* sXCb = (bf16*)(lds + w * 18432);
        bf16* sWT = sXCb + 64 * LD64; float* sZ = (float*)sWT;
        const float* convw = C.in(8) + (size_t)e * 4 * 512; const float* convb = C.in(9) + (size_t)e * 512;
        {   const int tq = lane >> 3, c8 = lane & 7; const int pc = 512 + n * 64 + 8 * c8;
            float cw[4][8], cb[8];
#pragma unroll
            for (int j = 0; j < 8; ++j) { cb[j] = convb[n * 64 + 8 * c8 + j];
#pragma unroll
                for (int k = 0; k < 4; ++k) cw[k][j] = convw[k * 512 + n * 64 + 8 * c8 + j]; }
            float x[4][8];
#pragma unroll
            for (int i = 0; i < 3; ++i) { const int t = t0 + 8 * tq - 3 + i;
                if (t >= 0) ld8(P + ((size_t)b * SEQ + t) * EV_COLS + pc, x[i]); else {
#pragma unroll
                    for (int j = 0; j < 8; ++j) x[i][j] = 0.f; } }
#pragma unroll
            for (int tt = 0; tt < 8; ++tt) {
                ld8(P + (m0 + 8 * tq + tt) * EV_COLS + pc, x[(tt + 3) & 3]);
                float o8[8];
#pragma unroll
                for (int j = 0; j < 8; ++j) { float a = cb[j];
#pragma unroll
                    for (int k = 0; k < 4; ++k) a += cw[k][j] * x[(tt + k) & 3][j];
                    o8[j] = a; }
                u32x4 pk; pk.x = pk2(o8[0], o8[1]); pk.y = pk2(o8[2], o8[3]); pk.z = pk2(o8[4], o8[5]); pk.w = pk2(o8[6], o8[7]);
                *(u32x4*)(sXCb + (8 * tq + tt) * LD64 + 8 * c8) = pk;
            }
        }
        bf16x8 bwa[2][4], bwx[2][4];
#pragma unroll 1
        for (int mat = 0; mat < 2; ++mat) { const float* src = (mat ? C.in(12) : C.in(10)) + ((size_t)e * 8 + n) * 4096;
#pragma unroll 8
            for (int d = 0; d < 64; d += 2) *(unsigned*)(sWT + lane * LD64 + d) = pk2(src[d * 64 + lane], src[(d + 1) * 64 + lane]);
            asm volatile("s_waitcnt lgkmcnt(0)" ::: "memory");
#pragma unroll
            for (int nt = 0; nt < 2; ++nt)
#pragma unroll
                for (int s = 0; s < 4; ++s) { const bf16x8 f = ldfrag(sWT + (32 * nt + r) * LD64 + 16 * s + 8 * hh); if (mat) bwx[nt][s] = f; else bwa[nt][s] = f; }
            asm volatile("s_waitcnt lgkmcnt(0)" ::: "memory");
        }
        const int ce = n * 64 + lane;
        const float g_ba = C.in(11)[(size_t)e * 512 + ce], g_bx = C.in(13)[(size_t)e * 512 + ce], g_sp = softplusf(-C.in(14)[(size_t)e * 512 + ce]);
        float hloc = 0.f, acum = 1.f;
#pragma unroll 1
        for (int tt = 0; tt < 2; ++tt) {
            float av[32];
#pragma unroll
            for (int nt = 0; nt < 2; ++nt) { f32x16 z;
#pragma unroll
                for (int g = 0; g < 16; ++g) z[g] = C.zf();
#pragma unroll
                for (int s = 0; s < 4; ++s) z = mfma32(ldfrag(sXCb + (32 * tt + r) * LD64 + 16 * s + 8 * hh), bwa[nt][s], z);
#pragma unroll
                for (int g = 0; g < 16; ++g) sZ[drow(g, hh) * 64 + 32 * nt + r] = z[g]; }
            asm volatile("s_waitcnt lgkmcnt(0)" ::: "memory");
#pragma unroll
            for (int t = 0; t < 32; ++t) av[t] = fexp(-8.0f * sigm(sZ[t * 64 + lane] + g_ba) * g_sp);
            asm volatile("s_waitcnt lgkmcnt(0)" ::: "memory");
#pragma unroll
            for (int nt = 0; nt < 2; ++nt) { f32x16 z;
#pragma unroll
                for (int g = 0; g < 16; ++g) z[g] = C.zf();
#pragma unroll
                for (int s = 0; s < 4; ++s) z = mfma32(ldfrag(sXCb + (32 * tt + r) * LD64 + 16 * s + 8 * hh), bwx[nt][s], z);
#pragma unroll
                for (int g = 0; g < 16; ++g) sZ[drow(g, hh) * 64 + 32 * nt + r] = z[g]; }
            asm volatile("s_waitcnt lgkmcnt(0)" ::: "memory");
            float zx[32];
#pragma unroll
            for (int t = 0; t < 32; ++t) zx[t] = sZ[t * 64 + lane];
            asm volatile("s_waitcnt lgkmcnt(0)" ::: "memory");
            bf16* hb = (bf16*)sZ; bf16* ab = hb + 32 * 64;
#pragma unroll
            for (int t = 0; t < 32; ++t) { const int tl = 32 * tt + t; const float a = av[t];
                float mult = sqrtf(fmaxf(1.0f - a * a, 0.f)); if (t0 + tl == 0) mult = 1.0f;
                const float u = sigm(zx[t] + g_bx) * bf2f(sXCb[tl * LD64 + lane]) * mult;
                hloc = a * hloc + u; acum *= a;
                hb[t * 64 + lane] = (bf16)f2bf(hloc); ab[t * 64 + lane] = (bf16)f2bf(acum); }
            asm volatile("s_waitcnt lgkmcnt(0)" ::: "memory");
#pragma unroll
            for (int i = 0; i < 4; ++i) { const int rw = 8 * i + (lane >> 3), pc8 = 8 * (lane & 7);
                const u32x4 hv = *(const u32x4*)(hb + rw * 64 + pc8), cv = *(const u32x4*)(ab + rw * 64 + pc8);
                *(u32x4*)(Y + (m0 + 32 * tt + rw) * DM + n * 64 + pc8) = hv; *(u32x4*)(ACUM + (m0 + 32 * tt + rw) * 512 + n * 64 + pc8) = cv; }
            asm volatile("s_waitcnt lgkmcnt(0)" ::: "memory");
        }
        SUMS[((size_t)tile * 2 + 0) * 512 + ce] = acum; SUMS[((size_t)tile * 2 + 1) * 512 + ce] = hloc;
    }
}

__device__ __forceinline__ void rwkv_chain_block(const Ctx& C, int e, int rb, unsigned char* lds) {
    const int tid = C.tid(), w = C.wave;
    const int bh = rb >> 2, q = rb & 3, b = bh >> 3, h = bh & 7;
    const bf16* P = GPTR(const bf16, C.ws + WS_R1); bf16* Y = GPTR(bf16, C.ws + WS_Y);
    const bf16* LW = GPTR(const bf16, C.ws + WS_LW); const bf16* AA = GPTR(const bf16, C.ws + WS_AA); const bf16* KK = GPTR(const bf16, C.ws + WS_KK);
    float* buf0 = (float*)lds; float* buf1 = buf0 + 10752; float* sY = buf1 + 10752;
    if (w >= 4) {
        const int pt = tid - 256, t = pt >> 3, c8 = pt & 7, hc = h * 64 + 8 * c8;
        const float* mu = C.in(15) + (size_t)e * 1792; const float* kap = C.in(22) + (size_t)e * 512;
        float mur[8], muk[8], muv[8], ka[8];
#pragma unroll
        for (int j = 0; j < 8; ++j) { mur[j] = mu[hc + j]; muk[j] = mu[512 + hc + j]; muv[j] = mu[1024 + hc + j]; ka[j] = kap[hc + j]; }
        u32x4 rc, rp, kc, kp, vc, vp, lwv, aav, kkv;
#define RW_LOAD(ch_) do { const size_t m_ = (size_t)b * SEQ + 32 * (ch_) + t; const bf16* row_ = P + m_ * EV_COLS; const bool hp_ = (32 * (ch_) + t) > 0; const bf16* prow_ = hp_ ? row_ - EV_COLS : row_; \
            rc = *(const u32x4*)(row_ + EC_R + hc); kc = *(const u32x4*)(row_ + EC_K + hc); vc = *(const u32x4*)(row_ + EC_V + hc); \
            rp = *(const u32x4*)(prow_ + EC_R + hc); kp = *(const u32x4*)(prow_ + EC_K + hc); vp = *(const u32x4*)(prow_ + EC_V + hc); \
            lwv = *(const u32x4*)(LW + m_ * 512 + hc); aav = *(const u32x4*)(AA + m_ * 512 + hc); kkv = *(const u32x4*)(KK + m_ * 512 + hc); } while (0)
#define RW_UNPK(v_, o_) do { o_[0] = bf2f(v_.x & 0xffffu); o_[1] = bf2f(v_.x >> 16); o_[2] = bf2f(v_.y & 0xffffu); o_[3] = bf2f(v_.y >> 16); o_[4] = bf2f(v_.z & 0xffffu); o_[5] = bf2f(v_.z >> 16); o_[6] = bf2f(v_.w & 0xffffu); o_[7] = bf2f(v_.w >> 16); } while (0)
#define RW_STAGE(ch_, dst_) do { const float pm_ = (32 * (ch_) + t) > 0 ? 1.0f : 0.0f; float a_[8], b_[8], o1_[8], o2_[8], o3_[8], o4_[8], o5_[8]; \
            RW_UNPK(rc, a_); RW_UNPK(rp, b_); _Pragma("unroll") for (int j = 0; j < 8; ++j) o5_[j] = a_[j] + mur[j] * (b_[j] * pm_ - a_[j]); \
            RW_UNPK(kc, a_); RW_UNPK(kp, b_); _Pragma("unroll") for (int j = 0; j < 8; ++j) o4_[j] = a_[j] + muk[j] * (b_[j] * pm_ - a_[j]); \
            RW_UNPK(aav, a_); RW_UNPK(kkv, b_); _Pragma("unroll") for (int j = 0; j < 8; ++j) { o4_[j] = o4_[j] * (1.0f + (a_[j] - 1.0f) * ka[j]); o2_[j] = b_[j]; o3_[j] = b_[j] * a_[j]; } \
            RW_UNPK(lwv, a_); _Pragma("unroll") for (int j = 0; j < 8; ++j) o1_[j] = fexp(a_[j]); \
            float* d_ = (dst_) + t * 64 + 8 * c8; \
            *(f32x4*)(d_) = (f32x4){o1_[0], o1_[1], o1_[2], o1_[3]}; *(f32x4*)(d_ + 4) = (f32x4){o1_[4], o1_[5], o1_[6], o1_[7]}; \
            *(f32x4*)(d_ + 2048) = (f32x4){o2_[0], o2_[1], o2_[2], o2_[3]}; *(f32x4*)(d_ + 2052) = (f32x4){o2_[4], o2_[5], o2_[6], o2_[7]}; \
            *(f32x4*)(d_ + 4096) = (f32x4){o3_[0], o3_[1], o3_[2], o3_[3]}; *(f32x4*)(d_ + 4100) = (f32x4){o3_[4], o3_[5], o3_[6], o3_[7]}; \
            *(f32x4*)(d_ + 6144) = (f32x4){o4_[0], o4_[1], o4_[2], o4_[3]}; *(f32x4*)(d_ + 6148) = (f32x4){o4_[4], o4_[5], o4_[6], o4_[7]}; \
            *(f32x4*)(d_ + 8192) = (f32x4){o5_[0], o5_[1], o5_[2], o5_[3]}; *(f32x4*)(d_ + 8196) = (f32x4){o5_[4], o5_[5], o5_[6], o5_[7]}; \
            if ((c8 >> 1) == q) { RW_UNPK(vc, a_); RW_UNPK(vp, b_); float* dv_ = (dst_) + 10240 + t * 16 + 8 * (c8 & 1); \
                *(f32x4*)(dv_) = (f32x4){a_[0] + muv[0] * (b_[0] * pm_ - a_[0]), a_[1] + muv[1] * (b_[1] * pm_ - a_[1]), a_[2] + muv[2] * (b_[2] * pm_ - a_[2]), a_[3] + muv[3] * (b_[3] * pm_ - a_[3])}; \
                *(f32x4*)(dv_ + 4) = (f32x4){a_[4] + muv[4] * (b_[4] * pm_ - a_[4]), a_[5] + muv[5] * (b_[5] * pm_ - a_[5]), a_[6] + muv[6] * (b_[6] * pm_ - a_[6]), a_[7] + muv[7] * (b_[7] * pm_ - a_[7])}; } } while (0)
        RW_LOAD(0); RW_STAGE(0, buf0); RW_LOAD(1);
        lds_barrier();
        for (int ch = 0; ch < SEQ / 32; ++ch) {
            if (ch + 1 < SEQ / 32) { RW_STAGE(ch + 1, ((ch + 1) & 1) ? buf1 : buf0); if (ch + 2 < SEQ / 32) RW_LOAD(ch + 2); }
            if (ch >= 1) { const float* sy = sY + ((ch - 1) & 1) * 512; const int pr = pt & 7; const size_t m = (size_t)b * SEQ + 32 * (ch - 1) + t;
                *(unsigned*)(Y + m * DM + 512 + h * 64 + 16 * q + 2 * pr) = pk2(sy[t * 16 + 2 * pr], sy[t * 16 + 2 * pr + 1]); }
            lds_barrier();
        }
        {   const float* sy = sY + ((SEQ / 32 - 1) & 1) * 512; const int pr = pt & 7; const size_t m = (size_t)b * SEQ + 32 * (SEQ / 32 - 1) + t;
            *(unsigned*)(Y + m * DM + 512 + h * 64 + 16 * q + 2 * pr) = pk2(sy[t * 16 + 2 * pr], sy[t * 16 + 2 * pr + 1]); }
#undef RW_LOAD
#undef RW_UNPK
#undef RW_STAGE
    } else {
        __builtin_amdgcn_s_setprio(3);
        const int row = tid >> 4, l16 = tid & 15;
        float S0 = 0.f, S1 = 0.f, S2 = 0.f, S3 = 0.f;
        lds_barrier();
        for (int ch = 0; ch < SEQ / 32; ++ch) {
            const float* bf = (ch & 1) ? buf1 : buf0; float* sy = sY + (ch & 1) * 512;
            const float* pw = bf + 4 * l16; const float* pv = bf + 10240 + row;
            f32x4 w4 = *(const f32x4*)(pw), kk4 = *(const f32x4*)(pw + 2048), b4 = *(const f32x4*)(pw + 4096), k4 = *(const f32x4*)(pw + 6144), r4 = *(const f32x4*)(pw + 8192);
            float v = pv[0];
#pragma unroll 8
            for (int t = 0; t < 32; ++t) {
                const int tn = t < 31 ? t + 1 : 31;
                const f32x4 w4n = *(const f32x4*)(pw + tn * 64), kk4n = *(const f32x4*)(pw + 2048 + tn * 64), b4n = *(const f32x4*)(pw + 4096 + tn * 64);
                const f32x4 k4n = *(const f32x4*)(pw + 6144 + tn * 64), r4n = *(const f32x4*)(pw + 8192 + tn * 64);
                const float vn = pv[tn * 16];
                float sk = (S0 * kk4[0] + S1 * kk4[1]) + (S2 * kk4[2] + S3 * kk4[3]);
                sk = row_sum16(sk);
                S0 = (S0 * w4[0] + v * k4[0]) - sk * b4[0]; S1 = (S1 * w4[1] + v * k4[1]) - sk * b4[1];
                S2 = (S2 * w4[2] + v * k4[2]) - sk * b4[2]; S3 = (S3 * w4[3] + v * k4[3]) - sk * b4[3];
                float y = (S0 * r4[0] + S1 * r4[1]) + (S2 * r4[2] + S3 * r4[3]);
                y = row_sum16(y);
                sy[t * 16 + row] = y;
                w4 = w4n; kk4 = kk4n; b4 = b4n; k4 = k4n; r4 = r4n; v = vn;
            }
            lds_barrier();
        }
        __builtin_amdgcn_s_setprio(0);
    }
}

#ifndef LRUPROBE
#define LRUPROBE 0
#endif
__device__ __forceinline__ void lru_pass2_tile(const Ctx& C, int tile, float* sm, bool rep = false) {
    const int tid = C.tid(); const int c = 4 * (tid & 127), part = __builtin_amdgcn_readfirstlane(tid >> 7); const int b = tile >> 6, jt = tile & 63;
    const bf16* P = GPTR(const bf16, C.ws + WS_R1); bf16* Y = GPTR(bf16, C.ws + WS_Y); const bf16* ACUM = GPTR(const bf16, C.ws + WS_ACUM); const float* SUMS = GPTR(const float, C.ws + WS_DEN);
    const int j0 = (jt * part) >> 2, j1 = (jt * (part + 1)) >> 2;
    const float z_ = C.zf(), o_ = z_ + 1.0f;
    f32x4 A = {o_, o_, o_, o_}, B = {z_, z_, z_, z_};
#pragma unroll 8
    for (int j = j0; j < ((rep && (LRUPROBE & 2)) ? j0 : j1); ++j) { const size_t tl = (size_t)b * 64 + j; const f32x4 a = *(const f32x4*)(SUMS + (tl * 2) * 512 + c), bb = *(const f32x4*)(SUMS + (tl * 2 + 1) * 512 + c); B = a * B + bb; A = a * A; }
    __syncthreads();
    *(f32x4*)(sm + part * 1024 + c) = A; *(f32x4*)(sm + part * 1024 + 512 + c) = B;
    __syncthreads();
    f32x4 carry = {z_, z_, z_, z_};
#pragma unroll
    for (int q = 0; q < 4; ++q) { const f32x4 a = *(const f32x4*)(sm + q * 1024 + c), bb = *(const f32x4*)(sm + q * 1024 + 512 + c); carry = a * carry + bb; }
#pragma unroll 1
    for (int t0_ = 0; t0_ < ((rep && (LRUPROBE & 4)) ? 0 : 16); t0_ += 8) {
        u32x2 rh[8], ra[8], rg[8];
#pragma unroll
        for (int t = 0; t < 8; ++t) { const size_t m = (size_t)tile * 64 + 16 * part + t0_ + t; rh[t] = *(const u32x2*)(Y + m * DM + c); ra[t] = *(const u32x2*)(ACUM + m * 512 + c); rg[t] = *(const u32x2*)(P + m * EV_COLS + c); }
#pragma unroll
        for (int t = 0; t < 8; ++t) { const size_t m = (size_t)tile * 64 + 16 * part + t0_ + t;
            const float hl[4] = {bf2f(rh[t].x & 0xffffu), bf2f(rh[t].x >> 16), bf2f(rh[t].y & 0xffffu), bf2f(rh[t].y >> 16)};
            const float ac[4] = {bf2f(ra[t].x & 0xffffu), bf2f(ra[t].x >> 16), bf2f(ra[t].y & 0xffffu), bf2f(ra[t].y >> 16)};
            const float g[4] = {bf2f(rg[t].x & 0xffffu), bf2f(rg[t].x >> 16), bf2f(rg[t].y & 0xffffu), bf2f(rg[t].y >> 16)};
            u32x2 pk; pk.x = pk2((hl[0] + ac[0] * carry[0]) * gelu_tanh(g[0]), (hl[1] + ac[1] * carry[1]) * gelu_tanh(g[1])); pk.y = pk2((hl[2] + ac[2] * carry[2]) * gelu_tanh(g[2]), (hl[3] + ac[3] * carry[3]) * gelu_tanh(g[3]));
            if (rep) *(u32x2*)(GPTR(bf16, C.ws + WS_XB + 16 * MiB) + m * 512 + c) = pk; else *(u32x2*)(Y + m * DM + c) = pk; }
    }
}

__device__ __forceinline__ void rwkv_post_tile2(const Ctx& C, int e, int tile, float* sm, bool rep = false) {
    const int tid = C.tid();
    const bf16* P = GPTR(const bf16, C.ws + WS_R1); bf16* Y = GPTR(bf16, C.ws + WS_Y); bf16* Yo = rep ? GPTR(bf16, C.ws + WS_XB + 16 * MiB) : Y; const float* bonus = GPTR(const float, C.ws + WS_BONUS);
    const float* mu = C.in(15) + (size_t)e * 1792; const float* g2 = C.in(20) + (size_t)e * 128 * 512;
    const size_t m0 = (size_t)tile * 64; const int t0 = (int)(m0 % SEQ);
    bf16* sGb = (bf16*)((unsigned char*)sm + 131072);
    __syncthreads();
#pragma unroll
    for (int i = 0; i < 2; ++i) { const int idx = tid + i * NTHREADS, t = idx >> 4, j0 = 8 * (idx & 15);
        float p8[8], q8[8]; ld8(P + (m0 + t) * EV_COLS + EC_XG + j0, p8);
        if ((t0 + t) > 0) ld8(P + (m0 + t - 1) * EV_COLS + EC_XG + j0, q8); else {
#pragma unroll
            for (int q = 0; q < 8; ++q) q8[q] = C.zf(); }
        const f32x4 ma = *(const f32x4*)(mu + 1664 + j0), mb = *(const f32x4*)(mu + 1664 + j0 + 4); float o8[8];
#pragma unroll
        for (int q = 0; q < 8; ++q) o8[q] = sigm(p8[q] + (q < 4 ? ma[q] : mb[q - 4]) * (q8[q] - p8[q]));
        u32x4 pk; pk.x = pk2(o8[0], o8[1]); pk.y = pk2(o8[2], o8[3]); pk.z = pk2(o8[4], o8[5]); pk.w = pk2(o8[6], o8[7]);
        *(u32x4*)(sGb + t * LD128 + j0) = pk; }
    __syncthreads();
    {   const int lane = tid & 63, r = lane & 31, hh = lane >> 5; const bf16* g2t = C.wset(2 * e, WOFF_G2);
#pragma unroll 1
        for (int cc = 0; cc < 2; ++cc) { const int ct = 2 * C.wave + cc;
            bf16x8 bfr[8];
#pragma unroll
            for (int s = 0; s < 8; ++s) bfr[s] = *(const bf16x8*)(g2t + (size_t)(32 * ct + r) * 128 + 16 * s + 8 * hh);
#pragma unroll
            for (int th = 0; th < 2; ++th) { f32x16 acc;
#pragma unroll
                for (int g = 0; g < 16; ++g) acc[g] = C.zf();
#pragma unroll
                for (int s = 0; s < 8; ++s) acc = mfma32(ldfrag(sGb + (32 * th + r) * LD128 + 16 * s + 8 * hh), bfr[s], acc);
#pragma unroll
                for (int g = 0; g < 16; ++g) sm[(32 * th + drow(g, hh)) * 512 + 32 * ct + r] = acc[g]; } }
    }
    asm volatile("s_waitcnt lgkmcnt(0)" ::: "memory");
    {
        const int lane = tid & 63, l8 = lane & 7, ts = lane >> 3, cb = 64 * C.wave + 8 * l8;
        float lnw[8], lnb[8], muv[8];
        {   const f32x4 a0 = *(const f32x4*)(C.in(24) + (size_t)e * 512 + cb), a1 = *(const f32x4*)(C.in(24) + (size_t)e * 512 + cb + 4);
            const f32x4 b0 = *(const f32x4*)(C.in(25) + (size_t)e * 512 + cb), b1 = *(const f32x4*)(C.in(25) + (size_t)e * 512 + cb + 4);
            const f32x4 c0 = *(const f32x4*)(mu + 1024 + cb), c1 = *(const f32x4*)(mu + 1024 + cb + 4);
#pragma unroll
            for (int j = 0; j < 4; ++j) { lnw[j] = a0[j]; lnw[4 + j] = a1[j]; lnb[j] = b0[j]; lnb[4 + j] = b1[j]; muv[j] = c0[j]; muv[4 + j] = c1[j]; } }
#pragma unroll 2
        for (int it = 0; it < 8; ++it) { const int t = 8 * it + ts; const size_t m = m0 + t; const bool hp = (t0 + t) > 0; const bf16* row = P + m * EV_COLS;
            float y8[8], v8[8], p8[8];
            ld8(Y + m * DM + 512 + cb, y8); ld8(row + EC_V + cb, v8);
            if (hp) ld8(row - EV_COLS + EC_V + cb, p8); else {
#pragma unroll
                for (int j = 0; j < 8; ++j) p8[j] = C.zf(); }
            const float bon = bonus[m * 8 + C.wave];
            const f32x4 g0 = *(const f32x4*)(sm + t * 512 + cb), g1 = *(const f32x4*)(sm + t * 512 + cb + 4);
            float sy = ((y8[0] + y8[1]) + (y8[2] + y8[3])) + ((y8[4] + y8[5]) + (y8[6] + y8[7]));
            sy += __shfl_xor(sy, 1); sy += __shfl_xor(sy, 2); sy += __shfl_xor(sy, 4);
            const float mean = sy * (1.0f / 64.0f);
            float d8[8], sq = C.zf();
#pragma unroll
            for (int j = 0; j < 8; ++j) { d8[j] = y8[j] - mean; sq += d8[j] * d8[j]; }
            sq += __shfl_xor(sq, 1); sq += __shfl_xor(sq, 2); sq += __shfl_xor(sq, 4);
            const float rs = frsq(sq * (1.0f / 64.0f) + 64e-5f);
            float o8[8];
#pragma unroll
            for (int j = 0; j < 8; ++j) { const float vs = v8[j] + muv[j] * (p8[j] - v8[j]); o8[j] = ((d8[j] * rs * lnw[j] + lnb[j]) + bon * vs) * (j < 4 ? g0[j] : g1[j - 4]); }
            u32x4 pk; pk.x = pk2(o8[0], o8[1]); pk.y = pk2(o8[2], o8[3]); pk.z = pk2(o8[4], o8[5]); pk.w = pk2(o8[6], o8[7]);
            *(u32x4*)(Yo + m * DM + 512 + cb) = pk; }
    }
}

__device__ __forceinline__ void gdn_chunk_block2(const Ctx& C, int o, int gb, unsigned char* lds) {
    const int tid = C.tid(), lane = C.lane(), w = C.wave, r = lane & 31, hh = lane >> 5;
    const int b = gb >> 2, h = gb & 3;
    const bf16* P = GPTR(const bf16, C.ws + WS_R1); bf16* Y = GPTR(bf16, C.ws + WS_Y);
    const float* convw = C.in(28) + (size_t)o * 4 * 1536;
    const float nA = -fexp(C.in(29)[o * 4 + h]); const float dtb = C.in(30)[o * 4 + h];
    bf16* Qh = (bf16*)lds; bf16* Kh = Qh + 64 * LD128; bf16* KT = Kh + 64 * LD128; bf16* QKd = KT + 128 * LD64; bf16* VNT = QKd + 64 * LD64; bf16* VNS = VNT + 128 * LD64; bf16* ST = VNS + 128 * LD64;
    float* sT = (float*)(ST + 128 * LD128);
    float* sCW = sT + 512;
    for (int i = tid; i < 128 * LD128 / 2; i += NTHREADS) ((unsigned*)ST)[i] = 0u;
    for (int i = tid; i < 64 * LD64 / 2; i += NTHREADS) ((unsigned*)QKd)[i] = 0u;
    for (int i = tid; i < 1024; i += NTHREADS) { const int k = i >> 8, c = i & 255; sCW[i] = convw[k * 1536 + (c >> 7) * 512 + h * 128 + (c & 127)]; }
    const int l16 = tid & 15, typ = (tid >> 4) & 1, tg = tid >> 5;
    const int pc = (typ ? 512 : 0) + h * 128 + 8 * l16;
    const int th = w >> 2, vj = w & 3;
    f32x16 S0, S1;
#pragma unroll
    for (int g = 0; g < 16; ++g) { S0[g] = C.zf(); S1[g] = C.zf(); }
    u32x4 px[7]; unsigned ar_next = 0; bf16x8 wf[8]; u32x4 u0, u1;
#define G2_PF(ch_) do { _Pragma("unroll") for (int i = 0; i < 7; ++i) { const int t_ = 64 * (ch_) + 4 * tg - 3 + i; \
            if (t_ >= 0) px[i] = *(const u32x4*)(P + ((size_t)b * SEQ + t_) * OD_PAD + pc); else px[i] = (u32x4){C.z0, C.z0, C.z0, C.z0}; } } while (0)
#define G2_AR(ch_) do { ar_next = P[((size_t)b * SEQ + 64 * (ch_) + (tid & 63)) * OD_PAD + OC_GA + h]; } while (0)
#define G2_WU(ch_) do { const bf16* Wg_ = GPTR(const bf16, C.ws + WS_XB + (size_t)((gb * 64) + (ch_)) * GDN_UNIT_BYTES); const bf16* Ug_ = Wg_ + 64 * 128; \
        _Pragma("unroll") for (int s = 0; s < 8; ++s) wf[s] = *(const bf16x8*)(Wg_ + (32 * th + r) * 128 + 16 * s + 8 * hh); \
        u0 = *(const u32x4*)(Ug_ + ((th * 4 + vj) * 64 + lane) * 16); u1 = *(const u32x4*)(Ug_ + ((th * 4 + vj) * 64 + lane) * 16 + 8); } while (0)
#define G2_GATES(buf_) do { if (tid < 64) { float g_ = nA * softplusf(bf2f(ar_next) + dtb); \
            _Pragma("unroll") for (int d = 1; d < 64; d <<= 1) { const float up_ = __shfl_up(g_, d); if (lane >= d) g_ += up_; } \
            const float gl_ = __shfl(g_, 63); float* tb_ = sT + (buf_) * 256; tb_[tid] = g_; tb_[64 + tid] = fexp(g_); tb_[128 + tid] = fexp(gl_ - g_); if (tid == 0) tb_[192] = fexp(gl_); } } while (0)
    G2_AR(0); G2_PF(0); G2_WU(0);
    G2_GATES(0);
    G2_AR(1);
    __syncthreads();
    for (int ch = 0; ch < SEQ / 64; ++ch) {
        const size_t m0 = (size_t)b * SEQ + ch * 64;
        const float* tb = sT + (ch & 1) * 256;
#ifndef GPROBE
#define GPROBE 0
#endif
        for (int rp1 = 0; rp1 < (GPROBE == 1 ? 2 : 1); ++rp1)
        {
            f32x16 acc;
            acc[0] = bf2f(u0.x & 0xffffu); acc[1] = bf2f(u0.x >> 16); acc[2] = bf2f(u0.y & 0xffffu); acc[3] = bf2f(u0.y >> 16);
            acc[4] = bf2f(u0.z & 0xffffu); acc[5] = bf2f(u0.z >> 16); acc[6] = bf2f(u0.w & 0xffffu); acc[7] = bf2f(u0.w >> 16);
            acc[8] = bf2f(u1.x & 0xffffu); acc[9] = bf2f(u1.x >> 16); acc[10] = bf2f(u1.y & 0xffffu); acc[11] = bf2f(u1.y >> 16);
            acc[12] = bf2f(u1.z & 0xffffu); acc[13] = bf2f(u1.z >> 16); acc[14] = bf2f(u1.w & 0xffffu); acc[15] = bf2f(u1.w >> 16);
#pragma unroll
            for (int s = 0; s < 8; ++s) acc = mfma32(wf[s], ldfrag(ST + (32 * vj + r) * LD128 + 16 * s + 8 * hh), acc);
#pragma unroll
            for (int g4 = 0; g4 < 4; ++g4) { const f32x4 ek = *(const f32x4*)(tb + 128 + 32 * th + 8 * g4 + 4 * hh);
                u32x2 pk; pk.x = pk2(acc[4 * g4], acc[4 * g4 + 1]); pk.y = pk2(acc[4 * g4 + 2], acc[4 * g4 + 3]);
                *(u32x2*)(VNT + (32 * vj + r) * LD64 + 32 * th + 8 * g4 + 4 * hh) = pk;
                pk.x = pk2(acc[4 * g4] * ek[0], acc[4 * g4 + 1] * ek[1]); pk.y = pk2(acc[4 * g4 + 2] * ek[2], acc[4 * g4 + 3] * ek[3]);
                *(u32x2*)(VNS + (32 * vj + r) * LD64 + 32 * th + 8 * g4 + 4 * hh) = pk; }
        }
        for (int rp2 = 0; rp2 < (GPROBE == 2 ? 2 : 1); ++rp2)
        {
            float cw[4][8];
#pragma unroll
            for (int k = 0; k < 4; ++k) { const f32x4 a = *(const f32x4*)(sCW + k * 256 + typ * 128 + 8 * l16), c2 = *(const f32x4*)(sCW + k * 256 + typ * 128 + 8 * l16 + 4);
                cw[k][0] = a[0]; cw[k][1] = a[1]; cw[k][2] = a[2]; cw[k][3] = a[3]; cw[k][4] = c2[0]; cw[k][5] = c2[1]; cw[k][6] = c2[2]; cw[k][7] = c2[3]; }
            float x[4][8], kprev[8];
            UNPK8(px[0], x[0]); UNPK8(px[1], x[1]); UNPK8(px[2], x[2]);
#pragma unroll
            for (int tt = 0; tt < 4; ++tt) { float o8[8]; float ss = 0.f;
                UNPK8(px[tt + 3], x[(tt + 3) & 3]);
#pragma unroll
                for (int j = 0; j < 8; ++j) { float a = 0.f;
#pragma unroll
                    for (int k = 0; k < 4; ++k) a += cw[k][j] * x[(tt + k) & 3][j];
                    a = siluf(a); o8[j] = a; ss += a * a; }
                ss = row_sum16(ss);
                const float sc = frsq(ss + 1e-6f) * (typ ? 1.0f : 0.08838834764831845f);
#pragma unroll
                for (int j = 0; j < 8; ++j) o8[j] *= sc;
                u32x4 pk; pk.x = pk2(o8[0], o8[1]); pk.y = pk2(o8[2], o8[3]); pk.z = pk2(o8[4], o8[5]); pk.w = pk2(o8[6], o8[7]);
                *(u32x4*)((typ ? Kh : Qh) + (4 * tg + tt) * LD128 + 8 * l16) = pk;
                if (typ) {
                    if (tt & 1) {
#pragma unroll
                        for (int j = 0; j < 8; ++j) *(unsigned*)(KT + (8 * l16 + j) * LD64 + 4 * tg + tt - 1) = pk2(kprev[j], o8[j]);
                    } else {
#pragma unroll
                        for (int j = 0; j < 8; ++j) kprev[j] = o8[j]; } } }
        }
        if (ch + 1 < SEQ / 64) { G2_PF(ch + 1); G2_WU(ch + 1); G2_GATES((ch + 1) & 1); if (ch + 2 < SEQ / 64) G2_AR(ch + 2); }
        lds_barrier();
        f32x16 oacc;
        for (int rp3 = 0; rp3 < (GPROBE == 3 ? 2 : 1); ++rp3) {
#pragma unroll
        for (int g = 0; g < 16; ++g) oacc[g] = C.zf();
#pragma unroll
        for (int s = 0; s < 8; ++s) oacc = mfma32(ldfrag(Qh + (32 * th + r) * LD128 + 16 * s + 8 * hh), ldfrag(ST + (32 * vj + r) * LD128 + 16 * s + 8 * hh), oacc);
#pragma unroll
        for (int g4 = 0; g4 < 4; ++g4) { const f32x4 eg = *(const f32x4*)(tb + 64 + 32 * th + 8 * g4 + 4 * hh);
            oacc[4 * g4] *= eg[0]; oacc[4 * g4 + 1] *= eg[1]; oacc[4 * g4 + 2] *= eg[2]; oacc[4 * g4 + 3] *= eg[3]; }
        if (w < 3) {
            const int ti = w > 0 ? 1 : 0, tj = w > 1 ? 1 : 0;
            f32x16 acc;
#pragma unroll
            for (int g = 0; g < 16; ++g) acc[g] = C.zf();
#pragma unroll
            for (int s = 0; s < 8; ++s) acc = mfma32(ldfrag(Kh + (32 * tj + r) * LD128 + 16 * s + 8 * hh), ldfrag(Qh + (32 * ti + r) * LD128 + 16 * s + 8 * hh), acc);
            const int i = 32 * ti + r; const float gi = tb[i];
#pragma unroll
            for (int g4 = 0; g4 < 4; ++g4) { const f32x4 gj = *(const f32x4*)(tb + 32 * tj + 8 * g4 + 4 * hh); float v4[4];
#pragma unroll
                for (int q = 0; q < 4; ++q) { const int j = 32 * tj + 8 * g4 + 4 * hh + q; v4[q] = (j <= i) ? acc[4 * g4 + q] * fexp(gi - gj[q]) : 0.f; }
                u32x2 pk; pk.x = pk2(v4[0], v4[1]); pk.y = pk2(v4[2], v4[3]);
                *(u32x2*)(QKd + i * LD64 + 32 * tj + 8 * g4 + 4 * hh) = pk; }
        }
        }
        lds_barrier();
        {
            f32x16 acc = oacc;
            for (int rp4 = 0; rp4 < (GPROBE == 4 ? 2 : 1); ++rp4) { acc = oacc;
#pragma unroll
            for (int s = 0; s < 4; ++s) acc = mfma32(ldfrag(QKd + (32 * th + r) * LD64 + 16 * s + 8 * hh), ldfrag(VNT + (32 * vj + r) * LD64 + 16 * s + 8 * hh), acc);
#pragma unroll
            for (int g = 0; g < 16; ++g) Y[(m0 + 32 * th + drow(g, hh)) * DM + h * 128 + 32 * vj + r] = (bf16)f2bf(acc[g]);
            }
            const float gl_ = tb[192];
            bf16x8 vs[4];
#pragma unroll
            for (int s = 0; s < 4; ++s) vs[s] = ldfrag(VNS + (32 * vj + r) * LD64 + 16 * s + 8 * hh);
#pragma unroll
            for (int q = 0; q < 2; ++q) { const int kt = 2 * th + q;
                f32x16 sa = q == 0 ? S0 : S1;
#pragma unroll
                for (int g = 0; g < 16; ++g) sa[g] *= gl_;
#pragma unroll
                for (int s = 0; s < 4; ++s) sa = mfma32(ldfrag(KT + (32 * kt + r) * LD64 + 16 * s + 8 * hh), vs[s], sa);
                if (q == 0) S0 = sa; else S1 = sa;
#pragma unroll
                for (int g4 = 0; g4 < 4; ++g4) { u32x2 pk; pk.x = pk2(sa[4 * g4], sa[4 * g4 + 1]); pk.y = pk2(sa[4 * g4 + 2], sa[4 * g4 + 3]);
                    *(u32x2*)(ST + (32 * vj + r) * LD128 + 32 * kt + 8 * g4 + 4 * hh) = pk; }
            }
        }
        lds_barrier();
    }
#undef G2_PF
#undef G2_AR
#undef G2_WU
#undef G2_GATES
}

__device__ __forceinline__ void mlstm_chunk_block2(const Ctx& C, int o, int mb, unsigned char* lds) {
    const int tid = C.tid(), lane = C.lane(), w = C.wave, r = lane & 31, hh = lane >> 5;
    const int b = mb >> 2, h = mb & 3;
    const bf16* P = GPTR(const bf16, C.ws + WS_R1); bf16* Y = GPTR(bf16, C.ws + WS_Y); float* den = GPTR(float, C.ws + WS_BONUS);
    const float* convw = C.in(32) + (size_t)o * 4 * 512;
    const float igb = C.in(33)[o * 4 + h], fgb = C.in(34)[o * 4 + h];
    bf16* Qh = (bf16*)lds; bf16* Kh = Qh + 64 * LD64; bf16* KT = Kh + 64 * LD64; bf16* Wm = KT + 64 * LD64;
    bf16* VT = Wm + 64 * LD64; bf16* VS = VT + 160 * LD64; bf16* CT0 = VS + 160 * LD64; bf16* CT1 = CT0 + 160 * LD64;
    float* sT = (float*)(CT1 + 160 * LD64);
    for (int i = tid; i < 2 * 160 * LD64 / 2; i += NTHREADS) ((unsigned*)CT0)[i] = 0u;
    for (int i = tid; i < 64 * LD64 / 2; i += NTHREADS) ((unsigned*)Wm)[i] = 0u;
    for (int i = tid; i < 32 * LD64; i += NTHREADS) { VT[128 * LD64 + i] = (i < 64) ? (bf16)0x3F80 : (bf16)0; VS[128 * LD64 + i] = (bf16)0; }
    const int l16 = tid & 15, typ = (tid >> 4) & 1, tg = tid >> 5;
    const int pc = OC_MQK + (typ ? 256 : 0) + h * 64 + 4 * l16;
    float cw[4][4];
#pragma unroll
    for (int k = 0; k < 4; ++k)
#pragma unroll
        for (int j = 0; j < 4; ++j) cw[k][j] = convw[k * 512 + (typ ? 256 : 0) + h * 64 + 4 * l16 + j];
    const int th = w >> 2, vj = w & 3; const bool two = (vj == 0);
    f32x16 Ca, Cb;
#pragma unroll
    for (int g = 0; g < 16; ++g) { Ca[g] = C.zf(); Cb[g] = C.zf(); }
    int cur = 0;
    u32x2 px[7]; u32x4 pva, pvb; unsigned pgi = 0, pgf = 0;
    const int vt = tid & 63, vg = tid >> 6;
#define M2_PF(ch_) do { _Pragma("unroll") for (int i = 0; i < 7; ++i) { const int t_ = 64 * (ch_) + 4 * tg - 3 + i; \
            if (t_ >= 0) px[i] = *(const u32x2*)(P + ((size_t)b * SEQ + t_) * OD_PAD + pc); else px[i] = (u32x2){C.z0, C.z0}; } \
        { const bf16* vr_ = P + ((size_t)b * SEQ + 64 * (ch_) + vt) * OD_PAD; pva = *(const u32x4*)(vr_ + OC_MV + h * 128 + 16 * vg); pvb = *(const u32x4*)(vr_ + OC_MV + h * 128 + 16 * vg + 8); } } while (0)
#define M2_GPF(ch_) do { const bf16* vr_ = P + ((size_t)b * SEQ + 64 * (ch_) + vt) * OD_PAD; pgi = vr_[OC_MI + h]; pgf = vr_[OC_MF + h]; } while (0)
#define M2_GATES(buf_) do { if (tid < 64) { const float ip_ = bf2f(pgi) + igb; float lf_ = logsigm(bf2f(pgf) + fgb); \
            _Pragma("unroll") for (int d = 1; d < 64; d <<= 1) { const float up_ = __shfl_up(lf_, d); if (lane >= d) lf_ += up_; } \
            const float bl_ = __shfl(lf_, 63); float* tb_ = sT + (buf_) * 256; tb_[tid] = lf_; tb_[64 + tid] = ip_; tb_[128 + tid] = fexp(lf_); tb_[192 + tid] = fexp(bl_ - lf_ + ip_); } } while (0)
    M2_GPF(0); M2_PF(0);
    M2_GATES(0);
    M2_GPF(1);
    __syncthreads();
    for (int ch = 0; ch < SEQ / 64; ++ch) {
        const size_t m0 = (size_t)b * SEQ + ch * 64;
        const float* tb = sT + (ch & 1) * 256;
        {
            float x[7][4], ko[4][4];
#pragma unroll
            for (int i = 0; i < 7; ++i) { x[i][0] = bf2f(px[i].x & 0xffffu); x[i][1] = bf2f(px[i].x >> 16); x[i][2] = bf2f(px[i].y & 0xffffu); x[i][3] = bf2f(px[i].y >> 16); }
#pragma unroll
            for (int tt = 0; tt < 4; ++tt) {
#pragma unroll
                for (int j = 0; j < 4; ++j) { float a = 0.f;
#pragma unroll
                    for (int k = 0; k < 4; ++k) a += cw[k][j] * x[tt + k][j];
                    a = siluf(a); ko[tt][j] = typ ? a : a * 0.125f; }
                u32x2 pk; pk.x = pk2(ko[tt][0], ko[tt][1]); pk.y = pk2(ko[tt][2], ko[tt][3]);
                *(u32x2*)((typ ? Kh : Qh) + (4 * tg + tt) * LD64 + 4 * l16) = pk; }
            if (typ) {
#pragma unroll
                for (int j = 0; j < 4; ++j) { u32x2 pk; pk.x = pk2(ko[0][j], ko[1][j]); pk.y = pk2(ko[2][j], ko[3][j]); *(u32x2*)(KT + (4 * l16 + j) * LD64 + 4 * tg) = pk; } }
            {   const float ek = tb[192 + vt]; const unsigned wv[8] = {pva.x, pva.y, pva.z, pva.w, pvb.x, pvb.y, pvb.z, pvb.w};
#pragma unroll
                for (int q = 0; q < 8; ++q) { const unsigned lo = wv[q] & 0xffffu, hi = wv[q] >> 16;
                    VT[(16 * vg + 2 * q) * LD64 + vt] = (bf16)lo; VT[(16 * vg + 2 * q + 1) * LD64 + vt] = (bf16)hi;
                    VS[(16 * vg + 2 * q) * LD64 + vt] = (bf16)f2bf(bf2f(lo) * ek); VS[(16 * vg + 2 * q + 1) * LD64 + vt] = (bf16)f2bf(bf2f(hi) * ek); }
                if (tid < 64) VS[128 * LD64 + tid] = (bf16)f2bf(ek); }
        }
        if (ch + 1 < SEQ / 64) { M2_PF(ch + 1); M2_GATES((ch + 1) & 1); if (ch + 2 < SEQ / 64) M2_GPF(ch + 2); }
        lds_barrier();
        if (w < 3) {
            const int ti = w > 0 ? 1 : 0, tj = w > 1 ? 1 : 0;
            f32x16 acc;
#pragma unroll
            for (int g = 0; g < 16; ++g) acc[g] = C.zf();
#pragma unroll
            for (int s = 0; s < 4; ++s) acc = mfma32(ldfrag(Kh + (32 * tj + r) * LD64 + 16 * s + 8 * hh), ldfrag(Qh + (32 * ti + r) * LD64 + 16 * s + 8 * hh), acc);
            const int i = 32 * ti + r; const float bi = tb[i];
#pragma unroll
            for (int g4 = 0; g4 < 4; ++g4) { const f32x4 bj = *(const f32x4*)(tb + 32 * tj + 8 * g4 + 4 * hh), ij = *(const f32x4*)(tb + 64 + 32 * tj + 8 * g4 + 4 * hh); float v4[4];
#pragma unroll
                for (int q = 0; q < 4; ++q) { const int j = 32 * tj + 8 * g4 + 4 * hh + q; v4[q] = (j <= i) ? acc[4 * g4 + q] * fexp(bi - bj[q] + ij[q]) : 0.f; }
                u32x2 pk; pk.x = pk2(v4[0], v4[1]); pk.y = pk2(v4[2], v4[3]);
                *(u32x2*)(Wm + i * LD64 + 32 * tj + 8 * g4 + 4 * hh) = pk; }
        }
        lds_barrier();
        {
            const bf16* CTc = cur ? CT1 : CT0; bf16* CTn = cur ? CT0 : CT1;
            const float F = tb[128 + 63];
#pragma unroll
            for (int q = 0; q < 2; ++q) {
                if (q == 1 && !two) break;
                const int vjj = q == 0 ? vj : 4;
                f32x16 num;
#pragma unroll
                for (int g = 0; g < 16; ++g) num[g] = C.zf();
#pragma unroll
                for (int s = 0; s < 4; ++s) num = mfma32(ldfrag(Qh + (32 * th + r) * LD64 + 16 * s + 8 * hh), ldfrag(CTc + (32 * vjj + r) * LD64 + 16 * s + 8 * hh), num);
#pragma unroll
                for (int g4 = 0; g4 < 4; ++g4) { const f32x4 eb = *(const f32x4*)(tb + 128 + 32 * th + 8 * g4 + 4 * hh);
                    num[4 * g4] *= eb[0]; num[4 * g4 + 1] *= eb[1]; num[4 * g4 + 2] *= eb[2]; num[4 * g4 + 3] *= eb[3]; }
#pragma unroll
                for (int s = 0; s < 4; ++s) num = mfma32(ldfrag(Wm + (32 * th + r) * LD64 + 16 * s + 8 * hh), ldfrag(VT + (32 * vjj + r) * LD64 + 16 * s + 8 * hh), num);
                if (vjj < 4) {
#pragma unroll
                    for (int g = 0; g < 16; ++g) Y[(m0 + 32 * th + drow(g, hh)) * DM + 512 + h * 128 + 32 * vjj + r] = (bf16)f2bf(num[g]);
                } else if (r == 0) {
#pragma unroll
                    for (int g = 0; g < 16; ++g) den[(m0 + 32 * th + drow(g, hh)) * 4 + h] = num[g];
                }
                f32x16 cacc = q == 0 ? Ca : Cb;
#pragma unroll
                for (int g = 0; g < 16; ++g) cacc[g] *= F;
#pragma unroll
                for (int s = 0; s < 4; ++s) cacc = mfma32(ldfrag(KT + (32 * th + r) * LD64 + 16 * s + 8 * hh), ldfrag(VS + (32 * vjj + r) * LD64 + 16 * s + 8 * hh), cacc);
                if (q == 0) Ca = cacc; else Cb = cacc;
#pragma unroll
                for (int g4 = 0; g4 < 4; ++g4) { u32x2 pk; pk.x = pk2(cacc[4 * g4], cacc[4 * g4 + 1]); pk.y = pk2(cacc[4 * g4 + 2], cacc[4 * g4 + 3]);
                    *(u32x2*)(CTn + (32 * vjj + r) * LD64 + 32 * th + 8 * g4 + 4 * hh) = pk; }
            }
        }
        cur ^= 1;
        lds_barrier();
    }
#undef M2_PF
#undef M2_GPF
#undef M2_GATES
}

constexpr size_t WS_RP = WS_R1 + (size_t)M * EV_COLS * 2, WS_YP = WS_RP + 16 * MiB, WS_ZP0 = WS_YP + 16 * MiB, WS_MM = WS_XB, WS_ZP1 = WS_END;
static_assert(WS_ZP0 + 8 * MiB == WS_R1 + 128 * MiB && WS_ZP1 + 8 * MiB <= 256 * MiB, "rwkv chunk operand map");
__device__ __forceinline__ unsigned char* rwkv_zp(const Ctx& C, int u) { return C.ws + (u < 1024 ? WS_ZP0 + (size_t)u * 8192 : WS_ZP1 + (size_t)(u - 1024) * 8192); }

#ifndef RPHEADS
#define RPHEADS 8
#endif
__device__ __forceinline__ void rwkv_pre_tile(const Ctx& C, int e_in, int tile_in, unsigned char* lds, int nheads = 8) {
    int e = e_in, tile = tile_in; asm volatile("" : "+s"(e), "+s"(tile));
    const size_t m0 = (size_t)tile * 64; const int b = tile >> 6, n = tile & 63, t0 = n * 64;
    const bf16* P = GPTR(const bf16, C.ws + WS_R1); float* bonus = GPTR(float, C.ws + WS_BONUS);
    const float* mu = C.in(15) + (size_t)e * 1792;
    const float* p_w2 = C.in(17) + (size_t)e * 64 * 512; const float* p_a2 = C.in(19) + (size_t)e * 64 * 512; const float* pw0 = C.in(16) + (size_t)e * 512;
    const float* pkk = C.in(21) + (size_t)e * 512; const float* pa0 = C.in(18) + (size_t)e * 512; const float* pka = C.in(22) + (size_t)e * 512; const float* prk = C.in(23) + (size_t)e * 512;
    float* Ab = (float*)lds; float* Rh = Ab + 64 * 68;
    bf16* KKt = (bf16*)(Rh + 64 * 68); bf16* Bh = KKt + 64 * LD64; bf16* Kh = Bh + 64 * LD64; bf16* Rt = Kh + 64 * LD64; bf16* VT = Rt + 64 * LD64;
    bf16* Ak = VT + 64 * LD64; bf16* Ark = Ak + 64 * LD64; bf16* ArbN = Ark + 64 * LD64; bf16* WT = ArbN + 64 * LD64; bf16* UT = WT + 64 * LD64; bf16* BbTN = UT + 64 * LD64; bf16* KbT = BbTN + 64 * LD64;
    float* sGL = (float*)(KbT + 64 * LD64);
    u32x4 gxw, gxwp, gxa, gxap, gr, grp, gk, gkp, gv, gvp; f32x4 gw0, gw1, ga0, ga1;
    {   const int tq = C.tid() >> 3, cq = C.tid() & 7; const bf16* row = P + (m0 + tq) * EV_COLS; const bf16* prow = (t0 + tq) > 0 ? row - EV_COLS : row;
        gxw = *(const u32x4*)(row + EC_XW + 8 * cq); gxwp = *(const u32x4*)(prow + EC_XW + 8 * cq); gxa = *(const u32x4*)(row + EC_XA + 8 * cq); gxap = *(const u32x4*)(prow + EC_XA + 8 * cq); }
#define RP_LOAD(h_) do { const int tq_ = C.tid() >> 3, cq_ = C.tid() & 7; const bf16* row_ = P + (m0 + tq_) * EV_COLS; const bf16* prow_ = (t0 + tq_) > 0 ? row_ - EV_COLS : row_; const int hc_ = (h_) * 64 + 8 * cq_; \
        gr = *(const u32x4*)(row_ + EC_R + hc_); grp = *(const u32x4*)(prow_ + EC_R + hc_); gk = *(const u32x4*)(row_ + EC_K + hc_); gkp = *(const u32x4*)(prow_ + EC_K + hc_); gv = *(const u32x4*)(row_ + EC_V + hc_); gvp = *(const u32x4*)(prow_ + EC_V + hc_); \
        const float* w2_ = p_w2 + (size_t)tq_ * 512 + hc_; const float* a2_ = p_a2 + (size_t)tq_ * 512 + hc_; \
        gw0 = *(const f32x4*)w2_; gw1 = *(const f32x4*)(w2_ + 4); ga0 = *(const f32x4*)a2_; ga1 = *(const f32x4*)(a2_ + 4); } while (0)
    float t_mw[8], t_ma[8];
    {   const int c8_ = C.tid() & 7;
#pragma unroll
        for (int j = 0; j < 8; ++j) { t_mw[j] = mu[1536 + 8 * c8_ + j]; t_ma[j] = mu[1600 + 8 * c8_ + j]; } }
    RP_LOAD(0);
#pragma unroll 1
    for (int h = 0; h < nheads; ++h) {
        int tid_ = C.tid(); asm volatile("" : "+v"(tid_));
        const int tid = tid_, lane = tid & 63, w = __builtin_amdgcn_readfirstlane(tid >> 6), r = lane & 31, hh = lane >> 5;
        const int u = (b * 8 + h) * 64 + n;
        float q_mur[8], q_muk[8], q_muv[8], q_kk[8], q_a0[8], q_ka[8], q_rk[8], q_w0;
        {   const int hc_ = h * 64 + 8 * (tid & 7);
#define RP_P8(dst_, src_) do { const f32x4 a_ = *(const f32x4*)((src_) + hc_), b_ = *(const f32x4*)((src_) + hc_ + 4); dst_[0] = a_[0]; dst_[1] = a_[1]; dst_[2] = a_[2]; dst_[3] = a_[3]; dst_[4] = b_[0]; dst_[5] = b_[1]; dst_[6] = b_[2]; dst_[7] = b_[3]; } while (0)
            q_w0 = pw0[h * 64 + (tid & 31) + 32 * ((tid >> 6) & 1)];
            RP_P8(q_mur, mu); RP_P8(q_muk, mu + 512); RP_P8(q_muv, mu + 1024); RP_P8(q_kk, pkk); RP_P8(q_a0, pa0); RP_P8(q_ka, pka); RP_P8(q_rk, prk);
#undef RP_P8
        }
        lds_barrier();
#ifndef RPROBE
#define RPROBE 0
#endif
        for (int rp = 0; rp < (RPROBE == 1 ? 2 : 1); ++rp) { if (rp) lds_barrier();
        {
            const int t = tid >> 3, c8 = tid & 7; const float pm0 = (t0 + t) > 0 ? 1.0f : 0.0f;
            float c[8], p[8], o[8];
            UNPK8(gxw, c); UNPK8(gxwp, p);
#pragma unroll
            for (int j = 0; j < 8; ++j) o[j] = ftanh(c[j] + t_mw[j] * (p[j] * pm0 - c[j]));
            u32x4 pk; pk.x = pk2(o[0], o[1]); pk.y = pk2(o[2], o[3]); pk.z = pk2(o[4], o[5]); pk.w = pk2(o[6], o[7]);
            *(u32x4*)(Ak + t * LD64 + 8 * c8) = pk;
            UNPK8(gxa, c); UNPK8(gxap, p);
#pragma unroll
            for (int j = 0; j < 8; ++j) o[j] = c[j] + t_ma[j] * (p[j] * pm0 - c[j]);
            pk.x = pk2(o[0], o[1]); pk.y = pk2(o[2], o[3]); pk.z = pk2(o[4], o[5]); pk.w = pk2(o[6], o[7]);
            *(u32x4*)(Ark + t * LD64 + 8 * c8) = pk;
            const f32x4 wa0 = gw0, wa1 = gw1, aa0 = ga0, aa1 = ga1;
#pragma unroll
            for (int j = 0; j < 4; ++j) { WT[(8 * c8 + j) * LD64 + t] = (bf16)f2bf(wa0[j]); WT[(8 * c8 + 4 + j) * LD64 + t] = (bf16)f2bf(wa1[j]);
                UT[(8 * c8 + j) * LD64 + t] = (bf16)f2bf(aa0[j]); UT[(8 * c8 + 4 + j) * LD64 + t] = (bf16)f2bf(aa1[j]); }
        }
        lds_barrier();
        {
            const int mat = w >> 2, tt = (w >> 1) & 1, nt = w & 1;
            f32x16 z;
#pragma unroll
            for (int g = 0; g < 16; ++g) z[g] = C.zf();
#pragma unroll
            for (int s = 0; s < 4; ++s) z = mfma32(ldfrag((mat ? Ark : Ak) + (32 * tt + r) * LD64 + 16 * s + 8 * hh), ldfrag((mat ? UT : WT) + (32 * nt + r) * LD64 + 16 * s + 8 * hh), z);
            float* dst = mat ? Rh : Ab;
            if (!mat) {
                const float p_w0 = q_w0;
#pragma unroll
                for (int g = 0; g < 16; ++g) z[g] = -fexp(-softplusf(-(p_w0 + z[g])) - 0.5f);
            }
#pragma unroll
            for (int g = 0; g < 16; ++g) dst[(32 * tt + drow(g, hh)) * 68 + 32 * nt + r] = z[g];
        }
        }
        lds_barrier();
        for (int rp = 0; rp < (RPROBE == 2 ? 2 : 1); ++rp)
        if (w == 0) {
            float cl = 0.f;
#pragma unroll 16
            for (int t = 0; t < 64; ++t) { cl += Ab[t * 68 + lane]; Ab[t * 68 + lane] = cl; }
            sGL[lane] = fexp(cl);
        }
        lds_barrier();
        {
            const int t = tid >> 3, c8 = tid & 7, hc = h * 64 + 8 * c8; const size_t m = m0 + t; const float pm = (t0 + t) > 0 ? 1.0f : 0.0f;
            float rs[8], ks[8], vs[8], tmp[8];
            UNPK8(gr, rs); UNPK8(grp, tmp);
#pragma unroll
            for (int j = 0; j < 8; ++j) rs[j] += q_mur[j] * (tmp[j] * pm - rs[j]);
            UNPK8(gk, ks); UNPK8(gkp, tmp);
#pragma unroll
            for (int j = 0; j < 8; ++j) ks[j] += q_muk[j] * (tmp[j] * pm - ks[j]);
            UNPK8(gv, vs); UNPK8(gvp, tmp);
#pragma unroll
            for (int j = 0; j < 8; ++j) vs[j] += q_muv[j] * (tmp[j] * pm - vs[j]);
            if (h + 1 < nheads) RP_LOAD(h + 1);
            float kkv[8], ss = 0.f;
#pragma unroll
            for (int j = 0; j < 8; ++j) { kkv[j] = ks[j] * q_kk[j]; ss += kkv[j] * kkv[j]; }
            ss += __shfl_xor(ss, 1); ss += __shfl_xor(ss, 2); ss += __shfl_xor(ss, 4);
            const float rn = frsq(ss + 1e-6f);
            const f32x4 cl0 = *(const f32x4*)(Ab + t * 68 + 8 * c8), cl1 = *(const f32x4*)(Ab + t * 68 + 8 * c8 + 4);
            const f32x4 za0 = *(const f32x4*)(Rh + t * 68 + 8 * c8), za1 = *(const f32x4*)(Rh + t * 68 + 8 * c8 + 4);
            const f32x4 cL0 = *(const f32x4*)(Ab + 63 * 68 + 8 * c8), cL1 = *(const f32x4*)(Ab + 63 * 68 + 8 * c8 + 4);
            f32x4 cp0 = {C.zf(), C.zf(), C.zf(), C.zf()}, cp1 = cp0;
            if (t > 0) { cp0 = *(const f32x4*)(Ab + (t - 1) * 68 + 8 * c8); cp1 = *(const f32x4*)(Ab + (t - 1) * 68 + 8 * c8 + 4); }
            float o1[8], o2[8], o3[8], o4[8], bon = 0.f;
#pragma unroll
            for (int j = 0; j < 8; ++j) { const float cl = j < 4 ? cl0[j] : cl1[j - 4], cp = j < 4 ? cp0[j] : cp1[j - 4], cL = j < 4 ? cL0[j] : cL1[j - 4], za = j < 4 ? za0[j] : za1[j - 4];
                const float a = sigm(q_a0[j] + za);
                const float kk = kkv[j] * rn, bb = kk * a, kp = ks[j] * (1.0f + (a - 1.0f) * q_ka[j]);
                bon += rs[j] * kp * q_rk[j];
                const float ig = fexp(-cl), eg = fexp(cl), el = fexp(cL - cl);
                o1[j] = kk * fexp(cp); o2[j] = bb * ig; o3[j] = kp * ig; o4[j] = rs[j] * eg;
                BbTN[(8 * c8 + j) * LD64 + t] = (bf16)f2bf(-bb * el); KbT[(8 * c8 + j) * LD64 + t] = (bf16)f2bf(kp * el); VT[(8 * c8 + j) * LD64 + t] = (bf16)f2bf(vs[j]); WT[(8 * c8 + j) * LD64 + t] = (bf16)f2bf(o1[j]); }
            bon += __shfl_xor(bon, 1); bon += __shfl_xor(bon, 2); bon += __shfl_xor(bon, 4);
            if (c8 == 0) bonus[m * 8 + h] = bon;
            u32x4 pk; pk.x = pk2(o1[0], o1[1]); pk.y = pk2(o1[2], o1[3]); pk.z = pk2(o1[4], o1[5]); pk.w = pk2(o1[6], o1[7]); *(u32x4*)(KKt + t * LD64 + 8 * c8) = pk;
            pk.x = pk2(o2[0], o2[1]); pk.y = pk2(o2[2], o2[3]); pk.z = pk2(o2[4], o2[5]); pk.w = pk2(o2[6], o2[7]); *(u32x4*)(Bh + t * LD64 + 8 * c8) = pk;
            pk.x = pk2(o3[0], o3[1]); pk.y = pk2(o3[2], o3[3]); pk.z = pk2(o3[4], o3[5]); pk.w = pk2(o3[6], o3[7]); *(u32x4*)(Kh + t * LD64 + 8 * c8) = pk;
            pk.x = pk2(o4[0], o4[1]); pk.y = pk2(o4[2], o4[3]); pk.z = pk2(o4[4], o4[5]); pk.w = pk2(o4[6], o4[7]); *(u32x4*)(Rt + t * LD64 + 8 * c8) = pk;
        }
        lds_barrier();
        bf16* AbI = (bf16*)Ab; bf16* AbT = AbI + 64 * LD64;
        bf16* WK0 = AbT + 64 * LD64; bf16* WK1 = Bh;
        {
#pragma unroll 1
            for (int job = w; job < 18; job += 8) {
                const bool tr = job >= 16; const int mat = tr ? 0 : (job >> 2), ti = tr ? (job - 16) : ((job >> 1) & 1), tj = tr ? ti : (job & 1);
                const bf16* first = mat < 2 ? KKt : Rt; const bf16* second = (mat == 0 || mat == 3) ? Bh : Kh;
                f32x16 acc;
#pragma unroll
                for (int g = 0; g < 16; ++g) acc[g] = C.zf();
                const bf16* opA = tr ? first + (32 * ti + r) * LD64 : second + (32 * tj + r) * LD64; const bf16* opB = tr ? second + (32 * tj + r) * LD64 : first + (32 * ti + r) * LD64;
                if (tj <= ti) {
#pragma unroll
                    for (int s4 = 0; s4 < 4; ++s4) acc = mfma32(ldfrag(opA + 16 * s4 + 8 * hh), ldfrag(opB + 16 * s4 + 8 * hh), acc);
                }
                const int fx = 32 * (tr ? tj : ti) + r; const bool incl = mat >= 2; const float sg = mat == 3 ? -1.0f : 1.0f;
                bf16* dstI = tr ? AbT : (mat == 0 ? AbI : (mat == 1 ? Ak : (mat == 2 ? Ark : ArbN)));
#pragma unroll
                for (int g4 = 0; g4 < 4; ++g4) { float v4[4];
#pragma unroll
                    for (int q = 0; q < 4; ++q) { const int y = 32 * (tr ? ti : tj) + 8 * g4 + 4 * hh + q; const int tt_ = tr ? y : fx, ii_ = tr ? fx : y;
                        v4[q] = (incl ? ii_ <= tt_ : ii_ < tt_) ? acc[4 * g4 + q] * sg : 0.f; }
                    u32x2 pk; pk.x = pk2(v4[0], v4[1]); pk.y = pk2(v4[2], v4[3]);
                    *(u32x2*)(dstI + fx * LD64 + 32 * (tr ? ti : tj) + 8 * g4 + 4 * hh) = pk; }
            }
        }
        lds_barrier();
        for (int rp = 0; rp < (RPROBE == 8 ? 2 : 1); ++rp)
        if (w < 2) {
            const int d = w; bf16* wk = d ? WK1 : WK0;
            bf16* PA = wk; bf16* PAT = wk + 1280; bf16* PB = wk + 2560; bf16* PBT = wk + 3840; bf16* TA = wk + 5120; bf16* TB = wk + 6400;
            const bf16* Pc = AbI + (32 * d) * LD64 + 32 * d; const bf16* PTc = AbT + (32 * d) * LD64 + 32 * d; int ldp = LD64;
            {   float v8[8], o8[8];
#pragma unroll
                for (int q = 0; q < 2; ++q) { ld8(Pc + r * LD64 + 16 * hh + 8 * q, v8);
#pragma unroll
                    for (int j = 0; j < 8; ++j) o8[j] = ((16 * hh + 8 * q + j) == r ? 1.0f : 0.0f) - v8[j];
                    u32x4 pk; pk.x = pk2(o8[0], o8[1]); pk.y = pk2(o8[2], o8[3]); pk.z = pk2(o8[4], o8[5]); pk.w = pk2(o8[6], o8[7]); *(u32x4*)(TA + r * 40 + 16 * hh + 8 * q) = pk; } }
            asm volatile("s_waitcnt lgkmcnt(0)" ::: "memory");
#pragma unroll
            for (int k = 0; k < 4; ++k) {
                bf16* Pn = (k & 1) ? PA : PB; bf16* PnT = (k & 1) ? PAT : PBT; const bf16* Tc = (k & 1) ? TB : TA; bf16* Tn = (k & 1) ? TA : TB;
                f32x16 a1, a2;
#pragma unroll
                for (int g = 0; g < 16; ++g) { a1[g] = C.zf(); a2[g] = C.zf(); }
#pragma unroll
                for (int s2 = 0; s2 < 2; ++s2) { const bf16x8 fp = ldfrag(Pc + r * ldp + 16 * s2 + 8 * hh), ft = ldfrag(PTc + r * ldp + 16 * s2 + 8 * hh);
                    a1 = mfma32(ft, fp, a1);
                    a2 = mfma32(fp, ft, a2); }
#pragma unroll
                for (int g4 = 0; g4 < 4; ++g4) { u32x2 pk; pk.x = pk2(a1[4 * g4], a1[4 * g4 + 1]); pk.y = pk2(a1[4 * g4 + 2], a1[4 * g4 + 3]); *(u32x2*)(Pn + r * 40 + 8 * g4 + 4 * hh) = pk;
                    pk.x = pk2(a2[4 * g4], a2[4 * g4 + 1]); pk.y = pk2(a2[4 * g4 + 2], a2[4 * g4 + 3]); *(u32x2*)(PnT + r * 40 + 8 * g4 + 4 * hh) = pk; }
                asm volatile("s_waitcnt lgkmcnt(0)" ::: "memory");
#pragma unroll
                for (int g = 0; g < 16; ++g) a1[g] = C.zf();
#pragma unroll
                for (int s2 = 0; s2 < 2; ++s2) a1 = mfma32(ldfrag(PnT + r * 40 + 16 * s2 + 8 * hh), ldfrag(Tc + r * 40 + 16 * s2 + 8 * hh), a1);
#pragma unroll
                for (int g4 = 0; g4 < 4; ++g4) { float t4[4]; ld4(Tc + r * 40 + 8 * g4 + 4 * hh, t4);
                    u32x2 pk; pk.x = pk2(t4[0] + a1[4 * g4], t4[1] + a1[4 * g4 + 1]); pk.y = pk2(t4[2] + a1[4 * g4 + 2], t4[3] + a1[4 * g4 + 3]); *(u32x2*)(Tn + r * 40 + 8 * g4 + 4 * hh) = pk; }
                asm volatile("s_waitcnt lgkmcnt(0)" ::: "memory");
                Pc = Pn; PTc = PnT; ldp = 40;
            }
        } else if (w >= 4) {
            const int ti = (w >> 1) & 1, vj = w & 1;
            f32x16 acc;
#pragma unroll
            for (int g = 0; g < 16; ++g) acc[g] = C.zf();
#pragma unroll
            for (int s4 = 0; s4 < 4; ++s4) acc = mfma32(ldfrag(Ak + (32 * ti + r) * LD64 + 16 * s4 + 8 * hh), ldfrag(VT + (32 * vj + r) * LD64 + 16 * s4 + 8 * hh), acc);
#pragma unroll
            for (int g4 = 0; g4 < 4; ++g4) { u32x2 pk; pk.x = pk2(acc[4 * g4], acc[4 * g4 + 1]); pk.y = pk2(acc[4 * g4 + 2], acc[4 * g4 + 3]); *(u32x2*)(UT + (32 * vj + r) * LD64 + 32 * ti + 8 * g4 + 4 * hh) = pk; }
        }
        lds_barrier();
        for (int rp = 0; rp < (RPROBE == 9 ? 2 : 1); ++rp)
        if (w < 4) {
            bf16* XT = (w < 2 ? WT : UT) + (32 * (w & 1) + r) * LD64;
            const bf16* T00 = WK0 + 5120; const bf16* T11 = WK1 + 5120;
            f32x16 acc;
#pragma unroll
            for (int g = 0; g < 16; ++g) acc[g] = C.zf();
#pragma unroll
            for (int s2 = 0; s2 < 2; ++s2) acc = mfma32(ldfrag(T00 + r * 40 + 16 * s2 + 8 * hh), ldfrag(XT + 16 * s2 + 8 * hh), acc);
#pragma unroll
            for (int g4 = 0; g4 < 4; ++g4) { u32x2 pk; pk.x = pk2(acc[4 * g4], acc[4 * g4 + 1]); pk.y = pk2(acc[4 * g4 + 2], acc[4 * g4 + 3]); *(u32x2*)(XT + 8 * g4 + 4 * hh) = pk; }
            asm volatile("s_waitcnt lgkmcnt(0)" ::: "memory");
#pragma unroll
            for (int g = 0; g < 16; ++g) acc[g] = C.zf();
#pragma unroll
            for (int s2 = 0; s2 < 2; ++s2) acc = mfma32(ldfrag(AbI + (32 + r) * LD64 + 16 * s2 + 8 * hh), ldfrag(XT + 16 * s2 + 8 * hh), acc);
#pragma unroll
            for (int g4 = 0; g4 < 4; ++g4) { float r4[4]; ld4(XT + 32 + 8 * g4 + 4 * hh, r4);
                u32x2 pk; pk.x = pk2(r4[0] - acc[4 * g4], r4[1] - acc[4 * g4 + 1]); pk.y = pk2(r4[2] - acc[4 * g4 + 2], r4[3] - acc[4 * g4 + 3]); *(u32x2*)(XT + 32 + 8 * g4 + 4 * hh) = pk; }
            asm volatile("s_waitcnt lgkmcnt(0)" ::: "memory");
#pragma unroll
            for (int g = 0; g < 16; ++g) acc[g] = C.zf();
#pragma unroll
            for (int s2 = 0; s2 < 2; ++s2) acc = mfma32(ldfrag(T11 + r * 40 + 16 * s2 + 8 * hh), ldfrag(XT + 32 + 16 * s2 + 8 * hh), acc);
#pragma unroll
            for (int g4 = 0; g4 < 4; ++g4) { u32x2 pk; pk.x = pk2(acc[4 * g4], acc[4 * g4 + 1]); pk.y = pk2(acc[4 * g4 + 2], acc[4 * g4 + 3]); *(u32x2*)(XT + 32 + 8 * g4 + 4 * hh) = pk; }
        }
        lds_barrier();
        {
            int t7 = tid; asm volatile("" : "+v"(t7));
            const int lane = t7 & 63, r = lane & 31, hh = lane >> 5;
            const int p2 = (w >> 1) & 1, xj = w & 1; const bool lo = w < 4;
            const bf16* A1 = lo ? Ark : KbT; const bf16* A2 = lo ? ArbN : BbTN;
            f32x16 acc;
#pragma unroll
            for (int g = 0; g < 16; ++g) acc[g] = C.zf();
#pragma unroll
            for (int s = 0; s < 4; ++s) acc = mfma32(ldfrag(A1 + (32 * p2 + r) * LD64 + 16 * s + 8 * hh), ldfrag(VT + (32 * xj + r) * LD64 + 16 * s + 8 * hh), acc);
#pragma unroll
            for (int s = 0; s < 4; ++s) acc = mfma32(ldfrag(A2 + (32 * p2 + r) * LD64 + 16 * s + 8 * hh), ldfrag(UT + (32 * xj + r) * LD64 + 16 * s + 8 * hh), acc);
            {   bf16* dst = lo ? GPTR(bf16, C.ws + WS_YP + (size_t)u * 8192) : (bf16*)GPTR(bf16, rwkv_zp(C, u));
                u32x4 q0, q1; q0.x = pk2(acc[0], acc[1]); q0.y = pk2(acc[2], acc[3]); q0.z = pk2(acc[4], acc[5]); q0.w = pk2(acc[6], acc[7]);
                q1.x = pk2(acc[8], acc[9]); q1.y = pk2(acc[10], acc[11]); q1.z = pk2(acc[12], acc[13]); q1.w = pk2(acc[14], acc[15]);
                *(u32x4*)(dst + ((p2 * 2 + xj) * 64 + lane) * 16) = q0; *(u32x4*)(dst + ((p2 * 2 + xj) * 64 + lane) * 16 + 8) = q1; }
#pragma unroll
            for (int g = 0; g < 16; ++g) acc[g] = C.zf();
#pragma unroll
            for (int s = 0; s < 4; ++s) acc = mfma32(ldfrag(WT + (32 * xj + r) * LD64 + 16 * s + 8 * hh), ldfrag(A2 + (32 * p2 + r) * LD64 + 16 * s + 8 * hh), acc);
            const int x = 32 * p2 + r;
            bf16* dst = lo ? GPTR(bf16, C.ws + WS_RP + (size_t)u * 8192) : GPTR(bf16, C.ws + WS_MM + (size_t)u * 8192);
#pragma unroll
            for (int g4 = 0; g4 < 4; ++g4) { const int c0 = 32 * xj + 8 * g4 + 4 * hh; float v4[4];
                if (lo) { float rt4[4]; ld4(Rt + x * LD64 + c0, rt4);
#pragma unroll
                    for (int q = 0; q < 4; ++q) v4[q] = acc[4 * g4 + q] + rt4[q]; }
                else {
#pragma unroll
                    for (int q = 0; q < 4; ++q) v4[q] = acc[4 * g4 + q] + ((c0 + q) == x ? sGL[x] : 0.f); }
                u32x2 pk; pk.x = pk2(v4[0], v4[1]); pk.y = pk2(v4[2], v4[3]);
                *(u32x2*)(dst + ((((x >> 5) * 4 + (c0 >> 4)) * 64 + (x & 31) + 32 * ((c0 >> 3) & 1)) * 8) + (c0 & 7)) = pk; }
        }
    }
}

#undef RP_LOAD
__device__ __forceinline__ void rwkv_chain3_block(const Ctx& C, int e, int rb, unsigned char* lds) {
    const int tid = C.tid(), lane = C.lane(), w = C.wave, r = lane & 31, hh = lane >> 5;
    const int b = rb >> 3, h = rb & 7;
    bf16* Y = GPTR(bf16, C.ws + WS_Y);
    bf16* ZT0 = (bf16*)lds; bf16* ZT1 = ZT0 + 64 * LD64;
    for (int i = tid; i < 2 * 64 * LD64 / 2; i += NTHREADS) ((unsigned*)ZT0)[i] = 0u;
    const bool lo = w < 4; const int p2 = (w >> 1) & 1, xj = w & 1;
    bf16x8 af[4][4]; u32x4 i0[4], i1[4];
#define R3_LOAD(j_, ch_) do { const int u_ = (rb * 64) + (ch_); const bf16* A_ = lo ? GPTR(const bf16, C.ws + WS_RP + (size_t)u_ * 8192) : GPTR(const bf16, C.ws + WS_MM + (size_t)u_ * 8192); \
        const bf16* I_ = lo ? GPTR(const bf16, C.ws + WS_YP + (size_t)u_ * 8192) : (const bf16*)GPTR(const bf16, rwkv_zp(C, u_)); \
        _Pragma("unroll") for (int s = 0; s < 4; ++s) af[j_][s] = *(const bf16x8*)(A_ + ((p2 * 4 + s) * 64 + lane) * 8); \
        i0[j_] = *(const u32x4*)(I_ + ((p2 * 2 + xj) * 64 + lane) * 16); i1[j_] = *(const u32x4*)(I_ + ((p2 * 2 + xj) * 64 + lane) * 16 + 8); } while (0)
    R3_LOAD(0, 0); RING_FENCE; R3_LOAD(1, 1); RING_FENCE; R3_LOAD(2, 2); RING_FENCE; R3_LOAD(3, 3); RING_FENCE;
    __syncthreads();
#pragma unroll 1
    for (int ch0 = 0; ch0 < SEQ / 64; ch0 += 4) {
#pragma unroll
        for (int j = 0; j < 4; ++j) {
            const int ch = ch0 + j;
            const bf16* ZTc = (j & 1) ? ZT1 : ZT0; bf16* ZTn = (j & 1) ? ZT0 : ZT1;
            f32x16 acc;
            acc[0] = bf2f(i0[j].x & 0xffffu); acc[1] = bf2f(i0[j].x >> 16); acc[2] = bf2f(i0[j].y & 0xffffu); acc[3] = bf2f(i0[j].y >> 16);
            acc[4] = bf2f(i0[j].z & 0xffffu); acc[5] = bf2f(i0[j].z >> 16); acc[6] = bf2f(i0[j].w & 0xffffu); acc[7] = bf2f(i0[j].w >> 16);
            acc[8] = bf2f(i1[j].x & 0xffffu); acc[9] = bf2f(i1[j].x >> 16); acc[10] = bf2f(i1[j].y & 0xffffu); acc[11] = bf2f(i1[j].y >> 16);
            acc[12] = bf2f(i1[j].z & 0xffffu); acc[13] = bf2f(i1[j].z >> 16); acc[14] = bf2f(i1[j].w & 0xffffu); acc[15] = bf2f(i1[j].w >> 16);
#pragma unroll
            for (int s = 0; s < 4; ++s) acc = mfma32(af[j][s], ldfrag(ZTc + (32 * xj + r) * LD64 + 16 * s + 8 * hh), acc);
            R3_LOAD(j, (ch + 4 < SEQ / 64 ? ch + 4 : SEQ / 64 - 1));
            if (lo) {
                const size_t m0 = (size_t)b * SEQ + 64 * ch;
#pragma unroll
                for (int g = 0; g < 16; ++g) Y[(m0 + 32 * p2 + drow(g, hh)) * DM + 512 + h * 64 + 32 * xj + r] = (bf16)f2bf(acc[g]);
            } else {
#pragma unroll
                for (int g4 = 0; g4 < 4; ++g4) { u32x2 pk; pk.x = pk2(acc[4 * g4], acc[4 * g4 + 1]); pk.y = pk2(acc[4 * g4 + 2], acc[4 * g4 + 3]);
                    *(u32x2*)(ZTn + (32 * xj + r) * LD64 + 32 * p2 + 8 * g4 + 4 * hh) = pk; }
            }
            lds_barrier();
        }
    }
#undef R3_LOAD
}

constexpr size_t WS_QKD = WS_R1 + (size_t)M * OD_PAD * 2;
static_assert(WS_QKD + 8 * MiB == WS_R1 + 128 * MiB, "odd-layer map");
constexpr size_t P_PITCH = (size_t)OD_PAD * 2;

__device__ __forceinline__ void gdn_pre3(const Ctx& C, int o_in, int unit_in, unsigned char* lds, bool dummy = false) {
    int o = o_in, unit = unit_in; asm volatile("" : "+s"(o), "+s"(unit));
    int tid_ = C.tid(); asm volatile("" : "+v"(tid_));
    const int tid = tid_, lane = tid & 63, w = __builtin_amdgcn_readfirstlane(tid >> 6), r = lane & 31, hh = lane >> 5;
    const int bh = unit >> 6, n = unit & 63, b = bh >> 2, h = bh & 3, t0 = n * 64;
    const size_t m0 = (size_t)b * SEQ + t0;
    const bf16* P = GPTR(const bf16, C.ws + WS_R1); const bf16* HALO = GPTR(const bf16, C.ws + WS_HALO);
    const float* convw = C.in(28) + (size_t)o * 4 * 1536;
    bf16* QhB = (bf16*)lds; bf16* KhB = QhB + 64 * LD128; bf16* XW = KhB + 64 * LD128; bf16* XU = XW + 128 * LD64;
    bf16* AbI = XU + 128 * LD64; bf16* AbT = AbI + 64 * LD64; bf16* QKdI = AbT + 64 * LD64; bf16* WK0 = QKdI + 64 * LD64; bf16* WK1 = WK0 + 7680;
    float* sGC = (float*)(WK1 + 7680); float* sBe = sGC + 64; float* sEg = sBe + 64; float* sBE = sEg + 64; float* sEk = sBE + 64;
    lds_barrier();
    if (w == 0) {
        const bf16* row = P + (m0 + lane) * OD_PAD; const float be = sigm(bf2f(row[OC_GB + h]));
        float g = -fexp(C.in(29)[o * 4 + h]) * softplusf(bf2f(row[OC_GA + h]) + C.in(30)[o * 4 + h]);
#pragma unroll
        for (int d = 1; d < 64; d <<= 1) { const float upv = __shfl_up(g, d); if (lane >= d) g += upv; }
        const float gl = __shfl(g, 63); const float eg = fexp(g);
        sGC[lane] = g; sBe[lane] = be; sEg[lane] = eg; sBE[lane] = be * eg;
        sEk[lane] = fexp(gl - g);
        if (lane == 0) (GPTR(float, C.ws + WS_DEN) + (size_t)unit * 256)[128] = fexp(gl);
    }
    const int l16 = tid & 15, typ = (tid >> 4) & 1, tg = tid >> 5;
    float ko[4][8];
#define G3_ROW(t_) ((t_) >= t0 ? P + ((size_t)b * SEQ + (t_)) * OD_PAD : HALO + ((size_t)((b * 64 + n - 1) * 3 + ((t_) - (t0 - 3)))) * OD_PAD)
    lds_barrier();
    {
#pragma unroll
        for (int pass = 0; pass < 2; ++pass) {
            if (pass == 1 && typ) break;
            const int pc = (pass ? 1024 : (typ ? 512 : 0)) + h * 128 + 8 * l16;
            float cw[4][8];
#pragma unroll
            for (int k = 0; k < 4; ++k) { const f32x4 a = *(const f32x4*)(convw + k * 1536 + pc), c2 = *(const f32x4*)(convw + k * 1536 + pc + 4);
                cw[k][0] = a[0]; cw[k][1] = a[1]; cw[k][2] = a[2]; cw[k][3] = a[3]; cw[k][4] = c2[0]; cw[k][5] = c2[1]; cw[k][6] = c2[2]; cw[k][7] = c2[3]; }
            float x[4][8];
#pragma unroll
            for (int i = 0; i < 3; ++i) { const int t = t0 + 4 * tg - 3 + i;
                if (t >= 0) ld8(G3_ROW(t) + pc, x[i]); else {
#pragma unroll
                    for (int j = 0; j < 8; ++j) x[i][j] = C.zf(); } }
            float vv[4][8];
#pragma unroll
            for (int tt = 0; tt < 4; ++tt) { const int tl = 4 * tg + tt; float o8[8]; float ss = C.zf();
                ld8(P + (m0 + tl) * OD_PAD + pc, x[(tt + 3) & 3]);
#pragma unroll
                for (int j = 0; j < 8; ++j) { float a = C.zf();
#pragma unroll
                    for (int k = 0; k < 4; ++k) a += cw[k][j] * x[(tt + k) & 3][j];
                    a = siluf(a); o8[j] = a; ss += a * a; }
                if (pass == 0) {
                    ss = row_sum16(ss);
                    const float sc = frsq(ss + 1e-6f) * (typ ? 1.0f : 0.08838834764831845f);
#pragma unroll
                    for (int j = 0; j < 8; ++j) o8[j] *= sc;
                    u32x4 pk; pk.x = pk2(o8[0], o8[1]); pk.y = pk2(o8[2], o8[3]); pk.z = pk2(o8[4], o8[5]); pk.w = pk2(o8[6], o8[7]);
                    *(u32x4*)((typ ? KhB : QhB) + tl * LD128 + 8 * l16) = pk;
                    if (typ) {
#pragma unroll
                        for (int j = 0; j < 8; ++j) ko[tt][j] = o8[j];
                    }
                } else {
#pragma unroll
                    for (int j = 0; j < 8; ++j) vv[tt][j] = o8[j] * sBe[tl];
                }
            }
            if (pass == 0 && typ) {
#pragma unroll
                for (int j = 0; j < 8; ++j) { u32x2 pk; pk.x = pk2(ko[0][j] * sBE[4 * tg], ko[1][j] * sBE[4 * tg + 1]); pk.y = pk2(ko[2][j] * sBE[4 * tg + 2], ko[3][j] * sBE[4 * tg + 3]); *(u32x2*)(XW + (8 * l16 + j) * LD64 + 4 * tg) = pk; }
            }
            if (pass == 1) {
#pragma unroll
                for (int j = 0; j < 8; ++j) { u32x2 pk; pk.x = pk2(vv[0][j], vv[1][j]); pk.y = pk2(vv[2][j], vv[3][j]); *(u32x2*)(XU + (8 * l16 + j) * LD64 + 4 * tg) = pk; }
            }
        }
    }
    lds_barrier();
    {
        bf16* Pw = GPTR(bf16, C.ws + WS_R1);
#pragma unroll
        for (int q = 0; q < 2; ++q) { const int p = tid + 512 * q, ln = p & 63, s8 = (p >> 6) & 7, R = p >> 9;
            float v8[8]; ld8(QhB + (32 * R + (ln & 31)) * LD128 + 16 * s8 + 8 * (ln >> 5), v8); const float eg = sEg[32 * R + (ln & 31)];
            u32x4 pk; pk.x = pk2(v8[0] * eg, v8[1] * eg); pk.y = pk2(v8[2] * eg, v8[3] * eg); pk.z = pk2(v8[4] * eg, v8[5] * eg); pk.w = pk2(v8[6] * eg, v8[7] * eg);
            if (!dummy) *(u32x4*)(Pw + (m0 + (p >> 4)) * OD_PAD + h * 128 + (p & 15) * 8) = pk; }
#pragma unroll
        for (int q = 0; q < 2; ++q) { const int p = tid + 512 * q, ln = p & 63, s4 = (p >> 6) & 3, kt = p >> 8;
            const int k = 32 * kt + (ln & 31), tq = 16 * s4 + 8 * (ln >> 5);
            float e[8];
#pragma unroll
            for (int j = 0; j < 8; ++j) e[j] = bf2f((unsigned)(unsigned short)KhB[(tq + j) * LD128 + k]) * sEk[tq + j];
            u32x4 pk; pk.x = pk2(e[0], e[1]); pk.y = pk2(e[2], e[3]); pk.z = pk2(e[4], e[5]); pk.w = pk2(e[6], e[7]);
            if (!dummy) *(u32x4*)(Pw + (m0 + (p >> 4)) * OD_PAD + 512 + h * 128 + (p & 15) * 8) = pk; }
#pragma unroll 1
        for (int job = w; job < 10; job += 8) {
            const bool tr = job == 4 || job == 5, isq = job >= 6; const int jj = isq ? job - 6 : job; const int ti = tr ? job - 4 : ((jj >> 1) & 1), tj = tr ? ti : (jj & 1);
            const bf16* first = isq ? QhB : KhB;
            f32x16 acc;
#pragma unroll
            for (int g = 0; g < 16; ++g) acc[g] = C.zf();
            const bf16* opA = tr ? first + (32 * ti + r) * LD128 : KhB + (32 * tj + r) * LD128; const bf16* opB = tr ? KhB + (32 * tj + r) * LD128 : first + (32 * ti + r) * LD128;
            if (tj <= ti) {
#pragma unroll
                for (int s8 = 0; s8 < 8; ++s8) acc = mfma32(ldfrag(opA + 16 * s8 + 8 * hh), ldfrag(opB + 16 * s8 + 8 * hh), acc);
            }
            const int fx = 32 * (tr ? tj : ti) + r;
            bf16* dstI = tr ? AbT : (isq ? QKdI : AbI);
#pragma unroll
            for (int g4 = 0; g4 < 4; ++g4) { float v4[4];
#pragma unroll
                for (int q = 0; q < 4; ++q) { const int y = 32 * (tr ? ti : tj) + 8 * g4 + 4 * hh + q; const int tt_ = tr ? y : fx, ii_ = tr ? fx : y;
                    const float dec = fexp(sGC[tt_] - sGC[ii_]);
                    v4[q] = isq ? (ii_ <= tt_ ? acc[4 * g4 + q] * dec : 0.f) : (ii_ < tt_ ? acc[4 * g4 + q] * dec * sBe[tt_] : 0.f); }
                u32x2 pk; pk.x = pk2(v4[0], v4[1]); pk.y = pk2(v4[2], v4[3]);
                *(u32x2*)(dstI + fx * LD64 + 32 * (tr ? ti : tj) + 8 * g4 + 4 * hh) = pk; }
        }
    }
    lds_barrier();
    if (w < 2) {
        const int d = w; bf16* wk = d ? WK1 : WK0;
        bf16* PA = wk; bf16* PAT = wk + 1280; bf16* PB = wk + 2560; bf16* PBT = wk + 3840; bf16* TA = wk + 5120; bf16* TB = wk + 6400;
        const bf16* Pc = AbI + (32 * d) * LD64 + 32 * d; const bf16* PTc = AbT + (32 * d) * LD64 + 32 * d; int ldp = LD64;
        {   float v8[8], o8[8];
#pragma unroll
            for (int q = 0; q < 2; ++q) { ld8(Pc + r * LD64 + 16 * hh + 8 * q, v8);
#pragma unroll
                for (int j = 0; j < 8; ++j) o8[j] = ((16 * hh + 8 * q + j) == r ? 1.0f : 0.0f) - v8[j];
                u32x4 pk; pk.x = pk2(o8[0], o8[1]); pk.y = pk2(o8[2], o8[3]); pk.z = pk2(o8[4], o8[5]); pk.w = pk2(o8[6], o8[7]); *(u32x4*)(TA + r * 40 + 16 * hh + 8 * q) = pk; } }
        asm volatile("s_waitcnt lgkmcnt(0)" ::: "memory");
#pragma unroll
        for (int k = 0; k < 4; ++k) {
            bf16* Pn = (k & 1) ? PA : PB; bf16* PnT = (k & 1) ? PAT : PBT; const bf16* Tc = (k & 1) ? TB : TA; bf16* Tn = (k & 1) ? TA : TB;
            f32x16 a1, a2;
#pragma unroll
            for (int g = 0; g < 16; ++g) { a1[g] = C.zf(); a2[g] = C.zf(); }
#pragma unroll
            for (int s2 = 0; s2 < 2; ++s2) { const bf16x8 fp = ldfrag(Pc + r * ldp + 16 * s2 + 8 * hh), ft = ldfrag(PTc + r * ldp + 16 * s2 + 8 * hh);
                a1 = mfma32(ft, fp, a1); a2 = mfma32(fp, ft, a2); }
#pragma unroll
            for (int g4 = 0; g4 < 4; ++g4) { u32x2 pk; pk.x = pk2(a1[4 * g4], a1[4 * g4 + 1]); pk.y = pk2(a1[4 * g4 + 2], a1[4 * g4 + 3]); *(u32x2*)(Pn + r * 40 + 8 * g4 + 4 * hh) = pk;
                pk.x = pk2(a2[4 * g4], a2[4 * g4 + 1]); pk.y = pk2(a2[4 * g4 + 2], a2[4 * g4 + 3]); *(u32x2*)(PnT + r * 40 + 8 * g4 + 4 * hh) = pk; }
            asm volatile("s_waitcnt lgkmcnt(0)" ::: "memory");
#pragma unroll
            for (int g = 0; g < 16; ++g) a1[g] = C.zf();
#pragma unroll
            for (int s2 = 0; s2 < 2; ++s2) a1 = mfma32(ldfrag(PnT + r * 40 + 16 * s2 + 8 * hh), ldfrag(Tc + r * 40 + 16 * s2 + 8 * hh), a1);
#pragma unroll
            for (int g4 = 0; g4 < 4; ++g4) { float t4[4]; ld4(Tc + r * 40 + 8 * g4 + 4 * hh, t4);
                u32x2 pk; pk.x = pk2(t4[0] + a1[4 * g4], t4[1] + a1[4 * g4 + 1]); pk.y = pk2(t4[2] + a1[4 * g4 + 2], t4[3] + a1[4 * g4 + 3]); *(u32x2*)(Tn + r * 40 + 8 * g4 + 4 * hh) = pk; }
            asm volatile("s_waitcnt lgkmcnt(0)" ::: "memory");
            Pc = Pn; PTc = PnT; ldp = 40;
        }
    }
    lds_barrier();
    {
        bf16* XT = (w < 4 ? XW : XU) + (32 * (w & 3) + r) * LD64;
        const bf16* T00 = WK0 + 5120; const bf16* T11 = WK1 + 5120;
        f32x16 acc;
#pragma unroll
        for (int g = 0; g < 16; ++g) acc[g] = C.zf();
#pragma unroll
        for (int s2 = 0; s2 < 2; ++s2) acc = mfma32(ldfrag(T00 + r * 40 + 16 * s2 + 8 * hh), ldfrag(XT + 16 * s2 + 8 * hh), acc);
#pragma unroll
        for (int g4 = 0; g4 < 4; ++g4) { u32x2 pk; pk.x = pk2(acc[4 * g4], acc[4 * g4 + 1]); pk.y = pk2(acc[4 * g4 + 2], acc[4 * g4 + 3]); *(u32x2*)(XT + 8 * g4 + 4 * hh) = pk; }
        asm volatile("s_waitcnt lgkmcnt(0)" ::: "memory");
#pragma unroll
        for (int g = 0; g < 16; ++g) acc[g] = C.zf();
#pragma unroll
        for (int s2 = 0; s2 < 2; ++s2) acc = mfma32(ldfrag(AbI + (32 + r) * LD64 + 16 * s2 + 8 * hh), ldfrag(XT + 16 * s2 + 8 * hh), acc);
#pragma unroll
        for (int g4 = 0; g4 < 4; ++g4) { float r4[4]; ld4(XT + 32 + 8 * g4 + 4 * hh, r4);
            u32x2 pk; pk.x = pk2(r4[0] - acc[4 * g4], r4[1] - acc[4 * g4 + 1]); pk.y = pk2(r4[2] - acc[4 * g4 + 2], r4[3] - acc[4 * g4 + 3]); *(u32x2*)(XT + 32 + 8 * g4 + 4 * hh) = pk; }
        asm volatile("s_waitcnt lgkmcnt(0)" ::: "memory");
#pragma unroll
        for (int g = 0; g < 16; ++g) acc[g] = C.zf();
#pragma unroll
        for (int s2 = 0; s2 < 2; ++s2) acc = mfma32(ldfrag(T11 + r * 40 + 16 * s2 + 8 * hh), ldfrag(XT + 32 + 16 * s2 + 8 * hh), acc);
#pragma unroll
        for (int g4 = 0; g4 < 4; ++g4) { u32x2 pk; pk.x = pk2(acc[4 * g4], acc[4 * g4 + 1]); pk.y = pk2(acc[4 * g4 + 2], acc[4 * g4 + 3]); *(u32x2*)(XT + 32 + 8 * g4 + 4 * hh) = pk; }
    }
    lds_barrier();
    {
        bf16* Wg = GPTR(bf16, C.ws + WS_XB + (size_t)unit * GDN_UNIT_BYTES); bf16* Ug = Wg + 64 * 128; bf16* Qg = GPTR(bf16, C.ws + WS_QKD + (size_t)unit * 8192);
#pragma unroll
        for (int q = 0; q < 2; ++q) { const int p = tid + 512 * q, ln = p & 63, s8 = (p >> 6) & 7, R = p >> 9; const int t = 32 * R + (ln & 31), c0 = 16 * s8 + 8 * (ln >> 5);
            unsigned e[8];
#pragma unroll
            for (int j = 0; j < 8; ++j) e[j] = XW[(c0 + j) * LD64 + t] ^ 0x8000u;
            u32x4 pk; pk.x = e[0] | (e[1] << 16); pk.y = e[2] | (e[3] << 16); pk.z = e[4] | (e[5] << 16); pk.w = e[6] | (e[7] << 16);
            *(u32x4*)(Wg + p * 8) = pk; }
#pragma unroll
        for (int q = 0; q < 2; ++q) { const int p = tid + 512 * q, tile = p >> 7, ln = (p >> 1) & 63, q8 = p & 1;
            const int v = 32 * (tile & 3) + (ln & 31), hq = ln >> 5, thh = tile >> 2;
            const u32x2 a = *(const u32x2*)(XU + v * LD64 + 32 * thh + 8 * (2 * q8) + 4 * hq), c2 = *(const u32x2*)(XU + v * LD64 + 32 * thh + 8 * (2 * q8 + 1) + 4 * hq);
            u32x4 pk; pk.x = a.x; pk.y = a.y; pk.z = c2.x; pk.w = c2.y;
            *(u32x4*)(Ug + p * 8) = pk; }
        {   const int p = tid, ln = p & 63, s4 = (p >> 6) & 3, R = p >> 8;
            *(u32x4*)(Qg + p * 8) = *(const u32x4*)(QKdI + (32 * R + (ln & 31)) * LD64 + 16 * s4 + 8 * (ln >> 5)); }
    }
#undef G3_ROW
}

__device__ __forceinline__ void gdn_chain4_block(const Ctx& C, int gb, int c, unsigned char* lds) {
    const int w = C.wave;
    const int b = gb >> 2, h = gb & 3;
    const bf16* P = GPTR(const bf16, C.ws + WS_R1); bf16* Y = GPTR(bf16, C.ws + WS_Y);
    bf16* VNT = (bf16*)lds; bf16* ST = VNT + 32 * LD64;
    for (int i = C.tid(); i < 32 * LD128 / 2; i += NTHREADS) ((unsigned*)ST)[i] = 0u;
#define G4_LANE int ln_ = C.lane(); asm volatile("" : "+v"(ln_)); const int lane = ln_, r = lane & 31, hh = lane >> 5;
    if (w < 2) {
        const int th = w; G4_LANE
        bf16x8 wf[4][8]; u32x4 u0[4], u1[4];
#define G4_LV(j_, ch_) do { const int u_ = gb * 64 + (ch_); const bf16* Wg_ = GPTR(const bf16, C.ws + WS_XB + (size_t)u_ * GDN_UNIT_BYTES); const bf16* Ug_ = Wg_ + 64 * 128; \
        _Pragma("unroll") for (int s = 0; s < 8; ++s) wf[j_][s] = *(const bf16x8*)(Wg_ + ((th * 8 + s) * 64 + lane) * 8); \
        u0[j_] = *(const u32x4*)(Ug_ + ((th * 4 + c) * 64 + lane) * 16); u1[j_] = *(const u32x4*)(Ug_ + ((th * 4 + c) * 64 + lane) * 16 + 8); } while (0)
        G4_LV(0, 0); RING_FENCE; G4_LV(1, 1); RING_FENCE; G4_LV(2, 2); RING_FENCE; G4_LV(3, 3); RING_FENCE;
        __syncthreads();
#pragma unroll 1
        for (int ch0 = 0; ch0 < SEQ / 64; ch0 += 4) {
#pragma unroll
            for (int j = 0; j < 4; ++j) {
                const int ch = ch0 + j;
                f32x16 acc;
                acc[0] = bf2f(u0[j].x & 0xffffu); acc[1] = bf2f(u0[j].x >> 16); acc[2] = bf2f(u0[j].y & 0xffffu); acc[3] = bf2f(u0[j].y >> 16);
                acc[4] = bf2f(u0[j].z & 0xffffu); acc[5] = bf2f(u0[j].z >> 16); acc[6] = bf2f(u0[j].w & 0xffffu); acc[7] = bf2f(u0[j].w >> 16);
                acc[8] = bf2f(u1[j].x & 0xffffu); acc[9] = bf2f(u1[j].x >> 16); acc[10] = bf2f(u1[j].y & 0xffffu); acc[11] = bf2f(u1[j].y >> 16);
                acc[12] = bf2f(u1[j].z & 0xffffu); acc[13] = bf2f(u1[j].z >> 16); acc[14] = bf2f(u1[j].w & 0xffffu); acc[15] = bf2f(u1[j].w >> 16);
#pragma unroll
                for (int s = 0; s < 8; ++s) acc = mfma32(wf[j][s], ldfrag(ST + r * LD128 + 16 * s + 8 * hh), acc);
#pragma unroll
                for (int g4 = 0; g4 < 4; ++g4) { u32x2 pk; pk.x = pk2(acc[4 * g4], acc[4 * g4 + 1]); pk.y = pk2(acc[4 * g4 + 2], acc[4 * g4 + 3]);
                    *(u32x2*)(VNT + r * LD64 + 32 * th + 8 * g4 + 4 * hh) = pk; }
                G4_LV(j, (ch + 4 < SEQ / 64 ? ch + 4 : SEQ / 64 - 1));
                lds_barrier();
                lds_barrier();
            }
        }
#undef G4_LV
    } else if (w < 4) {
        const int th = w - 2; G4_LANE
        bf16x8 qf[4][8], kq[2][4];
#define G4_LO(j_, ch_) do { const int u_ = gb * 64 + (ch_); const bf16* qsec_ = P + ((size_t)b * SEQ + 64 * (ch_)) * OD_PAD + h * 128; (void)u_; \
        _Pragma("unroll") for (int s = 0; s < 8; ++s) { const int p_ = (th * 8 + s) * 64 + lane; qf[j_][s] = *(const bf16x8*)(qsec_ + (size_t)(p_ >> 4) * OD_PAD + (p_ & 15) * 8); } \
        } while (0)
#define G4_LK(j_, ch_) do { const bf16* Qg_ = GPTR(const bf16, C.ws + WS_QKD + (size_t)(gb * 64 + (ch_)) * 8192); \
        _Pragma("unroll") for (int s = 0; s < 4; ++s) kq[j_][s] = *(const bf16x8*)(Qg_ + ((th * 4 + s) * 64 + lane) * 8); } while (0)
        G4_LO(0, 0); G4_LK(0, 0); RING_FENCE; G4_LO(1, 1); G4_LK(1, 1); RING_FENCE; G4_LO(2, 2); RING_FENCE; G4_LO(3, 3); RING_FENCE;
        __syncthreads();
#pragma unroll 1
        for (int ch0 = 0; ch0 < SEQ / 64; ch0 += 4) {
#pragma unroll
            for (int j = 0; j < 4; ++j) {
                const int ch = ch0 + j; const size_t m0 = (size_t)b * SEQ + 64 * ch;
                f32x16 oacc;
#pragma unroll
                for (int g = 0; g < 16; ++g) oacc[g] = C.zf();
#pragma unroll
                for (int s = 0; s < 8; ++s) oacc = mfma32(ldfrag(ST + r * LD128 + 16 * s + 8 * hh), qf[j][s], oacc);
                lds_barrier();
#pragma unroll
                for (int s = 0; s < 4; ++s) oacc = mfma32(ldfrag(VNT + r * LD64 + 16 * s + 8 * hh), kq[j & 1][s], oacc);
                G4_LK(j & 1, (ch + 2 < SEQ / 64 ? ch + 2 : SEQ / 64 - 1)); G4_LO(j, (ch + 4 < SEQ / 64 ? ch + 4 : SEQ / 64 - 1));
#pragma unroll
                for (int g4 = 0; g4 < 4; ++g4) { u32x2 pk; pk.x = pk2(oacc[4 * g4], oacc[4 * g4 + 1]); pk.y = pk2(oacc[4 * g4 + 2], oacc[4 * g4 + 3]);
                    *(u32x2*)(Y + (m0 + 32 * th + r) * DM + h * 128 + 32 * c + 8 * g4 + 4 * hh) = pk; }
                lds_barrier();
            }
        }
#undef G4_LO
#undef G4_LK
    } else {
        const int kt = w - 4; G4_LANE
        int lz = 0; asm volatile("" : "+v"(lz));
        bf16x8 kf[4][4]; float glv[4];
        f32x16 S;
#pragma unroll
        for (int g = 0; g < 16; ++g) S[g] = C.zf();
#define G4_LS(j_, ch_) do { const int u_ = gb * 64 + (ch_); const bf16* ksec_ = P + ((size_t)b * SEQ + 64 * (ch_)) * OD_PAD + 512 + h * 128; \
        _Pragma("unroll") for (int s = 0; s < 4; ++s) { const int p_ = (kt * 4 + s) * 64 + lane; kf[j_][s] = *(const bf16x8*)(ksec_ + (size_t)(p_ >> 4) * OD_PAD + (p_ & 15) * 8); } \
        glv[j_] = (GPTR(const float, C.ws + WS_DEN) + (size_t)u_ * 256)[128 + lz]; } while (0)
        G4_LS(0, 0); RING_FENCE; G4_LS(1, 1); RING_FENCE; G4_LS(2, 2); RING_FENCE; G4_LS(3, 3); RING_FENCE;
        __syncthreads();
#pragma unroll 1
        for (int ch0 = 0; ch0 < SEQ / 64; ch0 += 4) {
#pragma unroll
            for (int j = 0; j < 4; ++j) {
                const int ch = ch0 + j;
                const float gl_ = glv[j];
#pragma unroll
                for (int g = 0; g < 16; ++g) S[g] *= gl_;
                lds_barrier();
#pragma unroll
                for (int s = 0; s < 4; ++s) S = mfma32(kf[j][s], ldfrag(VNT + r * LD64 + 16 * s + 8 * hh), S);
#pragma unroll
                for (int g4 = 0; g4 < 4; ++g4) { u32x2 pk; pk.x = pk2(S[4 * g4], S[4 * g4 + 1]); pk.y = pk2(S[4 * g4 + 2], S[4 * g4 + 3]);
                    *(u32x2*)(ST + r * LD128 + 32 * kt + 8 * g4 + 4 * hh) = pk; }
                G4_LS(j, (ch + 4 < SEQ / 64 ? ch + 4 : SEQ / 64 - 1));
                lds_barrier();
            }
        }
#undef G4_LS
    }
#undef G4_LANE
}

__device__ __forceinline__ bf16* ml_dc_piece(bf16* Pw, size_t m0, int h, int p) {
    const int pr = p & 15; return Pw + (m0 + (p >> 4)) * OD_PAD + OC_MQK + (pr < 8 ? h * 64 + pr * 8 : 256 + h * 64 + (pr - 8) * 8); }
__device__ __forceinline__ void mlstm_pre3(const Ctx& C, int o_in, int unit_in, unsigned char* lds, bool dummy = false) {
    int o = o_in, unit = unit_in; asm volatile("" : "+s"(o), "+s"(unit));
    int tid_ = C.tid(); asm volatile("" : "+v"(tid_));
    const int tid = tid_, lane = tid & 63, w = __builtin_amdgcn_readfirstlane(tid >> 6), r = lane & 31, hh = lane >> 5;
    const int bh = unit >> 6, n = unit & 63, b = bh >> 2, h = bh & 3, t0 = n * 64;
    const size_t m0 = (size_t)b * SEQ + t0;
    const bf16* P = GPTR(const bf16, C.ws + WS_R1); const bf16* HALO = GPTR(const bf16, C.ws + WS_HALO);
    const float* convw = C.in(32) + (size_t)o * 4 * 512;
    bf16* Qh = (bf16*)lds; bf16* Kh = Qh + 64 * LD64; bf16* KTs = Kh + 64 * LD64; bf16* Wm = KTs + 64 * LD64; bf16* VT = Wm + 64 * LD64;
    float* sB = (float*)(VT + 160 * LD64); float* sI = sB + 64; float* sEB = sI + 64; float* sEK = sEB + 64;
    float* tab = GPTR(float, C.ws + WS_DEN) + (size_t)unit * 256; float* tab2 = GPTR(float, C.ws + WS_BONUS + 512 * 1024) + (size_t)unit * 128;
    lds_barrier();
    if (w == 0) {
        const bf16* row = P + (m0 + lane) * OD_PAD; const float ip = bf2f(row[OC_MI + h]) + C.in(33)[o * 4 + h]; float lf = logsigm(bf2f(row[OC_MF + h]) + C.in(34)[o * 4 + h]);
#pragma unroll
        for (int d = 1; d < 64; d <<= 1) { const float up = __shfl_up(lf, d); if (lane >= d) lf += up; }
        const float bl = __shfl(lf, 63);
        sB[lane] = lf; sI[lane] = ip; sEB[lane] = fexp(lf); sEK[lane] = fexp(bl - lf + ip); if (lane == 0) tab[129] = fexp(bl);
    }
    for (int i = tid; i < 32 * LD64; i += NTHREADS) VT[128 * LD64 + i] = (i < 64) ? (bf16)0x3F80 : (bf16)0;
    for (int i = tid; i < 64 * LD64 / 2; i += NTHREADS) ((unsigned*)Wm)[i] = C.z0;
    const int l16 = tid & 15, typ = (tid >> 4) & 1, tg = tid >> 5;
    const int pc = OC_MQK + (typ ? 256 : 0) + h * 64 + 4 * l16;
    lds_barrier();
    {
        float cw[4][4], x[7][4], ko[4][4];
#pragma unroll
        for (int k = 0; k < 4; ++k)
#pragma unroll
            for (int j = 0; j < 4; ++j) cw[k][j] = convw[k * 512 + (typ ? 256 : 0) + h * 64 + 4 * l16 + j];
#pragma unroll
        for (int i = 0; i < 7; ++i) { const int t = t0 + 4 * tg - 3 + i;
            if (t >= 0) ld4((t >= t0 ? P + ((size_t)b * SEQ + t) * OD_PAD : HALO + ((size_t)((b * 64 + n - 1) * 3 + (t - (t0 - 3)))) * OD_PAD) + pc, x[i]);
            else { x[i][0] = x[i][1] = x[i][2] = x[i][3] = C.zf(); } }
#pragma unroll
        for (int tt = 0; tt < 4; ++tt) {
#pragma unroll
            for (int j = 0; j < 4; ++j) { float a = C.zf();
#pragma unroll
                for (int k = 0; k < 4; ++k) a += cw[k][j] * x[tt + k][j];
                a = siluf(a); ko[tt][j] = typ ? a : a * 0.125f; }
            u32x2 pk; pk.x = pk2(ko[tt][0], ko[tt][1]); pk.y = pk2(ko[tt][2], ko[tt][3]);
            *(u32x2*)((typ ? Kh : Qh) + (4 * tg + tt) * LD64 + 4 * l16) = pk; }
        if (typ) {
#pragma unroll
            for (int j = 0; j < 4; ++j) { u32x2 pk; pk.x = pk2(ko[0][j] * sEK[4 * tg], ko[1][j] * sEK[4 * tg + 1]); pk.y = pk2(ko[2][j] * sEK[4 * tg + 2], ko[3][j] * sEK[4 * tg + 3]); *(u32x2*)(KTs + (4 * l16 + j) * LD64 + 4 * tg) = pk; } }
        {   const int vt = tid & 63, vg = tid >> 6; const bf16* vr = P + (m0 + vt) * OD_PAD + OC_MV + h * 128 + 16 * vg; const u32x4 a = *(const u32x4*)vr, c2 = *(const u32x4*)(vr + 8);
            const unsigned wv[8] = {a.x, a.y, a.z, a.w, c2.x, c2.y, c2.z, c2.w};
#pragma unroll
            for (int q = 0; q < 8; ++q) { VT[(16 * vg + 2 * q) * LD64 + vt] = (bf16)(wv[q] & 0xffffu); VT[(16 * vg + 2 * q + 1) * LD64 + vt] = (bf16)(wv[q] >> 16); } }
    }
    lds_barrier();
    if (w < 3) {
        const int ti = w > 0 ? 1 : 0, tj = w > 1 ? 1 : 0;
        f32x16 acc;
#pragma unroll
        for (int g = 0; g < 16; ++g) acc[g] = C.zf();
#pragma unroll
        for (int s = 0; s < 4; ++s) acc = mfma32(ldfrag(Kh + (32 * tj + r) * LD64 + 16 * s + 8 * hh), ldfrag(Qh + (32 * ti + r) * LD64 + 16 * s + 8 * hh), acc);
        const int i = 32 * ti + r; const float bi = sB[i];
#pragma unroll
        for (int g4 = 0; g4 < 4; ++g4) { const f32x4 bj = *(const f32x4*)(sB + 32 * tj + 8 * g4 + 4 * hh), ij = *(const f32x4*)(sI + 32 * tj + 8 * g4 + 4 * hh); float v4[4];
#pragma unroll
            for (int q = 0; q < 4; ++q) { const int j = 32 * tj + 8 * g4 + 4 * hh + q; v4[q] = (j <= i) ? acc[4 * g4 + q] * fexp(bi - bj[q] + ij[q]) : 0.f; }
            u32x2 pk; pk.x = pk2(v4[0], v4[1]); pk.y = pk2(v4[2], v4[3]);
            *(u32x2*)(Wm + i * LD64 + 32 * tj + 8 * g4 + 4 * hh) = pk; }
    } else if (w >= 4) {
        bf16* Pw = GPTR(bf16, C.ws + WS_R1);
#pragma unroll
        for (int q = 0; q < 2; ++q) { const int p = (tid - 256) + 256 * q, ln = p & 63, s4 = (p >> 6) & 3, R = p >> 8; const int t = 32 * R + (ln & 31);
            float v8[8]; ld8(Qh + t * LD64 + 16 * s4 + 8 * (ln >> 5), v8); const float eb = sEB[t];
            u32x4 pk; pk.x = pk2(v8[0] * eb, v8[1] * eb); pk.y = pk2(v8[2] * eb, v8[3] * eb); pk.z = pk2(v8[4] * eb, v8[5] * eb); pk.w = pk2(v8[6] * eb, v8[7] * eb);
            if (!dummy) *(u32x4*)(Pw + (m0 + (p >> 4)) * OD_PAD + 1024 + h * 128 + (p & 15) * 8) = pk; }
    }
    lds_barrier();
    {
        bf16* Pw = GPTR(bf16, C.ws + WS_R1);
#pragma unroll 1
        for (int job = w; job < 20; job += 8) {
            const bool isc = job >= 10; const int jj = isc ? job - 10 : job, rt = jj / 5, vjj = jj % 5;
            const bf16* A = (isc ? KTs : Wm) + (32 * rt + r) * LD64;
            f32x16 acc;
#pragma unroll
            for (int g = 0; g < 16; ++g) acc[g] = C.zf();
#pragma unroll
            for (int s = 0; s < 4; ++s) acc = mfma32(ldfrag(A + 16 * s + 8 * hh), ldfrag(VT + (32 * vjj + r) * LD64 + 16 * s + 8 * hh), acc);
            if (vjj < 4) {
                u32x4 q0, q1; q0.x = pk2(acc[0], acc[1]); q0.y = pk2(acc[2], acc[3]); q0.z = pk2(acc[4], acc[5]); q0.w = pk2(acc[6], acc[7]);
                q1.x = pk2(acc[8], acc[9]); q1.y = pk2(acc[10], acc[11]); q1.z = pk2(acc[12], acc[13]); q1.w = pk2(acc[14], acc[15]);
                const int p0 = ((rt * 4 + vjj) * 64 + lane) * 2;
                if (dummy) {} else if (isc) { *(u32x4*)ml_dc_piece(Pw, m0, h, p0) = q0; *(u32x4*)ml_dc_piece(Pw, m0, h, p0 + 1) = q1; }
                else { *(u32x4*)(Pw + (m0 + (p0 >> 4)) * OD_PAD + OC_MV + h * 128 + (p0 & 15) * 8) = q0; *(u32x4*)(Pw + (m0 + ((p0 + 1) >> 4)) * OD_PAD + OC_MV + h * 128 + ((p0 + 1) & 15) * 8) = q1; }
            } else if (r == 0) {
#pragma unroll
                for (int g = 0; g < 16; ++g) tab2[(isc ? 64 : 0) + 32 * rt + drow(g, hh)] = acc[g];
            }
        }
    }
}

__device__ __forceinline__ void mlstm_chain4_block(const Ctx& C, int mb, int c, unsigned char* lds) {
    const int w = C.wave;
    const int b = mb >> 2, h = mb & 3;
    const bf16* P = GPTR(const bf16, C.ws + WS_R1); bf16* Y = GPTR(bf16, C.ws + WS_Y); float* den = GPTR(float, C.ws + WS_BONUS);
    bf16* CT0 = (bf16*)lds; bf16* CT1 = CT0 + 32 * LD64; float* sN = (float*)(CT1 + 32 * LD64);
    for (int i = C.tid(); i < 2 * 32 * LD64 / 2; i += NTHREADS) ((unsigned*)CT0)[i] = 0u;
    if (C.tid() < 128) sN[C.tid()] = 0.f;
#define M4_LANE int ln_ = C.lane(); asm volatile("" : "+v"(ln_)); const int lane = ln_, r = lane & 31, hh = lane >> 5; int lz = 0; asm volatile("" : "+v"(lz));
#define M4_QD(j_, mm_) _Pragma("unroll") for (int s = 0; s < 4; ++s) { const int p_ = (th * 4 + s) * 64 + lane; qd[j_][s] = *(const bf16x8*)(P + ((mm_) + (p_ >> 4)) * OD_PAD + 1024 + h * 128 + (p_ & 15) * 8); }
    if (w < 2) {
        const int th = w; M4_LANE
        f32x16 Cacc;
#pragma unroll
        for (int g = 0; g < 16; ++g) Cacc[g] = C.zf();
        bf16x8 qd[4][4]; u32x4 n0[4], n1[4], d0[4], d1[4]; float Fv[4];
#define M4_LT(j_, ch_) do { const size_t mm_ = (size_t)b * SEQ + 64 * (ch_); const int u_ = mb * 64 + (ch_); M4_QD(j_, mm_) \
        const int p0_ = ((th * 4 + c) * 64 + lane) * 2; \
        n0[j_] = *(const u32x4*)(P + (mm_ + (p0_ >> 4)) * OD_PAD + OC_MV + h * 128 + (p0_ & 15) * 8); n1[j_] = *(const u32x4*)(P + (mm_ + ((p0_ + 1) >> 4)) * OD_PAD + OC_MV + h * 128 + ((p0_ + 1) & 15) * 8); \
        d0[j_] = *(const u32x4*)ml_dc_piece((bf16*)P, mm_, h, p0_); d1[j_] = *(const u32x4*)ml_dc_piece((bf16*)P, mm_, h, p0_ + 1); \
        Fv[j_] = (GPTR(const float, C.ws + WS_DEN) + (size_t)u_ * 256)[129 + lz]; } while (0)
        M4_LT(0, 0); RING_FENCE; M4_LT(1, 1); RING_FENCE; M4_LT(2, 2); RING_FENCE; M4_LT(3, 3); RING_FENCE;
        __syncthreads();
#pragma unroll 1
        for (int ch0 = 0; ch0 < SEQ / 64; ch0 += 4) {
#pragma unroll
            for (int j = 0; j < 4; ++j) {
                const int ch = ch0 + j; const size_t m0 = (size_t)b * SEQ + 64 * ch;
                const bf16* CTc = (j & 1) ? CT1 : CT0; bf16* CTn = (j & 1) ? CT0 : CT1;
                const float F = Fv[j];
                f32x16 num;
                num[0] = bf2f(n0[j].x & 0xffffu); num[1] = bf2f(n0[j].x >> 16); num[2] = bf2f(n0[j].y & 0xffffu); num[3] = bf2f(n0[j].y >> 16); num[4] = bf2f(n0[j].z & 0xffffu); num[5] = bf2f(n0[j].z >> 16); num[6] = bf2f(n0[j].w & 0xffffu); num[7] = bf2f(n0[j].w >> 16);
                num[8] = bf2f(n1[j].x & 0xffffu); num[9] = bf2f(n1[j].x >> 16); num[10] = bf2f(n1[j].y & 0xffffu); num[11] = bf2f(n1[j].y >> 16); num[12] = bf2f(n1[j].z & 0xffffu); num[13] = bf2f(n1[j].z >> 16); num[14] = bf2f(n1[j].w & 0xffffu); num[15] = bf2f(n1[j].w >> 16);
#pragma unroll
                for (int s = 0; s < 4; ++s) num = mfma32(qd[j][s], ldfrag(CTc + r * LD64 + 16 * s + 8 * hh), num);
                {   float dc[16];
                    dc[0] = bf2f(d0[j].x & 0xffffu); dc[1] = bf2f(d0[j].x >> 16); dc[2] = bf2f(d0[j].y & 0xffffu); dc[3] = bf2f(d0[j].y >> 16); dc[4] = bf2f(d0[j].z & 0xffffu); dc[5] = bf2f(d0[j].z >> 16); dc[6] = bf2f(d0[j].w & 0xffffu); dc[7] = bf2f(d0[j].w >> 16);
                    dc[8] = bf2f(d1[j].x & 0xffffu); dc[9] = bf2f(d1[j].x >> 16); dc[10] = bf2f(d1[j].y & 0xffffu); dc[11] = bf2f(d1[j].y >> 16); dc[12] = bf2f(d1[j].z & 0xffffu); dc[13] = bf2f(d1[j].z >> 16); dc[14] = bf2f(d1[j].w & 0xffffu); dc[15] = bf2f(d1[j].w >> 16);
#pragma unroll
                    for (int g = 0; g < 16; ++g) Cacc[g] = F * Cacc[g] + dc[g]; }
#pragma unroll
                for (int g4 = 0; g4 < 4; ++g4) { u32x2 pk; pk.x = pk2(Cacc[4 * g4], Cacc[4 * g4 + 1]); pk.y = pk2(Cacc[4 * g4 + 2], Cacc[4 * g4 + 3]);
                    *(u32x2*)(CTn + r * LD64 + 32 * th + 8 * g4 + 4 * hh) = pk; }
                M4_LT(j, (ch + 4 < SEQ / 64 ? ch + 4 : SEQ / 64 - 1));
#pragma unroll
                for (int g = 0; g < 16; ++g) Y[(m0 + 32 * th + drow(g, hh)) * DM + 512 + h * 128 + 32 * c + r] = (bf16)f2bf(num[g]);
                lds_barrier();
            }
        }
#undef M4_LT
    } else if (w < 4 && c == 0) {
        const int th = w - 2; M4_LANE
        bf16x8 qd[4][4]; float Fv[4], dpv[4], dnv[4];
#define M4_LD(j_, ch_) do { const size_t mm_ = (size_t)b * SEQ + 64 * (ch_); const int u_ = mb * 64 + (ch_); M4_QD(j_, mm_) \
        Fv[j_] = (GPTR(const float, C.ws + WS_DEN) + (size_t)u_ * 256)[129 + lz]; \
        { const float* t2_ = GPTR(const float, C.ws + WS_BONUS + 512 * 1024) + (size_t)u_ * 128; dpv[j_] = t2_[32 * th + r]; dnv[j_] = t2_[64 + lane]; } } while (0)
        M4_LD(0, 0); RING_FENCE; M4_LD(1, 1); RING_FENCE; M4_LD(2, 2); RING_FENCE; M4_LD(3, 3); RING_FENCE;
        __syncthreads();
#pragma unroll 1
        for (int ch0 = 0; ch0 < SEQ / 64; ch0 += 4) {
#pragma unroll
            for (int j = 0; j < 4; ++j) {
                const int ch = ch0 + j; const size_t m0 = (size_t)b * SEQ + 64 * ch;
                const float F = Fv[j];
                const float* nc = sN + (j & 1) * 64; float* nn = sN + ((j + 1) & 1) * 64;
                float dsum = C.zf();
#pragma unroll
                for (int s = 0; s < 4; ++s) { const f32x4 na = *(const f32x4*)(nc + 16 * s + 8 * hh), nb = *(const f32x4*)(nc + 16 * s + 8 * hh + 4); float q8[8]; const u32x4 qq = __builtin_bit_cast(u32x4, qd[j][s]); UNPK8(qq, q8);
                    dsum += (q8[0] * na[0] + q8[1] * na[1]) + (q8[2] * na[2] + q8[3] * na[3]) + (q8[4] * nb[0] + q8[5] * nb[1]) + (q8[6] * nb[2] + q8[7] * nb[3]); }
                dsum += __shfl_xor(dsum, 32);
                if (hh == 0) den[(m0 + 32 * th + r) * 4 + h] = dsum + dpv[j];
                if (th == 1) nn[lane] = F * nc[lane] + dnv[j];
                M4_LD(j, (ch + 4 < SEQ / 64 ? ch + 4 : SEQ / 64 - 1));
                lds_barrier();
            }
        }
#undef M4_LD
    } else {
        __syncthreads();
#pragma unroll 1
        for (int ch = 0; ch < SEQ / 64; ++ch) lds_barrier();
    }
#undef M4_QD
#undef M4_LANE
}

#ifndef MLX
#define MLX 0
#endif
__device__ __forceinline__ void mlstm_chain3_block(const Ctx& C, int mb, unsigned char* lds, bool rep = false) {
    const int tid = C.tid(), lane = tid & 63, w = C.wave, r = lane & 31, hh = lane >> 5;
    const int b = mb >> 2, h = mb & 3;
    const bf16* P = GPTR(const bf16, C.ws + WS_R1); bf16* Y = GPTR(bf16, C.ws + WS_Y); float* den = GPTR(float, C.ws + WS_BONUS);
    bf16* CT0 = (bf16*)lds; bf16* CT1 = CT0 + 128 * LD64; float* sN = (float*)(CT1 + 128 * LD64);
    for (int i = tid; i < 2 * 128 * LD64 / 2; i += NTHREADS) ((unsigned*)CT0)[i] = 0u;
    if (tid < 128) sN[tid] = 0.f;
    const int th = w >> 2, vj = w & 3;
    f32x16 Cacc;
#pragma unroll
    for (int g = 0; g < 16; ++g) Cacc[g] = C.zf();
    int lz = 0; asm volatile("" : "+v"(lz));
    bf16x8 qd[4][4]; u32x4 n0[4], n1[4], d0[4], d1[4]; float Fv[4], dpv[4], dnv[4];
#define M3_LOAD(j_, ch_) do { const size_t mm_ = (size_t)b * SEQ + 64 * (ch_); const int u_ = mb * 64 + (ch_); \
        _Pragma("unroll") for (int s = 0; s < 4; ++s) { const int p_ = (th * 4 + s) * 64 + lane; qd[j_][s] = *(const bf16x8*)(P + (mm_ + (p_ >> 4)) * OD_PAD + 1024 + h * 128 + (p_ & 15) * 8); } \
        const int p0_ = ((th * 4 + vj) * 64 + lane) * 2; \
        n0[j_] = *(const u32x4*)(P + (mm_ + (p0_ >> 4)) * OD_PAD + OC_MV + h * 128 + (p0_ & 15) * 8); n1[j_] = *(const u32x4*)(P + (mm_ + ((p0_ + 1) >> 4)) * OD_PAD + OC_MV + h * 128 + ((p0_ + 1) & 15) * 8); \
        d0[j_] = *(const u32x4*)ml_dc_piece((bf16*)P, mm_, h, p0_); d1[j_] = *(const u32x4*)ml_dc_piece((bf16*)P, mm_, h, p0_ + 1); \
        Fv[j_] = (GPTR(const float, C.ws + WS_DEN) + (size_t)u_ * 256)[129 + lz]; \
        { const float* t2_ = GPTR(const float, C.ws + WS_BONUS + 512 * 1024) + (size_t)u_ * 128; dpv[j_] = t2_[32 * th + r]; dnv[j_] = t2_[64 + lane]; } } while (0)
#pragma unroll
    for (int j = 0; j < 4; ++j) { dpv[j] = C.zf(); dnv[j] = C.zf(); }
    M3_LOAD(0, 0); RING_FENCE; M3_LOAD(1, 1); RING_FENCE; M3_LOAD(2, 2); RING_FENCE; M3_LOAD(3, 3); RING_FENCE;
    __syncthreads();
#pragma unroll 1
    for (int ch0 = 0; ch0 < SEQ / 64; ch0 += 4) {
#pragma unroll
        for (int j = 0; j < 4; ++j) {
            const int ch = ch0 + j;
            const size_t m0 = (size_t)b * SEQ + 64 * ch;
            const bf16* CTc = (j & 1) ? CT1 : CT0; bf16* CTn = (j & 1) ? CT0 : CT1;
            const float F = Fv[j];
            f32x16 num;
            num[0] = bf2f(n0[j].x & 0xffffu); num[1] = bf2f(n0[j].x >> 16); num[2] = bf2f(n0[j].y & 0xffffu); num[3] = bf2f(n0[j].y >> 16); num[4] = bf2f(n0[j].z & 0xffffu); num[5] = bf2f(n0[j].z >> 16); num[6] = bf2f(n0[j].w & 0xffffu); num[7] = bf2f(n0[j].w >> 16);
            num[8] = bf2f(n1[j].x & 0xffffu); num[9] = bf2f(n1[j].x >> 16); num[10] = bf2f(n1[j].y & 0xffffu); num[11] = bf2f(n1[j].y >> 16); num[12] = bf2f(n1[j].z & 0xffffu); num[13] = bf2f(n1[j].z >> 16); num[14] = bf2f(n1[j].w & 0xffffu); num[15] = bf2f(n1[j].w >> 16);
#pragma unroll
            for (int s = 0; s < 4; ++s) num = mfma32(qd[j][s], ldfrag(CTc + (32 * vj + r) * LD64 + 16 * s + 8 * hh), num);
            {   float dc[16];
                dc[0] = bf2f(d0[j].x & 0xffffu); dc[1] = bf2f(d0[j].x >> 16); dc[2] = bf2f(d0[j].y & 0xffffu); dc[3] = bf2f(d0[j].y >> 16); dc[4] = bf2f(d0[j].z & 0xffffu); dc[5] = bf2f(d0[j].z >> 16); dc[6] = bf2f(d0[j].w & 0xffffu); dc[7] = bf2f(d0[j].w >> 16);
                dc[8] = bf2f(d1[j].x & 0xffffu); dc[9] = bf2f(d1[j].x >> 16); dc[10] = bf2f(d1[j].y & 0xffffu); dc[11] = bf2f(d1[j].y >> 16); dc[12] = bf2f(d1[j].z & 0xffffu); dc[13] = bf2f(d1[j].z >> 16); dc[14] = bf2f(d1[j].w & 0xffffu); dc[15] = bf2f(d1[j].w >> 16);
#pragma unroll
                for (int g = 0; g < 16; ++g) Cacc[g] = F * Cacc[g] + dc[g]; }
#pragma unroll
            for (int g4 = 0; g4 < 4; ++g4) { u32x2 pk; pk.x = pk2(Cacc[4 * g4], Cacc[4 * g4 + 1]); pk.y = pk2(Cacc[4 * g4 + 2], Cacc[4 * g4 + 3]);
                *(u32x2*)(CTn + (32 * vj + r) * LD64 + 32 * th + 8 * g4 + 4 * hh) = pk; }
            if (vj == 3 && !((MLX & 2) && rep)) {
                const float* nc = sN + (j & 1) * 64; float* nn = sN + ((j + 1) & 1) * 64;
                float dsum = C.zf();
#pragma unroll
                for (int s = 0; s < 4; ++s) { const f32x4 na = *(const f32x4*)(nc + 16 * s + 8 * hh), nb = *(const f32x4*)(nc + 16 * s + 8 * hh + 4); float q8[8]; const u32x4 qq = __builtin_bit_cast(u32x4, qd[j][s]); UNPK8(qq, q8);
                    dsum += (q8[0] * na[0] + q8[1] * na[1]) + (q8[2] * na[2] + q8[3] * na[3]) + (q8[4] * nb[0] + q8[5] * nb[1]) + (q8[6] * nb[2] + q8[7] * nb[3]); }
                dsum += __shfl_xor(dsum, 32);
                if (hh == 0) den[(m0 + 32 * th + r) * 4 + h] = dsum + dpv[j];
                if (th == 1) nn[lane] = F * nc[lane] + dnv[j];
            }
            M3_LOAD(j, (ch + 4 < SEQ / 64 ? ch + 4 : SEQ / 64 - 1));
            if (!((MLX & 1) && rep)) {
#pragma unroll
            for (int g = 0; g < 16; ++g) Y[(m0 + 32 * th + drow(g, hh)) * DM + 512 + h * 128 + 32 * vj + r] = (bf16)f2bf(num[g]); }
            lds_barrier();
        }
    }
#undef M3_LOAD
}

__device__ __forceinline__ void run_phase(const Ctx& C, int ph, unsigned char* lds, bool rep = false) {
    float* sm = (float*)lds;
    const int bid = C.bid;
    bf16* XB = (bf16*)C.out; bf16* Y = GPTR(bf16, C.ws + WS_Y); bf16* R1 = GPTR(bf16, C.ws + WS_R1); float* slots = GPTR(float, C.ws + WS_SLOTS);
#ifndef ONLY
#define ONLY -1
#endif
#define ON(x) (ONLY < 0 || ONLY == (x))
#ifndef CONVPROBE
#define CONVPROBE 0
#endif
#ifndef PREO_PROBE
#define PREO_PROBE 0
#endif
#ifndef G3PROBE
#define G3PROBE 0
#endif
#ifndef PREPART
#define PREPART 3
#endif
    if (ph == 0) { if (ON(10)) { prologue_rows(C); convert_layer(C, 0, sm, 0, C.G); } return; }
    if (ph == N_PHASES - 1) { if (ON(11)) final_rows(C); return; }
    const int l = (ph - 1) / 7, k7 = (ph - 1) % 7; const bool even = (l & 1) == 0; const int li = l >> 1;
    const int k = k7 == 0 ? 0 : (k7 == 1 ? 6 : k7 - 1);
    if (k == 6) {
        if (even) { if (ON(20)) { for (int tile = bid; tile < M / 64; tile += C.G) { if ((PREPART & 1) && !(rep && REP_SKIP == 2)) even_pre_tile(C, li, tile, lds); }
                                   for (int tile = bid; tile < M / 64; tile += C.G) { if ((PREPART & 2) && !(rep && REP_SKIP == 1)) rwkv_pre_tile(C, li, tile, lds, rep ? RPHEADS : 8); } } }
        else { if (ON(19)) for (int unit = bid; unit < 1024; unit += C.G) { const bool dummy = PREO_PROBE && !rep; if (!(PREO_PROBE & 2) || !dummy) gdn_pre3(C, li, unit, lds, dummy); if (!(PREO_PROBE & 4) || !dummy) mlstm_pre3(C, li, unit, lds, dummy); } }
        return; }
    if (k == 0 && ON(0)) {
        const int N = even ? EV_COLS : OD_PAD;
        pg8::Gemm g{XB, C.wset(l, WOFF_IN), M, N, DM}; pg8::StaticOrder S; S.init(M, N, C.G, bid);
        pg8::EpiScaleBf16<0> E{R1, N, slots, even ? nullptr : GPTR(bf16, C.ws + WS_HALO)};
        pg8::gemm_phase<pg8::EpiScaleBf16<0>, pg8::StaticOrder, true, true>((PG8_LAS unsigned char*)lds, g, S, E, C.tid());
    } else if (k == 1 && (ON(1) || ON(12) || ON(13) || ON(14) || ON(15))) {
        if (even) { if (bid < 32) { if (ON(1) || ON(12)) rwkv_chain3_block(C, li, bid, lds); } else if (rep && LRUPROBE) { for (int tile = bid - 32; tile < M / 64; tile += C.G - 32) lru_pass2_tile(C, tile, sm, true); }
                    else if (!rep && (ON(1) || ON(13))) { for (int tile = bid - 32; tile < M / 64; tile += C.G - 32) lru_pass2_tile(C, tile, sm); __syncthreads(); if (l + 1 < DEPTH) { convert_layer(C, l + 1, sm, 32, C.G - 32); if (CONVPROBE) { __syncthreads(); convert_layer(C, l + 1, sm, 32, C.G - 32); } } } }
        else { if (bid < 64) { if ((ON(1) || ON(14)) && !(rep && (REP_SKIP & 1))) gdn_chain4_block(C, bid & 15, bid >> 4, lds); } else if (bid < 128) { if ((ON(1) || ON(15)) && !(rep && (REP_SKIP & 2))) mlstm_chain4_block(C, (bid - 64) & 15, (bid - 64) >> 4, lds); }
               else if (!rep && l + 1 < DEPTH) convert_layer(C, l + 1, sm, 128, C.G - 128); }
    } else if (k == 2 && (ON(2) || ON(16) || ON(17) || ON(18))) {
        if (even) { if (ON(2) || ON(16)) for (int tile = bid; tile < M / 64; tile += C.G) rwkv_post_tile2(C, li, tile, sm, rep); }
        else { if (ON(2) || ON(17)) odd_post(C, li, rep); }
    } else if (k == 3 && ON(3)) {
        pg8::Gemm g{Y, C.wset(l, WOFF_OUT), M, DM, DM}; pg8::StaticOrder S; S.init(M, DM, C.G, bid);
        pg8::EpiRes E{XB, rep ? GPTR(bf16, C.ws + WS_XB) : XB, slots, rep};
        pg8::gemm_phase<pg8::EpiRes, pg8::StaticOrder, true, true>((PG8_LAS unsigned char*)lds, g, S, E, C.tid());
    } else if (k == 4 && ON(4)) {
        pg8::Gemm g{XB, C.wset(l, WOFF_UP), M, DFF, DM}; pg8::StaticOrder S; S.init(M, DFF, C.G, bid);
        pg8::EpiScaleBf16<1> E{R1, DFF, slots, nullptr, rep ? G3PROBE : 0};
        pg8::gemm_phase<pg8::EpiScaleBf16<1>, pg8::StaticOrder, true, true>((PG8_LAS unsigned char*)lds, g, S, E, C.tid());
    } else if (k == 5 && ON(5)) {
        pg8::Gemm g{R1, C.wset(l, WOFF_DOWN), M, DM, DFF}; pg8::StaticOrder S; S.init(M, DM, C.G, bid);
        pg8::EpiRes E{XB, (l + 1 < DEPTH && !rep) ? XB : GPTR(bf16, C.ws + WS_XB), slots, rep};
        pg8::gemm_phase<pg8::EpiRes, pg8::StaticOrder, true, true>((PG8_LAS unsigned char*)lds, g, S, E, C.tid());
    }
}

#ifndef MK_SINGLE
#define MK_SINGLE 1
#endif
#ifndef REP_SKIP
#define REP_SKIP 0
#endif
#ifndef MK_XCDBAR
#define MK_XCDBAR 1
#endif
constexpr int CW_BAR = 4096;
#define XB_TMO      128
#define XB_XCNT(j)  (256  + 64 * (j))
#define XB_XSUB(j)  (1280 + 64 * (j))
#define XB_XGEN(j)  (2304 + 64 * (j))
#define XB_TOP      3328
#define XB_TOPGEN   3392
#define XCD_BAR_WORDS 3456
#define XB_SPIN_CAP (1u << 18)

__device__ __forceinline__ unsigned xb_ld(unsigned* p)              { return __hip_atomic_load(p, __ATOMIC_RELAXED, __HIP_MEMORY_SCOPE_AGENT); }
__device__ __forceinline__ unsigned xb_add(unsigned* p, unsigned v) { return __hip_atomic_fetch_add(p, v, __ATOMIC_RELAXED, __HIP_MEMORY_SCOPE_AGENT); }
__device__ __forceinline__ unsigned xb_xcc_id() { return (unsigned)__builtin_amdgcn_s_getreg((3 << 11) | 20) & 0xFu; }
#define XB_SPIN(cond, bar) do { unsigned _sp = 0; while (cond) { __builtin_amdgcn_s_sleep(1); \
    if ((++_sp & 255u) == 0u) { if (xb_ld(&(bar)[XB_TMO])) break; if (_sp > XB_SPIN_CAP) { atomicAdd(&(bar)[XB_TMO], 1u); break; } } } } while (0)

struct XcdBarrier {
    unsigned* bar; unsigned x;
    volatile LAS unsigned* st;
};

__device__ __forceinline__ XcdBarrier xcd_barrier_post(unsigned* bar, volatile LAS unsigned* st) {
    XcdBarrier b; b.bar = bar; b.x = xb_xcc_id(); b.st = st;
    if (threadIdx.x == 0) (void)xb_add(&bar[XB_XCNT(b.x)], 1u);
    return b;
}
__device__ __forceinline__ void xcd_barrier_complete(unsigned* bar, unsigned x, unsigned& nloc, unsigned& nx) {
    const unsigned G = gridDim.x * gridDim.y * gridDim.z;
    unsigned sum, cnt, mine, sp = 0u;
    for (;;) {
        sum = 0u; cnt = 0u; mine = 0u;
#pragma unroll
        for (unsigned j = 0; j < 16; ++j) { const unsigned c = xb_ld(&bar[XB_XCNT(j)]); sum += c; cnt += (c > 0u) ? 1u : 0u; mine = (j == x) ? c : mine; }
        if (sum == G) break;
        __builtin_amdgcn_s_sleep(1);
        if ((++sp & 255u) == 0u) { if (xb_ld(&bar[XB_TMO])) break; if (sp > XB_SPIN_CAP) { atomicAdd(&bar[XB_TMO], 1u); break; } }
    }
    nloc = mine > 0u ? mine : 1u; nx = cnt > 0u ? cnt : 1u;
}

__device__ __forceinline__ void xcd_barrier(const XcdBarrier& b, bool lead  ) {
    asm volatile("s_waitcnt vmcnt(0)" ::: "memory");
    __syncthreads();
    if (lead) {
        unsigned* bar = b.bar;
        __builtin_amdgcn_s_waitcnt(0);
        unsigned nloc = b.st[0], nx = b.st[1];
        if (nloc == 0u) { xcd_barrier_complete(bar, b.x, nloc, nx); b.st[0] = nloc; b.st[1] = nx; }
        const unsigned old = xb_add(&bar[XB_XSUB(b.x)], 1u);
        const unsigned gen = old / nloc;
        if (old + 1u == (gen + 1u) * nloc) {
            __builtin_amdgcn_fence(__ATOMIC_RELEASE, "agent");
            asm volatile("s_waitcnt vmcnt(0)" ::: "memory");
            const unsigned og = xb_add(&bar[XB_TOP], 1u);
            const unsigned tg = og / nx;
            if (og + 1u == (tg + 1u) * nx) xb_add(&bar[XB_TOPGEN], 1u);
            else XB_SPIN(xb_ld(&bar[XB_TOPGEN]) == tg, bar);
            __builtin_amdgcn_fence(__ATOMIC_ACQUIRE, "agent");
            xb_add(&bar[XB_XGEN(b.x)], 1u);
            asm volatile("s_waitcnt vmcnt(0)" ::: "memory");
        } else {
            XB_SPIN(xb_ld(&bar[XB_XGEN(b.x)]) == gen, bar);
            __builtin_amdgcn_fence(__ATOMIC_ACQUIRE, "agent");
            asm volatile("s_waitcnt vmcnt(0)" ::: "memory");
        }
    }
    __syncthreads();
}


__global__ void __launch_bounds__(NTHREADS, 2) mega(Args args) {
    extern __shared__ __attribute__((aligned(16))) unsigned char lds[];
    {   unsigned long long* t = (unsigned long long*)(args.ws + WS_TBL + (size_t)blockIdx.x * 512);
        if (threadIdx.x == 0) {
#pragma unroll
            for (int i = 0; i < 36; ++i) t[i] = (unsigned long long)args.in[i];
        }
    }
#if MK_SINGLE && MK_XCDBAR
    volatile LAS unsigned* bst = (volatile LAS unsigned*)((LAS unsigned char*)lds + (LDS_BYTES - 64));
    if (threadIdx.x < 2) bst[threadIdx.x] = 0u;
    __syncthreads();
    const XcdBarrier xbar = xcd_barrier_post((unsigned*)(args.ws + WS_CTL) + CW_BAR, bst);
#endif
    __syncthreads();
    const int wave_s = __builtin_amdgcn_readfirstlane((int)threadIdx.x >> 6);
#ifdef REPEAT_MASK
    for (int ph2 = args.ph_lo * 2; ph2 < args.ph_hi * 2; ++ph2) {
        const int ph = ph2 >> 1; const bool rep = (ph2 & 1) != 0;
        if (rep) { const int l_ = (ph - 1) / 7, k7_ = (ph - 1) % 7; const bool ev_ = (l_ & 1) == 0; const int k_ = (ph == 0 || ph == N_PHASES - 1) ? -1 : (k7_ == 0 ? 0 : (k7_ == 1 ? 6 : k7_ - 1));
                   const int code_ = ph == 0 ? 16 : (k_ < 0 ? -1 : (k_ + (ev_ ? 0 : 8)));
                   if (!(code_ >= 0 && ((REPEAT_MASK >> code_) & 1))) continue; }
#else
    for (int ph = args.ph_lo; ph < args.ph_hi; ++ph) { const bool rep = false;
#endif
        Ctx C;
        int wv_ = wave_s; unsigned z0_ = 0u; asm volatile("" : "+s"(wv_), "+s"(z0_));
        int bx = blockIdx.x, G = gridDim.x; unsigned char* ws = args.ws; float* out = args.out;
        asm volatile("" : "+s"(bx)); asm volatile("" : "+s"(G)); asm volatile("" : "+s"(ws)); asm volatile("" : "+s"(out));
        ws = GPTR(unsigned char, ws); out = GPTR(float, out);
        C.tbl = (const unsigned long long*)(ws + WS_TBL + (size_t)bx * 512); C.out = out; C.ws = ws;
        C.wave = wv_; C.z0 = z0_;
        C.G = G; C.vcu = (G % 8 == 0) ? (bx % 8) * (G / 8) + bx / 8 : bx; C.bid = bx;
        int zoff = 0; asm volatile("" : "+s"(zoff));
        run_phase(C, ph, lds + zoff, rep);
#if MK_SINGLE
#if MK_XCDBAR
#ifdef REPEAT_MASK
        xcd_barrier(xbar, C.tid() == 0);
#else
        if (ph + 1 < args.ph_hi) xcd_barrier(xbar, C.tid() == 0);
#endif
#else
        if (ph + 1 < args.ph_hi) cg::this_grid().sync();
#endif
#endif
    }
#ifdef BARPROBE
    for (int i = 0; i < BARPROBE; ++i) xcd_barrier(xbar, threadIdx.x == 0);
#endif
}

extern "C" void kernel_launch(void* const* d_in, const int* in_sizes, int n_in, void* d_out, int out_size, void* d_ws, size_t ws_size, hipStream_t stream) {
    static int grid = 0;
    if (grid == 0) {
        if (n_in != 36 || out_size != M * DM || ws_size < 256 * MiB) { fprintf(stderr, "kernel_launch: unexpected shapes (n_in %d, out %d, ws %zu); nothing launched\n", n_in, out_size, ws_size); grid = -1; return; }
        int dev = 0, cus = 0, per_cu = 0;
        (void)hipGetDevice(&dev); (void)hipDeviceGetAttribute(&cus, hipDeviceAttributeMultiprocessorCount, dev);
        if (hipFuncSetAttribute((const void*)mega, hipFuncAttributeMaxDynamicSharedMemorySize, LDS_BYTES) != hipSuccess) { fprintf(stderr, "kernel_launch: hipFuncSetAttribute failed\n"); grid = -1; return; }
        if (hipOccupancyMaxActiveBlocksPerMultiprocessor(&per_cu, (const void*)mega, NTHREADS, LDS_BYTES) != hipSuccess || per_cu < 1) { fprintf(stderr, "kernel_launch: occupancy query says %d\n", per_cu); per_cu = 1; }
        (void)hipGetLastError();
        grid = cus > 0 ? cus : 256;
        fprintf(stderr, "kernel_launch: cus %d per_cu %d grid %d ws %zu\n", cus, per_cu, grid, ws_size);
    }
    if (grid < 0) return;
    Args a{};
    for (int i = 0; i < 36; ++i) a.in[i] = (const float*)d_in[i];
    a.out = (float*)d_out; a.ws = (unsigned char*)d_ws;
#if MK_SINGLE
    a.ph_lo = 0; a.ph_hi = N_PHASES;
#if MK_XCDBAR
    if (hipMemsetAsync((char*)d_ws + WS_CTL, 0, 65536, stream) != hipSuccess) { fprintf(stderr, "kernel_launch: hipMemsetAsync failed\n"); return; }
    hipLaunchKernelGGL(mega, dim3(grid), dim3(NTHREADS), LDS_BYTES, stream, a);
#else
    void* kargs[] = {&a};
    hipError_t e = hipLaunchCooperativeKernel((const void*)mega, dim3(grid), dim3(NTHREADS), kargs, LDS_BYTES, stream);
    if (e != hipSuccess) fprintf(stderr, "kernel_launch: cooperative launch failed: %s\n", hipGetErrorString(e));
#endif
#else
    for (int ph = 0; ph < N_PHASES; ++ph) {
        a.ph_lo = ph; a.ph_hi = ph + 1;
        hipLaunchKernelGGL(mega, dim3(grid), dim3(NTHREADS), LDS_BYTES, stream, a);
    }
#endif
}
```

```cpp
#include <hip/hip_runtime.h>
#include <hip/hip_cooperative_groups.h>
#include <cstdio>
#include <cstdint>
namespace cg = cooperative_groups;
namespace pg8 {
#define PG8_LAS __attribute__((address_space(3)))
typedef unsigned short bf16_t;
typedef short bf16x8 __attribute__((ext_vector_type(8)));
typedef float f32x4 __attribute__((ext_vector_type(4)));
typedef unsigned u32x4 __attribute__((ext_vector_type(4)));
constexpr int BM = 256, BK = 64, HALF = 128, HTB = HALF * BK * 2  , STAGE_BYTES = 8 * HTB, NXCD = 8, WGM = 8;

__host__ __device__ __forceinline__ int lds_byte(int r, int c) { const int st = (r >> 4) * 2 + (c >> 5), rr = r & 15, cc = c & 31, ob = rr * 64 + cc * 2; return st * 1024 + (ob ^ (((ob >> 9) & 1) << 5)); }
__host__ __device__ __forceinline__ void stage_rc(int b, int& R, int& C) { const int st = b / 1024, sb = b % 1024, swz = sb ^ (((sb >> 9) & 1) << 5); R = (st >> 1) * 16 + swz / 64; C = (st & 1) * 32 + (swz % 64) / 2; }
__host__ __device__ __forceinline__ int perm32(int rho) { const int n = rho >> 4, i = rho & 15; return 8 * (i >> 2) + 4 * n + (i & 3); }

struct Unit { int pm, pn; };
struct Gemm { const bf16_t* A; const bf16_t* Bt; int M, N, K; };

struct StaticOrder {
    int nM, nN, nwg, G, c;
    __host__ __device__ void init(int M, int N, int G_, int c_) { nM = M / BM; nN = N / BM; nwg = nM * nN; G = G_; c = c_; }
    __host__ __device__ bool next(int i, Unit& u) const {
        const long L = (long)i * G + c; if (L >= nwg) return false;
        int wgid = (int)L; { const int q = nwg / NXCD, r = nwg % NXCD, xcd = wgid % NXCD, off = wgid / NXCD; wgid = (xcd < r ? xcd * (q + 1) : r * (q + 1) + (xcd - r) * q) + off; }
        const int nig = WGM * nN, gid = wgid / nig, fm = gid * WGM, gsz = (nM - fm) < WGM ? (nM - fm) : WGM;
        u.pm = fm + ((wgid % nig) % gsz); u.pn = (wgid % nig) / gsz; return true;
    }
    __device__ __forceinline__ void a_ready(const Unit&) const {}
    __device__ __forceinline__ void done(const Unit&) const {}
};

__device__ __forceinline__ unsigned cvt_pk_bf16(float lo, float hi) { unsigned r; asm volatile("v_cvt_pk_bf16_f32 %0, %1, %2" : "=v"(r) : "v"(lo), "v"(hi)); return r; }
__device__ __forceinline__ float row_rstd(const float* slots, int row) {
    const f32x4* s = (const f32x4*)(slots + (size_t)row * 16);
    const f32x4 a = s[0], b = s[1], c = s[2], d = s[3];
    const float t = ((a[0] + a[1]) + (a[2] + a[3])) + ((b[0] + b[1]) + (b[2] + b[3])) + ((c[0] + c[1]) + (c[2] + c[3])) + ((d[0] + d[1]) + (d[2] + d[3]));
    return 1.0f / sqrtf(t * (1.0f / 1024.0f) + 1e-6f);
}
__device__ __forceinline__ float row_rstd_q(const float* slots, int row, int fq) {
    const f32x4 a = *(const f32x4*)(slots + (size_t)row * 16 + 4 * fq);
    float t = (a[0] + a[1]) + (a[2] + a[3]);
    t += __shfl_xor(t, 16); t += __shfl_xor(t, 32);
    return 1.0f / sqrtf(t * (1.0f / 1024.0f) + 1e-6f);
}
__device__ __forceinline__ void st16_wt(void* p, u32x4 v) { asm volatile("global_store_dwordx4 %0, %1, off sc1\n\ts_nop 1" :: "v"(p), "v"(v) : "memory"); }
template <int ACT> struct EpiScaleBf16 {
    static constexpr bool PERM = true, AFTER_DRAIN = false, WIDE = true;
    struct Pref { f32x4 q[4]; };
    bf16_t* O; int ldc; const float* slots; bf16_t* halo = nullptr; int probe = 0;
    __device__ __forceinline__ void prefetch(const Unit& u, int wr, int fr, int fq, Pref& pf) const {
#pragma unroll
        for (int m = 0; m < 4; ++m) pf.q[m] = *(const f32x4*)(slots + (size_t)(u.pm * BM + wr * 64 + fr + m * 16) * 16 + 4 * fq);
    }
    __device__ __forceinline__ void operator()(const f32x4 (&acc)[2][2][4][2], const Unit& u, int wr, int wc, int fr, int fq, const Pref& pf) const {
        const int row0 = u.pm * BM + wr * 64 + fr, col0 = u.pn * BM + wc * 64 + 8 * fq;
        f32x4 q1[4];
#pragma unroll
        for (int m = 0; m < 4; ++m) q1[m] = *(const f32x4*)(slots + (size_t)(row0 + HALF + m * 16) * 16 + 4 * fq);
#pragma unroll
        for (int ai = 0; ai < 2; ++ai)
#pragma unroll
            for (int m = 0; m < 4; ++m) {
                const int row = row0 + ai * HALF + m * 16;
                float rs; { const f32x4 a = (ai == 0) ? pf.q[m] : q1[m]; float t = (a[0] + a[1]) + (a[2] + a[3]); t += __shfl_xor(t, 16); t += __shfl_xor(t, 32); rs = 1.0f / sqrtf(t * (1.0f / 1024.0f) + 1e-6f); }
                bf16_t* rowp = O + (size_t)row * ldc + col0;
#pragma unroll
                for (int bj = 0; bj < 2; ++bj) {
                    f32x4 v0 = acc[ai][bj][m][0] * rs, v1 = acc[ai][bj][m][1] * rs;
                    if (ACT == 1) {
#pragma unroll
                        for (int q = 0; q < 4; ++q) { float a = fmaxf(v0[q], 0.f), b = fmaxf(v1[q], 0.f); v0[q] = a * a; v1[q] = b * b; }
                    }
                    u32x4 w; w.x = cvt_pk_bf16(v0[0], v0[1]); w.y = cvt_pk_bf16(v0[2], v0[3]); w.z = cvt_pk_bf16(v1[0], v1[1]); w.w = cvt_pk_bf16(v1[2], v1[3]);
                    if (!(probe & 1)) { if (ACT == 0) st16_wt(rowp + bj * 32, w); else *(u32x4*)(rowp + bj * 32) = w; }
                    if (halo && m == 3 && fr >= 13) *(u32x4*)(halo + ((size_t)(row >> 6) * 3 + (row & 63) - 61) * ldc + col0 + bj * 32) = w;
                }
            }
    }
};
struct EpiRes {
    static constexpr bool PERM = true, AFTER_DRAIN = false, WIDE = true;
    struct Pref { };
    __device__ __forceinline__ void prefetch(const Unit&, int, int, int, Pref&) const { }
    const bf16_t* XI; bf16_t* XO; float* slots; bool noslots = false;
    __device__ __forceinline__ void operator()(const f32x4 (&acc)[2][2][4][2], const Unit& u, int wr, int wc, int fr, int fq, const Pref&) const {
        const int col0 = u.pn * BM + wc * 64 + 8 * fq;
        u32x4 xin[2][4][2];
#pragma unroll
        for (int ai = 0; ai < 2; ++ai)
#pragma unroll
            for (int m = 0; m < 4; ++m)
#pragma unroll
                for (int bj = 0; bj < 2; ++bj) xin[ai][m][bj] = *(const u32x4*)(XI + (size_t)(u.pm * BM + ai * HALF + wr * 64 + m * 16 + fr) * 1024 + col0 + bj * 32);
#pragma unroll
        for (int ai = 0; ai < 2; ++ai)
#pragma unroll
            for (int m = 0; m < 4; ++m) {
                const int row = u.pm * BM + ai * HALF + wr * 64 + m * 16 + fr;
                const size_t off = (size_t)row * 1024 + col0;
                float ss = 0.f;
#pragma unroll
                for (int bj = 0; bj < 2; ++bj) {
                    const u32x4 xi = xin[ai][m][bj];
                    f32x4 v0, v1;
                    v0[0] = __uint_as_float(xi.x << 16); v0[1] = __uint_as_float(xi.x & 0xffff0000u); v0[2] = __uint_as_float(xi.y << 16); v0[3] = __uint_as_float(xi.y & 0xffff0000u);
                    v1[0] = __uint_as_float(xi.z << 16); v1[1] = __uint_as_float(xi.z & 0xffff0000u); v1[2] = __uint_as_float(xi.w << 16); v1[3] = __uint_as_float(xi.w & 0xffff0000u);
                    v0 = v0 + acc[ai][bj][m][0]; v1 = v1 + acc[ai][bj][m][1];
                    u32x4 w; w.x = cvt_pk_bf16(v0[0], v0[1]); w.y = cvt_pk_bf16(v0[2], v0[3]); w.z = cvt_pk_bf16(v1[0], v1[1]); w.w = cvt_pk_bf16(v1[2], v1[3]);
                    *(u32x4*)(XO + off + bj * 32) = w;
                    const float r0 = __uint_as_float(w.x << 16), r1 = __uint_as_float(w.x & 0xffff0000u), r2 = __uint_as_float(w.y << 16), r3 = __uint_as_float(w.y & 0xffff0000u);
                    const float r4 = __uint_as_float(w.z << 16), r5 = __uint_as_float(w.z & 0xffff0000u), r6 = __uint_as_float(w.w << 16), r7 = __uint_as_float(w.w & 0xffff0000u);
                    ss += ((r0 * r0 + r1 * r1) + (r2 * r2 + r3 * r3)) + ((r4 * r4 + r5 * r5) + (r6 * r6 + r7 * r7));
                }
                ss += __shfl_xor(ss, 16); ss += __shfl_xor(ss, 32);
                if (fq == 0 && !noslots) slots[(size_t)row * 16 + u.pn * 4 + wc] = ss;
            }
    }
};
template <class Epi, class Sched, bool ALIGN_EPI = false, bool SP2 = false>
__device__ __forceinline__ void gemm_phase(PG8_LAS unsigned char* lds, const Gemm g, const Sched& S, const Epi& E, int tid_in) {
    int tid_ = tid_in; asm volatile("" : "+v"(tid_));
    const int tid = tid_, wid = __builtin_amdgcn_readfirstlane(tid >> 6), lane = tid & 63, wr = wid >> 2, wc = wid & 3, fr = lane & 15, fq = lane >> 4;
    const int K = g.K, nt = K / BK;
    unsigned voffA[2], voffB[2];
#pragma unroll
    for (int i = 0; i < 2; ++i) { int R, C; stage_rc(tid * 16 + i * 8192, R, C); const int Rb = Epi::WIDE ? (64 * (R >> 5) + perm32(R & 31)) : (Epi::PERM ? ((R & ~31) + perm32(R & 31)) : R);
        voffA[i] = (unsigned)(R * K + C) * 2u; voffB[i] = (unsigned)(Rb * K + C) * 2u; }
    const size_t kstep = (size_t)(BK * 2);
    const size_t hstep = (size_t)HALF * K * 2;
    const size_t hstepB = Epi::WIDE ? (size_t)32 * K * 2 : hstep;
    const size_t tstep = 2 * hstep;
    const unsigned ldsw = (unsigned)wid * 1024u;
    const int aoff = lds_byte(wr * 64 + fr, fq * 8), boff = lds_byte(wc * 32 + fr, fq * 8);
#define PG8_SA(b, h) (((b) * 2 + (h)) * HTB)
#define PG8_SB(b, h) ((4 + (b) * 2 + (h)) * HTB)
#define PG8_STAGE(bufoff, gbase, voff) do { _Pragma("unroll") for (int _i = 0; _i < 2; ++_i) \
        __builtin_amdgcn_global_load_lds((const unsigned*)((const char*)(gbase) + (voff)[_i]), (PG8_LAS unsigned*)(lds + (bufoff) + ldsw + _i * 8192), 16, 0, 0); } while (0)
#define PG8_LDA(dst, b, h) do { _Pragma("unroll") for (int m = 0; m < 4; ++m) _Pragma("unroll") for (int k = 0; k < 2; ++k) dst[m][k] = *(const PG8_LAS bf16x8*)(lds + PG8_SA(b, h) + aoff + m * 2048 + k * 1024); } while (0)
#define PG8_LDB(dst, b, h) do { _Pragma("unroll") for (int n = 0; n < 2; ++n) _Pragma("unroll") for (int k = 0; k < 2; ++k) dst[n][k] = *(const PG8_LAS bf16x8*)(lds + PG8_SB(b, h) + boff + n * 2048 + k * 1024); } while (0)
#define PG8_MMA(ai, bj, At, Bt) do { __builtin_amdgcn_s_setprio(1); _Pragma("unroll") for (int m = 0; m < 4; ++m) _Pragma("unroll") for (int n = 0; n < 2; ++n) _Pragma("unroll") for (int k = 0; k < 2; ++k) \
        acc[ai][bj][m][n] = __builtin_amdgcn_mfma_f32_16x16x32_bf16(Bt[n][k], At[m][k], acc[ai][bj][m][n], 0, 0, 0); __builtin_amdgcn_s_setprio(0); } while (0)
#define PG8_WAIT_V(n) asm volatile("s_waitcnt vmcnt(" #n ")" ::: "memory")
#define PG8_WAIT_L(n) asm volatile("s_waitcnt lgkmcnt(" #n ")" ::: "memory")
#define PG8_BAR __builtin_amdgcn_s_barrier()
#define PG8_SCHED __builtin_amdgcn_sched_barrier(0)
    Unit cur, nxt; int ui = 0;
    typename Epi::Pref PF;
    if (!S.next(0, cur)) return;
    f32x4 acc[2][2][4][2];
#pragma unroll
    for (int a = 0; a < 2; ++a)
#pragma unroll
        for (int b = 0; b < 2; ++b)
#pragma unroll
            for (int m = 0; m < 4; ++m)
#pragma unroll
                for (int n = 0; n < 2; ++n) acc[a][b][m][n] = (f32x4){0.f, 0.f, 0.f, 0.f};
    bf16x8 At[4][2], B0[2][2], B1[2][2];
    const char* cA = (const char*)g.A + (size_t)cur.pm * tstep; const char* cB = (const char*)g.Bt + (size_t)cur.pn * tstep;
    S.a_ready(cur);
    if constexpr (SP2) {
        PG8_STAGE(PG8_SB(0, 0), cB, voffB); PG8_STAGE(PG8_SB(0, 1), cB + hstepB, voffB); PG8_STAGE(PG8_SA(0, 0), cA, voffA); PG8_STAGE(PG8_SA(0, 1), cA + hstep, voffA);
        if (wr == 1) PG8_BAR;
        PG8_WAIT_V(2); PG8_BAR;
        PG8_STAGE(PG8_SB(1, 0), cB + kstep, voffB); PG8_STAGE(PG8_SA(1, 0), cA + kstep, voffA); PG8_STAGE(PG8_SB(1, 1), cB + hstepB + kstep, voffB);
        PG8_WAIT_V(6); PG8_BAR;
    } else {
        PG8_STAGE(PG8_SB(0, 0), cB, voffB); PG8_STAGE(PG8_SA(0, 0), cA, voffA); PG8_STAGE(PG8_SB(0, 1), cB + hstepB, voffB); PG8_STAGE(PG8_SA(0, 1), cA + hstep, voffA);
        if (wr == 1) PG8_BAR;
        PG8_WAIT_V(4); PG8_BAR;
        PG8_STAGE(PG8_SB(1, 0), cB + kstep, voffB); PG8_STAGE(PG8_SA(1, 0), cA + kstep, voffA); PG8_STAGE(PG8_SB(1, 1), cB + hstepB + kstep, voffB);
        PG8_WAIT_V(6); PG8_BAR;
    }
    for (;;) {
        const bool has_next = S.next(ui + 1, nxt);
        const char* nA = has_next ? (const char*)g.A + (size_t)nxt.pm * tstep : cA; const char* nB = has_next ? (const char*)g.Bt + (size_t)nxt.pn * tstep : cB;
        for (int t = 0; t < nt; t += 2) {
            const bool last = (t == nt - 2);
            const char* a1 = cA + (size_t)(t + 1) * kstep;
            const char* a2 = last ? nA : cA + (size_t)(t + 2) * kstep; const char* b2 = last ? nB : cB + (size_t)(t + 2) * kstep;
            const char* a3 = a2 + kstep; const char* b3 = b2 + kstep;
            if (last && has_next) S.a_ready(nxt);
            if (last) E.prefetch(cur, wr, fr, fq, PF);
            if constexpr (SP2) {
            PG8_LDB(B0, 0, 0); PG8_LDB(B1, 0, 1); PG8_SCHED; PG8_LDA(At, 0, 0); PG8_STAGE(PG8_SA(1, 1), a1 + hstep, voffA);
            PG8_WAIT_V(8); PG8_WAIT_L(0); PG8_BAR; PG8_MMA(0, 0, At, B0); PG8_MMA(0, 1, At, B1); PG8_BAR; PG8_SCHED;
            PG8_LDA(At, 0, 1); PG8_STAGE(PG8_SB(0, 0), b2, voffB); PG8_STAGE(PG8_SB(0, 1), b2 + hstepB, voffB); PG8_STAGE(PG8_SA(0, 0), a2, voffA);
            PG8_WAIT_V(8); PG8_WAIT_L(0); PG8_BAR; PG8_MMA(1, 0, At, B0); PG8_MMA(1, 1, At, B1); PG8_BAR; PG8_SCHED;
            PG8_LDB(B0, 1, 0); PG8_LDB(B1, 1, 1); PG8_SCHED; PG8_LDA(At, 1, 0); PG8_STAGE(PG8_SA(0, 1), a2 + hstep, voffA);
            PG8_WAIT_V(8); PG8_WAIT_L(0); PG8_BAR; PG8_MMA(0, 0, At, B0); PG8_MMA(0, 1, At, B1); PG8_BAR; PG8_SCHED;
            PG8_LDA(At, 1, 1); PG8_STAGE(PG8_SB(1, 0), b3, voffB); PG8_STAGE(PG8_SB(1, 1), b3 + hstepB, voffB); PG8_STAGE(PG8_SA(1, 0), a3, voffA);
            PG8_WAIT_V(8); PG8_WAIT_L(0); PG8_BAR; PG8_MMA(1, 0, At, B0); PG8_MMA(1, 1, At, B1); PG8_BAR; PG8_SCHED;
            } else {
            PG8_LDB(B0, 0, 0); PG8_SCHED; PG8_LDA(At, 0, 0); PG8_STAGE(PG8_SA(1, 1), a1 + hstep, voffA);
            PG8_WAIT_L(8); PG8_BAR; PG8_WAIT_L(0); PG8_MMA(0, 0, At, B0); PG8_BAR; PG8_SCHED;
            PG8_LDB(B1, 0, 1); PG8_STAGE(PG8_SB(0, 0), b2, voffB);
            PG8_BAR; PG8_WAIT_L(0); PG8_MMA(0, 1, At, B1); PG8_BAR;
            PG8_LDA(At, 0, 1); PG8_STAGE(PG8_SA(0, 0), a2, voffA);
            PG8_BAR; PG8_WAIT_L(0); PG8_MMA(1, 0, At, B0); PG8_BAR; PG8_SCHED;
            PG8_STAGE(PG8_SB(0, 1), b2 + hstepB, voffB);
            PG8_WAIT_V(6); PG8_BAR; PG8_MMA(1, 1, At, B1); PG8_BAR;
            PG8_LDB(B0, 1, 0); PG8_SCHED; PG8_LDA(At, 1, 0); PG8_STAGE(PG8_SA(0, 1), a2 + hstep, voffA);
            PG8_WAIT_L(8); PG8_BAR; PG8_WAIT_L(0); PG8_MMA(0, 0, At, B0); PG8_BAR; PG8_SCHED;
            PG8_LDB(B1, 1, 1); PG8_STAGE(PG8_SB(1, 0), b3, voffB);
            PG8_BAR; PG8_WAIT_L(0); PG8_MMA(0, 1, At, B1); PG8_BAR;
            PG8_LDA(At, 1, 1); PG8_STAGE(PG8_SA(1, 0), a3, voffA);
            PG8_BAR; PG8_WAIT_L(0); PG8_MMA(1, 0, At, B0); PG8_BAR; PG8_SCHED;
            PG8_STAGE(PG8_SB(1, 1), b3 + hstepB, voffB);
            PG8_WAIT_V(6); PG8_BAR; PG8_MMA(1, 1, At, B1); PG8_BAR;
            }
        }
        if constexpr (ALIGN_EPI) { if (wr == 0) PG8_BAR; }
        if constexpr (!Epi::AFTER_DRAIN) {
            int te_ = tid; asm volatile("" : "+v"(te_)); const int le_ = te_ & 63, we_ = __builtin_amdgcn_readfirstlane(te_ >> 6);
            E(acc, cur, we_ >> 2, we_ & 3, le_ & 15, le_ >> 4, PF); S.done(cur); }
        if (!has_next) break;
#pragma unroll
        for (int a = 0; a < 2; ++a)
#pragma unroll
            for (int b = 0; b < 2; ++b)
#pragma unroll
                for (int m = 0; m < 4; ++m)
#pragma unroll
                    for (int n = 0; n < 2; ++n) acc[a][b][m][n] = (f32x4){0.f, 0.f, 0.f, 0.f};
        cur = nxt; cA = nA; cB = nB; ++ui;
        if constexpr (ALIGN_EPI) { if (wr == 1) PG8_BAR; }
    }
    PG8_WAIT_V(0);
    if constexpr (!ALIGN_EPI) { if (wr == 0) PG8_BAR; }
    PG8_BAR;
    if constexpr (Epi::AFTER_DRAIN) { E.fused(acc, cur, wr, wc, fr, fq, lds, wid, lane); S.done(cur); }
#undef PG8_SA
#undef PG8_SB
#undef PG8_STAGE
#undef PG8_LDA
#undef PG8_LDB
#undef PG8_MMA
#undef PG8_WAIT_V
#undef PG8_WAIT_L
#undef PG8_BAR
#undef PG8_SCHED
}
}

typedef unsigned short bf16;
typedef float f32x4 __attribute__((ext_vector_type(4)));
typedef unsigned u32x4 __attribute__((ext_vector_type(4)));
typedef unsigned u32x2 __attribute__((ext_vector_type(2)));
#define LAS __attribute__((address_space(3)))
#define GAS __attribute__((address_space(1)))
constexpr int NWAVES = 8, NTHREADS = 512;
constexpr int BATCH = 4, SEQ = 4096, DM = 1024, DFF = 4096, DEPTH = 4, M = BATCH * SEQ;
constexpr int EV_COLS = 2816, OD_COLS = 3600, OD_PAD = 3840;
constexpr int OC_Z = 1536, OC_MQK = 2048, OC_MV = 2560, OC_MOG = 3072, OC_GB = 3584, OC_GA = 3588, OC_MI = 3592, OC_MF = 3596;
constexpr int EC_R = 1024, EC_K = 1536, EC_V = 2048, EC_XW = 2560, EC_XA = 2624, EC_XG = 2688;
constexpr int LDS_BYTES = 151552;
constexpr int LDS_TBL_OFF = LDS_BYTES - 384;
constexpr int N_PHASES = 2 + 7 * DEPTH;

constexpr size_t MiB = 1u << 20;
constexpr size_t WS_CTL = 0, CTL_BYTES = 1 * MiB;
constexpr size_t WS_TBL = 512 * 1024;
constexpr size_t WSET_BYTES = 26 * MiB;
constexpr size_t WS_WSET0 = 1 * MiB, WS_WSET1 = WS_WSET0 + WSET_BYTES;
constexpr size_t WOFF_IN = 0, WOFF_OUT = (size_t)OD_PAD * DM * 2, WOFF_UP = WOFF_OUT + (size_t)DM * DM * 2, WOFF_DOWN = WOFF_UP + (size_t)DFF * DM * 2, WOFF_G2 = WOFF_DOWN + (size_t)DM * DFF * 2, WOFF_LG = WOFF_G2 + (size_t)512 * 128 * 2;
static_assert(WOFF_LG + (size_t)2 * 8 * 64 * 64 * 2 <= WSET_BYTES, "weight set");
constexpr size_t WS_SLOTS = WS_WSET1 + WSET_BYTES;
constexpr size_t WS_DEN = WS_SLOTS + 1 * MiB;
constexpr size_t WS_BONUS = WS_DEN + 1 * MiB;
constexpr size_t WS_XB = WS_BONUS + 1 * MiB;
constexpr size_t WS_Y = WS_XB + 32 * MiB;
constexpr size_t WS_R1 = WS_Y + 32 * MiB;
constexpr size_t WS_END = WS_R1 + 128 * MiB;
constexpr size_t WS_HALO = WS_END;
static_assert(WS_END <= 256 * MiB, "d_ws budget");

#ifndef REP_SKIP
#define REP_SKIP 0
#endif
struct Args {
    const float* in[36];
    float* out; unsigned char* ws;
    int ph_lo, ph_hi;
};

__device__ __forceinline__ float bf2f(unsigned h) { return __uint_as_float(h << 16); }
__device__ __forceinline__ unsigned f2bf(float f) { unsigned u = __float_as_uint(f); return (u + 0x7fffu + ((u >> 16) & 1u)) >> 16; }
__device__ __forceinline__ unsigned pk2(float lo, float hi) { typedef float f2_t __attribute__((ext_vector_type(2))); typedef __bf16 b2_t __attribute__((ext_vector_type(2)));
    const f2_t v = {lo, hi}; const b2_t c = __builtin_convertvector(v, b2_t); return __builtin_bit_cast(unsigned, c); }
__device__ __forceinline__ float fexp(float x) { return __builtin_amdgcn_exp2f(x * 1.4426950408889634f); }
__device__ __forceinline__ float flog(float x) { return __builtin_amdgcn_logf(x) * 0.6931471805599453f; }
__device__ __forceinline__ float frcp(float x) { return __builtin_amdgcn_rcpf(x); }
__device__ __forceinline__ float frsq(float x) { return __builtin_amdgcn_rsqf(x); }
__device__ __forceinline__ float sigm(float x) { return frcp(1.0f + fexp(-x)); }
__device__ __forceinline__ float softplusf(float x) { return fmaxf(x, 0.f) + flog(1.0f + fexp(-fabsf(x))); }
__device__ __forceinline__ float siluf(float x) { return x * sigm(x); }
__device__ __forceinline__ float ftanh(float x) { const float e = fexp(-2.0f * fabsf(x)); const float t = (1.0f - e) * frcp(1.0f + e); return x < 0.f ? -t : t; }
__device__ __forceinline__ float gelu_tanh(float x) { const float u = 0.7978845608028654f * (x + 0.044715f * x * x * x); return 0.5f * x * (1.0f + ftanh(u)); }
template <int CTRL> __device__ __forceinline__ float dpp_mov(float v) { return __int_as_float(__builtin_amdgcn_update_dpp(0, __float_as_int(v), CTRL, 0xF, 0xF, true)); }
__device__ __forceinline__ float row_sum16(float v) {
    v += dpp_mov<0x128>(v); v += dpp_mov<0x124>(v); v += dpp_mov<0x122>(v); v += dpp_mov<0x121>(v); return v;
}
__device__ __forceinline__ float wave_sum(float v) {
    v = row_sum16(v); v += __shfl_xor(v, 16); v += __shfl_xor(v, 32); return v;
}
__device__ __forceinline__ void ld4(const bf16* p, float* o) { const u32x2 w = *(const u32x2*)p; o[0] = bf2f(w.x & 0xffffu); o[1] = bf2f(w.x >> 16); o[2] = bf2f(w.y & 0xffffu); o[3] = bf2f(w.y >> 16); }
__device__ __forceinline__ void ld8(const bf16* p, float* o) { const u32x4 w = *(const u32x4*)p;
    o[0] = bf2f(w.x & 0xffffu); o[1] = bf2f(w.x >> 16); o[2] = bf2f(w.y & 0xffffu); o[3] = bf2f(w.y >> 16); o[4] = bf2f(w.z & 0xffffu); o[5] = bf2f(w.z >> 16); o[6] = bf2f(w.w & 0xffffu); o[7] = bf2f(w.w >> 16); }
__device__ __forceinline__ void ld2(const bf16* p, float* o) { const unsigned w = *(const unsigned*)p; o[0] = bf2f(w & 0xffffu); o[1] = bf2f(w >> 16); }

__device__ __forceinline__ void lds_barrier() { asm volatile("s_waitcnt lgkmcnt(0)" ::: "memory"); __builtin_amdgcn_s_barrier(); asm volatile("" ::: "memory"); }
#define GPTR(T, p) ((T*)(GAS T*)(unsigned long long)(p))
__device__ __forceinline__ void unpk8(const u32x4 w, float* o) { o[0] = bf2f(w.x & 0xffffu); o[1] = bf2f(w.x >> 16); o[2] = bf2f(w.y & 0xffffu); o[3] = bf2f(w.y >> 16); o[4] = bf2f(w.z & 0xffffu); o[5] = bf2f(w.z >> 16); o[6] = bf2f(w.w & 0xffffu); o[7] = bf2f(w.w >> 16); }
__device__ __forceinline__ void stwt16(void* p, u32x4 v) { asm volatile("global_store_dwordx4 %0, %1, off sc1\n\ts_nop 1" :: "v"(p), "v"(v) : "memory"); }
#define RING_FENCE asm volatile("" ::: "memory")
struct Ctx {
    const unsigned long long* tbl; float* out; unsigned char* ws;
    int wave, vcu, G, bid; unsigned z0;
    __device__ __forceinline__ int lane() const { return (int)__builtin_amdgcn_mbcnt_hi(~0u, __builtin_amdgcn_mbcnt_lo(~0u, z0)); }
    __device__ __forceinline__ int tid() const { return wave * 64 + lane(); }
    __device__ __forceinline__ float zf() const { return __uint_as_float(z0); }
    __device__ __forceinline__ const float* in(int i) const {
        extern __shared__ __attribute__((aligned(16))) unsigned char lds_in_tbl_[];
        const unsigned long long v = *(const LAS unsigned long long*)((const LAS unsigned char*)lds_in_tbl_ + (LDS_TBL_OFF + 8 * i + (int)z0));
        const unsigned lo = __builtin_amdgcn_readfirstlane((unsigned)v), hi = __builtin_amdgcn_readfirstlane((unsigned)(v >> 32));
        return (const float*)(const GAS float*)(((unsigned long long)hi << 32) | lo);
    }
    __device__ __forceinline__ bf16* wset(int l, size_t off) const { return (bf16*)(ws + ((l & 1) ? WS_WSET1 : WS_WSET0) + off); }
};

__device__ __forceinline__ void transpose_item(const float* W, int ldw, int K, int src_col0, bf16* WT, int dst_row0, const float* g, int kb, float* scr, int lane, bool frag = false) {
    const int k0 = 64 * kb; const int c = lane & 7;
    float wv[32];
#pragma unroll
    for (int i = 0; i < 32; ++i) wv[i] = __builtin_nontemporal_load(&W[(size_t)(k0 + 2 * i + (lane >> 5)) * ldw + src_col0 + (lane & 31)]);
    const float* gsrc = g ? g + k0 + 8 * c : W;
    const f32x4 ga = *(const f32x4*)gsrc, gb = *(const f32x4*)(gsrc + 4);
    const float g8[8] = {g ? ga[0] : 1.0f, g ? ga[1] : 1.0f, g ? ga[2] : 1.0f, g ? ga[3] : 1.0f, g ? gb[0] : 1.0f, g ? gb[1] : 1.0f, g ? gb[2] : 1.0f, g ? gb[3] : 1.0f};
#pragma unroll
    for (int i = 0; i < 32; ++i) { const int kk = 2 * i + (lane >> 5); scr[kk * 33 + (lane & 31)] = wv[i]; }
    asm volatile("s_waitcnt lgkmcnt(0)" ::: "memory");
#pragma unroll
    for (int j = 0; j < 4; ++j) { const int n = (lane >> 3) + 8 * j; const float* s = scr + (8 * c) * 33 + n;
        u32x4 o; o.x = pk2(s[0 * 33] * g8[0], s[1 * 33] * g8[1]); o.y = pk2(s[2 * 33] * g8[2], s[3 * 33] * g8[3]); o.z = pk2(s[4 * 33] * g8[4], s[5 * 33] * g8[5]); o.w = pk2(s[6 * 33] * g8[6], s[7 * 33] * g8[7]);
        if (frag) { const int nn = dst_row0 + n, kk = 8 * c; stwt16(WT + (size_t)((((nn >> 5) * 4 + (kk >> 4)) * 64 + ((kk >> 3) & 1) * 32 + (nn & 31)) * 8), o); }
        else stwt16(WT + (size_t)(dst_row0 + n) * K + k0 + 8 * c, o); }
    asm volatile("s_waitcnt lgkmcnt(0)" ::: "memory");
}
__device__ __forceinline__ void convert_layer(const Ctx& C, int l, float* sm, int first_blk, int nblk, int part = 0) {
    float* scr = sm + C.wave * (64 * 33 + 16);
    const int gw = (C.bid - first_blk) * NWAVES + C.wave, NGW = nblk * NWAVES;
    const bool even = (l & 1) == 0; const int li = l >> 1;
    const float* Win = even ? C.in(6) + (size_t)li * DM * EV_COLS : C.in(26) + (size_t)li * DM * OD_COLS;
    const float* Wout = even ? C.in(7) + (size_t)li * DM * DM : C.in(27) + (size_t)li * DM * DM;
    const float* Wup = C.in(3) + (size_t)l * DM * DFF; const float* Wdn = C.in(4) + (size_t)l * DFF * DM;
    const float* gmix = C.in(1) + (size_t)l * DM; const float* gmlp = C.in(2) + (size_t)l * DM;
    bf16* Tin = C.wset(l, WOFF_IN); bf16* Tout = C.wset(l, WOFF_OUT); bf16* Tup = C.wset(l, WOFF_UP); bf16* Tdn = C.wset(l, WOFF_DOWN);
    const int ldin = even ? EV_COLS : OD_COLS;
    const int nb_in = even ? EV_COLS / 32 : 3584 / 32;
    const int I_IN = 16 * nb_in, I_OUT = 16 * 32, I_UP = 16 * 128, I_DN = 64 * 32;
    const int I_G2 = even ? 32 : 0;
    const int I_LG = even ? 32 : 0;
    const int NIT = I_IN + I_OUT + I_UP + I_DN + I_G2 + I_LG;
    const int it_lo = part == 2 ? I_IN + I_OUT : 0, NITP = part == 2 ? I_UP + I_DN : (part == 1 ? NIT - I_UP - I_DN : NIT);
    for (int it = gw; it < NITP; it += NGW) {
        int r = it + it_lo; if (part == 1 && r >= I_IN + I_OUT) r += I_UP + I_DN;
        if (r < I_IN) { const int kb = r / nb_in, nb = r % nb_in; const int dst = 32 * nb; int src = dst; if (!even && dst >= 2048) src = dst + 8;
            transpose_item(Win, ldin, DM, src, Tin, dst, gmix, kb, scr, C.lane()); continue; } r -= I_IN;
        if (r < I_OUT) { transpose_item(Wout, DM, DM, 32 * (r % 32), Tout, 32 * (r % 32), nullptr, r / 32, scr, C.lane()); continue; } r -= I_OUT;
        if (r < I_UP) { transpose_item(Wup, DFF, DM, 32 * (r % 128), Tup, 32 * (r % 128), gmlp, r / 128, scr, C.lane()); continue; } r -= I_UP;
        if (r < I_DN) { transpose_item(Wdn, DM, DFF, 32 * (r % 32), Tdn, 32 * (r % 32), nullptr, r / 32, scr, C.lane()); continue; } r -= I_DN;
        if (r < I_G2) { transpose_item(C.in(20) + (size_t)li * 128 * 512, 512, 128, 32 * (r % 16), C.wset(l, WOFF_G2), 32 * (r % 16), nullptr, r / 16, scr, C.lane()); continue; } r -= I_G2;
        {   const int mat = r >> 4, blk = (r >> 1) & 7, nb = r & 1;
            transpose_item((mat ? C.in(12) : C.in(10)) + ((size_t)li * 8 + blk) * 4096, 64, 64, 32 * nb, C.wset(l, WOFF_LG) + (size_t)(mat * 8 + blk) * 4096, 32 * nb, nullptr, 0, scr, C.lane(), true); }
    }
    if (!even && part != 2) {
        const int gt = (C.bid - first_blk) * NTHREADS + C.tid(), NGT = nblk * NTHREADS;
        for (int i = gt; i < 16 * DM; i += NGT) { const int n = i >> 10, k = i & 1023; const int src = n < 8 ? 2048 + n : 3592 + (n - 8);
            Tin[(size_t)(3584 + n) * DM + k] = (bf16)f2bf(Win[(size_t)k * OD_COLS + src] * gmix[k]); }
        u32x4* z = (u32x4*)(Tin + (size_t)3600 * DM); const int nz = 240 * DM / 8;
        for (int i = gt; i < nz; i += NGT) z[i] = (u32x4){C.z0, C.z0, C.z0, C.z0};
    }
}

__device__ __forceinline__ void prologue_rows(const Ctx& C) {
    const int gw = C.vcu * NWAVES + C.wave, NGW = C.G * NWAVES;
    const float* x = C.in(0); bf16* XB = (bf16*)C.out; float* slots = GPTR(float, C.ws + WS_SLOTS);
    for (int m0 = gw; m0 < M; m0 += 4 * NGW) {
        f32x4 v[4][4];
#pragma unroll
        for (int q = 0; q < 4; ++q) { const int m = m0 + q * NGW; const f32x4* xr = (const f32x4*)(x + (size_t)m * DM) + C.lane();
#pragma unroll
            for (int j = 0; j < 4; ++j) v[q][j] = __builtin_nontemporal_load(xr + 64 * j); }
#pragma unroll
        for (int q = 0; q < 4; ++q) { const int m = m0 + q * NGW; u32x2* brow = (u32x2*)(XB + (size_t)m * DM) + C.lane(); float s = 0.f;
#pragma unroll
            for (int j = 0; j < 4; ++j) { u32x2 w; w.x = pk2(v[q][j][0], v[q][j][1]); w.y = pk2(v[q][j][2], v[q][j][3]); brow[64 * j] = w;
                const float r0 = __uint_as_float(w.x << 16), r1 = __uint_as_float(w.x & 0xffff0000u), r2 = __uint_as_float(w.y << 16), r3 = __uint_as_float(w.y & 0xffff0000u); s += (r0 * r0 + r1 * r1) + (r2 * r2 + r3 * r3); }
            s = wave_sum(s);
            if (C.lane() < 16) slots[(size_t)m * 16 + C.lane()] = (C.lane() == 0) ? s : 0.f; }
    }
}
__device__ __forceinline__ void final_rows(const Ctx& C) {
    const int gw = C.vcu * NWAVES + C.wave, NGW = C.G * NWAVES;
    const float* slots = GPTR(const float, C.ws + WS_SLOTS); const f32x4* g = (const f32x4*)C.in(5) + C.lane();
    for (int m0 = gw; m0 < M; m0 += 4 * NGW) {
        u32x2 w[4][4]; float rs[4];
#pragma unroll
        for (int q = 0; q < 4; ++q) { const int m = m0 + q * NGW; rs[q] = pg8::row_rstd(slots, m); const u32x2* brow = (const u32x2*)(GPTR(const bf16, C.ws + WS_XB) + (size_t)m * DM) + C.lane();
#pragma unroll
            for (int j = 0; j < 4; ++j) w[q][j] = __builtin_nontemporal_load(brow + 64 * j); }
#pragma unroll
        for (int q = 0; q < 4; ++q) { const int m = m0 + q * NGW; f32x4* orow = (f32x4*)(C.out + (size_t)m * DM) + C.lane();
#pragma unroll
            for (int j = 0; j < 4; ++j) { f32x4 v; v[0] = __uint_as_float(w[q][j].x << 16); v[1] = __uint_as_float(w[q][j].x & 0xffff0000u); v[2] = __uint_as_float(w[q][j].y << 16); v[3] = __uint_as_float(w[q][j].y & 0xffff0000u);
                v = v * rs[q] * g[64 * j]; __builtin_nontemporal_store(v, orow + 64 * j); } }
    }
}

__device__ __forceinline__ void lru_block(const Ctx& C, int e, int lb, float* sm) {
    const int tid = C.tid(), lane = C.lane(), wave = C.wave;
    const int b = lb >> 3, n = lb & 7;
    const bf16* P = GPTR(const bf16, C.ws + WS_R1); bf16* Y = GPTR(bf16, C.ws + WS_Y);
    const float* convw = C.in(8) + (size_t)e * 4 * 512; const float* convb = C.in(9) + (size_t)e * 512;
    const float* wa = C.in(10) + ((size_t)e * 8 + n) * 4096; const float* ba = C.in(11) + (size_t)e * 512;
    const float* wx = C.in(12) + ((size_t)e * 8 + n) * 4096; const float* bx = C.in(13) + (size_t)e * 512;
    const float* lam = C.in(14) + (size_t)e * 512;
    float* sWA = sm; float* sWX = sWA + 4096; float* sXC = sWX + 4096; float* sA = sXC + 4096; float* sU = sA + 4096; float* sH = sU + 4096;
    for (int i = tid; i < 4096; i += NTHREADS) { sWA[i] = wa[i]; sWX[i] = wx[i]; }
    float hc = 0.f;
    const int ct = tid >> 3, l8 = tid & 7;
    float cw[4][8], cb[8];
#pragma unroll
    for (int j = 0; j < 8; ++j) { const int c = n * 64 + 8 * l8 + j; cb[j] = convb[c];
#pragma unroll
        for (int k = 0; k < 4; ++k) cw[k][j] = convw[k * 512 + c]; }
    const int ce = n * 64 + lane;
    const float g_ba = ba[ce], g_bx = bx[ce], g_sp = softplusf(-lam[ce]);
    __syncthreads();
    for (int ch = 0; ch < SEQ / 64; ++ch) {
        const int t0 = ch * 64; const size_t m0 = (size_t)b * SEQ + t0;
        {
            float acc[8];
#pragma unroll
            for (int j = 0; j < 8; ++j) acc[j] = cb[j];
#pragma unroll
            for (int k = 0; k < 4; ++k) { const int t = t0 + ct - 3 + k;
                if (t >= 0) { float v[8]; ld8(P + ((size_t)b * SEQ + t) * EV_COLS + 512 + n * 64 + 8 * l8, v);
#pragma unroll
                    for (int j = 0; j < 8; ++j) acc[j] += cw[k][j] * v[j]; } }
            *(f32x4*)(sXC + ct * 64 + 8 * l8) = (f32x4){acc[0], acc[1], acc[2], acc[3]};
            *(f32x4*)(sXC + ct * 64 + 8 * l8 + 4) = (f32x4){acc[4], acc[5], acc[6], acc[7]};
        }
        __syncthreads();
        {
            float ar[8], ai[8];
#pragma unroll
            for (int q = 0; q < 8; ++q) { ar[q] = 0.f; ai[q] = 0.f; }
#pragma unroll 1
            for (int d = 0; d < 64; d += 4) {
                float war[4], wxr[4];
#pragma unroll
                for (int dd = 0; dd < 4; ++dd) { war[dd] = sWA[(d + dd) * 64 + lane]; wxr[dd] = sWX[(d + dd) * 64 + lane]; }
#pragma unroll
                for (int q = 0; q < 8; ++q) { const f32x4 xv = *(const f32x4*)(sXC + (wave * 8 + q) * 64 + d);
#pragma unroll
                    for (int dd = 0; dd < 4; ++dd) { ar[q] += xv[dd] * war[dd]; ai[q] += xv[dd] * wxr[dd]; } }
            }
#pragma unroll
            for (int q = 0; q < 8; ++q) { const int t = wave * 8 + q;
                const float r = sigm(ar[q] + g_ba), ig = sigm(ai[q] + g_bx);
                const float log_a = -8.0f * r * g_sp; const float a = fexp(log_a);
                float mult = sqrtf(-expm1f(2.0f * log_a)); if (t0 + t == 0) mult = 1.0f;
                sA[t * 64 + lane] = a; sU[t * 64 + lane] = ig * sXC[t * 64 + lane] * mult; }
        }
        __syncthreads();
        if (wave == 0) {
#pragma unroll 8
            for (int t = 0; t < 64; ++t) { hc = sA[t * 64 + lane] * hc + sU[t * 64 + lane]; sH[t * 64 + lane] = hc; }
        }
        __syncthreads();
        {
            float gv[8]; ld8(P + (m0 + ct) * EV_COLS + n * 64 + 8 * l8, gv);
            const f32x4 h0 = *(const f32x4*)(sH + ct * 64 + 8 * l8), h1 = *(const f32x4*)(sH + ct * 64 + 8 * l8 + 4);
            u32x4 w; w.x = pk2(h0[0] * gelu_tanh(gv[0]), h0[1] * gelu_tanh(gv[1])); w.y = pk2(h0[2] * gelu_tanh(gv[2]), h0[3] * gelu_tanh(gv[3]));
            w.z = pk2(h1[0] * gelu_tanh(gv[4]), h1[1] * gelu_tanh(gv[5])); w.w = pk2(h1[2] * gelu_tanh(gv[6]), h1[3] * gelu_tanh(gv[7]));
            *(u32x4*)(Y + (m0 + ct) * DM + n * 64 + 8 * l8) = w;
        }
    }
}

constexpr int RW_TC = 32;
__device__ __forceinline__ void rwkv_block(const Ctx& C, int e, int rb, float* sm) {
    const int tid = C.tid(), lane = C.lane(), wave = C.wave;
    const int bh = rb >> 1, half = rb & 1, b = bh >> 3, h = bh & 7;
    const bf16* P = GPTR(const bf16, C.ws + WS_R1); float* yraw = GPTR(float, C.ws + WS_XB); float* bonus = GPTR(float, C.ws + WS_BONUS);
    const float* mu = C.in(15) + (size_t)e * 1792; const float* w0 = C.in(16) + (size_t)e * 512; const float* w2 = C.in(17) + (size_t)e * 64 * 512;
    const float* a0 = C.in(18) + (size_t)e * 512; const float* a2 = C.in(19) + (size_t)e * 64 * 512;
    const float* kkp = C.in(21) + (size_t)e * 512; const float* kap = C.in(22) + (size_t)e * 512; const float* rkp = C.in(23) + (size_t)e * 512;
    float* sW2 = sm; float* sA2 = sW2 + 4096; float* sXW = sA2 + 4096; float* sXA = sXW + 2048;
    float* cW = sXA + 2048; float* cKK = cW + 2048; float* cB = cKK + 2048; float* cK = cB + 2048; float* cR = cK + 2048;
    float* cV = cR + 2048; float* sY = cV + 1024;
    for (int i = tid; i < 4096; i += NTHREADS) { const int j = i >> 6, c = i & 63; sW2[i] = w2[(size_t)j * 512 + h * 64 + c]; sA2[i] = a2[(size_t)j * 512 + h * 64 + c]; }
    const int tt = tid >> 4, l16 = tid & 15;
    float mur[4], muk[4], muv[4], muw[4], mua[4];
#pragma unroll
    for (int j = 0; j < 4; ++j) { const int c = 4 * l16 + j; mur[j] = mu[h * 64 + c]; muk[j] = mu[512 + h * 64 + c]; muv[j] = mu[1024 + h * 64 + c]; muw[j] = mu[1536 + c]; mua[j] = mu[1600 + c]; }
    const int hc = h * 64 + lane;
    const float p_w0 = w0[hc], p_a0 = a0[hc], p_kk = kkp[hc], p_ka = kap[hc], p_rk = rkp[hc];
    float S[4] = {0.f, 0.f, 0.f, 0.f};
    __syncthreads();
    for (int ch = 0; ch < SEQ / RW_TC; ++ch) {
        const int t0 = ch * RW_TC; const size_t m0 = (size_t)b * SEQ + t0;
        {
            const bf16* row = P + (m0 + tt) * EV_COLS; const bool hp = (t0 + tt) > 0; const bf16* prow = row - EV_COLS;
            float c4[4], p4[4], o[4];
#define SHIFT4(col, muv_) do { ld4(row + (col), c4); if (hp) ld4(prow + (col), p4); else { p4[0] = p4[1] = p4[2] = p4[3] = 0.f; } \
            _Pragma("unroll") for (int j = 0; j < 4; ++j) o[j] = c4[j] + muv_[j] * (p4[j] - c4[j]); } while (0)
            SHIFT4(EC_R + h * 64 + 4 * l16, mur); *(f32x4*)(cR + tt * 64 + 4 * l16) = (f32x4){o[0], o[1], o[2], o[3]};
            SHIFT4(EC_K + h * 64 + 4 * l16, muk); *(f32x4*)(cK + tt * 64 + 4 * l16) = (f32x4){o[0], o[1], o[2], o[3]};
            SHIFT4(EC_V + h * 64 + 4 * l16, muv); if ((l16 >> 3) == half) *(f32x4*)(cV + tt * 32 + 4 * (l16 & 7)) = (f32x4){o[0], o[1], o[2], o[3]};
            SHIFT4(EC_XW + 4 * l16, muw); *(f32x4*)(sXW + tt * 64 + 4 * l16) = (f32x4){ftanh(o[0]), ftanh(o[1]), ftanh(o[2]), ftanh(o[3])};
            SHIFT4(EC_XA + 4 * l16, mua); *(f32x4*)(sXA + tt * 64 + 4 * l16) = (f32x4){o[0], o[1], o[2], o[3]};
#undef SHIFT4
        }
        __syncthreads();
        {
            float zw[4] = {0.f, 0.f, 0.f, 0.f}, za[4] = {0.f, 0.f, 0.f, 0.f};
#pragma unroll 1
            for (int j = 0; j < 64; j += 4) {
                float w2v[4], a2v[4];
#pragma unroll
                for (int jj = 0; jj < 4; ++jj) { w2v[jj] = sW2[(j + jj) * 64 + lane]; a2v[jj] = sA2[(j + jj) * 64 + lane]; }
#pragma unroll
                for (int q = 0; q < 4; ++q) { const f32x4 xw = *(const f32x4*)(sXW + (wave * 4 + q) * 64 + j), xa = *(const f32x4*)(sXA + (wave * 4 + q) * 64 + j);
#pragma unroll
                    for (int jj = 0; jj < 4; ++jj) { zw[q] += xw[jj] * w2v[jj]; za[q] += xa[jj] * a2v[jj]; } }
            }
#pragma unroll
            for (int q = 0; q < 4; ++q) { const int t = wave * 4 + q;
                const float wlog = -softplusf(-(p_w0 + zw[q])) - 0.5f; const float dec = fexp(-fexp(wlog));
                const float a = sigm(p_a0 + za[q]);
                const float kraw = cK[t * 64 + lane], r = cR[t * 64 + lane];
                const float kkv = kraw * p_kk; const float ss = wave_sum(kkv * kkv); const float kkn = kkv * (frsq(ss + 1e-6f));
                const float kp = kraw * (1.0f + (a - 1.0f) * p_ka);
                const float bon = wave_sum(r * kp * p_rk);
                if (half == 0 && lane == 0) bonus[(m0 + t) * 8 + h] = bon;
                cW[t * 64 + lane] = dec; cKK[t * 64 + lane] = kkn; cB[t * 64 + lane] = kkn * a; cK[t * 64 + lane] = kp; }
        }
        __syncthreads();
        {
            const int row = tid >> 4;
#pragma unroll 4
            for (int t = 0; t < RW_TC; ++t) {
                const f32x4 w4 = *(const f32x4*)(cW + t * 64 + 4 * l16), kk4 = *(const f32x4*)(cKK + t * 64 + 4 * l16), b4 = *(const f32x4*)(cB + t * 64 + 4 * l16);
                const f32x4 k4 = *(const f32x4*)(cK + t * 64 + 4 * l16), r4 = *(const f32x4*)(cR + t * 64 + 4 * l16);
                const float v = cV[t * 32 + row];
                float sk = (S[0] * kk4[0] + S[1] * kk4[1]) + (S[2] * kk4[2] + S[3] * kk4[3]);
                sk = row_sum16(sk);
#pragma unroll
                for (int j = 0; j < 4; ++j) S[j] = (S[j] * w4[j] + v * k4[j]) - sk * b4[j];
                float y = (S[0] * r4[0] + S[1] * r4[1]) + (S[2] * r4[2] + S[3] * r4[3]);
                y = row_sum16(y);
                if (l16 == 0) sY[t * 32 + row] = y;
            }
        }
        __syncthreads();
#pragma unroll
        for (int i = 0; i < 2; ++i) { const int idx = tid + i * NTHREADS, t = idx >> 5, rr = idx & 31; yraw[(m0 + t) * 512 + h * 64 + 32 * half + rr] = sY[idx]; }
    }
}

__device__ __forceinline__ void rwkv_post_tile(const Ctx& C, int e, int tile, float* sm) {
    const int tid = C.tid(), lane = C.lane(), wave = C.wave;
    const bf16* P = GPTR(const bf16, C.ws + WS_R1); const float* yraw = GPTR(const float, C.ws + WS_XB); const float* bonus = GPTR(const float, C.ws + WS_BONUS); bf16* Y = GPTR(bf16, C.ws + WS_Y);
    const float* mu = C.in(15) + (size_t)e * 1792; const float* g2 = C.in(20) + (size_t)e * 128 * 512;
    const float* lnw = C.in(24) + (size_t)e * 512; const float* lnb = C.in(25) + (size_t)e * 512;
    const size_t m0 = (size_t)tile * 64; const int t0 = (int)(m0 % SEQ);
    float* sG = sm;
    __syncthreads();
    for (int i = 0; i < 16; ++i) { const int idx = tid + i * NTHREADS, t = idx >> 7, j = idx & 127;
        const float p = bf2f(P[(m0 + t) * EV_COLS + EC_XG + j]); const float pp = (t0 + t) > 0 ? bf2f(P[(m0 + t - 1) * EV_COLS + EC_XG + j]) : 0.f;
        sG[idx] = sigm(p + mu[1664 + j] * (pp - p)); }
    __syncthreads();
    const int c = tid;
    float acc[64];
#pragma unroll
    for (int t = 0; t < 64; ++t) acc[t] = 0.f;
#pragma unroll 1
    for (int j = 0; j < 128; j += 4) {
        const float g0 = g2[(size_t)(j + 0) * 512 + c], g1 = g2[(size_t)(j + 1) * 512 + c], g2v = g2[(size_t)(j + 2) * 512 + c], g3 = g2[(size_t)(j + 3) * 512 + c];
#pragma unroll
        for (int t = 0; t < 64; ++t) { const f32x4 s = *(const f32x4*)(sG + t * 128 + j); acc[t] += (s[0] * g0 + s[1] * g1) + (s[2] * g2v + s[3] * g3); }
    }
    __syncthreads();
#pragma unroll
    for (int t = 0; t < 64; ++t) sm[t * 512 + c] = acc[t];
    const float p_lnw = lnw[c], p_lnb = lnb[c], p_muv = mu[1024 + c];
#pragma unroll 2
    for (int t = 0; t < 64; ++t) { const size_t m = m0 + t;
        const float y = yraw[m * 512 + c]; const float mean = wave_sum(y) * (1.0f / 64.0f); const float d = y - mean; const float var = wave_sum(d * d) * (1.0f / 64.0f);
        const float yn = d * (frsq(var + 64e-5f)) * p_lnw + p_lnb;
        const float pv = bf2f(P[m * EV_COLS + EC_V + c]); const float pvp = (t0 + t) > 0 ? bf2f(P[(m - 1) * EV_COLS + EC_V + c]) : 0.f; const float vs = pv + p_muv * (pvp - pv);
        Y[m * DM + 512 + c] = (bf16)f2bf((yn + bonus[m * 8 + wave] * vs) * sm[t * 512 + c]); }
}

constexpr int OD_TC = 32;
__device__ __forceinline__ void gdn_block(const Ctx& C, int o, int gb, float* sm) {
    const int tid = C.tid();
    const int bh = gb >> 2, cgp = gb & 3, b = bh >> 2, h = bh & 3;
    const bf16* P = GPTR(const bf16, C.ws + WS_R1); bf16* oraw = GPTR(bf16, C.ws + WS_Y);
    const float* convw = C.in(28) + (size_t)o * 4 * 1536;
    const float nA = -fexp(C.in(29)[o * 4 + h]); const float dtb = C.in(30)[o * 4 + h];
    float* cQ = sm; float* cK = cQ + 4096; float* cV = cK + 4096; float* cAl = cV + 1024; float* cBe = cAl + 32; float* cQK = cBe + 32; float* sO = cQK + 32;
    const int tt = tid >> 4, l16 = tid & 15;
    const int qc = h * 128 + 8 * l16, kc = 512 + h * 128 + 8 * l16, vc = 1024 + h * 128 + 32 * cgp + 2 * l16;
    float wq[4][8], wk[4][8], wv[4][2];
#pragma unroll
    for (int k = 0; k < 4; ++k) {
#pragma unroll
        for (int j = 0; j < 8; ++j) { wq[k][j] = convw[k * 1536 + qc + j]; wk[k][j] = convw[k * 1536 + kc + j]; }
        wv[k][0] = convw[k * 1536 + vc]; wv[k][1] = convw[k * 1536 + vc + 1]; }
    float S[8];
#pragma unroll
    for (int j = 0; j < 8; ++j) S[j] = 0.f;
    for (int ch = 0; ch < SEQ / OD_TC; ++ch) {
        const int t0 = ch * OD_TC; const size_t m0 = (size_t)b * SEQ + t0;
        __syncthreads();
        {
            float q[8], kx[8], v2[2] = {0.f, 0.f};
#pragma unroll
            for (int j = 0; j < 8; ++j) { q[j] = 0.f; kx[j] = 0.f; }
#pragma unroll
            for (int k = 0; k < 4; ++k) { const int t = t0 + tt - 3 + k;
                if (t >= 0) { const bf16* row = P + ((size_t)b * SEQ + t) * OD_PAD; float a8[8], b8[8], c2[2]; ld8(row + qc, a8); ld8(row + kc, b8); ld2(row + vc, c2);
#pragma unroll
                    for (int j = 0; j < 8; ++j) { q[j] += wq[k][j] * a8[j]; kx[j] += wk[k][j] * b8[j]; }
                    v2[0] += wv[k][0] * c2[0]; v2[1] += wv[k][1] * c2[1]; } }
            float sq = 0.f, sk = 0.f;
#pragma unroll
            for (int j = 0; j < 8; ++j) { q[j] = siluf(q[j]); kx[j] = siluf(kx[j]); sq += q[j] * q[j]; sk += kx[j] * kx[j]; }
            sq = row_sum16(sq); sk = row_sum16(sk);
            const float rq = (frsq(sq + 1e-6f)) * 0.08838834764831845f, rk = frsq(sk + 1e-6f);
            float qk = 0.f;
#pragma unroll
            for (int j = 0; j < 8; ++j) { q[j] *= rq; kx[j] *= rk; qk += q[j] * kx[j]; }
            qk = row_sum16(qk);
            *(f32x4*)(cQ + tt * 128 + 8 * l16) = (f32x4){q[0], q[1], q[2], q[3]}; *(f32x4*)(cQ + tt * 128 + 8 * l16 + 4) = (f32x4){q[4], q[5], q[6], q[7]};
            *(f32x4*)(cK + tt * 128 + 8 * l16) = (f32x4){kx[0], kx[1], kx[2], kx[3]}; *(f32x4*)(cK + tt * 128 + 8 * l16 + 4) = (f32x4){kx[4], kx[5], kx[6], kx[7]};
            cV[tt * 32 + 2 * l16] = siluf(v2[0]); cV[tt * 32 + 2 * l16 + 1] = siluf(v2[1]);
            if (l16 == 0) { const bf16* row = P + (m0 + tt) * OD_PAD; const float braw = bf2f(row[OC_GB + h]), araw = bf2f(row[OC_GA + h]);
                cBe[tt] = sigm(braw); cAl[tt] = fexp(nA * softplusf(araw + dtb)); cQK[tt] = qk; }
        }
        __syncthreads();
        {
            const int col = tid >> 4;
#pragma unroll 2
            for (int t = 0; t < OD_TC; ++t) {
                const f32x4 k0 = *(const f32x4*)(cK + t * 128 + 8 * l16), k1 = *(const f32x4*)(cK + t * 128 + 8 * l16 + 4);
                const f32x4 q0 = *(const f32x4*)(cQ + t * 128 + 8 * l16), q1 = *(const f32x4*)(cQ + t * 128 + 8 * l16 + 4);
                const float v = cV[t * 32 + col], al = cAl[t], be = cBe[t], qk = cQK[t];
                float kS = ((S[0] * k0[0] + S[1] * k0[1]) + (S[2] * k0[2] + S[3] * k0[3])) + ((S[4] * k1[0] + S[5] * k1[1]) + (S[6] * k1[2] + S[7] * k1[3]));
                float qS = ((S[0] * q0[0] + S[1] * q0[1]) + (S[2] * q0[2] + S[3] * q0[3])) + ((S[4] * q1[0] + S[5] * q1[1]) + (S[6] * q1[2] + S[7] * q1[3]));
                kS = row_sum16(kS); qS = row_sum16(qS);
                const float delta = be * (v - al * kS);
#pragma unroll
                for (int j = 0; j < 4; ++j) { S[j] = al * S[j] + k0[j] * delta; S[4 + j] = al * S[4 + j] + k1[j] * delta; }
                if (l16 == 0) sO[t * 32 + col] = al * qS + qk * delta;
            }
        }
        __syncthreads();
#pragma unroll
        for (int i = 0; i < 2; ++i) { const int idx = tid + i * NTHREADS, t = idx >> 5, cc = idx & 31; oraw[(m0 + t) * DM + h * 128 + 32 * cgp + cc] = (bf16)f2bf(sO[idx]); }
    }
}

__device__ __forceinline__ void mlstm_block(const Ctx& C, int o, int mb, float* sm) {
    const int tid = C.tid();
    const int bh = mb / 5, cgp = mb % 5, b = bh >> 2, h = bh & 3;
    const bf16* P = GPTR(const bf16, C.ws + WS_R1); float* nraw = GPTR(float, C.ws + WS_XB); float* den = GPTR(float, C.ws + WS_DEN);
    const float* convw = C.in(32) + (size_t)o * 4 * 512;
    const float igb = C.in(33)[o * 4 + h], fgb = C.in(34)[o * 4 + h];
    float* cQ = sm; float* cIK = cQ + 2048; float* cV = cIK + 2048; float* cF = cV + 1024; float* sO = cF + 32;
    const int tt = tid >> 4, l16 = tid & 15;
    const int qc = h * 64 + 4 * l16, kc = 256 + h * 64 + 4 * l16;
    float wq[4][4], wk[4][4];
#pragma unroll
    for (int k = 0; k < 4; ++k)
#pragma unroll
        for (int j = 0; j < 4; ++j) { wq[k][j] = convw[k * 512 + qc + j]; wk[k][j] = convw[k * 512 + kc + j]; }
    float Cs[4] = {0.f, 0.f, 0.f, 0.f};
    for (int ch = 0; ch < SEQ / OD_TC; ++ch) {
        const int t0 = ch * OD_TC; const size_t m0 = (size_t)b * SEQ + t0;
        __syncthreads();
        {
            float q[4] = {0.f, 0.f, 0.f, 0.f}, kx[4] = {0.f, 0.f, 0.f, 0.f};
#pragma unroll
            for (int k = 0; k < 4; ++k) { const int t = t0 + tt - 3 + k;
                if (t >= 0) { const bf16* row = P + ((size_t)b * SEQ + t) * OD_PAD + OC_MQK; float a4[4], b4[4]; ld4(row + qc, a4); ld4(row + kc, b4);
#pragma unroll
                    for (int j = 0; j < 4; ++j) { q[j] += wq[k][j] * a4[j]; kx[j] += wk[k][j] * b4[j]; } } }
            const bf16* row = P + (m0 + tt) * OD_PAD;
            const float ei = fexp(bf2f(row[OC_MI + h]) + igb);
            *(f32x4*)(cQ + tt * 64 + 4 * l16) = (f32x4){siluf(q[0]) * 0.125f, siluf(q[1]) * 0.125f, siluf(q[2]) * 0.125f, siluf(q[3]) * 0.125f};
            *(f32x4*)(cIK + tt * 64 + 4 * l16) = (f32x4){siluf(kx[0]) * ei, siluf(kx[1]) * ei, siluf(kx[2]) * ei, siluf(kx[3]) * ei};
            if (cgp < 4) { float c2[2]; ld2(row + OC_MV + h * 128 + 32 * cgp + 2 * l16, c2); cV[tt * 32 + 2 * l16] = c2[0]; cV[tt * 32 + 2 * l16 + 1] = c2[1]; }
            else { cV[tt * 32 + 2 * l16] = 1.0f; cV[tt * 32 + 2 * l16 + 1] = 1.0f; }
            if (l16 == 0) cF[tt] = sigm(bf2f(row[OC_MF + h]) + fgb);
        }
        __syncthreads();
        {
            const int col = tid >> 4;
#pragma unroll 4
            for (int t = 0; t < OD_TC; ++t) {
                const f32x4 ik = *(const f32x4*)(cIK + t * 64 + 4 * l16), q4 = *(const f32x4*)(cQ + t * 64 + 4 * l16);
                const float v = cV[t * 32 + col], f = cF[t];
#pragma unroll
                for (int j = 0; j < 4; ++j) Cs[j] = f * Cs[j] + v * ik[j];
                float nm = (Cs[0] * q4[0] + Cs[1] * q4[1]) + (Cs[2] * q4[2] + Cs[3] * q4[3]);
                nm = row_sum16(nm);
                if (l16 == 0) sO[t * 32 + col] = nm;
            }
        }
        __syncthreads();
        if (cgp < 4) {
#pragma unroll
            for (int i = 0; i < 2; ++i) { const int idx = tid + i * NTHREADS, t = idx >> 5, cc = idx & 31; nraw[(m0 + t) * 512 + h * 128 + 32 * cgp + cc] = sO[idx]; }
        } else if (tid < OD_TC) den[(m0 + tid) * 4 + h] = sO[tid * 32];
    }
}

__device__ __forceinline__ void odd_post(const Ctx& C, int o, bool rep = false) {
    const int gw = C.vcu * NWAVES + C.wave, NGW = C.G * NWAVES, lane = C.lane();
    const bf16* P = GPTR(const bf16, C.ws + WS_R1); const float* den = GPTR(const float, C.ws + WS_BONUS);
    bf16* Y = GPTR(bf16, C.ws + WS_Y); bf16* Yo = rep ? GPTR(bf16, C.ws + WS_XB) : Y;
    const float* gng = C.in(31) + (size_t)o * 128; const float* mng = C.in(35) + (size_t)o * 128;
    float gg[8], mg[8];
#pragma unroll
    for (int j = 0; j < 8; ++j) { gg[j] = gng[(8 * lane + j) & 127]; mg[j] = mng[(8 * lane + j) & 127]; }
    for (int mb = gw; mb < M; mb += 4 * NGW) {
        u32x4 rov[4], rnv[4], rz[4], rog[4]; float dn4[4];
#pragma unroll
        for (int q = 0; q < 4; ++q) { const int m = mb + q * NGW;
            rov[q] = *(const u32x4*)(Y + (size_t)m * DM + 8 * lane); rnv[q] = *(const u32x4*)(Y + (size_t)m * DM + 512 + 8 * lane);
            dn4[q] = den[(size_t)m * 4 + (lane >> 4)];
            rz[q] = *(const u32x4*)(P + (size_t)m * OD_PAD + OC_Z + 8 * lane); rog[q] = *(const u32x4*)(P + (size_t)m * OD_PAD + OC_MOG + 8 * lane); }
#pragma unroll
        for (int q = 0; q < 4; ++q) { const int m = mb + q * NGW;
            float ov[8], nv[8], z8[8], og8[8]; unpk8(rov[q], ov); unpk8(rnv[q], nv); unpk8(rz[q], z8); unpk8(rog[q], og8);
            const float inv = 1.0f / fmaxf(fabsf(dn4[q]), 1.0f);
            float s1 = 0.f, s2 = 0.f;
#pragma unroll
            for (int j = 0; j < 8; ++j) { nv[j] *= inv; s1 += ov[j] * ov[j]; s2 += nv[j] * nv[j]; }
            s1 = row_sum16(s1); s2 = row_sum16(s2);
            const float r1 = frsq(s1 * (1.0f / 128.0f) + 1e-6f), r2 = frsq(s2 * (1.0f / 128.0f) + 1e-6f);
            float y1[8], y2[8];
#pragma unroll
            for (int j = 0; j < 8; ++j) { y1[j] = ov[j] * r1 * gg[j] * siluf(z8[j]); y2[j] = nv[j] * r2 * mg[j] * sigm(og8[j]); }
            u32x4 w1, w2; w1.x = pk2(y1[0], y1[1]); w1.y = pk2(y1[2], y1[3]); w1.z = pk2(y1[4], y1[5]); w1.w = pk2(y1[6], y1[7]);
            w2.x = pk2(y2[0], y2[1]); w2.y = pk2(y2[2], y2[3]); w2.z = pk2(y2[4], y2[5]); w2.w = pk2(y2[6], y2[7]);
            stwt16(Yo + (size_t)m * DM + 8 * lane, w1); stwt16(Yo + (size_t)m * DM + 512 + 8 * lane, w2); }
    }
}

typedef short bf16x8 __attribute__((ext_vector_type(8)));
typedef short bf16x4 __attribute__((ext_vector_type(4)));
typedef float f32x16 __attribute__((ext_vector_type(16)));
__device__ __forceinline__ f32x16 mfma32(bf16x8 a, bf16x8 b, f32x16 c) { return __builtin_amdgcn_mfma_f32_32x32x16_bf16(a, b, c, 0, 0, 0); }
__device__ __forceinline__ bf16x8 ldfrag(const bf16* p) { return *(const bf16x8*)p; }
__device__ __forceinline__ int drow(int g, int hh) { return (g & 3) + 8 * (g >> 2) + 4 * hh; }
__device__ __forceinline__ float logsigm(float x) { return -softplusf(-x); }
constexpr int LD64 = 72, LD128 = 136;

__device__ __forceinline__ void mlstm_chunk_block(const Ctx& C, int o, int mb, unsigned char* lds) {
    const int tid = C.tid(), lane = C.lane(), w = C.wave, r = lane & 31, hh = lane >> 5;
    const int b = mb >> 2, h = mb & 3;
    const bf16* P = GPTR(const bf16, C.ws + WS_R1); bf16* Y = GPTR(bf16, C.ws + WS_Y); float* den = GPTR(float, C.ws + WS_DEN);
    const float* convw = C.in(32) + (size_t)o * 4 * 512;
    const float igb = C.in(33)[o * 4 + h], fgb = C.in(34)[o * 4 + h];
    bf16* Qh = (bf16*)lds; bf16* Kh = Qh + 64 * LD64; bf16* QD = Kh + 64 * LD64; bf16* KTT = QD + 64 * LD64; bf16* Wm = KTT + 64 * LD64;
    bf16* VT = Wm + 64 * LD64; bf16* CT0 = VT + 160 * LD64; bf16* CT1 = CT0 + 160 * LD64;
    float* sB = (float*)(CT1 + 160 * LD64); float* sI = sB + 64;
    for (int i = tid; i < 2 * 160 * LD64 / 2; i += NTHREADS) ((unsigned*)CT0)[i] = 0u;
    for (int i = tid; i < 32 * LD64; i += NTHREADS) VT[128 * LD64 + i] = (i < 64) ? (bf16)0x3F80 : (bf16)0;
    const int l16 = tid & 15, typ = (tid >> 4) & 1, tg = tid >> 5;
    const int pc = OC_MQK + (typ ? 256 : 0) + h * 64 + 4 * l16;
    float cw[4][4];
#pragma unroll
    for (int k = 0; k < 4; ++k)
#pragma unroll
        for (int j = 0; j < 4; ++j) cw[k][j] = convw[k * 512 + (typ ? 256 : 0) + h * 64 + 4 * l16 + j];
    const int th = w >> 2, vj = w & 3; const bool two = (vj == 0);
    f32x16 Ca, Cb;
#pragma unroll
    for (int g = 0; g < 16; ++g) { Ca[g] = C.zf(); Cb[g] = C.zf(); }
    int cur = 0;
    u32x2 px[7]; u32x4 pva, pvb; unsigned pgi = 0, pgf = 0;
    const int vt = tid & 63, vg = tid >> 6;
#define ML_PF(ch_) do { _Pragma("unroll") for (int i = 0; i < 7; ++i) { const int t_ = 64 * (ch_) + 4 * tg - 3 + i; \
            if (t_ >= 0) px[i] = *(const u32x2*)(P + ((size_t)b * SEQ + t_) * OD_PAD + pc); else px[i] = (u32x2){C.z0, C.z0}; } \
        { const bf16* vr_ = P + ((size_t)b * SEQ + 64 * (ch_) + vt) * OD_PAD; pva = *(const u32x4*)(vr_ + OC_MV + h * 128 + 16 * vg); pvb = *(const u32x4*)(vr_ + OC_MV + h * 128 + 16 * vg + 8); pgi = vr_[OC_MI + h]; pgf = vr_[OC_MF + h]; } } while (0)
    ML_PF(0);
    __syncthreads();
    for (int ch = 0; ch < SEQ / 64; ++ch) {
        const int t0 = ch * 64; const size_t m0 = (size_t)b * SEQ + t0;
        {
            float x[7][4];
#pragma unroll
            for (int i = 0; i < 7; ++i) { x[i][0] = bf2f(px[i].x & 0xffffu); x[i][1] = bf2f(px[i].x >> 16); x[i][2] = bf2f(px[i].y & 0xffffu); x[i][3] = bf2f(px[i].y >> 16); }
#pragma unroll
            for (int tt = 0; tt < 4; ++tt) { float o4[4];
#pragma unroll
                for (int j = 0; j < 4; ++j) { float a = 0.f;
#pragma unroll
                    for (int k = 0; k < 4; ++k) a += cw[k][j] * x[tt + k][j];
                    a = siluf(a); o4[j] = typ ? a : a * 0.125f; }
                u32x2 pk; pk.x = pk2(o4[0], o4[1]); pk.y = pk2(o4[2], o4[3]);
                *(u32x2*)((typ ? Kh : Qh) + (4 * tg + tt) * LD64 + 4 * l16) = pk; }
            {   const int t = vt; const unsigned wv[8] = {pva.x, pva.y, pva.z, pva.w, pvb.x, pvb.y, pvb.z, pvb.w};
#pragma unroll
                for (int q = 0; q < 8; ++q) { VT[(16 * vg + 2 * q) * LD64 + t] = (bf16)(wv[q] & 0xffffu); VT[(16 * vg + 2 * q + 1) * LD64 + t] = (bf16)(wv[q] >> 16); } }
            if (tid < 64) { const float ip = bf2f(pgi) + igb; float lf = logsigm(bf2f(pgf) + fgb);
#pragma unroll
                for (int d = 1; d < 64; d <<= 1) { const float up = __shfl_up(lf, d); if (lane >= d) lf += up; }
                sB[tid] = lf; sI[tid] = ip; }
            if (ch + 1 < SEQ / 64) ML_PF(ch + 1);
        }
        lds_barrier();
        if (w < 4) {
            const int ti = w >> 1, tj = w & 1;
            f32x16 acc;
#pragma unroll
            for (int g = 0; g < 16; ++g) acc[g] = C.zf();
            if (tj <= ti) {
#pragma unroll
                for (int s = 0; s < 4; ++s) acc = mfma32(ldfrag(Kh + (32 * tj + r) * LD64 + 16 * s + 8 * hh), ldfrag(Qh + (32 * ti + r) * LD64 + 16 * s + 8 * hh), acc);
            }
            const int i = 32 * ti + r; const float bi = sB[i];
#pragma unroll
            for (int g4 = 0; g4 < 4; ++g4) { float v4[4];
#pragma unroll
                for (int q = 0; q < 4; ++q) { const int j = 32 * tj + 8 * g4 + 4 * hh + q; v4[q] = (j <= i) ? acc[4 * g4 + q] * fexp(bi - sB[j] + sI[j]) : 0.f; }
                u32x2 pk; pk.x = pk2(v4[0], v4[1]); pk.y = pk2(v4[2], v4[3]);
                *(u32x2*)(Wm + i * LD64 + 32 * tj + 8 * g4 + 4 * hh) = pk; }
        } else {
            const int lt = tid - 256;
            {   const int t = lt >> 2, kq = lt & 3; const float eb = fexp(sB[t]);
#pragma unroll
                for (int q = 0; q < 2; ++q) { float v8[8]; ld8(Qh + t * LD64 + 16 * kq + 8 * q, v8);
                    u32x4 pk; pk.x = pk2(v8[0] * eb, v8[1] * eb); pk.y = pk2(v8[2] * eb, v8[3] * eb); pk.z = pk2(v8[4] * eb, v8[5] * eb); pk.w = pk2(v8[6] * eb, v8[7] * eb);
                    *(u32x4*)(QD + t * LD64 + 16 * kq + 8 * q) = pk; } }
            {   const int k = lt & 63, tq = lt >> 6; const float bl = sB[63];
                float v16[16];
#pragma unroll
                for (int q = 0; q < 16; ++q) { const int t = 16 * tq + q; v16[q] = bf2f(Kh[t * LD64 + k]) * fexp(bl - sB[t] + sI[t]); }
                u32x4 p0, p1; p0.x = pk2(v16[0], v16[1]); p0.y = pk2(v16[2], v16[3]); p0.z = pk2(v16[4], v16[5]); p0.w = pk2(v16[6], v16[7]);
                p1.x = pk2(v16[8], v16[9]); p1.y = pk2(v16[10], v16[11]); p1.z = pk2(v16[12], v16[13]); p1.w = pk2(v16[14], v16[15]);
                *(u32x4*)(KTT + k * LD64 + 16 * tq) = p0; *(u32x4*)(KTT + k * LD64 + 16 * tq + 8) = p1; }
        }
        lds_barrier();
        {
            const bf16* CTc = cur ? CT1 : CT0; bf16* CTn = cur ? CT0 : CT1;
            const float F = fexp(sB[63]);
#pragma unroll
            for (int q = 0; q < 2; ++q) {
                if (q == 1 && !two) break;
                const int vjj = q == 0 ? vj : 4;
                bf16x8 vf[4];
                f32x16 num;
#pragma unroll
                for (int g = 0; g < 16; ++g) num[g] = C.zf();
#pragma unroll
                for (int s = 0; s < 4; ++s) { vf[s] = ldfrag(VT + (32 * vjj + r) * LD64 + 16 * s + 8 * hh);
                    num = mfma32(ldfrag(QD + (32 * th + r) * LD64 + 16 * s + 8 * hh), ldfrag(CTc + (32 * vjj + r) * LD64 + 16 * s + 8 * hh), num); }
#pragma unroll
                for (int s = 0; s < 4; ++s) num = mfma32(ldfrag(Wm + (32 * th + r) * LD64 + 16 * s + 8 * hh), vf[s], num);
                if (vjj < 4) {
#pragma unroll
                    for (int g = 0; g < 16; ++g) Y[(m0 + 32 * th + drow(g, hh)) * DM + 512 + h * 128 + 32 * vjj + r] = (bf16)f2bf(num[g]);
                } else if (r == 0) {
#pragma unroll
                    for (int g = 0; g < 16; ++g) den[(m0 + 32 * th + drow(g, hh)) * 4 + h] = num[g];
                }
                f32x16 cacc = q == 0 ? Ca : Cb;
#pragma unroll
                for (int g = 0; g < 16; ++g) cacc[g] *= F;
#pragma unroll
                for (int s = 0; s < 4; ++s) cacc = mfma32(ldfrag(KTT + (32 * th + r) * LD64 + 16 * s + 8 * hh), vf[s], cacc);
                if (q == 0) Ca = cacc; else Cb = cacc;
#pragma unroll
                for (int g4 = 0; g4 < 4; ++g4) { u32x2 pk; pk.x = pk2(cacc[4 * g4], cacc[4 * g4 + 1]); pk.y = pk2(cacc[4 * g4 + 2], cacc[4 * g4 + 3]);
                    *(u32x2*)(CTn + (32 * vjj + r) * LD64 + 32 * th + 8 * g4 + 4 * hh) = pk; }
            }
        }
        cur ^= 1;
        lds_barrier();
    }
}
#undef ML_PF

constexpr size_t GDN_UNIT_BYTES = 32768;
__device__ __forceinline__ void gdn_pre(const Ctx& C, int o, unsigned char* lds) {
    const int tid = C.tid(), half = tid >> 8, lt = tid & 255, lw = lt >> 6, lane = C.lane(), r = lane & 31, hh = lane >> 5;
    const bf16* P = GPTR(const bf16, C.ws + WS_R1);
    const float* convw = C.in(28) + (size_t)o * 4 * 1536;
    unsigned char* base = lds + half * 53248;
    bf16* KhB = (bf16*)base; bf16* VhB = KhB + 64 * LD128; float* Amat = (float*)(VhB + 64 * LD128); float* sGC = Amat + 64 * 68; float* sBe = sGC + 64; float* sEg = sBe + 64;
    const int l16 = lt & 15, typ = (lt >> 4) & 1, tg = lt >> 5;
    for (int up = C.bid; up < 512; up += C.G) {
        const int unit = 2 * up + half, bh = unit >> 6, n = unit & 63, b = bh >> 2, h = bh & 3, t0 = n * 64;
        const size_t m0 = (size_t)b * SEQ + t0;
        {
            const int pc = (typ ? 1024 : 512) + h * 128 + 8 * l16;
            float cw[4][8];
#pragma unroll
            for (int k = 0; k < 4; ++k)
#pragma unroll
                for (int j = 0; j < 8; ++j) cw[k][j] = convw[k * 1536 + pc + j];
            float x[4][8];
#pragma unroll
            for (int i = 0; i < 3; ++i) { const int t = t0 + 8 * tg - 3 + i;
                if (t >= 0) ld8(P + ((size_t)b * SEQ + t) * OD_PAD + pc, x[i]); else {
#pragma unroll
                    for (int j = 0; j < 8; ++j) x[i][j] = 0.f; } }
#pragma unroll
            for (int tt = 0; tt < 8; ++tt) {
                ld8(P + (m0 + 8 * tg + tt) * OD_PAD + pc, x[(tt + 3) & 3]);
                float o8[8]; float ss = 0.f;
#pragma unroll
                for (int j = 0; j < 8; ++j) { float a = 0.f;
#pragma unroll
                    for (int k = 0; k < 4; ++k) a += cw[k][j] * x[(tt + k) & 3][j];
                    a = siluf(a); o8[j] = a; ss += a * a; }
                ss = row_sum16(ss);
                const float sc = typ ? 1.0f : frsq(ss + 1e-6f);
                u32x4 pk; pk.x = pk2(o8[0] * sc, o8[1] * sc); pk.y = pk2(o8[2] * sc, o8[3] * sc); pk.z = pk2(o8[4] * sc, o8[5] * sc); pk.w = pk2(o8[6] * sc, o8[7] * sc);
                *(u32x4*)((typ ? VhB : KhB) + (8 * tg + tt) * LD128 + 8 * l16) = pk;
            }
            if (lt < 64) { const bf16* row = P + (m0 + lt) * OD_PAD; const float be = sigm(bf2f(row[OC_GB + h]));
                float g = -fexp(C.in(29)[o * 4 + h]) * softplusf(bf2f(row[OC_GA + h]) + C.in(30)[o * 4 + h]);
#pragma unroll
                for (int d = 1; d < 64; d <<= 1) { const float upv = __shfl_up(g, d); if (lane >= d) g += upv; }
                sGC[lt] = g; sBe[lt] = be; sEg[lt] = be * fexp(g); }
        }
        __syncthreads();
        {
            const int ti = lw >> 1, tj = lw & 1;
            f32x16 acc;
#pragma unroll
            for (int g = 0; g < 16; ++g) acc[g] = C.zf();
            if (tj <= ti) {
#pragma unroll
                for (int s = 0; s < 8; ++s) acc = mfma32(ldfrag(KhB + (32 * ti + r) * LD128 + 16 * s + 8 * hh), ldfrag(KhB + (32 * tj + r) * LD128 + 16 * s + 8 * hh), acc);
            }
            const int j = 32 * tj + r; const float gj = sGC[j];
#pragma unroll
            for (int g = 0; g < 16; ++g) { const int i = 32 * ti + drow(g, hh);
                Amat[i * 68 + j] = (j < i) ? sBe[i] * acc[g] * fexp(sGC[i] - gj) : 0.f; }
        }
        __syncthreads();
        {
            const bool isw = lt < 128; const bf16* src = isw ? (KhB + lt) : (VhB + lt - 128);
            float X[64];
#pragma unroll
            for (int i = 0; i < 64; ++i) X[i] = 0.f;
#pragma unroll
            for (int i = 0; i < 64; ++i) {
                const float zz = C.zf(); float p[8] = {zz, zz, zz, zz, zz, zz, zz, zz};
#pragma unroll
                for (int j4 = 0; j4 < (i + 3) / 4; ++j4) { const f32x4 av = *(const f32x4*)(Amat + i * 68 + 4 * j4); const int o = (j4 & 1) * 4;
                    p[o] += av[0] * X[4 * j4]; p[o + 1] += av[1] * X[4 * j4 + 1]; p[o + 2] += av[2] * X[4 * j4 + 2]; p[o + 3] += av[3] * X[4 * j4 + 3]; }
                X[i] = (isw ? sEg[i] : sBe[i]) * bf2f(src[i * LD128]) - (((p[0] + p[1]) + (p[2] + p[3])) + ((p[4] + p[5]) + (p[6] + p[7])));
            }
            bf16* dst = isw ? (KhB + lt) : (VhB + lt - 128);
#pragma unroll
            for (int i = 0; i < 64; ++i) dst[i * LD128] = (bf16)f2bf(isw ? -X[i] : X[i]);
        }
        __syncthreads();
        {
            bf16* Wg = (bf16*)(C.ws + WS_XB + (size_t)unit * GDN_UNIT_BYTES); bf16* Ug = Wg + 64 * 128;
#pragma unroll
            for (int q = 0; q < 4; ++q) { const int p = lt + 256 * q, t = p >> 4, cp = (p & 15) * 8;
                *(u32x4*)(Wg + t * 128 + cp) = *(const u32x4*)(KhB + t * LD128 + cp); }
#pragma unroll
            for (int q = 0; q < 4; ++q) { const int p = lt + 256 * q, tile = p >> 7, ln = (p >> 1) & 63, q8 = p & 1;
                const int v = 32 * (tile & 3) + (ln & 31), hq = ln >> 5, thh = tile >> 2;
                unsigned e[8];
#pragma unroll
                for (int gg = 0; gg < 8; ++gg) e[gg] = VhB[(32 * thh + drow(8 * q8 + gg, hq)) * LD128 + v];
                u32x4 pk; pk.x = e[0] | (e[1] << 16); pk.y = e[2] | (e[3] << 16); pk.z = e[4] | (e[5] << 16); pk.w = e[6] | (e[7] << 16);
                *(u32x4*)(Ug + p * 8) = pk; }
        }
        __syncthreads();
    }
}

__device__ __forceinline__ void gdn_chunk_block(const Ctx& C, int o, int gb, unsigned char* lds) {
    const int tid = C.tid(), lane = C.lane(), w = C.wave, r = lane & 31, hh = lane >> 5;
    const int b = gb >> 2, h = gb & 3;
    const bf16* P = GPTR(const bf16, C.ws + WS_R1); bf16* Y = GPTR(bf16, C.ws + WS_Y);
    const float* convw = C.in(28) + (size_t)o * 4 * 1536;
    const float nA = -fexp(C.in(29)[o * 4 + h]); const float dtb = C.in(30)[o * 4 + h];
    bf16* Qh = (bf16*)lds; bf16* Kh = Qh + 64 * LD128; bf16* QD = Kh + 64 * LD128; bf16* KDT = QD + 64 * LD128; bf16* QKd = KDT + 128 * LD64; bf16* VNT = QKd + 64 * LD64; bf16* ST = VNT + 128 * LD64;
    float* sGC = (float*)(ST + 128 * LD128);
    for (int i = tid; i < 128 * LD128 / 2; i += NTHREADS) ((unsigned*)ST)[i] = 0u;
    const int l16 = tid & 15, typ = (tid >> 4) & 1, tg = tid >> 5;
    const int pc = (typ ? 512 : 0) + h * 128 + 8 * l16;
    float* sCW = sGC + 64;
    for (int i = tid; i < 1024; i += NTHREADS) { const int k = i >> 8, c = i & 255; sCW[i] = convw[k * 1536 + (c >> 7) * 512 + h * 128 + (c & 127)]; }
    const int th = w >> 2, vj = w & 3;
    f32x16 S0, S1;
#pragma unroll
    for (int g = 0; g < 16; ++g) { S0[g] = C.zf(); S1[g] = C.zf(); }
    u32x4 px[7]; unsigned ar_raw = 0; bf16x8 wf[8]; u32x4 u0, u1;
#define GDN_PF(ch_) do { _Pragma("unroll") for (int i = 0; i < 7; ++i) { const int t_ = 64 * (ch_) + 4 * tg - 3 + i; \
            if (t_ >= 0) px[i] = *(const u32x4*)(P + ((size_t)b * SEQ + t_) * OD_PAD + pc); else px[i] = (u32x4){C.z0, C.z0, C.z0, C.z0}; } \
        ar_raw = P[((size_t)b * SEQ + 64 * (ch_) + (tid & 63)) * OD_PAD + OC_GA + h]; } while (0)
#define GDN_WU(ch_) do { const bf16* Wg_ = (const bf16*)(C.ws + WS_XB + (size_t)((gb * 64) + (ch_)) * GDN_UNIT_BYTES); const bf16* Ug_ = Wg_ + 64 * 128; \
        _Pragma("unroll") for (int s = 0; s < 8; ++s) wf[s] = *(const bf16x8*)(Wg_ + (32 * th + r) * 128 + 16 * s + 8 * hh); \
        u0 = *(const u32x4*)(Ug_ + ((th * 4 + vj) * 64 + lane) * 16); u1 = *(const u32x4*)(Ug_ + ((th * 4 + vj) * 64 + lane) * 16 + 8); } while (0)
#define UNPK8(v_, o_) do { o_[0] = bf2f(v_.x & 0xffffu); o_[1] = bf2f(v_.x >> 16); o_[2] = bf2f(v_.y & 0xffffu); o_[3] = bf2f(v_.y >> 16); o_[4] = bf2f(v_.z & 0xffffu); o_[5] = bf2f(v_.z >> 16); o_[6] = bf2f(v_.w & 0xffffu); o_[7] = bf2f(v_.w >> 16); } while (0)
    GDN_PF(0); GDN_WU(0);
    __syncthreads();
    for (int ch = 0; ch < SEQ / 64; ++ch) {
        const int t0 = ch * 64; const size_t m0 = (size_t)b * SEQ + t0;
        {
            float cw[4][8];
#pragma unroll
            for (int k = 0; k < 4; ++k) { const f32x4 a = *(const f32x4*)(sCW + k * 256 + typ * 128 + 8 * l16), c2 = *(const f32x4*)(sCW + k * 256 + typ * 128 + 8 * l16 + 4);
                cw[k][0] = a[0]; cw[k][1] = a[1]; cw[k][2] = a[2]; cw[k][3] = a[3]; cw[k][4] = c2[0]; cw[k][5] = c2[1]; cw[k][6] = c2[2]; cw[k][7] = c2[3]; }
            float x[4][8];
            UNPK8(px[0], x[0]); UNPK8(px[1], x[1]); UNPK8(px[2], x[2]);
#pragma unroll
            for (int tt = 0; tt < 4; ++tt) { float o8[8]; float ss = 0.f;
                UNPK8(px[tt + 3], x[(tt + 3) & 3]);
#pragma unroll
                for (int j = 0; j < 8; ++j) { float a = 0.f;
#pragma unroll
                    for (int k = 0; k < 4; ++k) a += cw[k][j] * x[(tt + k) & 3][j];
                    a = siluf(a); o8[j] = a; ss += a * a; }
                ss = row_sum16(ss);
                const float sc = (frsq(ss + 1e-6f)) * (typ ? 1.0f : 0.08838834764831845f);
                u32x4 pk; pk.x = pk2(o8[0] * sc, o8[1] * sc); pk.y = pk2(o8[2] * sc, o8[3] * sc); pk.z = pk2(o8[4] * sc, o8[5] * sc); pk.w = pk2(o8[6] * sc, o8[7] * sc);
                *(u32x4*)((typ ? Kh : Qh) + (4 * tg + tt) * LD128 + 8 * l16) = pk; }
            if (tid < 64) { float g = nA * softplusf(bf2f(ar_raw) + dtb);
#pragma unroll
                for (int d = 1; d < 64; d <<= 1) { const float upv = __shfl_up(g, d); if (lane >= d) g += upv; }
                sGC[tid] = g; }
            if (ch + 1 < SEQ / 64) GDN_PF(ch + 1);
        }
        lds_barrier();
        if (w < 4) {
            const int ti = w >> 1, tj = w & 1;
            f32x16 acc;
#pragma unroll
            for (int g = 0; g < 16; ++g) acc[g] = C.zf();
            if (tj <= ti) {
#pragma unroll
                for (int s = 0; s < 8; ++s) acc = mfma32(ldfrag(Kh + (32 * tj + r) * LD128 + 16 * s + 8 * hh), ldfrag(Qh + (32 * ti + r) * LD128 + 16 * s + 8 * hh), acc);
            }
            const int i = 32 * ti + r; const float gi = sGC[i];
#pragma unroll
            for (int g4 = 0; g4 < 4; ++g4) { float v4[4];
#pragma unroll
                for (int q = 0; q < 4; ++q) { const int j = 32 * tj + 8 * g4 + 4 * hh + q; v4[q] = (j <= i) ? acc[4 * g4 + q] * fexp(gi - sGC[j]) : 0.f; }
                u32x2 pk; pk.x = pk2(v4[0], v4[1]); pk.y = pk2(v4[2], v4[3]);
                *(u32x2*)(QKd + i * LD64 + 32 * tj + 8 * g4 + 4 * hh) = pk; }
        } else {
            const int lt = tid - 256;
            {   const int t = lt >> 2, kq = lt & 3; const float eg = fexp(sGC[t]);
#pragma unroll
                for (int q = 0; q < 4; ++q) { float v8[8]; ld8(Qh + t * LD128 + 32 * kq + 8 * q, v8);
                    u32x4 pk; pk.x = pk2(v8[0] * eg, v8[1] * eg); pk.y = pk2(v8[2] * eg, v8[3] * eg); pk.z = pk2(v8[4] * eg, v8[5] * eg); pk.w = pk2(v8[6] * eg, v8[7] * eg);
                    *(u32x4*)(QD + t * LD128 + 32 * kq + 8 * q) = pk; } }
            {   const int k = lt & 127, tq = lt >> 7; const float gl_ = sGC[63];
#pragma unroll
                for (int q4 = 0; q4 < 4; ++q4) { float v8[8];
#pragma unroll
                    for (int q = 0; q < 8; ++q) { const int t = 32 * tq + 8 * q4 + q; v8[q] = bf2f(Kh[t * LD128 + k]) * fexp(gl_ - sGC[t]); }
                    u32x4 pk; pk.x = pk2(v8[0], v8[1]); pk.y = pk2(v8[2], v8[3]); pk.z = pk2(v8[4], v8[5]); pk.w = pk2(v8[6], v8[7]);
                    *(u32x4*)(KDT + k * LD64 + 32 * tq + 8 * q4) = pk; } }
        }
        lds_barrier();
        bf16x8 sf[8];
        {
            f32x16 acc;
            acc[0] = bf2f(u0.x & 0xffffu); acc[1] = bf2f(u0.x >> 16); acc[2] = bf2f(u0.y & 0xffffu); acc[3] = bf2f(u0.y >> 16);
            acc[4] = bf2f(u0.z & 0xffffu); acc[5] = bf2f(u0.z >> 16); acc[6] = bf2f(u0.w & 0xffffu); acc[7] = bf2f(u0.w >> 16);
            acc[8] = bf2f(u1.x & 0xffffu); acc[9] = bf2f(u1.x >> 16); acc[10] = bf2f(u1.y & 0xffffu); acc[11] = bf2f(u1.y >> 16);
            acc[12] = bf2f(u1.z & 0xffffu); acc[13] = bf2f(u1.z >> 16); acc[14] = bf2f(u1.w & 0xffffu); acc[15] = bf2f(u1.w >> 16);
#pragma unroll
            for (int s = 0; s < 8; ++s) { sf[s] = ldfrag(ST + (32 * vj + r) * LD128 + 16 * s + 8 * hh); acc = mfma32(wf[s], sf[s], acc); }
#pragma unroll
            for (int g4 = 0; g4 < 4; ++g4) { u32x2 pk; pk.x = pk2(acc[4 * g4], acc[4 * g4 + 1]); pk.y = pk2(acc[4 * g4 + 2], acc[4 * g4 + 3]);
                *(u32x2*)(VNT + (32 * vj + r) * LD64 + 32 * th + 8 * g4 + 4 * hh) = pk; }
            if (ch + 1 < SEQ / 64) GDN_WU(ch + 1);
        }
        lds_barrier();
        {
            f32x16 acc;
#pragma unroll
            for (int g = 0; g < 16; ++g) acc[g] = C.zf();
#pragma unroll
            for (int s = 0; s < 8; ++s) acc = mfma32(ldfrag(QD + (32 * th + r) * LD128 + 16 * s + 8 * hh), sf[s], acc);
            bf16x8 vf[4];
#pragma unroll
            for (int s = 0; s < 4; ++s) { vf[s] = ldfrag(VNT + (32 * vj + r) * LD64 + 16 * s + 8 * hh); acc = mfma32(ldfrag(QKd + (32 * th + r) * LD64 + 16 * s + 8 * hh), vf[s], acc); }
#pragma unroll
            for (int g = 0; g < 16; ++g) Y[(m0 + 32 * th + drow(g, hh)) * DM + h * 128 + 32 * vj + r] = (bf16)f2bf(acc[g]);
            const float gl_ = fexp(sGC[63]);
#pragma unroll
            for (int q = 0; q < 2; ++q) { const int kt = 2 * th + q;
                f32x16 sa = q == 0 ? S0 : S1;
#pragma unroll
                for (int g = 0; g < 16; ++g) sa[g] *= gl_;
#pragma unroll
                for (int s = 0; s < 4; ++s) sa = mfma32(ldfrag(KDT + (32 * kt + r) * LD64 + 16 * s + 8 * hh), vf[s], sa);
                if (q == 0) S0 = sa; else S1 = sa;
#pragma unroll
                for (int g4 = 0; g4 < 4; ++g4) { u32x2 pk; pk.x = pk2(sa[4 * g4], sa[4 * g4 + 1]); pk.y = pk2(sa[4 * g4 + 2], sa[4 * g4 + 3]);
                    *(u32x2*)(ST + (32 * vj + r) * LD128 + 32 * kt + 8 * g4 + 4 * hh) = pk; }
            }
        }
        lds_barrier();
    }
}
#undef GDN_PF
#undef GDN_WU

constexpr size_t WS_LW = WS_R1 + (size_t)M * EV_COLS * 2, WS_AA = WS_LW + (size_t)M * 512 * 2, WS_KK = WS_XB, WS_ACUM = WS_XB + (size_t)M * 512 * 2;
static_assert(WS_AA + (size_t)M * 512 * 2 <= WS_END, "even-layer scratch");

__device__ __forceinline__ void even_pre_tile(const Ctx& C, int e_in, int tile_in, unsigned char* lds) {
    int e = e_in, tile = tile_in; asm volatile("" : "+s"(e), "+s"(tile));
    int tid_ = C.tid(); asm volatile("" : "+v"(tid_));
    const int tid = tid_, lane = tid & 63, w = __builtin_amdgcn_readfirstlane(tid >> 6), r = lane & 31, hh = lane >> 5;
    const size_t m0 = (size_t)tile * 64; const int b = tile >> 6, t0 = (tile & 63) * 64;
    const bf16* P = GPTR(const bf16, C.ws + WS_R1); bf16* Y = GPTR(bf16, C.ws + WS_Y);
    bf16* ACUM = GPTR(bf16, C.ws + WS_ACUM); float* SUMS = GPTR(float, C.ws + WS_DEN);
    bf16* LW = GPTR(bf16, C.ws + WS_LW); bf16* AA = GPTR(bf16, C.ws + WS_AA); bf16* KK = GPTR(bf16, C.ws + WS_KK);
    {
        const int n = w;
        bf16* sXCb = (bf16*)(lds + w * 18432);
        bf16* sWT = sXCb + 64 * LD64; float* sZ = (float*)sWT;
        const float* convw = C.in(8) + (size_t)e * 4 * 512; const float* convb = C.in(9) + (size_t)e * 512;
        bf16x8 bwa[2][4], bwx[2][4];
        {   const bf16* gl = C.wset(2 * e, WOFF_LG) + (size_t)n * 4096;
#pragma unroll
            for (int nt = 0; nt < 2; ++nt)
#pragma unroll
                for (int s = 0; s < 4; ++s) { bwa[nt][s] = *(const bf16x8*)(gl + ((nt * 4 + s) * 64 + lane) * 8); bwx[nt][s] = *(const bf16x8*)(gl + 8 * 4096 + ((nt * 4 + s) * 64 + lane) * 8); }
        }
        const int ce = n * 64 + lane;
        const float g_ba = C.in(11)[(size_t)e * 512 + ce], g_bx = C.in(13)[(size_t)e * 512 + ce], g_spr = C.in(14)[(size_t)e * 512 + ce];
        {   const int tq = lane >> 3, c8 = lane & 7; const int pc = 512 + n * 64 + 8 * c8;
            float cw[4][8], cb[8];
#pragma unroll
            for (int j = 0; j < 8; ++j) { cb[j] = convb[n * 64 + 8 * c8 + j];
#pragma unroll
                for (int k = 0; k < 4; ++k) cw[k][j] = convw[k * 512 + n * 64 + 8 * c8 + j]; }
            float x[11][8];
#pragma unroll
            for (int i = 0; i < 3; ++i) { const int t = t0 + 8 * tq - 3 + i;
                ld8(P + ((size_t)b * SEQ + (t >= 0 ? t : 0)) * EV_COLS + pc, x[i]);
#pragma unroll
                for (int j = 0; j < 8; ++j) x[i][j] = t >= 0 ? x[i][j] : 0.f; }
#pragma unroll
            for (int tt = 0; tt < 8; ++tt) ld8(P + (m0 + 8 * tq + tt) * EV_COLS + pc, x[tt + 3]);
#pragma unroll
            for (int tt = 0; tt < 8; ++tt) {
                float o8[8];
#pragma unroll
                for (int j = 0; j < 8; ++j) { float a = cb[j];
#pragma unroll
                    for (int k = 0; k < 4; ++k) a += cw[k][j] * x[tt + k][j];
                    o8[j] = a; }
                u32x4 pk; pk.x = pk2(o8[0], o8[1]); pk.y = pk2(o8[2], o8[3]); pk.z = pk2(o8[4], o8[5]); pk.w = pk2(o8[6], o8[7]);
                *(u32x4*)(sXCb + (8 * tq + tt) * LD64 + 8 * c8) = pk;
            }
        }
        const float g_sp = softplusf(-g_spr);
        float hloc = 0.f, acum = 1.f;
#pragma unroll 1
        for (int tt = 0; tt < 2; ++tt) {
            float av[32];
#pragma unroll
            for (int nt = 0; nt < 2; ++nt) { f32x16 z;
#pragma unroll
                for (int g = 0; g < 16; ++g) z[g] = C.zf();
#pragma unroll
                for (int s = 0; s < 4; ++s) z = mfma32(ldfrag(sXCb + (32 * tt + r) * LD64 + 16 * s + 8 * hh), bwa[nt][s], z);
#pragma unroll
                for (int g = 0; g < 16; ++g) sZ[drow(g, hh) * 64 + 32 * nt + r] = z[g]; }
            asm volatile("s_waitcnt lgkmcnt(0)" ::: "memory");
#pragma unroll
            for (int t = 0; t < 32; ++t) av[t] = fexp(-8.0f * sigm(sZ[t * 64 + lane] + g_ba) * g_sp);
            asm volatile("s_waitcnt lgkmcnt(0)" ::: "memory");
#pragma unroll
            for (int nt = 0; nt < 2; ++nt) { f32x16 z;
#pragma unroll
                for (int g = 0; g < 16; ++g) z[g] = C.zf();
#pragma unroll
                for (int s = 0; s < 4; ++s) z = mfma32(ldfrag(sXCb + (32 * tt + r) * LD64 + 16 * s + 8 * hh), bwx[nt][s], z);
#pragma unroll
                for (int g = 0; g < 16; ++g) sZ[drow(g, hh) * 64 + 32 * nt + r] = z[g]; }
            asm volatile("s_waitcnt lgkmcnt(0)" ::: "memory");
            float zx[32];
#pragma unroll
            for (int t = 0; t < 32; ++t) zx[t] = sZ[t * 64 + lane];
            asm volatile("s_waitcnt lgkmcnt(0)" ::: "memory");
            bf16* hb = (bf16*)sZ; bf16* ab = hb + 32 * 64;
#pragma unroll
            for (int t = 0; t < 32; ++t) { const int tl = 32 * tt + t; const float a = av[t];
                float mult = sqrtf(fmaxf(1.0f - a * a, 0.f)); if (t0 + tl == 0) mult = 1.0f;
                const float u = sigm(zx[t] + g_bx) * bf2f(sXCb[tl * LD64 + lane]) * mult;
                hloc = a * hloc + u; acum *= a;
                hb[t * 64 + lane] = (bf16)f2bf(hloc); ab[t * 64 + lane] = (bf16)f2bf(acum); }
            asm volatile("s_waitcnt lgkmcnt(0)" ::: "memory");
#pragma unroll
            for (int i = 0; i < 4; ++i) { const int rw = 8 * i + (lane >> 3), pc8 = 8 * (lane & 7);
                const u32x4 hv = *(const u32x4*)(hb + rw * 64 + pc8), cv = *(const u32x4*)(ab + rw * 64 + pc8);
                stwt16(Y + (m0 + 32 * tt + rw) * DM + n * 64 + pc8, hv); stwt16(ACUM + (m0 + 32 * tt + rw) * 512 + n * 64 + pc8, cv); }
            asm volatile("s_waitcnt lgkmcnt(0)" ::: "memory");
        }
        SUMS[((size_t)tile * 2 + 0) * 512 + ce] = acum; SUMS[((size_t)tile * 2 + 1) * 512 + ce] = hloc;
    }
}

__device__ __forceinline__ void rwkv_chain_block(const Ctx& C, int e, int rb, unsigned char* lds) {
    const int tid = C.tid(), w = C.wave;
    const int bh = rb >> 2, q = rb & 3, b = bh >> 3, h = bh & 7;
    const bf16* P = GPTR(const bf16, C.ws + WS_R1); bf16* Y = GPTR(bf16, C.ws + WS_Y);
    const bf16* LW = GPTR(const bf16, C.ws + WS_LW); const bf16* AA = GPTR(const bf16, C.ws + WS_AA); const bf16* KK = GPTR(const bf16, C.ws + WS_KK);
    float* buf0 = (float*)lds; float* buf1 = buf0 + 10752; float* sY = buf1 + 10752;
    if (w >= 4) {
        const int pt = tid - 256, t = pt >> 3, c8 = pt & 7, hc = h * 64 + 8 * c8;
        const float* mu = C.in(15) + (size_t)e * 1792; const float* kap = C.in(22) + (size_t)e * 512;
        float mur[8], muk[8], muv[8], ka[8];
#pragma unroll
        for (int j = 0; j < 8; ++j) { mur[j] = mu[hc + j]; muk[j] = mu[512 + hc + j]; muv[j] = mu[1024 + hc + j]; ka[j] = kap[hc + j]; }
        u32x4 rc, rp, kc, kp, vc, vp, lwv, aav, kkv;
#define RW_LOAD(ch_) do { const size_t m_ = (size_t)b * SEQ + 32 * (ch_) + t; const bf16* row_ = P + m_ * EV_COLS; const bool hp_ = (32 * (ch_) + t) > 0; const bf16* prow_ = hp_ ? row_ - EV_COLS : row_; \
            rc = *(const u32x4*)(row_ + EC_R + hc); kc = *(const u32x4*)(row_ + EC_K + hc); vc = *(const u32x4*)(row_ + EC_V + hc); \
            rp = *(const u32x4*)(prow_ + EC_R + hc); kp = *(const u32x4*)(prow_ + EC_K + hc); vp = *(const u32x4*)(prow_ + EC_V + hc); \
            lwv = *(const u32x4*)(LW + m_ * 512 + hc); aav = *(const u32x4*)(AA + m_ * 512 + hc); kkv = *(const u32x4*)(KK + m_ * 512 + hc); } while (0)
#define RW_UNPK(v_, o_) do { o_[0] = bf2f(v_.x & 0xffffu); o_[1] = bf2f(v_.x >> 16); o_[2] = bf2f(v_.y & 0xffffu); o_[3] = bf2f(v_.y >> 16); o_[4] = bf2f(v_.z & 0xffffu); o_[5] = bf2f(v_.z >> 16); o_[6] = bf2f(v_.w & 0xffffu); o_[7] = bf2f(v_.w >> 16); } while (0)
#define RW_STAGE(ch_, dst_) do { const float pm_ = (32 * (ch_) + t) > 0 ? 1.0f : 0.0f; float a_[8], b_[8], o1_[8], o2_[8], o3_[8], o4_[8], o5_[8]; \
            RW_UNPK(rc, a_); RW_UNPK(rp, b_); _Pragma("unroll") for (int j = 0; j < 8; ++j) o5_[j] = a_[j] + mur[j] * (b_[j] * pm_ - a_[j]); \
            RW_UNPK(kc, a_); RW_UNPK(kp, b_); _Pragma("unroll") for (int j = 0; j < 8; ++j) o4_[j] = a_[j] + muk[j] * (b_[j] * pm_ - a_[j]); \
            RW_UNPK(aav, a_); RW_UNPK(kkv, b_); _Pragma("unroll") for (int j = 0; j < 8; ++j) { o4_[j] = o4_[j] * (1.0f + (a_[j] - 1.0f) * ka[j]); o2_[j] = b_[j]; o3_[j] = b_[j] * a_[j]; } \
            RW_UNPK(lwv, a_); _Pragma("unroll") for (int j = 0; j < 8; ++j) o1_[j] = fexp(a_[j]); \
            float* d_ = (dst_) + t * 64 + 8 * c8; \
            *(f32x4*)(d_) = (f32x4){o1_[0], o1_[1], o1_[2], o1_[3]}; *(f32x4*)(d_ + 4) = (f32x4){o1_[4], o1_[5], o1_[6], o1_[7]}; \
            *(f32x4*)(d_ + 2048) = (f32x4){o2_[0], o2_[1], o2_[2], o2_[3]}; *(f32x4*)(d_ + 2052) = (f32x4){o2_[4], o2_[5], o2_[6], o2_[7]}; \
            *(f32x4*)(d_ + 4096) = (f32x4){o3_[0], o3_[1], o3_[2], o3_[3]}; *(f32x4*)(d_ + 4100) = (f32x4){o3_[4], o3_[5], o3_[6], o3_[7]}; \
            *(f32x4*)(d_ + 6144) = (f32x4){o4_[0], o4_[1], o4_[2], o4_[3]}; *(f32x4*)(d_ + 6148) = (f32x4){o4_[4], o4_[5], o4_[6], o4_[7]}; \
            *(f32x4*)(d_ + 8192) = (f32x4){o5_[0], o5_[1], o5_[2], o5_[3]}; *(f32x4*)(d_ + 8196) = (f32x4){o5_[4], o5_[5], o5_[6], o5_[7]}; \
            if ((c8 >> 1) == q) { RW_UNPK(vc, a_); RW_UNPK(vp, b_); float* dv_ = (dst_) + 10240 + t * 16 + 8 * (c8 & 1); \
                *(f32x4*)(dv_) = (f32x4){a_[0] + muv[0] * (b_[0] * pm_ - a_[0]), a_[1] + muv[1] * (b_[1] * pm_ - a_[1]), a_[2] + muv[2] * (b_[2] * pm_ - a_[2]), a_[3] + muv[3] * (b_[3] * pm_ - a_[3])}; \
                *(f32x4*)(dv_ + 4) = (f32x4){a_[4] + muv[4] * (b_[4] * pm_ - a_[4]), a_[5] + muv[5] * (b_[5] * pm_ - a_[5]), a_[6] + muv[6] * (b_[6] * pm_ - a_[6]), a_[7] + muv[7] * (b_[7] * pm_ - a_[7])}; } } while (0)
        RW_LOAD(0); RW_STAGE(0, buf0); RW_LOAD(1);
        lds_barrier();
        for (int ch = 0; ch < SEQ / 32; ++ch) {
            if (ch + 1 < SEQ / 32) { RW_STAGE(ch + 1, ((ch + 1) & 1) ? buf1 : buf0); if (ch + 2 < SEQ / 32) RW_LOAD(ch + 2); }
            if (ch >= 1) { const float* sy = sY + ((ch - 1) & 1) * 512; const int pr = pt & 7; const size_t m = (size_t)b * SEQ + 32 * (ch - 1) + t;
                *(unsigned*)(Y + m * DM + 512 + h * 64 + 16 * q + 2 * pr) = pk2(sy[t * 16 + 2 * pr], sy[t * 16 + 2 * pr + 1]); }
            lds_barrier();
        }
        {   const float* sy = sY + ((SEQ / 32 - 1) & 1) * 512; const int pr = pt & 7; const size_t m = (size_t)b * SEQ + 32 * (SEQ / 32 - 1) + t;
            *(unsigned*)(Y + m * DM + 512 + h * 64 + 16 * q + 2 * pr) = pk2(sy[t * 16 + 2 * pr], sy[t * 16 + 2 * pr + 1]); }
#undef RW_LOAD
#undef RW_UNPK
#undef RW_STAGE
    } else {
        __builtin_amdgcn_s_setprio(3);
        const int row = tid >> 4, l16 = tid & 15;
        float S0 = 0.f, S1 = 0.f, S2 = 0.f, S3 = 0.f;
        lds_barrier();
        for (int ch = 0; ch < SEQ / 32; ++ch) {
            const float* bf = (ch & 1) ? buf1 : buf0; float* sy = sY + (ch & 1) * 512;
            const float* pw = bf + 4 * l16; const float* pv = bf + 10240 + row;
            f32x4 w4 = *(const f32x4*)(pw), kk4 = *(const f32x4*)(pw + 2048), b4 = *(const f32x4*)(pw + 4096), k4 = *(const f32x4*)(pw + 6144), r4 = *(const f32x4*)(pw + 8192);
            float v = pv[0];
#pragma unroll 8
            for (int t = 0; t < 32; ++t) {
                const int tn = t < 31 ? t + 1 : 31;
                const f32x4 w4n = *(const f32x4*)(pw + tn * 64), kk4n = *(const f32x4*)(pw + 2048 + tn * 64), b4n = *(const f32x4*)(pw + 4096 + tn * 64);
                const f32x4 k4n = *(const f32x4*)(pw + 6144 + tn * 64), r4n = *(const f32x4*)(pw + 8192 + tn * 64);
                const float vn = pv[tn * 16];
                float sk = (S0 * kk4[0] + S1 * kk4[1]) + (S2 * kk4[2] + S3 * kk4[3]);
                sk = row_sum16(sk);
                S0 = (S0 * w4[0] + v * k4[0]) - sk * b4[0]; S1 = (S1 * w4[1] + v * k4[1]) - sk * b4[1];
                S2 = (S2 * w4[2] + v * k4[2]) - sk * b4[2]; S3 = (S3 * w4[3] + v * k4[3]) - sk * b4[3];
                float y = (S0 * r4[0] + S1 * r4[1]) + (S2 * r4[2] + S3 * r4[3]);
                y = row_sum16(y);
                sy[t * 16 + row] = y;
                w4 = w4n; kk4 = kk4n; b4 = b4n; k4 = k4n; r4 = r4n; v = vn;
            }
            lds_barrier();
        }
        __builtin_amdgcn_s_setprio(0);
    }
}

#ifndef LRUPROBE
#define LRUPROBE 0
#endif
__device__ __forceinline__ void lru_pass2_tile(const Ctx& C, int tile, float* sm, bool rep = false) {
    const int tid = C.tid(); const int c = 4 * (tid & 127), part = __builtin_amdgcn_readfirstlane(tid >> 7); const int b = tile >> 6, jt = tile & 63;
    const bf16* P = GPTR(const bf16, C.ws + WS_R1); bf16* Y = GPTR(bf16, C.ws + WS_Y); const bf16* ACUM = GPTR(const bf16, C.ws + WS_ACUM); const float* SUMS = GPTR(const float, C.ws + WS_DEN);
    const int j0 = (jt * part) >> 2, j1 = (jt * (part + 1)) >> 2;
    const float z_ = C.zf(), o_ = z_ + 1.0f;
    f32x4 A = {o_, o_, o_, o_}, B = {z_, z_, z_, z_};
#pragma unroll 8
    for (int j = j0; j < ((rep && (LRUPROBE & 2)) ? j0 : j1); ++j) { const size_t tl = (size_t)b * 64 + j; const f32x4 a = *(const f32x4*)(SUMS + (tl * 2) * 512 + c), bb = *(const f32x4*)(SUMS + (tl * 2 + 1) * 512 + c); B = a * B + bb; A = a * A; }
    __syncthreads();
    *(f32x4*)(sm + part * 1024 + c) = A; *(f32x4*)(sm + part * 1024 + 512 + c) = B;
    __syncthreads();
    f32x4 carry = {z_, z_, z_, z_};
#pragma unroll
    for (int q = 0; q < 4; ++q) { const f32x4 a = *(const f32x4*)(sm + q * 1024 + c), bb = *(const f32x4*)(sm + q * 1024 + 512 + c); carry = a * carry + bb; }
#pragma unroll 1
    for (int t0_ = 0; t0_ < ((rep && (LRUPROBE & 4)) ? 0 : 16); t0_ += 8) {
        u32x2 rh[8], ra[8], rg[8];
#pragma unroll
        for (int t = 0; t < 8; ++t) { const size_t m = (size_t)tile * 64 + 16 * part + t0_ + t; rh[t] = __builtin_nontemporal_load((const u32x2*)(Y + m * DM + c)); ra[t] = __builtin_nontemporal_load((const u32x2*)(ACUM + m * 512 + c)); rg[t] = __builtin_nontemporal_load((const u32x2*)(P + m * EV_COLS + c)); }
#pragma unroll
        for (int t = 0; t < 8; ++t) { const size_t m = (size_t)tile * 64 + 16 * part + t0_ + t;
            const float hl[4] = {bf2f(rh[t].x & 0xffffu), bf2f(rh[t].x >> 16), bf2f(rh[t].y & 0xffffu), bf2f(rh[t].y >> 16)};
            const float ac[4] = {bf2f(ra[t].x & 0xffffu), bf2f(ra[t].x >> 16), bf2f(ra[t].y & 0xffffu), bf2f(ra[t].y >> 16)};
            const float g[4] = {bf2f(rg[t].x & 0xffffu), bf2f(rg[t].x >> 16), bf2f(rg[t].y & 0xffffu), bf2f(rg[t].y >> 16)};
            u32x2 pk; pk.x = pk2((hl[0] + ac[0] * carry[0]) * gelu_tanh(g[0]), (hl[1] + ac[1] * carry[1]) * gelu_tanh(g[1])); pk.y = pk2((hl[2] + ac[2] * carry[2]) * gelu_tanh(g[2]), (hl[3] + ac[3] * carry[3]) * gelu_tanh(g[3]));
            if (rep) *(u32x2*)(GPTR(bf16, C.ws + WS_XB + 16 * MiB) + m * 512 + c) = pk; else *(u32x2*)(Y + m * DM + c) = pk; }
    }
}

__device__ __forceinline__ void rwkv_post_tile2(const Ctx& C, int e, int tile, float* sm, bool rep = false) {
    const int tid = C.tid();
    const bf16* P = GPTR(const bf16, C.ws + WS_R1); bf16* Y = GPTR(bf16, C.ws + WS_Y); bf16* Yo = rep ? GPTR(bf16, C.ws + WS_XB + 16 * MiB) : Y; const float* bonus = GPTR(const float, C.ws + WS_BONUS);
    const float* mu = C.in(15) + (size_t)e * 1792; const float* g2 = C.in(20) + (size_t)e * 128 * 512;
    const size_t m0 = (size_t)tile * 64; const int t0 = (int)(m0 % SEQ);
    bf16* sGb = (bf16*)((unsigned char*)sm + 131072);
    __syncthreads();
#pragma unroll
    for (int i = 0; i < 2; ++i) { const int idx = tid + i * NTHREADS, t = idx >> 4, j0 = 8 * (idx & 15);
        float p8[8], q8[8]; ld8(P + (m0 + t) * EV_COLS + EC_XG + j0, p8);
        ld8(P + (m0 + t - ((t0 + t) > 0 ? 1 : 0)) * EV_COLS + EC_XG + j0, q8);
#pragma unroll
        for (int q = 0; q < 8; ++q) q8[q] = (t0 + t) > 0 ? q8[q] : 0.f;
        const f32x4 ma = *(const f32x4*)(mu + 1664 + j0), mb = *(const f32x4*)(mu + 1664 + j0 + 4); float o8[8];
#pragma unroll
        for (int q = 0; q < 8; ++q) o8[q] = sigm(p8[q] + (q < 4 ? ma[q] : mb[q - 4]) * (q8[q] - p8[q]));
        u32x4 pk; pk.x = pk2(o8[0], o8[1]); pk.y = pk2(o8[2], o8[3]); pk.z = pk2(o8[4], o8[5]); pk.w = pk2(o8[6], o8[7]);
        *(u32x4*)(sGb + t * LD128 + j0) = pk; }
    __syncthreads();
    const int l8 = (tid & 63) & 7, ts = (tid & 63) >> 3, cb = 64 * C.wave + 8 * l8;
        float lnw[8], lnb[8], muv[8];
        {   const f32x4 a0 = *(const f32x4*)(C.in(24) + (size_t)e * 512 + cb), a1 = *(const f32x4*)(C.in(24) + (size_t)e * 512 + cb + 4);
            const f32x4 b0 = *(const f32x4*)(C.in(25) + (size_t)e * 512 + cb), b1 = *(const f32x4*)(C.in(25) + (size_t)e * 512 + cb + 4);
            const f32x4 c0 = *(const f32x4*)(mu + 1024 + cb), c1 = *(const f32x4*)(mu + 1024 + cb + 4);
#pragma unroll
            for (int j = 0; j < 4; ++j) { lnw[j] = a0[j]; lnw[4 + j] = a1[j]; lnb[j] = b0[j]; lnb[4 + j] = b1[j]; muv[j] = c0[j]; muv[4 + j] = c1[j]; } }
        u32x4 ry[8], rv[8], rp[8]; float bo[8];
#pragma unroll
        for (int it = 0; it < 8; ++it) { const int t = 8 * it + ts; const size_t m = m0 + t; const bool hp = (t0 + t) > 0; const bf16* row = P + m * EV_COLS;
            ry[it] = *(const u32x4*)(Y + m * DM + 512 + cb); rv[it] = *(const u32x4*)(row + EC_V + cb); rp[it] = *(const u32x4*)((hp ? row - EV_COLS : row) + EC_V + cb); bo[it] = bonus[m * 8 + C.wave]; }
    {   const int lane = tid & 63, r = lane & 31, hh = lane >> 5; const bf16* g2t = C.wset(2 * e, WOFF_G2);
        bf16x8 bfa[2][8];
#pragma unroll
        for (int cc = 0; cc < 2; ++cc)
#pragma unroll
            for (int s = 0; s < 8; ++s) bfa[cc][s] = *(const bf16x8*)(g2t + (size_t)(32 * (2 * C.wave + cc) + r) * 128 + 16 * s + 8 * hh);
#pragma unroll
        for (int cc = 0; cc < 2; ++cc) { const int ct = 2 * C.wave + cc;
            const bf16x8 (&bfr)[8] = bfa[cc];
#pragma unroll
            for (int th = 0; th < 2; ++th) { f32x16 acc;
#pragma unroll
                for (int g = 0; g < 16; ++g) acc[g] = C.zf();
#pragma unroll
                for (int s = 0; s < 8; ++s) acc = mfma32(ldfrag(sGb + (32 * th + r) * LD128 + 16 * s + 8 * hh), bfr[s], acc);
#pragma unroll
                for (int g = 0; g < 16; ++g) sm[(32 * th + drow(g, hh)) * 512 + 32 * ct + r] = acc[g]; } }
    }
    asm volatile("s_waitcnt lgkmcnt(0)" ::: "memory");
    {
#pragma unroll
        for (int it = 0; it < 8; ++it) { const int t = 8 * it + ts; const size_t m = m0 + t; const bool hp = (t0 + t) > 0;
            float y8[8], v8[8], p8[8]; UNPK8(ry[it], y8); UNPK8(rv[it], v8); UNPK8(rp[it], p8);
#pragma unroll
            for (int j = 0; j < 8; ++j) p8[j] = hp ? p8[j] : 0.f;
            const float bon = bo[it];
            const f32x4 g0 = *(const f32x4*)(sm + t * 512 + cb), g1 = *(const f32x4*)(sm + t * 512 + cb + 4);
            float sy = ((y8[0] + y8[1]) + (y8[2] + y8[3])) + ((y8[4] + y8[5]) + (y8[6] + y8[7]));
            sy += __shfl_xor(sy, 1); sy += __shfl_xor(sy, 2); sy += __shfl_xor(sy, 4);
            const float mean = sy * (1.0f / 64.0f);
            float d8[8], sq = C.zf();
#pragma unroll
            for (int j = 0; j < 8; ++j) { d8[j] = y8[j] - mean; sq += d8[j] * d8[j]; }
            sq += __shfl_xor(sq, 1); sq += __shfl_xor(sq, 2); sq += __shfl_xor(sq, 4);
            const float rs = frsq(sq * (1.0f / 64.0f) + 64e-5f);
            float o8[8];
#pragma unroll
            for (int j = 0; j < 8; ++j) { const float vs = v8[j] + muv[j] * (p8[j] - v8[j]); o8[j] = ((d8[j] * rs * lnw[j] + lnb[j]) + bon * vs) * (j < 4 ? g0[j] : g1[j - 4]); }
            u32x4 pk; pk.x = pk2(o8[0], o8[1]); pk.y = pk2(o8[2], o8[3]); pk.z = pk2(o8[4], o8[5]); pk.w = pk2(o8[6], o8[7]);
            stwt16(Yo + m * DM + 512 + cb, pk); }
    }
}

__device__ __forceinline__ void gdn_chunk_block2(const Ctx& C, int o, int gb, unsigned char* lds) {
    const int tid = C.tid(), lane = C.lane(), w = C.wave, r = lane & 31, hh = lane >> 5;
    const int b = gb >> 2, h = gb & 3;
    const bf16* P = GPTR(const bf16, C.ws + WS_R1); bf16* Y = GPTR(bf16, C.ws + WS_Y);
    const float* convw = C.in(28) + (size_t)o * 4 * 1536;
    const float nA = -fexp(C.in(29)[o * 4 + h]); const float dtb = C.in(30)[o * 4 + h];
    bf16* Qh = (bf16*)lds; bf16* Kh = Qh + 64 * LD128; bf16* KT = Kh + 64 * LD128; bf16* QKd = KT + 128 * LD64; bf16* VNT = QKd + 64 * LD64; bf16* VNS = VNT + 128 * LD64; bf16* ST = VNS + 128 * LD64;
    float* sT = (float*)(ST + 128 * LD128);
    float* sCW = sT + 512;
    for (int i = tid; i < 128 * LD128 / 2; i += NTHREADS) ((unsigned*)ST)[i] = 0u;
    for (int i = tid; i < 64 * LD64 / 2; i += NTHREADS) ((unsigned*)QKd)[i] = 0u;
    for (int i = tid; i < 1024; i += NTHREADS) { const int k = i >> 8, c = i & 255; sCW[i] = convw[k * 1536 + (c >> 7) * 512 + h * 128 + (c & 127)]; }
    const int l16 = tid & 15, typ = (tid >> 4) & 1, tg = tid >> 5;
    const int pc = (typ ? 512 : 0) + h * 128 + 8 * l16;
    const int th = w >> 2, vj = w & 3;
    f32x16 S0, S1;
#pragma unroll
    for (int g = 0; g < 16; ++g) { S0[g] = C.zf(); S1[g] = C.zf(); }
    u32x4 px[7]; unsigned ar_next = 0; bf16x8 wf[8]; u32x4 u0, u1;
#define G2_PF(ch_) do { _Pragma("unroll") for (int i = 0; i < 7; ++i) { const int t_ = 64 * (ch_) + 4 * tg - 3 + i; \
            if (t_ >= 0) px[i] = *(const u32x4*)(P + ((size_t)b * SEQ + t_) * OD_PAD + pc); else px[i] = (u32x4){C.z0, C.z0, C.z0, C.z0}; } } while (0)
#define G2_AR(ch_) do { ar_next = P[((size_t)b * SEQ + 64 * (ch_) + (tid & 63)) * OD_PAD + OC_GA + h]; } while (0)
#define G2_WU(ch_) do { const bf16* Wg_ = GPTR(const bf16, C.ws + WS_XB + (size_t)((gb * 64) + (ch_)) * GDN_UNIT_BYTES); const bf16* Ug_ = Wg_ + 64 * 128; \
        _Pragma("unroll") for (int s = 0; s < 8; ++s) wf[s] = *(const bf16x8*)(Wg_ + (32 * th + r) * 128 + 16 * s + 8 * hh); \
        u0 = *(const u32x4*)(Ug_ + ((th * 4 + vj) * 64 + lane) * 16); u1 = *(const u32x4*)(Ug_ + ((th * 4 + vj) * 64 + lane) * 16 + 8); } while (0)
#define G2_GATES(buf_) do { if (tid < 64) { float g_ = nA * softplusf(bf2f(ar_next) + dtb); \
            _Pragma("unroll") for (int d = 1; d < 64; d <<= 1) { const float up_ = __shfl_up(g_, d); if (lane >= d) g_ += up_; } \
            const float gl_ = __shfl(g_, 63); float* tb_ = sT + (buf_) * 256; tb_[tid] = g_; tb_[64 + tid] = fexp(g_); tb_[128 + tid] = fexp(gl_ - g_); if (tid == 0) tb_[192] = fexp(gl_); } } while (0)
    G2_AR(0); G2_PF(0); G2_WU(0);
    G2_GATES(0);
    G2_AR(1);
    __syncthreads();
    for (int ch = 0; ch < SEQ / 64; ++ch) {
        const size_t m0 = (size_t)b * SEQ + ch * 64;
        const float* tb = sT + (ch & 1) * 256;
#ifndef GPROBE
#define GPROBE 0
#endif
        for (int rp1 = 0; rp1 < (GPROBE == 1 ? 2 : 1); ++rp1)
        {
            f32x16 acc;
            acc[0] = bf2f(u0.x & 0xffffu); acc[1] = bf2f(u0.x >> 16); acc[2] = bf2f(u0.y & 0xffffu); acc[3] = bf2f(u0.y >> 16);
            acc[4] = bf2f(u0.z & 0xffffu); acc[5] = bf2f(u0.z >> 16); acc[6] = bf2f(u0.w & 0xffffu); acc[7] = bf2f(u0.w >> 16);
            acc[8] = bf2f(u1.x & 0xffffu); acc[9] = bf2f(u1.x >> 16); acc[10] = bf2f(u1.y & 0xffffu); acc[11] = bf2f(u1.y >> 16);
            acc[12] = bf2f(u1.z & 0xffffu); acc[13] = bf2f(u1.z >> 16); acc[14] = bf2f(u1.w & 0xffffu); acc[15] = bf2f(u1.w >> 16);
#pragma unroll
            for (int s = 0; s < 8; ++s) acc = mfma32(wf[s], ldfrag(ST + (32 * vj + r) * LD128 + 16 * s + 8 * hh), acc);
#pragma unroll
            for (int g4 = 0; g4 < 4; ++g4) { const f32x4 ek = *(const f32x4*)(tb + 128 + 32 * th + 8 * g4 + 4 * hh);
                u32x2 pk; pk.x = pk2(acc[4 * g4], acc[4 * g4 + 1]); pk.y = pk2(acc[4 * g4 + 2], acc[4 * g4 + 3]);
                *(u32x2*)(VNT + (32 * vj + r) * LD64 + 32 * th + 8 * g4 + 4 * hh) = pk;
                pk.x = pk2(acc[4 * g4] * ek[0], acc[4 * g4 + 1] * ek[1]); pk.y = pk2(acc[4 * g4 + 2] * ek[2], acc[4 * g4 + 3] * ek[3]);
                *(u32x2*)(VNS + (32 * vj + r) * LD64 + 32 * th + 8 * g4 + 4 * hh) = pk; }
        }
        for (int rp2 = 0; rp2 < (GPROBE == 2 ? 2 : 1); ++rp2)
        {
            float cw[4][8];
#pragma unroll
            for (int k = 0; k < 4; ++k) { const f32x4 a = *(const f32x4*)(sCW + k * 256 + typ * 128 + 8 * l16), c2 = *(const f32x4*)(sCW + k * 256 + typ * 128 + 8 * l16 + 4);
                cw[k][0] = a[0]; cw[k][1] = a[1]; cw[k][2] = a[2]; cw[k][3] = a[3]; cw[k][4] = c2[0]; cw[k][5] = c2[1]; cw[k][6] = c2[2]; cw[k][7] = c2[3]; }
            float x[4][8], kprev[8];
            UNPK8(px[0], x[0]); UNPK8(px[1], x[1]); UNPK8(px[2], x[2]);
#pragma unroll
            for (int tt = 0; tt < 4; ++tt) { float o8[8]; float ss = 0.f;
                UNPK8(px[tt + 3], x[(tt + 3) & 3]);
#pragma unroll
                for (int j = 0; j < 8; ++j) { float a = 0.f;
#pragma unroll
                    for (int k = 0; k < 4; ++k) a += cw[k][j] * x[(tt + k) & 3][j];
                    a = siluf(a); o8[j] = a; ss += a * a; }
                ss = row_sum16(ss);
                const float sc = frsq(ss + 1e-6f) * (typ ? 1.0f : 0.08838834764831845f);
#pragma unroll
                for (int j = 0; j < 8; ++j) o8[j] *= sc;
                u32x4 pk; pk.x = pk2(o8[0], o8[1]); pk.y = pk2(o8[2], o8[3]); pk.z = pk2(o8[4], o8[5]); pk.w = pk2(o8[6], o8[7]);
                *(u32x4*)((typ ? Kh : Qh) + (4 * tg + tt) * LD128 + 8 * l16) = pk;
                if (typ) {
                    if (tt & 1) {
#pragma unroll
                        for (int j = 0; j < 8; ++j) *(unsigned*)(KT + (8 * l16 + j) * LD64 + 4 * tg + tt - 1) = pk2(kprev[j], o8[j]);
                    } else {
#pragma unroll
                        for (int j = 0; j < 8; ++j) kprev[j] = o8[j]; } } }
        }
        if (ch + 1 < SEQ / 64) { G2_PF(ch + 1); G2_WU(ch + 1); G2_GATES((ch + 1) & 1); if (ch + 2 < SEQ / 64) G2_AR(ch + 2); }
        lds_barrier();
        f32x16 oacc;
        for (int rp3 = 0; rp3 < (GPROBE == 3 ? 2 : 1); ++rp3) {
#pragma unroll
        for (int g = 0; g < 16; ++g) oacc[g] = C.zf();
#pragma unroll
        for (int s = 0; s < 8; ++s) oacc = mfma32(ldfrag(Qh + (32 * th + r) * LD128 + 16 * s + 8 * hh), ldfrag(ST + (32 * vj + r) * LD128 + 16 * s + 8 * hh), oacc);
#pragma unroll
        for (int g4 = 0; g4 < 4; ++g4) { const f32x4 eg = *(const f32x4*)(tb + 64 + 32 * th + 8 * g4 + 4 * hh);
            oacc[4 * g4] *= eg[0]; oacc[4 * g4 + 1] *= eg[1]; oacc[4 * g4 + 2] *= eg[2]; oacc[4 * g4 + 3] *= eg[3]; }
        if (w < 3) {
            const int ti = w > 0 ? 1 : 0, tj = w > 1 ? 1 : 0;
            f32x16 acc;
#pragma unroll
            for (int g = 0; g < 16; ++g) acc[g] = C.zf();
#pragma unroll
            for (int s = 0; s < 8; ++s) acc = mfma32(ldfrag(Kh + (32 * tj + r) * LD128 + 16 * s + 8 * hh), ldfrag(Qh + (32 * ti + r) * LD128 + 16 * s + 8 * hh), acc);
            const int i = 32 * ti + r; const float gi = tb[i];
#pragma unroll
            for (int g4 = 0; g4 < 4; ++g4) { const f32x4 gj = *(const f32x4*)(tb + 32 * tj + 8 * g4 + 4 * hh); float v4[4];
#pragma unroll
                for (int q = 0; q < 4; ++q) { const int j = 32 * tj + 8 * g4 + 4 * hh + q; v4[q] = (j <= i) ? acc[4 * g4 + q] * fexp(gi - gj[q]) : 0.f; }
                u32x2 pk; pk.x = pk2(v4[0], v4[1]); pk.y = pk2(v4[2], v4[3]);
                *(u32x2*)(QKd + i * LD64 + 32 * tj + 8 * g4 + 4 * hh) = pk; }
        }
        }
        lds_barrier();
        {
            f32x16 acc = oacc;
            for (int rp4 = 0; rp4 < (GPROBE == 4 ? 2 : 1); ++rp4) { acc = oacc;
#pragma unroll
            for (int s = 0; s < 4; ++s) acc = mfma32(ldfrag(QKd + (32 * th + r) * LD64 + 16 * s + 8 * hh), ldfrag(VNT + (32 * vj + r) * LD64 + 16 * s + 8 * hh), acc);
#pragma unroll
            for (int g = 0; g < 16; ++g) Y[(m0 + 32 * th + drow(g, hh)) * DM + h * 128 + 32 * vj + r] = (bf16)f2bf(acc[g]);
            }
            const float gl_ = tb[192];
            bf16x8 vs[4];
#pragma unroll
            for (int s = 0; s < 4; ++s) vs[s] = ldfrag(VNS + (32 * vj + r) * LD64 + 16 * s + 8 * hh);
#pragma unroll
            for (int q = 0; q < 2; ++q) { const int kt = 2 * th + q;
                f32x16 sa = q == 0 ? S0 : S1;
#pragma unroll
                for (int g = 0; g < 16; ++g) sa[g] *= gl_;
#pragma unroll
                for (int s = 0; s < 4; ++s) sa = mfma32(ldfrag(KT + (32 * kt + r) * LD64 + 16 * s + 8 * hh), vs[s], sa);
                if (q == 0) S0 = sa; else S1 = sa;
#pragma unroll
                for (int g4 = 0; g4 < 4; ++g4) { u32x2 pk; pk.x = pk2(sa[4 * g4], sa[4 * g4 + 1]); pk.y = pk2(sa[4 * g4 + 2], sa[4 * g4 + 3]);
                    *(u32x2*)(ST + (32 * vj + r) * LD128 + 32 * kt + 8 * g4 + 4 * hh) = pk; }
            }
        }
        lds_barrier();
    }
#undef G2_PF
#undef G2_AR
#undef G2_WU
#undef G2_GATES
}

__device__ __forceinline__ void mlstm_chunk_block2(const Ctx& C, int o, int mb, unsigned char* lds) {
    const int tid = C.tid(), lane = C.lane(), w = C.wave, r = lane & 31, hh = lane >> 5;
    const int b = mb >> 2, h = mb & 3;
    const bf16* P = GPTR(const bf16, C.ws + WS_R1); bf16* Y = GPTR(bf16, C.ws + WS_Y); float* den = GPTR(float, C.ws + WS_BONUS);
    const float* convw = C.in(32) + (size_t)o * 4 * 512;
    const float igb = C.in(33)[o * 4 + h], fgb = C.in(34)[o * 4 + h];
    bf16* Qh = (bf16*)lds; bf16* Kh = Qh + 64 * LD64; bf16* KT = Kh + 64 * LD64; bf16* Wm = KT + 64 * LD64;
    bf16* VT = Wm + 64 * LD64; bf16* VS = VT + 160 * LD64; bf16* CT0 = VS + 160 * LD64; bf16* CT1 = CT0 + 160 * LD64;
    float* sT = (float*)(CT1 + 160 * LD64);
    for (int i = tid; i < 2 * 160 * LD64 / 2; i += NTHREADS) ((unsigned*)CT0)[i] = 0u;
    for (int i = tid; i < 64 * LD64 / 2; i += NTHREADS) ((unsigned*)Wm)[i] = 0u;
    for (int i = tid; i < 32 * LD64; i += NTHREADS) { VT[128 * LD64 + i] = (i < 64) ? (bf16)0x3F80 : (bf16)0; VS[128 * LD64 + i] = (bf16)0; }
    const int l16 = tid & 15, typ = (tid >> 4) & 1, tg = tid >> 5;
    const int pc = OC_MQK + (typ ? 256 : 0) + h * 64 + 4 * l16;
    float cw[4][4];
#pragma unroll
    for (int k = 0; k < 4; ++k)
#pragma unroll
        for (int j = 0; j < 4; ++j) cw[k][j] = convw[k * 512 + (typ ? 256 : 0) + h * 64 + 4 * l16 + j];
    const int th = w >> 2, vj = w & 3; const bool two = (vj == 0);
    f32x16 Ca, Cb;
#pragma unroll
    for (int g = 0; g < 16; ++g) { Ca[g] = C.zf(); Cb[g] = C.zf(); }
    int cur = 0;
    u32x2 px[7]; u32x4 pva, pvb; unsigned pgi = 0, pgf = 0;
    const int vt = tid & 63, vg = tid >> 6;
#define M2_PF(ch_) do { _Pragma("unroll") for (int i = 0; i < 7; ++i) { const int t_ = 64 * (ch_) + 4 * tg - 3 + i; \
            if (t_ >= 0) px[i] = *(const u32x2*)(P + ((size_t)b * SEQ + t_) * OD_PAD + pc); else px[i] = (u32x2){C.z0, C.z0}; } \
        { const bf16* vr_ = P + ((size_t)b * SEQ + 64 * (ch_) + vt) * OD_PAD; pva = *(const u32x4*)(vr_ + OC_MV + h * 128 + 16 * vg); pvb = *(const u32x4*)(vr_ + OC_MV + h * 128 + 16 * vg + 8); } } while (0)
#define M2_GPF(ch_) do { const bf16* vr_ = P + ((size_t)b * SEQ + 64 * (ch_) + vt) * OD_PAD; pgi = vr_[OC_MI + h]; pgf = vr_[OC_MF + h]; } while (0)
#define M2_GATES(buf_) do { if (tid < 64) { const float ip_ = bf2f(pgi) + igb; float lf_ = logsigm(bf2f(pgf) + fgb); \
            _Pragma("unroll") for (int d = 1; d < 64; d <<= 1) { const float up_ = __shfl_up(lf_, d); if (lane >= d) lf_ += up_; } \
            const float bl_ = __shfl(lf_, 63); float* tb_ = sT + (buf_) * 256; tb_[tid] = lf_; tb_[64 + tid] = ip_; tb_[128 + tid] = fexp(lf_); tb_[192 + tid] = fexp(bl_ - lf_ + ip_); } } while (0)
    M2_GPF(0); M2_PF(0);
    M2_GATES(0);
    M2_GPF(1);
    __syncthreads();
    for (int ch = 0; ch < SEQ / 64; ++ch) {
        const size_t m0 = (size_t)b * SEQ + ch * 64;
        const float* tb = sT + (ch & 1) * 256;
        {
            float x[7][4], ko[4][4];
#pragma unroll
            for (int i = 0; i < 7; ++i) { x[i][0] = bf2f(px[i].x & 0xffffu); x[i][1] = bf2f(px[i].x >> 16); x[i][2] = bf2f(px[i].y & 0xffffu); x[i][3] = bf2f(px[i].y >> 16); }
#pragma unroll
            for (int tt = 0; tt < 4; ++tt) {
#pragma unroll
                for (int j = 0; j < 4; ++j) { float a = 0.f;
#pragma unroll
                    for (int k = 0; k < 4; ++k) a += cw[k][j] * x[tt + k][j];
                    a = siluf(a); ko[tt][j] = typ ? a : a * 0.125f; }
                u32x2 pk; pk.x = pk2(ko[tt][0], ko[tt][1]); pk.y = pk2(ko[tt][2], ko[tt][3]);
                *(u32x2*)((typ ? Kh : Qh) + (4 * tg + tt) * LD64 + 4 * l16) = pk; }
            if (typ) {
#pragma unroll
                for (int j = 0; j < 4; ++j) { u32x2 pk; pk.x = pk2(ko[0][j], ko[1][j]); pk.y = pk2(ko[2][j], ko[3][j]); *(u32x2*)(KT + (4 * l16 + j) * LD64 + 4 * tg) = pk; } }
            {   const float ek = tb[192 + vt]; const unsigned wv[8] = {pva.x, pva.y, pva.z, pva.w, pvb.x, pvb.y, pvb.z, pvb.w};
#pragma unroll
                for (int q = 0; q < 8; ++q) { const unsigned lo = wv[q] & 0xffffu, hi = wv[q] >> 16;
                    VT[(16 * vg + 2 * q) * LD64 + vt] = (bf16)lo; VT[(16 * vg + 2 * q + 1) * LD64 + vt] = (bf16)hi;
                    VS[(16 * vg + 2 * q) * LD64 + vt] = (bf16)f2bf(bf2f(lo) * ek); VS[(16 * vg + 2 * q + 1) * LD64 + vt] = (bf16)f2bf(bf2f(hi) * ek); }
                if (tid < 64) VS[128 * LD64 + tid] = (bf16)f2bf(ek); }
        }
        if (ch + 1 < SEQ / 64) { M2_PF(ch + 1); M2_GATES((ch + 1) & 1); if (ch + 2 < SEQ / 64) M2_GPF(ch + 2); }
        lds_barrier();
        if (w < 3) {
            const int ti = w > 0 ? 1 : 0, tj = w > 1 ? 1 : 0;
            f32x16 acc;
#pragma unroll
            for (int g = 0; g < 16; ++g) acc[g] = C.zf();
#pragma unroll
            for (int s = 0; s < 4; ++s) acc = mfma32(ldfrag(Kh + (32 * tj + r) * LD64 + 16 * s + 8 * hh), ldfrag(Qh + (32 * ti + r) * LD64 + 16 * s + 8 * hh), acc);
            const int i = 32 * ti + r; const float bi = tb[i];
#pragma unroll
            for (int g4 = 0; g4 < 4; ++g4) { const f32x4 bj = *(const f32x4*)(tb + 32 * tj + 8 * g4 + 4 * hh), ij = *(const f32x4*)(tb + 64 + 32 * tj + 8 * g4 + 4 * hh); float v4[4];
#pragma unroll
                for (int q = 0; q < 4; ++q) { const int j = 32 * tj + 8 * g4 + 4 * hh + q; v4[q] = (j <= i) ? acc[4 * g4 + q] * fexp(bi - bj[q] + ij[q]) : 0.f; }
                u32x2 pk; pk.x = pk2(v4[0], v4[1]); pk.y = pk2(v4[2], v4[3]);
                *(u32x2*)(Wm + i * LD64 + 32 * tj + 8 * g4 + 4 * hh) = pk; }
        }
        lds_barrier();
        {
            const bf16* CTc = cur ? CT1 : CT0; bf16* CTn = cur ? CT0 : CT1;
            const float F = tb[128 + 63];
#pragma unroll
            for (int q = 0; q < 2; ++q) {
                if (q == 1 && !two) break;
                const int vjj = q == 0 ? vj : 4;
                f32x16 num;
#pragma unroll
                for (int g = 0; g < 16; ++g) num[g] = C.zf();
#pragma unroll
                for (int s = 0; s < 4; ++s) num = mfma32(ldfrag(Qh + (32 * th + r) * LD64 + 16 * s + 8 * hh), ldfrag(CTc + (32 * vjj + r) * LD64 + 16 * s + 8 * hh), num);
#pragma unroll
                for (int g4 = 0; g4 < 4; ++g4) { const f32x4 eb = *(const f32x4*)(tb + 128 + 32 * th + 8 * g4 + 4 * hh);
                    num[4 * g4] *= eb[0]; num[4 * g4 + 1] *= eb[1]; num[4 * g4 + 2] *= eb[2]; num[4 * g4 + 3] *= eb[3]; }
#pragma unroll
                for (int s = 0; s < 4; ++s) num = mfma32(ldfrag(Wm + (32 * th + r) * LD64 + 16 * s + 8 * hh), ldfrag(VT + (32 * vjj + r) * LD64 + 16 * s + 8 * hh), num);
                if (vjj < 4) {
#pragma unroll
                    for (int g = 0; g < 16; ++g) Y[(m0 + 32 * th + drow(g, hh)) * DM + 512 + h * 128 + 32 * vjj + r] = (bf16)f2bf(num[g]);
                } else if (r == 0) {
#pragma unroll
                    for (int g = 0; g < 16; ++g) den[(m0 + 32 * th + drow(g, hh)) * 4 + h] = num[g];
                }
                f32x16 cacc = q == 0 ? Ca : Cb;
#pragma unroll
                for (int g = 0; g < 16; ++g) cacc[g] *= F;
#pragma unroll
                for (int s = 0; s < 4; ++s) cacc = mfma32(ldfrag(KT + (32 * th + r) * LD64 + 16 * s + 8 * hh), ldfrag(VS + (32 * vjj + r) * LD64 + 16 * s + 8 * hh), cacc);
                if (q == 0) Ca = cacc; else Cb = cacc;
#pragma unroll
                for (int g4 = 0; g4 < 4; ++g4) { u32x2 pk; pk.x = pk2(cacc[4 * g4], cacc[4 * g4 + 1]); pk.y = pk2(cacc[4 * g4 + 2], cacc[4 * g4 + 3]);
                    *(u32x2*)(CTn + (32 * vjj + r) * LD64 + 32 * th + 8 * g4 + 4 * hh) = pk; }
            }
        }
        cur ^= 1;
        lds_barrier();
    }
#undef M2_PF
#undef M2_GPF
#undef M2_GATES
}

constexpr size_t WS_RP = WS_R1 + (size_t)M * EV_COLS * 2, WS_YP = WS_RP + 16 * MiB, WS_ZP0 = WS_YP + 16 * MiB, WS_MM = WS_XB, WS_ZP1 = WS_END;
static_assert(WS_ZP0 + 8 * MiB == WS_R1 + 128 * MiB && WS_ZP1 + 8 * MiB <= 256 * MiB, "rwkv chunk operand map");
#define SW8(R_, q_) (8 * ((q_) ^ (((R_) >> 3) & 7)))
__device__ __forceinline__ unsigned char* rwkv_zp(const Ctx& C, int u) { return C.ws + (u < 1024 ? WS_ZP0 + (size_t)u * 8192 : WS_ZP1 + (size_t)(u - 1024) * 8192); }

#ifndef RPHEADS
#define RPHEADS 8
#endif
#ifdef TP_RW
#define RW_MARK(k_) do { const unsigned long long tn_ = __builtin_amdgcn_s_memrealtime(); if ((TP_RW >> (k_)) & 1) { while (__builtin_amdgcn_s_memrealtime() - tn_ < tn_ - rw_tprev_) __builtin_amdgcn_s_sleep(2); } rw_tprev_ = __builtin_amdgcn_s_memrealtime(); } while (0)
#else
#define RW_MARK(k_) do { } while (0)
#endif
__device__ __forceinline__ void rwkv_pre_tile(const Ctx& C, int e_in, int tile_in, unsigned char* lds, int nheads = 8) {
    int e = e_in, tile = tile_in; asm volatile("" : "+s"(e), "+s"(tile));
    const size_t m0 = (size_t)tile * 64; const int b = tile >> 6, n = tile & 63, t0 = n * 64;
    const bf16* P = GPTR(const bf16, C.ws + WS_R1); float* bonus = GPTR(float, C.ws + WS_BONUS);
    const float* mu = C.in(15) + (size_t)e * 1792;
    const float* p_w2 = C.in(17) + (size_t)e * 64 * 512; const float* p_a2 = C.in(19) + (size_t)e * 64 * 512; const float* pw0 = C.in(16) + (size_t)e * 512;
    const float* pkk = C.in(21) + (size_t)e * 512; const float* pa0 = C.in(18) + (size_t)e * 512; const float* pka = C.in(22) + (size_t)e * 512; const float* prk = C.in(23) + (size_t)e * 512;
    float* Ab = (float*)lds; float* Rh = Ab + 64 * 68;
    bf16* KKt = (bf16*)(Rh + 64 * 68); bf16* Bh = KKt + 64 * LD64; bf16* Kh = Bh + 64 * LD64; bf16* Rt = Kh + 64 * LD64; bf16* VT = Rt + 64 * LD64;
    bf16* Ak = VT + 64 * LD64; bf16* Ark = Ak + 64 * LD64; bf16* ArbN = Ark + 64 * LD64; bf16* WT = ArbN + 64 * LD64; bf16* UT = WT + 64 * LD64; bf16* BbTN = UT + 64 * LD64; bf16* KbT = BbTN + 64 * LD64;
    float* sGL = (float*)(KbT + 64 * LD64);
    u32x4 gxw, gxwp, gxa, gxap, gr, grp, gk, gkp, gv, gvp; f32x4 gw0, gw1, ga0, ga1;
    {   const int tq = C.tid() >> 3, cq = C.tid() & 7; const bf16* row = P + (m0 + tq) * EV_COLS; const bf16* prow = (t0 + tq) > 0 ? row - EV_COLS : row;
        gxw = *(const u32x4*)(row + EC_XW + 8 * cq); gxwp = *(const u32x4*)(prow + EC_XW + 8 * cq); gxa = *(const u32x4*)(row + EC_XA + 8 * cq); gxap = *(const u32x4*)(prow + EC_XA + 8 * cq); }
#define RP_LOAD(h_) do { const int tq_ = C.tid() >> 3, cq_ = C.tid() & 7; const bf16* row_ = P + (m0 + tq_) * EV_COLS; const bf16* prow_ = (t0 + tq_) > 0 ? row_ - EV_COLS : row_; const int hc_ = (h_) * 64 + 8 * cq_; \
        gr = *(const u32x4*)(row_ + EC_R + hc_); grp = *(const u32x4*)(prow_ + EC_R + hc_); gk = *(const u32x4*)(row_ + EC_K + hc_); gkp = *(const u32x4*)(prow_ + EC_K + hc_); gv = *(const u32x4*)(row_ + EC_V + hc_); gvp = *(const u32x4*)(prow_ + EC_V + hc_); \
        const float* w2_ = p_w2 + (size_t)tq_ * 512 + hc_; const float* a2_ = p_a2 + (size_t)tq_ * 512 + hc_; \
        gw0 = *(const f32x4*)w2_; gw1 = *(const f32x4*)(w2_ + 4); ga0 = *(const f32x4*)a2_; ga1 = *(const f32x4*)(a2_ + 4); } while (0)
    float t_mw[8], t_ma[8];
    {   const int c8_ = C.tid() & 7;
#pragma unroll
        for (int j = 0; j < 8; ++j) { t_mw[j] = mu[1536 + 8 * c8_ + j]; t_ma[j] = mu[1600 + 8 * c8_ + j]; } }
#ifdef TP_RW
    unsigned long long rw_tprev_ = __builtin_amdgcn_s_memrealtime();
#endif
    RP_LOAD(0);
#pragma unroll 1
    for (int h = 0; h < nheads; ++h) {
        int tid_ = C.tid(); asm volatile("" : "+v"(tid_));
        const int tid = tid_, lane = tid & 63, w = __builtin_amdgcn_readfirstlane(tid >> 6), r = lane & 31, hh = lane >> 5;
        const int u = (b * 8 + h) * 64 + n;
        float q_mur[8], q_muk[8], q_muv[8], q_kk[8], q_a0[8], q_ka[8], q_rk[8], q_w0;
        {   const int hc_ = h * 64 + 8 * (tid & 7);
#define RP_P8(dst_, src_) do { const f32x4 a_ = *(const f32x4*)((src_) + hc_), b_ = *(const f32x4*)((src_) + hc_ + 4); dst_[0] = a_[0]; dst_[1] = a_[1]; dst_[2] = a_[2]; dst_[3] = a_[3]; dst_[4] = b_[0]; dst_[5] = b_[1]; dst_[6] = b_[2]; dst_[7] = b_[3]; } while (0)
            q_w0 = pw0[h * 64 + (tid & 31) + 32 * ((tid >> 6) & 1)];
            RP_P8(q_mur, mu); RP_P8(q_muk, mu + 512); RP_P8(q_muv, mu + 1024); RP_P8(q_kk, pkk); RP_P8(q_a0, pa0); RP_P8(q_ka, pka); RP_P8(q_rk, prk);
#undef RP_P8
        }
        lds_barrier(); RW_MARK(8);
#ifndef RPROBE
#define RPROBE 0
#endif
        for (int rp = 0; rp < (RPROBE == 1 ? 2 : 1); ++rp) { if (rp) lds_barrier();
        {
            const int t = tid >> 3, c8 = tid & 7; const float pm0 = (t0 + t) > 0 ? 1.0f : 0.0f;
            float c[8], p[8], o[8];
            UNPK8(gxw, c); UNPK8(gxwp, p);
#pragma unroll
            for (int j = 0; j < 8; ++j) o[j] = ftanh(c[j] + t_mw[j] * (p[j] * pm0 - c[j]));
            u32x4 pk; pk.x = pk2(o[0], o[1]); pk.y = pk2(o[2], o[3]); pk.z = pk2(o[4], o[5]); pk.w = pk2(o[6], o[7]);
            *(u32x4*)(Ak + t * LD64 + 8 * c8) = pk;
            UNPK8(gxa, c); UNPK8(gxap, p);
#pragma unroll
            for (int j = 0; j < 8; ++j) o[j] = c[j] + t_ma[j] * (p[j] * pm0 - c[j]);
            pk.x = pk2(o[0], o[1]); pk.y = pk2(o[2], o[3]); pk.z = pk2(o[4], o[5]); pk.w = pk2(o[6], o[7]);
            *(u32x4*)(Ark + t * LD64 + 8 * c8) = pk;
            const f32x4 wa0 = gw0, wa1 = gw1, aa0 = ga0, aa1 = ga1;
            const int tsw = SW8(8 * c8, t >> 3) + (t & 7);
#pragma unroll
            for (int j = 0; j < 4; ++j) { WT[(8 * c8 + j) * LD64 + tsw] = (bf16)f2bf(wa0[j]); WT[(8 * c8 + 4 + j) * LD64 + tsw] = (bf16)f2bf(wa1[j]);
                UT[(8 * c8 + j) * LD64 + tsw] = (bf16)f2bf(aa0[j]); UT[(8 * c8 + 4 + j) * LD64 + tsw] = (bf16)f2bf(aa1[j]); }
        }
        lds_barrier(); RW_MARK(1);
        {
            const int mat = w >> 2, tt = (w >> 1) & 1, nt = w & 1;
            f32x16 z;
#pragma unroll
            for (int g = 0; g < 16; ++g) z[g] = C.zf();
#pragma unroll
            for (int s = 0; s < 4; ++s) z = mfma32(ldfrag((mat ? Ark : Ak) + (32 * tt + r) * LD64 + 16 * s + 8 * hh), ldfrag((mat ? UT : WT) + (32 * nt + r) * LD64 + SW8(32 * nt + r, 2 * s + hh)), z);
            float* dst = mat ? Rh : Ab;
            if (!mat) {
                const float p_w0 = q_w0;
#pragma unroll
                for (int g = 0; g < 16; ++g) z[g] = -fexp(-softplusf(-(p_w0 + z[g])) - 0.5f);
            }
#pragma unroll
            for (int g = 0; g < 16; ++g) dst[(32 * tt + drow(g, hh)) * 68 + 32 * nt + r] = z[g];
        }
        }
        lds_barrier(); RW_MARK(2);
        for (int rp = 0; rp < (RPROBE == 2 ? 2 : 1); ++rp)
        if (w == 0) {
            float cl = 0.f;
#pragma unroll 16
            for (int t = 0; t < 64; ++t) { cl += Ab[t * 68 + lane]; Ab[t * 68 + lane] = cl; }
            sGL[lane] = fexp(cl);
        }
        lds_barrier(); RW_MARK(3);
        {
            const int t = tid >> 3, c8 = tid & 7, hc = h * 64 + 8 * c8; const size_t m = m0 + t; const float pm = (t0 + t) > 0 ? 1.0f : 0.0f;
            float rs[8], ks[8], vs[8], tmp[8];
            UNPK8(gr, rs); UNPK8(grp, tmp);
#pragma unroll
            for (int j = 0; j < 8; ++j) rs[j] += q_mur[j] * (tmp[j] * pm - rs[j]);
            UNPK8(gk, ks); UNPK8(gkp, tmp);
#pragma unroll
            for (int j = 0; j < 8; ++j) ks[j] += q_muk[j] * (tmp[j] * pm - ks[j]);
            UNPK8(gv, vs); UNPK8(gvp, tmp);
#pragma unroll
            for (int j = 0; j < 8; ++j) vs[j] += q_muv[j] * (tmp[j] * pm - vs[j]);
            float kkv[8], ss = 0.f;
#pragma unroll
            for (int j = 0; j < 8; ++j) { kkv[j] = ks[j] * q_kk[j]; ss += kkv[j] * kkv[j]; }
            ss += __shfl_xor(ss, 1); ss += __shfl_xor(ss, 2); ss += __shfl_xor(ss, 4);
            const float rn = frsq(ss + 1e-6f);
            const f32x4 cl0 = *(const f32x4*)(Ab + t * 68 + 8 * c8), cl1 = *(const f32x4*)(Ab + t * 68 + 8 * c8 + 4);
            const f32x4 za0 = *(const f32x4*)(Rh + t * 68 + 8 * c8), za1 = *(const f32x4*)(Rh + t * 68 + 8 * c8 + 4);
            const f32x4 cL0 = *(const f32x4*)(Ab + 63 * 68 + 8 * c8), cL1 = *(const f32x4*)(Ab + 63 * 68 + 8 * c8 + 4);
            f32x4 cp0 = {C.zf(), C.zf(), C.zf(), C.zf()}, cp1 = cp0;
            if (t > 0) { cp0 = *(const f32x4*)(Ab + (t - 1) * 68 + 8 * c8); cp1 = *(const f32x4*)(Ab + (t - 1) * 68 + 8 * c8 + 4); }
            float o1[8], o2[8], o3[8], o4[8], bon = 0.f; const int tsw3 = SW8(8 * c8, t >> 3) + (t & 7);
#pragma unroll
            for (int j = 0; j < 8; ++j) { const float cl = j < 4 ? cl0[j] : cl1[j - 4], cp = j < 4 ? cp0[j] : cp1[j - 4], cL = j < 4 ? cL0[j] : cL1[j - 4], za = j < 4 ? za0[j] : za1[j - 4];
                const float a = sigm(q_a0[j] + za);
                const float kk = kkv[j] * rn, bb = kk * a, kp = ks[j] * (1.0f + (a - 1.0f) * q_ka[j]);
                bon += rs[j] * kp * q_rk[j];
                const float ig = fexp(-cl), eg = fexp(cl), el = fexp(cL - cl);
                o1[j] = kk * fexp(cp); o2[j] = bb * ig; o3[j] = kp * ig; o4[j] = rs[j] * eg;
                BbTN[(8 * c8 + j) * LD64 + tsw3] = (bf16)f2bf(-bb * el); KbT[(8 * c8 + j) * LD64 + tsw3] = (bf16)f2bf(kp * el); VT[(8 * c8 + j) * LD64 + tsw3] = (bf16)f2bf(vs[j]); WT[(8 * c8 + j) * LD64 + tsw3] = (bf16)f2bf(o1[j]);
                }
            bon += __shfl_xor(bon, 1); bon += __shfl_xor(bon, 2); bon += __shfl_xor(bon, 4);
            if (c8 == 0) bonus[m * 8 + h] = bon;
            if (h + 1 < nheads) RP_LOAD(h + 1);
            u32x4 pk; pk.x = pk2(o1[0], o1[1]); pk.y = pk2(o1[2], o1[3]); pk.z = pk2(o1[4], o1[5]); pk.w = pk2(o1[6], o1[7]); *(u32x4*)(KKt + t * LD64 + 8 * c8) = pk;
            pk.x = pk2(o2[0], o2[1]); pk.y = pk2(o2[2], o2[3]); pk.z = pk2(o2[4], o2[5]); pk.w = pk2(o2[6], o2[7]); *(u32x4*)(Bh + t * LD64 + 8 * c8) = pk;
            pk.x = pk2(o3[0], o3[1]); pk.y = pk2(o3[2], o3[3]); pk.z = pk2(o3[4], o3[5]); pk.w = pk2(o3[6], o3[7]); *(u32x4*)(Kh + t * LD64 + 8 * c8) = pk;
            pk.x = pk2(o4[0], o4[1]); pk.y = pk2(o4[2], o4[3]); pk.z = pk2(o4[4], o4[5]); pk.w = pk2(o4[6], o4[7]); *(u32x4*)(Rt + t * LD64 + 8 * c8) = pk;
        }
        lds_barrier(); RW_MARK(4);
        bf16* AbI = (bf16*)Ab; bf16* AbT = AbI + 64 * LD64;
        bf16* WK0 = AbT + 64 * LD64; bf16* WK1 = Bh;
        {
#pragma unroll 1
            for (int job = w; job < 18; job += 8) {
                const bool tr = job >= 16; const int mat = tr ? 0 : (job >> 2), ti = tr ? (job - 16) : ((job >> 1) & 1), tj = tr ? ti : (job & 1);
                const bf16* first = mat < 2 ? KKt : Rt; const bf16* second = (mat == 0 || mat == 3) ? Bh : Kh;
                f32x16 acc;
#pragma unroll
                for (int g = 0; g < 16; ++g) acc[g] = C.zf();
                const bf16* opA = tr ? first + (32 * ti + r) * LD64 : second + (32 * tj + r) * LD64; const bf16* opB = tr ? second + (32 * tj + r) * LD64 : first + (32 * ti + r) * LD64;
                if (tj <= ti) {
#pragma unroll
                    for (int s4 = 0; s4 < 4; ++s4) acc = mfma32(ldfrag(opA + 16 * s4 + 8 * hh), ldfrag(opB + 16 * s4 + 8 * hh), acc);
                }
                const int fx = 32 * (tr ? tj : ti) + r; const bool incl = mat >= 2; const float sg = mat == 3 ? -1.0f : 1.0f;
                bf16* dstI = tr ? AbT : (mat == 0 ? AbI : (mat == 1 ? Ak : (mat == 2 ? Ark : ArbN)));
#pragma unroll
                for (int g4 = 0; g4 < 4; ++g4) { float v4[4];
#pragma unroll
                    for (int q = 0; q < 4; ++q) { const int y = 32 * (tr ? ti : tj) + 8 * g4 + 4 * hh + q; const int tt_ = tr ? y : fx, ii_ = tr ? fx : y;
                        v4[q] = (incl ? ii_ <= tt_ : ii_ < tt_) ? acc[4 * g4 + q] * sg : 0.f; }
                    u32x2 pk; pk.x = pk2(v4[0], v4[1]); pk.y = pk2(v4[2], v4[3]);
                    *(u32x2*)(dstI + fx * LD64 + 32 * (tr ? ti : tj) + 8 * g4 + 4 * hh) = pk; }
            }
        }
        lds_barrier(); RW_MARK(5);
        for (int rp = 0; rp < (RPROBE == 8 ? 2 : 1); ++rp)
        if (w < 2) {
            const int d = w; bf16* wk = d ? WK1 : WK0;
            bf16* PA = wk; bf16* PAT = wk + 1280; bf16* PB = wk + 2560; bf16* PBT = wk + 3840; bf16* TA = wk + 5120; bf16* TB = wk + 6400;
            const bf16* Pc = AbI + (32 * d) * LD64 + 32 * d; const bf16* PTc = AbT + (32 * d) * LD64 + 32 * d; int ldp = LD64;
            {   float v8[8], o8[8];
#pragma unroll
                for (int q = 0; q < 2; ++q) { ld8(Pc + r * LD64 + 16 * hh + 8 * q, v8);
#pragma unroll
                    for (int j = 0; j < 8; ++j) o8[j] = ((16 * hh + 8 * q + j) == r ? 1.0f : 0.0f) - v8[j];
                    u32x4 pk; pk.x = pk2(o8[0], o8[1]); pk.y = pk2(o8[2], o8[3]); pk.z = pk2(o8[4], o8[5]); pk.w = pk2(o8[6], o8[7]); *(u32x4*)(TA + r * 40 + 16 * hh + 8 * q) = pk; } }
            asm volatile("s_waitcnt lgkmcnt(0)" ::: "memory");
#pragma unroll
            for (int k = 0; k < 4; ++k) {
                bf16* Pn = (k & 1) ? PA : PB; bf16* PnT = (k & 1) ? PAT : PBT; const bf16* Tc = (k & 1) ? TB : TA; bf16* Tn = (k & 1) ? TA : TB;
                f32x16 a1, a2;
#pragma unroll
                for (int g = 0; g < 16; ++g) { a1[g] = C.zf(); a2[g] = C.zf(); }
#pragma unroll
                for (int s2 = 0; s2 < 2; ++s2) { const bf16x8 fp = ldfrag(Pc + r * ldp + 16 * s2 + 8 * hh), ft = ldfrag(PTc + r * ldp + 16 * s2 + 8 * hh);
                    a1 = mfma32(ft, fp, a1);
                    a2 = mfma32(fp, ft, a2); }
#pragma unroll
                for (int g4 = 0; g4 < 4; ++g4) { u32x2 pk; pk.x = pk2(a1[4 * g4], a1[4 * g4 + 1]); pk.y = pk2(a1[4 * g4 + 2], a1[4 * g4 + 3]); *(u32x2*)(Pn + r * 40 + 8 * g4 + 4 * hh) = pk;
                    pk.x = pk2(a2[4 * g4], a2[4 * g4 + 1]); pk.y = pk2(a2[4 * g4 + 2], a2[4 * g4 + 3]); *(u32x2*)(PnT + r * 40 + 8 * g4 + 4 * hh) = pk; }
                asm volatile("s_waitcnt lgkmcnt(0)" ::: "memory");
#pragma unroll
                for (int g = 0; g < 16; ++g) a1[g] = C.zf();
#pragma unroll
                for (int s2 = 0; s2 < 2; ++s2) a1 = mfma32(ldfrag(PnT + r * 40 + 16 * s2 + 8 * hh), ldfrag(Tc + r * 40 + 16 * s2 + 8 * hh), a1);
#pragma unroll
                for (int g4 = 0; g4 < 4; ++g4) { float t4[4]; ld4(Tc + r * 40 + 8 * g4 + 4 * hh, t4);
                    u32x2 pk; pk.x = pk2(t4[0] + a1[4 * g4], t4[1] + a1[4 * g4 + 1]); pk.y = pk2(t4[2] + a1[4 * g4 + 2], t4[3] + a1[4 * g4 + 3]); *(u32x2*)(Tn + r * 40 + 8 * g4 + 4 * hh) = pk; }
                asm volatile("s_waitcnt lgkmcnt(0)" ::: "memory");
                Pc = Pn; PTc = PnT; ldp = 40;
            }
        } else if (w >= 4) {
            const int ti = (w >> 1) & 1, vj = w & 1;
            f32x16 acc;
#pragma unroll
            for (int g = 0; g < 16; ++g) acc[g] = C.zf();
#pragma unroll
            for (int s4 = 0; s4 < 4; ++s4) acc = mfma32(ldfrag(Ak + (32 * ti + r) * LD64 + 16 * s4 + 8 * hh), ldfrag(VT + (32 * vj + r) * LD64 + SW8(32 * vj + r, 2 * s4 + hh)), acc);
#pragma unroll
            for (int g4 = 0; g4 < 4; ++g4) { u32x2 pk; pk.x = pk2(acc[4 * g4], acc[4 * g4 + 1]); pk.y = pk2(acc[4 * g4 + 2], acc[4 * g4 + 3]); *(u32x2*)(UT + (32 * vj + r) * LD64 + SW8(32 * vj + r, 4 * ti + g4) + 4 * hh) = pk; }
        }
        lds_barrier(); RW_MARK(6);
        for (int rp = 0; rp < (RPROBE == 9 ? 2 : 1); ++rp)
        if (w < 4) {
            const int R6 = 32 * (w & 1) + r; bf16* XT = (w < 2 ? WT : UT) + R6 * LD64;
            const bf16* T00 = WK0 + 5120; const bf16* T11 = WK1 + 5120;
            f32x16 acc;
#pragma unroll
            for (int g = 0; g < 16; ++g) acc[g] = C.zf();
#pragma unroll
            for (int s2 = 0; s2 < 2; ++s2) acc = mfma32(ldfrag(T00 + r * 40 + 16 * s2 + 8 * hh), ldfrag(XT + SW8(R6, 2 * s2 + hh)), acc);
#pragma unroll
            for (int g4 = 0; g4 < 4; ++g4) { u32x2 pk; pk.x = pk2(acc[4 * g4], acc[4 * g4 + 1]); pk.y = pk2(acc[4 * g4 + 2], acc[4 * g4 + 3]); *(u32x2*)(XT + SW8(R6, g4) + 4 * hh) = pk; }
            asm volatile("s_waitcnt lgkmcnt(0)" ::: "memory");
#pragma unroll
            for (int g = 0; g < 16; ++g) acc[g] = C.zf();
#pragma unroll
            for (int s2 = 0; s2 < 2; ++s2) acc = mfma32(ldfrag(AbI + (32 + r) * LD64 + 16 * s2 + 8 * hh), ldfrag(XT + SW8(R6, 2 * s2 + hh)), acc);
#pragma unroll
            for (int g4 = 0; g4 < 4; ++g4) { float r4[4]; ld4(XT + SW8(R6, 4 + g4) + 4 * hh, r4);
                u32x2 pk; pk.x = pk2(r4[0] - acc[4 * g4], r4[1] - acc[4 * g4 + 1]); pk.y = pk2(r4[2] - acc[4 * g4 + 2], r4[3] - acc[4 * g4 + 3]); *(u32x2*)(XT + SW8(R6, 4 + g4) + 4 * hh) = pk; }
            asm volatile("s_waitcnt lgkmcnt(0)" ::: "memory");
#pragma unroll
            for (int g = 0; g < 16; ++g) acc[g] = C.zf();
#pragma unroll
            for (int s2 = 0; s2 < 2; ++s2) acc = mfma32(ldfrag(T11 + r * 40 + 16 * s2 + 8 * hh), ldfrag(XT + SW8(R6, 4 + 2 * s2 + hh)), acc);
#pragma unroll
            for (int g4 = 0; g4 < 4; ++g4) { u32x2 pk; pk.x = pk2(acc[4 * g4], acc[4 * g4 + 1]); pk.y = pk2(acc[4 * g4 + 2], acc[4 * g4 + 3]); *(u32x2*)(XT + SW8(R6, 4 + g4) + 4 * hh) = pk; }
        }
        lds_barrier(); RW_MARK(7);
        {
            int t7 = tid; asm volatile("" : "+v"(t7));
            const int lane = t7 & 63, r = lane & 31, hh = lane >> 5;
            const int p2 = (w >> 1) & 1, xj = w & 1; const bool lo = w < 4;
            const bf16* A1 = lo ? Ark : KbT; const bf16* A2 = lo ? ArbN : BbTN;
            f32x16 acc;
#pragma unroll
            for (int g = 0; g < 16; ++g) acc[g] = C.zf();
#pragma unroll
            for (int s = 0; s < 4; ++s) acc = mfma32(ldfrag(A1 + (32 * p2 + r) * LD64 + (lo ? 16 * s + 8 * hh : SW8(32 * p2 + r, 2 * s + hh))), ldfrag(VT + (32 * xj + r) * LD64 + SW8(32 * xj + r, 2 * s + hh)), acc);
#pragma unroll
            for (int s = 0; s < 4; ++s) acc = mfma32(ldfrag(A2 + (32 * p2 + r) * LD64 + (lo ? 16 * s + 8 * hh : SW8(32 * p2 + r, 2 * s + hh))), ldfrag(UT + (32 * xj + r) * LD64 + SW8(32 * xj + r, 2 * s + hh)), acc);
            {   bf16* dst = lo ? GPTR(bf16, C.ws + WS_YP + (size_t)u * 8192) : (bf16*)GPTR(bf16, rwkv_zp(C, u));
                u32x4 q0, q1; q0.x = pk2(acc[0], acc[1]); q0.y = pk2(acc[2], acc[3]); q0.z = pk2(acc[4], acc[5]); q0.w = pk2(acc[6], acc[7]);
                q1.x = pk2(acc[8], acc[9]); q1.y = pk2(acc[10], acc[11]); q1.z = pk2(acc[12], acc[13]); q1.w = pk2(acc[14], acc[15]);
                *(u32x4*)(dst + ((p2 * 2 + xj) * 64 + lane) * 16) = q0; *(u32x4*)(dst + ((p2 * 2 + xj) * 64 + lane) * 16 + 8) = q1; }
#pragma unroll
            for (int g = 0; g < 16; ++g) acc[g] = C.zf();
#pragma unroll
            for (int s = 0; s < 4; ++s) acc = mfma32(ldfrag(WT + (32 * xj + r) * LD64 + SW8(32 * xj + r, 2 * s + hh)), ldfrag(A2 + (32 * p2 + r) * LD64 + (lo ? 16 * s + 8 * hh : SW8(32 * p2 + r, 2 * s + hh))), acc);
            const int x = 32 * p2 + r;
            bf16* dst = lo ? GPTR(bf16, C.ws + WS_RP + (size_t)u * 8192) : GPTR(bf16, C.ws + WS_MM + (size_t)u * 8192);
#pragma unroll
            for (int g4 = 0; g4 < 4; ++g4) { const int c0 = 32 * xj + 8 * g4 + 4 * hh; float v4[4];
                if (lo) { float rt4[4]; ld4(Rt + x * LD64 + c0, rt4);
#pragma unroll
                    for (int q = 0; q < 4; ++q) v4[q] = acc[4 * g4 + q] + rt4[q]; }
                else {
#pragma unroll
                    for (int q = 0; q < 4; ++q) v4[q] = acc[4 * g4 + q] + ((c0 + q) == x ? sGL[x] : 0.f); }
                u32x2 pk; pk.x = pk2(v4[0], v4[1]); pk.y = pk2(v4[2], v4[3]);
                *(u32x2*)(dst + ((((x >> 5) * 4 + (c0 >> 4)) * 64 + (x & 31) + 32 * ((c0 >> 3) & 1)) * 8) + (c0 & 7)) = pk; }
        }
        RW_MARK(9);
    }
}

#undef RP_LOAD
__device__ __forceinline__ void rwkv_chain3_block(const Ctx& C, int e, int rb, int xs, unsigned char* lds) {
    const int tid = C.tid(), lane = C.lane(), w = C.wave, r = lane & 31, hh = lane >> 5;
    const int b = rb >> 3, h = rb & 7;
    bf16* Y = GPTR(bf16, C.ws + WS_Y);
    bf16* ZT0 = (bf16*)lds; bf16* ZT1 = ZT0 + 32 * LD64; bf16* ys = ZT1 + 32 * LD64 + (w & 1) * (32 * 40);
    for (int i = tid; i < 2 * 32 * LD64 / 2; i += NTHREADS) ((unsigned*)ZT0)[i] = 0u;
    if (w >= 4) { __syncthreads();
#pragma unroll 1
        for (int ch = 0; ch < SEQ / 64; ++ch) lds_barrier();
        return; }
    const bool lo = w < 2; const int p2 = w & 1, xj = xs;
    bf16x8 af[8][4]; u32x4 i0[8], i1[8];
#define R3_LOAD(j_, ch_) do { const int u_ = (rb * 64) + (ch_); const bf16* A_ = lo ? GPTR(const bf16, C.ws + WS_RP + (size_t)u_ * 8192) : GPTR(const bf16, C.ws + WS_MM + (size_t)u_ * 8192); \
        const bf16* I_ = lo ? GPTR(const bf16, C.ws + WS_YP + (size_t)u_ * 8192) : (const bf16*)GPTR(const bf16, rwkv_zp(C, u_)); \
        _Pragma("unroll") for (int s = 0; s < 4; ++s) af[j_][s] = *(const bf16x8*)(A_ + ((p2 * 4 + s) * 64 + lane) * 8); \
        i0[j_] = *(const u32x4*)(I_ + ((p2 * 2 + xj) * 64 + lane) * 16); i1[j_] = *(const u32x4*)(I_ + ((p2 * 2 + xj) * 64 + lane) * 16 + 8); } while (0)
    R3_LOAD(0, 0); RING_FENCE; R3_LOAD(1, 1); RING_FENCE; R3_LOAD(2, 2); RING_FENCE; R3_LOAD(3, 3); RING_FENCE; R3_LOAD(4, 4); RING_FENCE; R3_LOAD(5, 5); RING_FENCE; R3_LOAD(6, 6); RING_FENCE; R3_LOAD(7, 7); RING_FENCE;
    __syncthreads();
#pragma unroll 1
    for (int ch0 = 0; ch0 < SEQ / 64; ch0 += 8) {
#pragma unroll
        for (int j = 0; j < 8; ++j) {
            const int ch = ch0 + j;
            const bf16* ZTc = (j & 1) ? ZT1 : ZT0; bf16* ZTn = (j & 1) ? ZT0 : ZT1;
            f32x16 acc;
            acc[0] = bf2f(i0[j].x & 0xffffu); acc[1] = bf2f(i0[j].x >> 16); acc[2] = bf2f(i0[j].y & 0xffffu); acc[3] = bf2f(i0[j].y >> 16);
            acc[4] = bf2f(i0[j].z & 0xffffu); acc[5] = bf2f(i0[j].z >> 16); acc[6] = bf2f(i0[j].w & 0xffffu); acc[7] = bf2f(i0[j].w >> 16);
            acc[8] = bf2f(i1[j].x & 0xffffu); acc[9] = bf2f(i1[j].x >> 16); acc[10] = bf2f(i1[j].y & 0xffffu); acc[11] = bf2f(i1[j].y >> 16);
            acc[12] = bf2f(i1[j].z & 0xffffu); acc[13] = bf2f(i1[j].z >> 16); acc[14] = bf2f(i1[j].w & 0xffffu); acc[15] = bf2f(i1[j].w >> 16);
#pragma unroll
            for (int s = 0; s < 4; ++s) acc = mfma32(af[j][s], ldfrag(ZTc + r * LD64 + 16 * s + 8 * hh), acc);
            R3_LOAD(j, (ch + 8 < SEQ / 64 ? ch + 8 : SEQ / 64 - 1));
            if (lo) {
                const size_t m0 = (size_t)b * SEQ + 64 * ch;
#pragma unroll
                for (int g = 0; g < 16; ++g) ys[drow(g, hh) * 40 + r] = (bf16)f2bf(acc[g]);
                asm volatile("s_waitcnt lgkmcnt(0)" ::: "memory");
#pragma unroll
                for (int q = 0; q < 2; ++q) { const int rw = 16 * q + (lane >> 2), pc = 8 * (lane & 3);
                    *(u32x4*)(Y + (m0 + 32 * p2 + rw) * DM + 512 + h * 64 + 32 * xj + pc) = *(const u32x4*)(ys + rw * 40 + pc); }
            } else {
#pragma unroll
                for (int g4 = 0; g4 < 4; ++g4) { u32x2 pk; pk.x = pk2(acc[4 * g4], acc[4 * g4 + 1]); pk.y = pk2(acc[4 * g4 + 2], acc[4 * g4 + 3]);
                    *(u32x2*)(ZTn + r * LD64 + 32 * p2 + 8 * g4 + 4 * hh) = pk; }
            }
            lds_barrier();
        }
    }
#undef R3_LOAD
}

constexpr size_t WS_QKD = WS_R1 + (size_t)M * OD_PAD * 2;
static_assert(WS_QKD + 8 * MiB == WS_R1 + 128 * MiB, "odd-layer map");
constexpr size_t P_PITCH = (size_t)OD_PAD * 2;

#ifdef TP_GD
#define GD_MARK(k_) do { const unsigned long long tn_ = __builtin_amdgcn_s_memrealtime(); if ((TP_GD >> (k_)) & 1) { while (__builtin_amdgcn_s_memrealtime() - tn_ < tn_ - gd_tprev_) __builtin_amdgcn_s_sleep(2); } gd_tprev_ = __builtin_amdgcn_s_memrealtime(); } while (0)
#else
#define GD_MARK(k_) do { } while (0)
#endif
__device__ __forceinline__ void gdn_pre3(const Ctx& C, int o_in, int unit_in, unsigned char* lds, bool dummy = false) {
#ifdef TP_GD
    unsigned long long gd_tprev_ = __builtin_amdgcn_s_memrealtime();
#endif
    int o = o_in, unit = unit_in; asm volatile("" : "+s"(o), "+s"(unit));
    int tid_ = C.tid(); asm volatile("" : "+v"(tid_));
    const int tid = tid_, lane = tid & 63, w = __builtin_amdgcn_readfirstlane(tid >> 6), r = lane & 31, hh = lane >> 5;
    const int bh = unit >> 6, n = unit & 63, b = bh >> 2, h = bh & 3, t0 = n * 64;
    const size_t m0 = (size_t)b * SEQ + t0;
    const bf16* P = GPTR(const bf16, C.ws + WS_R1); const bf16* HALO = GPTR(const bf16, C.ws + WS_HALO);
    const float* convw = C.in(28) + (size_t)o * 4 * 1536;
    bf16* QhB = (bf16*)lds; bf16* KhB = QhB + 64 * LD128; bf16* XW = KhB + 64 * LD128; bf16* XU = XW + 128 * LD64;
    bf16* AbI = XU + 128 * LD64; bf16* AbT = AbI + 64 * LD64; bf16* QKdI = AbT + 64 * LD64; bf16* WK0 = QKdI + 64 * LD64; bf16* WK1 = WK0 + 7680;
    float* sGC = (float*)(WK1 + 7680); float* sBe = sGC + 64; float* sEg = sBe + 64; float* sBE = sEg + 64; float* sEk = sBE + 64;
    const int l16 = tid & 15, typ = (tid >> 4) & 1, tg = tid >> 5;
#define G3_ROW(t_) ((t_) >= t0 ? P + ((size_t)b * SEQ + (t_)) * OD_PAD : HALO + ((size_t)((b * 64 + n - 1) * 3 + ((t_) - (t0 - 3)))) * OD_PAD)
    const float g_al = C.in(29)[o * 4 + h], g_dt = C.in(30)[o * 4 + h];
    const int pc0 = (typ ? 512 : 0) + h * 128 + 8 * l16, pc1 = 1024 + h * 128 + 8 * l16, tv0 = 4 * tg + 2 * typ;
    float cw[4][8], cv[4][8], x[7][8], xv[5][8];
#pragma unroll
    for (int k = 0; k < 4; ++k) { const f32x4 a = *(const f32x4*)(convw + k * 1536 + pc0), c2 = *(const f32x4*)(convw + k * 1536 + pc0 + 4);
        cw[k][0] = a[0]; cw[k][1] = a[1]; cw[k][2] = a[2]; cw[k][3] = a[3]; cw[k][4] = c2[0]; cw[k][5] = c2[1]; cw[k][6] = c2[2]; cw[k][7] = c2[3];
        const f32x4 a1 = *(const f32x4*)(convw + k * 1536 + pc1), c3 = *(const f32x4*)(convw + k * 1536 + pc1 + 4);
        cv[k][0] = a1[0]; cv[k][1] = a1[1]; cv[k][2] = a1[2]; cv[k][3] = a1[3]; cv[k][4] = c3[0]; cv[k][5] = c3[1]; cv[k][6] = c3[2]; cv[k][7] = c3[3]; }
#pragma unroll
    for (int i = 0; i < 7; ++i) { const int t = t0 + 4 * tg - 3 + i;
        const int tc = t >= 0 ? t : 0; ld8(G3_ROW(tc) + pc0, x[i]);
#pragma unroll
        for (int j = 0; j < 8; ++j) x[i][j] = t >= 0 ? x[i][j] : 0.f; }
#pragma unroll
    for (int i = 0; i < 5; ++i) { const int t = t0 + tv0 - 3 + i;
        const int tc = t >= 0 ? t : 0; ld8(G3_ROW(tc) + pc1, xv[i]);
#pragma unroll
        for (int j = 0; j < 8; ++j) xv[i][j] = t >= 0 ? xv[i][j] : 0.f; }
    float gq_b, gq_a;
    { const bf16* row = P + (m0 + lane) * OD_PAD; gq_b = bf2f(row[OC_GB + h]); gq_a = bf2f(row[OC_GA + h]); }
    lds_barrier(); GD_MARK(1);
    if (w == 0) {
        const float be = sigm(gq_b);
        float g = -fexp(g_al) * softplusf(gq_a + g_dt);
#pragma unroll
        for (int d = 1; d < 64; d <<= 1) { const float upv = __shfl_up(g, d); if (lane >= d) g += upv; }
        const float gl = __shfl(g, 63); const float eg = fexp(g);
        sGC[lane] = g; sBe[lane] = be; sEg[lane] = eg; sBE[lane] = be * eg;
        sEk[lane] = fexp(gl - g);
        if (lane == 0) (GPTR(float, C.ws + WS_DEN) + (size_t)unit * 256)[128] = fexp(gl);
    }
    float ko[4][8];
    float vo[2][8];
    {
#pragma unroll
        for (int tt = 0; tt < 4; ++tt) { const int tl = 4 * tg + tt; float o8[8]; float ss = C.zf();
#pragma unroll
            for (int j = 0; j < 8; ++j) { float a = C.zf();
#pragma unroll
                for (int k = 0; k < 4; ++k) a += cw[k][j] * x[tt + k][j];
                a = siluf(a); o8[j] = a; ss += a * a; }
            ss = row_sum16(ss);
            const float sc = frsq(ss + 1e-6f) * (typ ? 1.0f : 0.08838834764831845f);
#pragma unroll
            for (int j = 0; j < 8; ++j) o8[j] *= sc;
            u32x4 pk; pk.x = pk2(o8[0], o8[1]); pk.y = pk2(o8[2], o8[3]); pk.z = pk2(o8[4], o8[5]); pk.w = pk2(o8[6], o8[7]);
            *(u32x4*)((typ ? KhB : QhB) + tl * LD128 + 8 * l16) = pk;
#pragma unroll
            for (int j = 0; j < 8; ++j) ko[tt][j] = o8[j];
        }
#pragma unroll
        for (int tt = 0; tt < 2; ++tt) {
#pragma unroll
            for (int j = 0; j < 8; ++j) { float a = C.zf();
#pragma unroll
                for (int k = 0; k < 4; ++k) a += cv[k][j] * xv[tt + k][j];
                vo[tt][j] = siluf(a); }
        }
    }
    lds_barrier(); GD_MARK(2);
    if (typ) {
#pragma unroll
        for (int j = 0; j < 8; ++j) { u32x2 pk; pk.x = pk2(ko[0][j] * sBE[4 * tg], ko[1][j] * sBE[4 * tg + 1]); pk.y = pk2(ko[2][j] * sBE[4 * tg + 2], ko[3][j] * sBE[4 * tg + 3]); *(u32x2*)(XW + (8 * l16 + j) * LD64 + 4 * tg) = pk; }
    }
    {
        const float b0 = sBe[tv0], b1 = sBe[tv0 + 1];
#pragma unroll
        for (int j = 0; j < 8; ++j) *(unsigned*)(XU + (8 * l16 + j) * LD64 + tv0) = pk2(vo[0][j] * b0, vo[1][j] * b1);
    }
    lds_barrier(); GD_MARK(3);
    {
        bf16* Pw = GPTR(bf16, C.ws + WS_R1);
#pragma unroll
        for (int q = 0; q < 2; ++q) { const int p = tid + 512 * q, ln = p & 63, s8 = (p >> 6) & 7, R = p >> 9;
            float v8[8]; ld8(QhB + (32 * R + (ln & 31)) * LD128 + 16 * s8 + 8 * (ln >> 5), v8); const float eg = sEg[32 * R + (ln & 31)];
            u32x4 pk; pk.x = pk2(v8[0] * eg, v8[1] * eg); pk.y = pk2(v8[2] * eg, v8[3] * eg); pk.z = pk2(v8[4] * eg, v8[5] * eg); pk.w = pk2(v8[6] * eg, v8[7] * eg);
            if (!dummy) stwt16(Pw + (m0 + (p >> 4)) * OD_PAD + h * 128 + (p & 15) * 8, pk); }
#pragma unroll
        for (int q = 0; q < 2; ++q) { const int p = tid + 512 * q, ln = p & 63, s4 = (p >> 6) & 3, kt = p >> 8;
            const int k = 32 * kt + (ln & 31), tq = 16 * s4 + 8 * (ln >> 5);
            float e[8];
#pragma unroll
            for (int j = 0; j < 8; ++j) e[j] = bf2f((unsigned)(unsigned short)KhB[(tq + j) * LD128 + k]) * sEk[tq + j];
            u32x4 pk; pk.x = pk2(e[0], e[1]); pk.y = pk2(e[2], e[3]); pk.z = pk2(e[4], e[5]); pk.w = pk2(e[6], e[7]);
            if (!dummy) stwt16(Pw + (m0 + (p >> 4)) * OD_PAD + 512 + h * 128 + (p & 15) * 8, pk); }
#pragma unroll 1
        for (int job = w; job < 10; job += 8) {
            const bool tr = job == 4 || job == 5, isq = job >= 6; const int jj = isq ? job - 6 : job; const int ti = tr ? job - 4 : ((jj >> 1) & 1), tj = tr ? ti : (jj & 1);
            const bf16* first = isq ? QhB : KhB;
            f32x16 acc;
#pragma unroll
            for (int g = 0; g < 16; ++g) acc[g] = C.zf();
            const bf16* opA = tr ? first + (32 * ti + r) * LD128 : KhB + (32 * tj + r) * LD128; const bf16* opB = tr ? KhB + (32 * tj + r) * LD128 : first + (32 * ti + r) * LD128;
            if (tj <= ti) {
#pragma unroll
                for (int s8 = 0; s8 < 8; ++s8) acc = mfma32(ldfrag(opA + 16 * s8 + 8 * hh), ldfrag(opB + 16 * s8 + 8 * hh), acc);
            }
            const int fx = 32 * (tr ? tj : ti) + r;
            bf16* dstI = tr ? AbT : (isq ? QKdI : AbI);
#pragma unroll
            for (int g4 = 0; g4 < 4; ++g4) { float v4[4];
#pragma unroll
                for (int q = 0; q < 4; ++q) { const int y = 32 * (tr ? ti : tj) + 8 * g4 + 4 * hh + q; const int tt_ = tr ? y : fx, ii_ = tr ? fx : y;
                    const float dec = fexp(sGC[tt_] - sGC[ii_]);
                    v4[q] = isq ? (ii_ <= tt_ ? acc[4 * g4 + q] * dec : 0.f) : (ii_ < tt_ ? acc[4 * g4 + q] * dec * sBe[tt_] : 0.f); }
                u32x2 pk; pk.x = pk2(v4[0], v4[1]); pk.y = pk2(v4[2], v4[3]);
                *(u32x2*)(dstI + fx * LD64 + 32 * (tr ? ti : tj) + 8 * g4 + 4 * hh) = pk; }
        }
    }
    lds_barrier(); GD_MARK(4);
    if (w < 2) {
        const int d = w; bf16* wk = d ? WK1 : WK0;
        bf16* PA = wk; bf16* PAT = wk + 1280; bf16* PB = wk + 2560; bf16* PBT = wk + 3840; bf16* TA = wk + 5120; bf16* TB = wk + 6400;
        const bf16* Pc = AbI + (32 * d) * LD64 + 32 * d; const bf16* PTc = AbT + (32 * d) * LD64 + 32 * d; int ldp = LD64;
        {   float v8[8], o8[8];
#pragma unroll
            for (int q = 0; q < 2; ++q) { ld8(Pc + r * LD64 + 16 * hh + 8 * q, v8);
#pragma unroll
                for (int j = 0; j < 8; ++j) o8[j] = ((16 * hh + 8 * q + j) == r ? 1.0f : 0.0f) - v8[j];
                u32x4 pk; pk.x = pk2(o8[0], o8[1]); pk.y = pk2(o8[2], o8[3]); pk.z = pk2(o8[4], o8[5]); pk.w = pk2(o8[6], o8[7]); *(u32x4*)(TA + r * 40 + 16 * hh + 8 * q) = pk; } }
        asm volatile("s_waitcnt lgkmcnt(0)" ::: "memory");
#pragma unroll
        for (int k = 0; k < 4; ++k) {
            bf16* Pn = (k & 1) ? PA : PB; bf16* PnT = (k & 1) ? PAT : PBT; const bf16* Tc = (k & 1) ? TB : TA; bf16* Tn = (k & 1) ? TA : TB;
            f32x16 a1, a2;
#pragma unroll
            for (int g = 0; g < 16; ++g) { a1[g] = C.zf(); a2[g] = C.zf(); }
#pragma unroll
            for (int s2 = 0; s2 < 2; ++s2) { const bf16x8 fp = ldfrag(Pc + r * ldp + 16 * s2 + 8 * hh), ft = ldfrag(PTc + r * ldp + 16 * s2 + 8 * hh);
                a1 = mfma32(ft, fp, a1); a2 = mfma32(fp, ft, a2); }
#pragma unroll
            for (int g4 = 0; g4 < 4; ++g4) { u32x2 pk; pk.x = pk2(a1[4 * g4], a1[4 * g4 + 1]); pk.y = pk2(a1[4 * g4 + 2], a1[4 * g4 + 3]); *(u32x2*)(Pn + r * 40 + 8 * g4 + 4 * hh) = pk;
                pk.x = pk2(a2[4 * g4], a2[4 * g4 + 1]); pk.y = pk2(a2[4 * g4 + 2], a2[4 * g4 + 3]); *(u32x2*)(PnT + r * 40 + 8 * g4 + 4 * hh) = pk; }
            asm volatile("s_waitcnt lgkmcnt(0)" ::: "memory");
#pragma unroll
            for (int g = 0; g < 16; ++g) a1[g] = C.zf();
#pragma unroll
            for (int s2 = 0; s2 < 2; ++s2) a1 = mfma32(ldfrag(PnT + r * 40 + 16 * s2 + 8 * hh), ldfrag(Tc + r * 40 + 16 * s2 + 8 * hh), a1);
#pragma unroll
            for (int g4 = 0; g4 < 4; ++g4) { float t4[4]; ld4(Tc + r * 40 + 8 * g4 + 4 * hh, t4);
                u32x2 pk; pk.x = pk2(t4[0] + a1[4 * g4], t4[1] + a1[4 * g4 + 1]); pk.y = pk2(t4[2] + a1[4 * g4 + 2], t4[3] + a1[4 * g4 + 3]); *(u32x2*)(Tn + r * 40 + 8 * g4 + 4 * hh) = pk; }
            asm volatile("s_waitcnt lgkmcnt(0)" ::: "memory");
            Pc = Pn; PTc = PnT; ldp = 40;
        }
    }
    lds_barrier(); GD_MARK(5);
    {
        bf16* XT = (w < 4 ? XW : XU) + (32 * (w & 3) + r) * LD64;
        const bf16* T00 = WK0 + 5120; const bf16* T11 = WK1 + 5120;
        f32x16 acc;
#pragma unroll
        for (int g = 0; g < 16; ++g) acc[g] = C.zf();
#pragma unroll
        for (int s2 = 0; s2 < 2; ++s2) acc = mfma32(ldfrag(T00 + r * 40 + 16 * s2 + 8 * hh), ldfrag(XT + 16 * s2 + 8 * hh), acc);
#pragma unroll
        for (int g4 = 0; g4 < 4; ++g4) { u32x2 pk; pk.x = pk2(acc[4 * g4], acc[4 * g4 + 1]); pk.y = pk2(acc[4 * g4 + 2], acc[4 * g4 + 3]); *(u32x2*)(XT + 8 * g4 + 4 * hh) = pk; }
        asm volatile("s_waitcnt lgkmcnt(0)" ::: "memory");
#pragma unroll
        for (int g = 0; g < 16; ++g) acc[g] = C.zf();
#pragma unroll
        for (int s2 = 0; s2 < 2; ++s2) acc = mfma32(ldfrag(AbI + (32 + r) * LD64 + 16 * s2 + 8 * hh), ldfrag(XT + 16 * s2 + 8 * hh), acc);
#pragma unroll
        for (int g4 = 0; g4 < 4; ++g4) { float r4[4]; ld4(XT + 32 + 8 * g4 + 4 * hh, r4);
            u32x2 pk; pk.x = pk2(r4[0] - acc[4 * g4], r4[1] - acc[4 * g4 + 1]); pk.y = pk2(r4[2] - acc[4 * g4 + 2], r4[3] - acc[4 * g4 + 3]); *(u32x2*)(XT + 32 + 8 * g4 + 4 * hh) = pk; }
        asm volatile("s_waitcnt lgkmcnt(0)" ::: "memory");
#pragma unroll
        for (int g = 0; g < 16; ++g) acc[g] = C.zf();
#pragma unroll
        for (int s2 = 0; s2 < 2; ++s2) acc = mfma32(ldfrag(T11 + r * 40 + 16 * s2 + 8 * hh), ldfrag(XT + 32 + 16 * s2 + 8 * hh), acc);
#pragma unroll
        for (int g4 = 0; g4 < 4; ++g4) { u32x2 pk; pk.x = pk2(acc[4 * g4], acc[4 * g4 + 1]); pk.y = pk2(acc[4 * g4 + 2], acc[4 * g4 + 3]); *(u32x2*)(XT + 32 + 8 * g4 + 4 * hh) = pk; }
    }
    lds_barrier(); GD_MARK(6);
    {
        bf16* Wg = GPTR(bf16, C.ws + WS_XB + (size_t)unit * GDN_UNIT_BYTES); bf16* Ug = Wg + 64 * 128; bf16* Qg = GPTR(bf16, C.ws + WS_QKD + (size_t)unit * 8192);
#pragma unroll
        for (int q = 0; q < 2; ++q) { const int p = tid + 512 * q, ln = p & 63, s8 = (p >> 6) & 7, R = p >> 9; const int t = 32 * R + (ln & 31), c0 = 16 * s8 + 8 * (ln >> 5);
            unsigned e[8];
#pragma unroll
            for (int j = 0; j < 8; ++j) e[j] = XW[(c0 + j) * LD64 + t] ^ 0x8000u;
            u32x4 pk; pk.x = e[0] | (e[1] << 16); pk.y = e[2] | (e[3] << 16); pk.z = e[4] | (e[5] << 16); pk.w = e[6] | (e[7] << 16);
            stwt16(Wg + p * 8, pk); }
#pragma unroll
        for (int q = 0; q < 2; ++q) { const int p = tid + 512 * q, tile = p >> 7, ln = (p >> 1) & 63, q8 = p & 1;
            const int v = 32 * (tile & 3) + (ln & 31), hq = ln >> 5, thh = tile >> 2;
            const u32x2 a = *(const u32x2*)(XU + v * LD64 + 32 * thh + 8 * (2 * q8) + 4 * hq), c2 = *(const u32x2*)(XU + v * LD64 + 32 * thh + 8 * (2 * q8 + 1) + 4 * hq);
            u32x4 pk; pk.x = a.x; pk.y = a.y; pk.z = c2.x; pk.w = c2.y;
            stwt16(Ug + p * 8, pk); }
        {   const int p = tid, ln = p & 63, s4 = (p >> 6) & 3, R = p >> 8;
            stwt16(Qg + p * 8, *(const u32x4*)(QKdI + (32 * R + (ln & 31)) * LD64 + 16 * s4 + 8 * (ln >> 5))); }
    }
#undef G3_ROW
    GD_MARK(7);
}

__device__ __forceinline__ void gdn_chain4_block(const Ctx& C, int gb, int c, unsigned char* lds) {
    const int w = C.wave;
    const int b = gb >> 2, h = gb & 3;
    const bf16* P = GPTR(const bf16, C.ws + WS_R1); bf16* Y = GPTR(bf16, C.ws + WS_Y);
    bf16* VNT = (bf16*)lds; bf16* ST = VNT + 32 * LD64; bf16* KQ = ST + 32 * LD128;
    for (int i = C.tid(); i < 32 * LD128 / 2; i += NTHREADS) ((unsigned*)ST)[i] = 0u;
#define G4_LANE int ln_ = C.lane(); asm volatile("" : "+v"(ln_)); const int lane = ln_, r = lane & 31, hh = lane >> 5;
    if (w < 2) {
        const int th = w; G4_LANE
        bf16x8 wf[4][8]; u32x4 u0[4], u1[4];
#define G4_LV(j_, ch_) do { const int u_ = gb * 64 + (ch_); const bf16* Wg_ = GPTR(const bf16, C.ws + WS_XB + (size_t)u_ * GDN_UNIT_BYTES); const bf16* Ug_ = Wg_ + 64 * 128; \
        _Pragma("unroll") for (int s = 0; s < 8; ++s) wf[j_][s] = *(const bf16x8*)(Wg_ + ((th * 8 + s) * 64 + lane) * 8); \
        u0[j_] = *(const u32x4*)(Ug_ + ((th * 4 + c) * 64 + lane) * 16); u1[j_] = *(const u32x4*)(Ug_ + ((th * 4 + c) * 64 + lane) * 16 + 8); } while (0)
        G4_LV(0, 0); RING_FENCE; G4_LV(1, 1); RING_FENCE; G4_LV(2, 2); RING_FENCE; G4_LV(3, 3); RING_FENCE;
        __syncthreads();
#pragma unroll 1
        for (int ch0 = 0; ch0 < SEQ / 64; ch0 += 4) {
#pragma unroll
            for (int j = 0; j < 4; ++j) {
                const int ch = ch0 + j;
                f32x16 acc;
                acc[0] = bf2f(u0[j].x & 0xffffu); acc[1] = bf2f(u0[j].x >> 16); acc[2] = bf2f(u0[j].y & 0xffffu); acc[3] = bf2f(u0[j].y >> 16);
                acc[4] = bf2f(u0[j].z & 0xffffu); acc[5] = bf2f(u0[j].z >> 16); acc[6] = bf2f(u0[j].w & 0xffffu); acc[7] = bf2f(u0[j].w >> 16);
                acc[8] = bf2f(u1[j].x & 0xffffu); acc[9] = bf2f(u1[j].x >> 16); acc[10] = bf2f(u1[j].y & 0xffffu); acc[11] = bf2f(u1[j].y >> 16);
                acc[12] = bf2f(u1[j].z & 0xffffu); acc[13] = bf2f(u1[j].z >> 16); acc[14] = bf2f(u1[j].w & 0xffffu); acc[15] = bf2f(u1[j].w >> 16);
#pragma unroll
                for (int s = 0; s < 8; ++s) acc = mfma32(wf[j][s], ldfrag(ST + r * LD128 + 16 * s + 8 * hh), acc);
#pragma unroll
                for (int g4 = 0; g4 < 4; ++g4) { u32x2 pk; pk.x = pk2(acc[4 * g4], acc[4 * g4 + 1]); pk.y = pk2(acc[4 * g4 + 2], acc[4 * g4 + 3]);
                    *(u32x2*)(VNT + r * LD64 + 32 * th + 8 * g4 + 4 * hh) = pk; }
                G4_LV(j, (ch + 4 < SEQ / 64 ? ch + 4 : SEQ / 64 - 1));
                lds_barrier();
                lds_barrier();
            }
        }
#undef G4_LV
    } else if (w < 4) {
        const int th = w - 2; G4_LANE
        bf16x8 qf[4][8];
#define G4_LO(j_, ch_) do { const int u_ = gb * 64 + (ch_); const bf16* qsec_ = P + ((size_t)b * SEQ + 64 * (ch_)) * OD_PAD + h * 128; (void)u_; \
        _Pragma("unroll") for (int s = 0; s < 8; ++s) { const int p_ = (th * 8 + s) * 64 + lane; qf[j_][s] = *(const bf16x8*)(qsec_ + (size_t)(p_ >> 4) * OD_PAD + (p_ & 15) * 8); } \
        } while (0)
        G4_LO(0, 0); RING_FENCE; G4_LO(1, 1); RING_FENCE; G4_LO(2, 2); RING_FENCE; G4_LO(3, 3); RING_FENCE;
        __syncthreads();
#pragma unroll 1
        for (int ch0 = 0; ch0 < SEQ / 64; ch0 += 4) {
#pragma unroll
            for (int j = 0; j < 4; ++j) {
                const int ch = ch0 + j; const size_t m0 = (size_t)b * SEQ + 64 * ch;
                f32x16 oacc;
#pragma unroll
                for (int g = 0; g < 16; ++g) oacc[g] = C.zf();
#pragma unroll
                for (int s = 0; s < 8; ++s) oacc = mfma32(ldfrag(ST + r * LD128 + 16 * s + 8 * hh), qf[j][s], oacc);
                lds_barrier();
#pragma unroll
                for (int s = 0; s < 4; ++s) oacc = mfma32(ldfrag(VNT + r * LD64 + 16 * s + 8 * hh), ldfrag(KQ + (j & 1) * 4096 + ((th * 4 + s) * 64 + lane) * 8), oacc);
                G4_LO(j, (ch + 4 < SEQ / 64 ? ch + 4 : SEQ / 64 - 1));
#pragma unroll
                for (int g4 = 0; g4 < 4; ++g4) { u32x2 pk; pk.x = pk2(oacc[4 * g4], oacc[4 * g4 + 1]); pk.y = pk2(oacc[4 * g4 + 2], oacc[4 * g4 + 3]);
                    *(u32x2*)(Y + (m0 + 32 * th + r) * DM + h * 128 + 32 * c + 8 * g4 + 4 * hh) = pk; }
                lds_barrier();
            }
        }
#undef G4_LO
    } else {
        const int kt = w - 4; G4_LANE
        int lz = 0; asm volatile("" : "+v"(lz));
        bf16x8 kf[4][4]; float glv[4]; u32x4 kqr[4][2];
        f32x16 S;
#pragma unroll
        for (int g = 0; g < 16; ++g) S[g] = C.zf();
#define G4_LS(j_, ch_) do { const int u_ = gb * 64 + (ch_); const bf16* ksec_ = P + ((size_t)b * SEQ + 64 * (ch_)) * OD_PAD + 512 + h * 128; \
        _Pragma("unroll") for (int s = 0; s < 4; ++s) { const int p_ = (kt * 4 + s) * 64 + lane; kf[j_][s] = *(const bf16x8*)(ksec_ + (size_t)(p_ >> 4) * OD_PAD + (p_ & 15) * 8); } \
        glv[j_] = (GPTR(const float, C.ws + WS_DEN) + (size_t)u_ * 256)[128 + lz]; \
        { const bf16* Qg_ = GPTR(const bf16, C.ws + WS_QKD + (size_t)u_ * 8192); kqr[j_][0] = *(const u32x4*)(Qg_ + ((kt * 2) * 64 + lane) * 8); kqr[j_][1] = *(const u32x4*)(Qg_ + ((kt * 2 + 1) * 64 + lane) * 8); } } while (0)
#define G4_KQ_PUT(buf_, e_) do { *(u32x4*)(KQ + (buf_) * 4096 + ((kt * 2) * 64 + lane) * 8) = kqr[e_][0]; *(u32x4*)(KQ + (buf_) * 4096 + ((kt * 2 + 1) * 64 + lane) * 8) = kqr[e_][1]; } while (0)
        G4_LS(0, 0); RING_FENCE; G4_LS(1, 1); RING_FENCE; G4_LS(2, 2); RING_FENCE; G4_LS(3, 3); RING_FENCE;
        G4_KQ_PUT(0, 0);
        __syncthreads();
#pragma unroll 1
        for (int ch0 = 0; ch0 < SEQ / 64; ch0 += 4) {
#pragma unroll
            for (int j = 0; j < 4; ++j) {
                const int ch = ch0 + j;
                const float gl_ = glv[j];
#pragma unroll
                for (int g = 0; g < 16; ++g) S[g] *= gl_;
                lds_barrier();
#pragma unroll
                for (int s = 0; s < 4; ++s) S = mfma32(kf[j][s], ldfrag(VNT + r * LD64 + 16 * s + 8 * hh), S);
#pragma unroll
                for (int g4 = 0; g4 < 4; ++g4) { u32x2 pk; pk.x = pk2(S[4 * g4], S[4 * g4 + 1]); pk.y = pk2(S[4 * g4 + 2], S[4 * g4 + 3]);
                    *(u32x2*)(ST + r * LD128 + 32 * kt + 8 * g4 + 4 * hh) = pk; }
                G4_KQ_PUT((j + 1) & 1, (j + 1) & 3);
                G4_LS(j, (ch + 4 < SEQ / 64 ? ch + 4 : SEQ / 64 - 1));
                lds_barrier();
            }
        }
#undef G4_LS
#undef G4_KQ_PUT
    }
#undef G4_LANE
}

__device__ __forceinline__ bf16* ml_dc_piece(bf16* Pw, size_t m0, int h, int p) {
    const int pr = p & 15; return Pw + (m0 + (p >> 4)) * OD_PAD + OC_MQK + (pr < 8 ? h * 64 + pr * 8 : 256 + h * 64 + (pr - 8) * 8); }
struct MlRaw { f32x4 cw[4]; u32x2 xr[7]; u32x4 va, vb; float gi, gf, bi, bf_; };
__device__ __forceinline__ void mlstm_pre3_load(const Ctx& C, int o_in, int unit_in, MlRaw& R) {
    int o = o_in, unit = unit_in; asm volatile("" : "+s"(o), "+s"(unit));
    const int tid = C.tid(), lane = tid & 63;
    const int bh = unit >> 6, n = unit & 63, b = bh >> 2, h = bh & 3, t0 = n * 64;
    const size_t m0 = (size_t)b * SEQ + t0;
    const bf16* P = GPTR(const bf16, C.ws + WS_R1); const bf16* HALO = GPTR(const bf16, C.ws + WS_HALO);
    const float* convw = C.in(32) + (size_t)o * 4 * 512;
    const int l16 = tid & 15, typ = (tid >> 4) & 1, tg = tid >> 5;
    const int pc = OC_MQK + (typ ? 256 : 0) + h * 64 + 4 * l16;
#pragma unroll
    for (int k = 0; k < 4; ++k) R.cw[k] = *(const f32x4*)(convw + k * 512 + (typ ? 256 : 0) + h * 64 + 4 * l16);
#pragma unroll
    for (int i = 0; i < 7; ++i) { const int t = t0 + 4 * tg - 3 + i; const int tc = t >= 0 ? t : 0;
        R.xr[i] = *(const u32x2*)((tc >= t0 ? P + ((size_t)b * SEQ + tc) * OD_PAD : HALO + ((size_t)((b * 64 + n - 1) * 3 + (tc - (t0 - 3)))) * OD_PAD) + pc); }
    {   const int vt = tid & 63, vg = tid >> 6; const bf16* vr = P + (m0 + vt) * OD_PAD + OC_MV + h * 128 + 16 * vg; R.va = *(const u32x4*)vr; R.vb = *(const u32x4*)(vr + 8); }
    {   const bf16* row = P + (m0 + lane) * OD_PAD; R.gi = bf2f(row[OC_MI + h]); R.gf = bf2f(row[OC_MF + h]); R.bi = C.in(33)[o * 4 + h]; R.bf_ = C.in(34)[o * 4 + h]; }
}
#ifdef TP_ML
#define ML_MARK(k_) do { const unsigned long long tn_ = __builtin_amdgcn_s_memrealtime(); if ((TP_ML >> (k_)) & 1) { while (__builtin_amdgcn_s_memrealtime() - tn_ < tn_ - ml_tprev_) __builtin_amdgcn_s_sleep(2); } ml_tprev_ = __builtin_amdgcn_s_memrealtime(); } while (0)
#else
#define ML_MARK(k_) do { } while (0)
#endif
__device__ __forceinline__ void mlstm_pre3(const Ctx& C, int o_in, int unit_in, unsigned char* lds, const MlRaw& R, bool dummy = false) {
#ifdef TP_ML
    unsigned long long ml_tprev_ = __builtin_amdgcn_s_memrealtime();
#endif
    int o = o_in, unit = unit_in; asm volatile("" : "+s"(o), "+s"(unit));
    int tid_ = C.tid(); asm volatile("" : "+v"(tid_));
    const int tid = tid_, lane = tid & 63, w = __builtin_amdgcn_readfirstlane(tid >> 6), r = lane & 31, hh = lane >> 5;
    const int bh = unit >> 6, n = unit & 63, b = bh >> 2, h = bh & 3, t0 = n * 64;
    const size_t m0 = (size_t)b * SEQ + t0;
    const bf16* P = GPTR(const bf16, C.ws + WS_R1); const bf16* HALO = GPTR(const bf16, C.ws + WS_HALO);
    const float* convw = C.in(32) + (size_t)o * 4 * 512;
    bf16* Qh = (bf16*)lds; bf16* Kh = Qh + 64 * LD64; bf16* KTs = Kh + 64 * LD64; bf16* Wm = KTs + 64 * LD64; bf16* VT = Wm + 64 * LD64;
    float* sB = (float*)(VT + 160 * LD64); float* sI = sB + 64; float* sEB = sI + 64; float* sEK = sEB + 64;
    float* tab = GPTR(float, C.ws + WS_DEN) + (size_t)unit * 256; float* tab2 = GPTR(float, C.ws + WS_BONUS + 512 * 1024) + (size_t)unit * 128;
    lds_barrier(); ML_MARK(1);
    if (w == 0) {
        const float ip = R.gi + R.bi; float lf = logsigm(R.gf + R.bf_);
#pragma unroll
        for (int d = 1; d < 64; d <<= 1) { const float up = __shfl_up(lf, d); if (lane >= d) lf += up; }
        const float bl = __shfl(lf, 63);
        sB[lane] = lf; sI[lane] = ip; sEB[lane] = fexp(lf); sEK[lane] = fexp(bl - lf + ip); if (lane == 0) tab[129] = fexp(bl);
    }
    for (int i = tid; i < 32 * LD64; i += NTHREADS) VT[128 * LD64 + i] = (i < 64) ? (bf16)0x3F80 : (bf16)0;
    for (int i = tid; i < 64 * LD64 / 2; i += NTHREADS) ((unsigned*)Wm)[i] = C.z0;
    const int l16 = tid & 15, typ = (tid >> 4) & 1, tg = tid >> 5;
    const int pc = OC_MQK + (typ ? 256 : 0) + h * 64 + 4 * l16;
    lds_barrier(); ML_MARK(2);
    {
        float cw[4][4], x[7][4], ko[4][4];
#pragma unroll
        for (int k = 0; k < 4; ++k)
#pragma unroll
            for (int j = 0; j < 4; ++j) cw[k][j] = R.cw[k][j];
#pragma unroll
        for (int i = 0; i < 7; ++i) { const int t = t0 + 4 * tg - 3 + i; const u32x2 wr_ = R.xr[i];
            x[i][0] = t >= 0 ? bf2f(wr_.x & 0xffffu) : 0.f; x[i][1] = t >= 0 ? bf2f(wr_.x >> 16) : 0.f; x[i][2] = t >= 0 ? bf2f(wr_.y & 0xffffu) : 0.f; x[i][3] = t >= 0 ? bf2f(wr_.y >> 16) : 0.f; }
#pragma unroll
        for (int tt = 0; tt < 4; ++tt) {
#pragma unroll
            for (int j = 0; j < 4; ++j) { float a = C.zf();
#pragma unroll
                for (int k = 0; k < 4; ++k) a += cw[k][j] * x[tt + k][j];
                a = siluf(a); ko[tt][j] = typ ? a : a * 0.125f; }
            u32x2 pk; pk.x = pk2(ko[tt][0], ko[tt][1]); pk.y = pk2(ko[tt][2], ko[tt][3]);
            *(u32x2*)((typ ? Kh : Qh) + (4 * tg + tt) * LD64 + 4 * l16) = pk; }
        if (typ) {
#pragma unroll
            for (int j = 0; j < 4; ++j) { u32x2 pk; pk.x = pk2(ko[0][j] * sEK[4 * tg], ko[1][j] * sEK[4 * tg + 1]); pk.y = pk2(ko[2][j] * sEK[4 * tg + 2], ko[3][j] * sEK[4 * tg + 3]); *(u32x2*)(KTs + (4 * l16 + j) * LD64 + 4 * tg) = pk; } }
        {   const int vt = tid & 63, vg = tid >> 6; const u32x4 a = R.va, c2 = R.vb;
            const unsigned wv[8] = {a.x, a.y, a.z, a.w, c2.x, c2.y, c2.z, c2.w};
#pragma unroll
            for (int q = 0; q < 8; ++q) { VT[(16 * vg + 2 * q) * LD64 + vt] = (bf16)(wv[q] & 0xffffu); VT[(16 * vg + 2 * q + 1) * LD64 + vt] = (bf16)(wv[q] >> 16); } }
    }
    lds_barrier(); ML_MARK(3);
    if (w < 3) {
        const int ti = w > 0 ? 1 : 0, tj = w > 1 ? 1 : 0;
        f32x16 acc;
#pragma unroll
        for (int g = 0; g < 16; ++g) acc[g] = C.zf();
#pragma unroll
        for (int s = 0; s < 4; ++s) acc = mfma32(ldfrag(Kh + (32 * tj + r) * LD64 + 16 * s + 8 * hh), ldfrag(Qh + (32 * ti + r) * LD64 + 16 * s + 8 * hh), acc);
        const int i = 32 * ti + r; const float bi = sB[i];
#pragma unroll
        for (int g4 = 0; g4 < 4; ++g4) { const f32x4 bj = *(const f32x4*)(sB + 32 * tj + 8 * g4 + 4 * hh), ij = *(const f32x4*)(sI + 32 * tj + 8 * g4 + 4 * hh); float v4[4];
#pragma unroll
            for (int q = 0; q < 4; ++q) { const int j = 32 * tj + 8 * g4 + 4 * hh + q; v4[q] = (j <= i) ? acc[4 * g4 + q] * fexp(bi - bj[q] + ij[q]) : 0.f; }
            u32x2 pk; pk.x = pk2(v4[0], v4[1]); pk.y = pk2(v4[2], v4[3]);
            *(u32x2*)(Wm + i * LD64 + 32 * tj + 8 * g4 + 4 * hh) = pk; }
    } else if (w >= 4) {
        bf16* Pw = GPTR(bf16, C.ws + WS_R1);
#pragma unroll
        for (int q = 0; q < 2; ++q) { const int p = (tid - 256) + 256 * q, ln = p & 63, s4 = (p >> 6) & 3, R = p >> 8; const int t = 32 * R + (ln & 31);
            float v8[8]; ld8(Qh + t * LD64 + 16 * s4 + 8 * (ln >> 5), v8); const float eb = sEB[t];
            u32x4 pk; pk.x = pk2(v8[0] * eb, v8[1] * eb); pk.y = pk2(v8[2] * eb, v8[3] * eb); pk.z = pk2(v8[4] * eb, v8[5] * eb); pk.w = pk2(v8[6] * eb, v8[7] * eb);
            if (!dummy) stwt16(Pw + (m0 + (p >> 4)) * OD_PAD + 1024 + h * 128 + (p & 15) * 8, pk); }
    }
    lds_barrier(); ML_MARK(4);
    {
        bf16* Pw = GPTR(bf16, C.ws + WS_R1);
#pragma unroll 1
        for (int job = w; job < 20; job += 8) {
            const bool isc = job >= 10; const int jj = isc ? job - 10 : job, rt = jj / 5, vjj = jj % 5;
            const bf16* A = (isc ? KTs : Wm) + (32 * rt + r) * LD64;
            f32x16 acc;
#pragma unroll
            for (int g = 0; g < 16; ++g) acc[g] = C.zf();
#pragma unroll
            for (int s = 0; s < 4; ++s) acc = mfma32(ldfrag(A + 16 * s + 8 * hh), ldfrag(VT + (32 * vjj + r) * LD64 + 16 * s + 8 * hh), acc);
            if (vjj < 4) {
                u32x4 q0, q1; q0.x = pk2(acc[0], acc[1]); q0.y = pk2(acc[2], acc[3]); q0.z = pk2(acc[4], acc[5]); q0.w = pk2(acc[6], acc[7]);
                q1.x = pk2(acc[8], acc[9]); q1.y = pk2(acc[10], acc[11]); q1.z = pk2(acc[12], acc[13]); q1.w = pk2(acc[14], acc[15]);
                const int p0 = ((rt * 4 + vjj) * 64 + lane) * 2;
                if (dummy) {} else if (isc) { stwt16(ml_dc_piece(Pw, m0, h, p0), q0); stwt16(ml_dc_piece(Pw, m0, h, p0 + 1), q1); }
                else { stwt16(Pw + (m0 + (p0 >> 4)) * OD_PAD + OC_MV + h * 128 + (p0 & 15) * 8, q0); stwt16(Pw + (m0 + ((p0 + 1) >> 4)) * OD_PAD + OC_MV + h * 128 + ((p0 + 1) & 15) * 8, q1); }
            } else if (r == 0) {
#pragma unroll
                for (int g = 0; g < 16; ++g) tab2[(isc ? 64 : 0) + 32 * rt + drow(g, hh)] = acc[g];
            }
        }
    }
    ML_MARK(5);
}

__device__ __forceinline__ void cnt_wait(const Ctx& C, unsigned* cnt, unsigned need) {
    if (C.tid() == 0) { unsigned sp = 0; while (__hip_atomic_load(cnt, __ATOMIC_RELAXED, __HIP_MEMORY_SCOPE_AGENT) < need) { __builtin_amdgcn_s_sleep(2); if (++sp > (1u << 22)) break; }
        __builtin_amdgcn_fence(__ATOMIC_ACQUIRE, "agent"); asm volatile("s_waitcnt vmcnt(0)" ::: "memory"); }
    __syncthreads();
}
#ifndef ML_CS
#define ML_CS 48
#endif
__device__ __forceinline__ void mlstm_chain4_block(const Ctx& C, int mb, int c, unsigned char* lds, unsigned* cntB, unsigned needB) {
    const int w = C.wave;
    const int b = mb >> 2, h = mb & 3;
    const bf16* P = GPTR(const bf16, C.ws + WS_R1); bf16* Y = GPTR(bf16, C.ws + WS_Y); float* den = GPTR(float, C.ws + WS_BONUS);
    bf16* CT0 = (bf16*)lds; bf16* CT1 = CT0 + 32 * LD64; float* sN = (float*)(CT1 + 32 * LD64);
    for (int i = C.tid(); i < 2 * 32 * LD64 / 2; i += NTHREADS) ((unsigned*)CT0)[i] = 0u;
    if (C.tid() < 128) sN[C.tid()] = 0.f;
#define M4_LANE int ln_ = C.lane(); asm volatile("" : "+v"(ln_)); const int lane = ln_, r = lane & 31, hh = lane >> 5; int lz = 0; asm volatile("" : "+v"(lz));
#define M4_QD(j_, mm_) _Pragma("unroll") for (int s = 0; s < 4; ++s) { const int p_ = (th * 4 + s) * 64 + lane; qd[j_][s] = *(const bf16x8*)(P + ((mm_) + (p_ >> 4)) * OD_PAD + 1024 + h * 128 + (p_ & 15) * 8); }
    if (w < 2) {
        const int th = w; M4_LANE
        f32x16 Cacc;
#pragma unroll
        for (int g = 0; g < 16; ++g) Cacc[g] = C.zf();
        bf16x8 qd[4][4]; u32x4 n0[4], n1[4], d0[4], d1[4]; float Fv[4];
#define M4_LT(j_, ch_) do { const size_t mm_ = (size_t)b * SEQ + 64 * (ch_); const int u_ = mb * 64 + (ch_); M4_QD(j_, mm_) \
        const int p0_ = ((th * 4 + c) * 64 + lane) * 2; \
        n0[j_] = *(const u32x4*)(P + (mm_ + (p0_ >> 4)) * OD_PAD + OC_MV + h * 128 + (p0_ & 15) * 8); n1[j_] = *(const u32x4*)(P + (mm_ + ((p0_ + 1) >> 4)) * OD_PAD + OC_MV + h * 128 + ((p0_ + 1) & 15) * 8); \
        d0[j_] = *(const u32x4*)ml_dc_piece((bf16*)P, mm_, h, p0_); d1[j_] = *(const u32x4*)ml_dc_piece((bf16*)P, mm_, h, p0_ + 1); \
        Fv[j_] = (GPTR(const float, C.ws + WS_DEN) + (size_t)u_ * 256)[129 + lz]; } while (0)
        M4_LT(0, 0); RING_FENCE; M4_LT(1, 1); RING_FENCE; M4_LT(2, 2); RING_FENCE; M4_LT(3, 3); RING_FENCE;
        __syncthreads();
#pragma unroll 1
        for (int ch0 = 0; ch0 < SEQ / 64; ch0 += 4) {
            if (ch0 == ML_CS - 4) cnt_wait(C, cntB, needB);
#pragma unroll
            for (int j = 0; j < 4; ++j) {
                const int ch = ch0 + j; const size_t m0 = (size_t)b * SEQ + 64 * ch;
                const bf16* CTc = (j & 1) ? CT1 : CT0; bf16* CTn = (j & 1) ? CT0 : CT1;
                const float F = Fv[j];
                f32x16 num;
                num[0] = bf2f(n0[j].x & 0xffffu); num[1] = bf2f(n0[j].x >> 16); num[2] = bf2f(n0[j].y & 0xffffu); num[3] = bf2f(n0[j].y >> 16); num[4] = bf2f(n0[j].z & 0xffffu); num[5] = bf2f(n0[j].z >> 16); num[6] = bf2f(n0[j].w & 0xffffu); num[7] = bf2f(n0[j].w >> 16);
                num[8] = bf2f(n1[j].x & 0xffffu); num[9] = bf2f(n1[j].x >> 16); num[10] = bf2f(n1[j].y & 0xffffu); num[11] = bf2f(n1[j].y >> 16); num[12] = bf2f(n1[j].z & 0xffffu); num[13] = bf2f(n1[j].z >> 16); num[14] = bf2f(n1[j].w & 0xffffu); num[15] = bf2f(n1[j].w >> 16);
#pragma unroll
                for (int s = 0; s < 4; ++s) num = mfma32(qd[j][s], ldfrag(CTc + r * LD64 + 16 * s + 8 * hh), num);
                {   float dc[16];
                    dc[0] = bf2f(d0[j].x & 0xffffu); dc[1] = bf2f(d0[j].x >> 16); dc[2] = bf2f(d0[j].y & 0xffffu); dc[3] = bf2f(d0[j].y >> 16); dc[4] = bf2f(d0[j].z & 0xffffu); dc[5] = bf2f(d0[j].z >> 16); dc[6] = bf2f(d0[j].w & 0xffffu); dc[7] = bf2f(d0[j].w >> 16);
                    dc[8] = bf2f(d1[j].x & 0xffffu); dc[9] = bf2f(d1[j].x >> 16); dc[10] = bf2f(d1[j].y & 0xffffu); dc[11] = bf2f(d1[j].y >> 16); dc[12] = bf2f(d1[j].z & 0xffffu); dc[13] = bf2f(d1[j].z >> 16); dc[14] = bf2f(d1[j].w & 0xffffu); dc[15] = bf2f(d1[j].w >> 16);
#pragma unroll
                    for (int g = 0; g < 16; ++g) Cacc[g] = F * Cacc[g] + dc[g]; }
#pragma unroll
                for (int g4 = 0; g4 < 4; ++g4) { u32x2 pk; pk.x = pk2(Cacc[4 * g4], Cacc[4 * g4 + 1]); pk.y = pk2(Cacc[4 * g4 + 2], Cacc[4 * g4 + 3]);
                    *(u32x2*)(CTn + r * LD64 + 32 * th + 8 * g4 + 4 * hh) = pk; }
                M4_LT(j, (ch + 4 < SEQ / 64 ? ch + 4 : SEQ / 64 - 1));
#pragma unroll
                for (int g = 0; g < 16; ++g) Y[(m0 + 32 * th + drow(g, hh)) * DM + 512 + h * 128 + 32 * c + r] = (bf16)f2bf(num[g]);
                lds_barrier();
            }
        }
#undef M4_LT
    } else if (w < 4 && c == 0) {
        const int th = w - 2; M4_LANE
        bf16x8 qd[4][4]; float Fv[4], dpv[4], dnv[4];
#define M4_LD(j_, ch_) do { const size_t mm_ = (size_t)b * SEQ + 64 * (ch_); const int u_ = mb * 64 + (ch_); M4_QD(j_, mm_) \
        Fv[j_] = (GPTR(const float, C.ws + WS_DEN) + (size_t)u_ * 256)[129 + lz]; \
        { const float* t2_ = GPTR(const float, C.ws + WS_BONUS + 512 * 1024) + (size_t)u_ * 128; dpv[j_] = t2_[32 * th + r]; dnv[j_] = t2_[64 + lane]; } } while (0)
        M4_LD(0, 0); RING_FENCE; M4_LD(1, 1); RING_FENCE; M4_LD(2, 2); RING_FENCE; M4_LD(3, 3); RING_FENCE;
        __syncthreads();
#pragma unroll 1
        for (int ch0 = 0; ch0 < SEQ / 64; ch0 += 4) {
            if (ch0 == ML_CS - 4) cnt_wait(C, cntB, needB);
#pragma unroll
            for (int j = 0; j < 4; ++j) {
                const int ch = ch0 + j; const size_t m0 = (size_t)b * SEQ + 64 * ch;
                const float F = Fv[j];
                const float* nc = sN + (j & 1) * 64; float* nn = sN + ((j + 1) & 1) * 64;
                float dsum = C.zf();
#pragma unroll
                for (int s = 0; s < 4; ++s) { const f32x4 na = *(const f32x4*)(nc + 16 * s + 8 * hh), nb = *(const f32x4*)(nc + 16 * s + 8 * hh + 4); float q8[8]; const u32x4 qq = __builtin_bit_cast(u32x4, qd[j][s]); UNPK8(qq, q8);
                    dsum += (q8[0] * na[0] + q8[1] * na[1]) + (q8[2] * na[2] + q8[3] * na[3]) + (q8[4] * nb[0] + q8[5] * nb[1]) + (q8[6] * nb[2] + q8[7] * nb[3]); }
                dsum += __shfl_xor(dsum, 32);
                if (hh == 0) den[(m0 + 32 * th + r) * 4 + h] = dsum + dpv[j];
                if (th == 1) nn[lane] = F * nc[lane] + dnv[j];
                M4_LD(j, (ch + 4 < SEQ / 64 ? ch + 4 : SEQ / 64 - 1));
                lds_barrier();
            }
        }
#undef M4_LD
    } else {
        __syncthreads();
#pragma unroll 1
        for (int ch = 0; ch < SEQ / 64; ++ch) { if (ch == ML_CS - 4) cnt_wait(C, cntB, needB); lds_barrier(); }
    }
#undef M4_QD
#undef M4_LANE
}

#ifndef MLX
#define MLX 0
#endif
__device__ __forceinline__ void mlstm_chain3_block(const Ctx& C, int mb, unsigned char* lds, bool rep = false) {
    const int tid = C.tid(), lane = tid & 63, w = C.wave, r = lane & 31, hh = lane >> 5;
    const int b = mb >> 2, h = mb & 3;
    const bf16* P = GPTR(const bf16, C.ws + WS_R1); bf16* Y = GPTR(bf16, C.ws + WS_Y); float* den = GPTR(float, C.ws + WS_BONUS);
    bf16* CT0 = (bf16*)lds; bf16* CT1 = CT0 + 128 * LD64; float* sN = (float*)(CT1 + 128 * LD64);
    for (int i = tid; i < 2 * 128 * LD64 / 2; i += NTHREADS) ((unsigned*)CT0)[i] = 0u;
    if (tid < 128) sN[tid] = 0.f;
    const int th = w >> 2, vj = w & 3;
    f32x16 Cacc;
#pragma unroll
    for (int g = 0; g < 16; ++g) Cacc[g] = C.zf();
    int lz = 0; asm volatile("" : "+v"(lz));
    bf16x8 qd[4][4]; u32x4 n0[4], n1[4], d0[4], d1[4]; float Fv[4], dpv[4], dnv[4];
#define M3_LOAD(j_, ch_) do { const size_t mm_ = (size_t)b * SEQ + 64 * (ch_); const int u_ = mb * 64 + (ch_); \
        _Pragma("unroll") for (int s = 0; s < 4; ++s) { const int p_ = (th * 4 + s) * 64 + lane; qd[j_][s] = *(const bf16x8*)(P + (mm_ + (p_ >> 4)) * OD_PAD + 1024 + h * 128 + (p_ & 15) * 8); } \
        const int p0_ = ((th * 4 + vj) * 64 + lane) * 2; \
        n0[j_] = *(const u32x4*)(P + (mm_ + (p0_ >> 4)) * OD_PAD + OC_MV + h * 128 + (p0_ & 15) * 8); n1[j_] = *(const u32x4*)(P + (mm_ + ((p0_ + 1) >> 4)) * OD_PAD + OC_MV + h * 128 + ((p0_ + 1) & 15) * 8); \
        d0[j_] = *(const u32x4*)ml_dc_piece((bf16*)P, mm_, h, p0_); d1[j_] = *(const u32x4*)ml_dc_piece((bf16*)P, mm_, h, p0_ + 1); \
        Fv[j_] = (GPTR(const float, C.ws + WS_DEN) + (size_t)u_ * 256)[129 + lz]; \
        { const float* t2_ = GPTR(const float, C.ws + WS_BONUS + 512 * 1024) + (size_t)u_ * 128; dpv[j_] = t2_[32 * th + r]; dnv[j_] = t2_[64 + lane]; } } while (0)
#pragma unroll
    for (int j = 0; j < 4; ++j) { dpv[j] = C.zf(); dnv[j] = C.zf(); }
    M3_LOAD(0, 0); RING_FENCE; M3_LOAD(1, 1); RING_FENCE; M3_LOAD(2, 2); RING_FENCE; M3_LOAD(3, 3); RING_FENCE;
    __syncthreads();
#pragma unroll 1
    for (int ch0 = 0; ch0 < SEQ / 64; ch0 += 4) {
#pragma unroll
        for (int j = 0; j < 4; ++j) {
            const int ch = ch0 + j;
            const size_t m0 = (size_t)b * SEQ + 64 * ch;
            const bf16* CTc = (j & 1) ? CT1 : CT0; bf16* CTn = (j & 1) ? CT0 : CT1;
            const float F = Fv[j];
            f32x16 num;
            num[0] = bf2f(n0[j].x & 0xffffu); num[1] = bf2f(n0[j].x >> 16); num[2] = bf2f(n0[j].y & 0xffffu); num[3] = bf2f(n0[j].y >> 16); num[4] = bf2f(n0[j].z & 0xffffu); num[5] = bf2f(n0[j].z >> 16); num[6] = bf2f(n0[j].w & 0xffffu); num[7] = bf2f(n0[j].w >> 16);
            num[8] = bf2f(n1[j].x & 0xffffu); num[9] = bf2f(n1[j].x >> 16); num[10] = bf2f(n1[j].y & 0xffffu); num[11] = bf2f(n1[j].y >> 16); num[12] = bf2f(n1[j].z & 0xffffu); num[13] = bf2f(n1[j].z >> 16); num[14] = bf2f(n1[j].w & 0xffffu); num[15] = bf2f(n1[j].w >> 16);
#pragma unroll
            for (int s = 0; s < 4; ++s) num = mfma32(qd[j][s], ldfrag(CTc + (32 * vj + r) * LD64 + 16 * s + 8 * hh), num);
            {   float dc[16];
                dc[0] = bf2f(d0[j].x & 0xffffu); dc[1] = bf2f(d0[j].x >> 16); dc[2] = bf2f(d0[j].y & 0xffffu); dc[3] = bf2f(d0[j].y >> 16); dc[4] = bf2f(d0[j].z & 0xffffu); dc[5] = bf2f(d0[j].z >> 16); dc[6] = bf2f(d0[j].w & 0xffffu); dc[7] = bf2f(d0[j].w >> 16);
                dc[8] = bf2f(d1[j].x & 0xffffu); dc[9] = bf2f(d1[j].x >> 16); dc[10] = bf2f(d1[j].y & 0xffffu); dc[11] = bf2f(d1[j].y >> 16); dc[12] = bf2f(d1[j].z & 0xffffu); dc[13] = bf2f(d1[j].z >> 16); dc[14] = bf2f(d1[j].w & 0xffffu); dc[15] = bf2f(d1[j].w >> 16);
#pragma unroll
                for (int g = 0; g < 16; ++g) Cacc[g] = F * Cacc[g] + dc[g]; }
#pragma unroll
            for (int g4 = 0; g4 < 4; ++g4) { u32x2 pk; pk.x = pk2(Cacc[4 * g4], Cacc[4 * g4 + 1]); pk.y = pk2(Cacc[4 * g4 + 2], Cacc[4 * g4 + 3]);
                *(u32x2*)(CTn + (32 * vj + r) * LD64 + 32 * th + 8 * g4 + 4 * hh) = pk; }
            if (vj == 3 && !((MLX & 2) && rep)) {
                const float* nc = sN + (j & 1) * 64; float* nn = sN + ((j + 1) & 1) * 64;
                float dsum = C.zf();
#pragma unroll
                for (int s = 0; s < 4; ++s) { const f32x4 na = *(const f32x4*)(nc + 16 * s + 8 * hh), nb = *(const f32x4*)(nc + 16 * s + 8 * hh + 4); float q8[8]; const u32x4 qq = __builtin_bit_cast(u32x4, qd[j][s]); UNPK8(qq, q8);
                    dsum += (q8[0] * na[0] + q8[1] * na[1]) + (q8[2] * na[2] + q8[3] * na[3]) + (q8[4] * nb[0] + q8[5] * nb[1]) + (q8[6] * nb[2] + q8[7] * nb[3]); }
                dsum += __shfl_xor(dsum, 32);
                if (hh == 0) den[(m0 + 32 * th + r) * 4 + h] = dsum + dpv[j];
                if (th == 1) nn[lane] = F * nc[lane] + dnv[j];
            }
            M3_LOAD(j, (ch + 4 < SEQ / 64 ? ch + 4 : SEQ / 64 - 1));
            if (!((MLX & 1) && rep)) {
#pragma unroll
            for (int g = 0; g < 16; ++g) Y[(m0 + 32 * th + drow(g, hh)) * DM + 512 + h * 128 + 32 * vj + r] = (bf16)f2bf(num[g]); }
            lds_barrier();
        }
    }
#undef M3_LOAD
}

__device__ __forceinline__ void run_phase(const Ctx& C, int ph, unsigned char* lds, bool rep = false) {
    float* sm = (float*)lds;
    const int bid = C.bid;
    bf16* XB = (bf16*)C.out; bf16* Y = GPTR(bf16, C.ws + WS_Y); bf16* R1 = GPTR(bf16, C.ws + WS_R1); float* slots = GPTR(float, C.ws + WS_SLOTS);
#ifndef ONLY
#define ONLY -1
#endif
#define ON(x) (ONLY < 0 || ONLY == (x))
#ifndef CONVPROBE
#define CONVPROBE 0
#endif
#ifndef PREO_PROBE
#define PREO_PROBE 0
#endif
#ifndef G3PROBE
#define G3PROBE 0
#endif
#ifndef ML_CS
#define ML_CS 48
#endif
#ifndef PREPART
#define PREPART 3
#endif
    if (ph == 0) { if (ON(10)) { prologue_rows(C); convert_layer(C, 0, sm, 0, C.G, 1); } return; }
    if (ph == N_PHASES - 1) { if (ON(11)) final_rows(C); return; }
    const int l = (ph - 1) / 7, k7 = (ph - 1) % 7; const bool even = (l & 1) == 0; const int li = l >> 1;
    const int k = k7 == 0 ? 0 : (k7 == 1 ? 6 : k7 - 1);
    if (k == 6) {
        if (even) { if (ON(20)) {
#ifdef TP_PRE
            const unsigned long long tq0_ = __builtin_amdgcn_s_memrealtime();
#endif
            for (int tile = bid; tile < M / 64; tile += C.G) { if ((PREPART & 1) && !(rep && REP_SKIP == 2)) even_pre_tile(C, li, tile, lds); }
#ifdef TP_PRE
            asm volatile("s_waitcnt vmcnt(0) lgkmcnt(0)" ::: "memory"); const unsigned long long tq1_ = __builtin_amdgcn_s_memrealtime();
            if (TP_PRE == 1) { while (__builtin_amdgcn_s_memrealtime() - tq1_ < tq1_ - tq0_) __builtin_amdgcn_s_sleep(16); }
            const unsigned long long tq2_ = __builtin_amdgcn_s_memrealtime();
#endif
                                   for (int tile = bid; tile < M / 64; tile += C.G) { if ((PREPART & 2) && !(rep && REP_SKIP == 1)) rwkv_pre_tile(C, li, tile, lds, rep ? RPHEADS : 8); }
#ifdef TP_PRE
            if (TP_PRE == 2) { asm volatile("s_waitcnt vmcnt(0) lgkmcnt(0)" ::: "memory"); const unsigned long long tq3_ = __builtin_amdgcn_s_memrealtime(); while (__builtin_amdgcn_s_memrealtime() - tq3_ < tq3_ - tq2_) __builtin_amdgcn_s_sleep(16); }
#endif
            } }
        else { if (ON(19)) for (int unit = bid; unit < 1024; unit += C.G) {
#ifdef TP_UNIT
            const unsigned long long tu0_ = __builtin_amdgcn_s_memrealtime();
#endif
            const bool dummy = PREO_PROBE && !rep; __syncthreads();
            if (!(PREO_PROBE & 2) || !dummy) gdn_pre3(C, li, unit, lds, dummy);
#ifdef TP_UNIT
            if ((unit >> 8) == TP_UNIT) { const unsigned long long tu1_ = __builtin_amdgcn_s_memrealtime(); while (__builtin_amdgcn_s_memrealtime() - tu1_ < tu1_ - tu0_) __builtin_amdgcn_s_sleep(8); }
#endif
            } }
        return; }
    if (k == 0 && ON(0)) {
        const int N = even ? EV_COLS : OD_PAD;
        pg8::Gemm g{XB, C.wset(l, WOFF_IN), M, N, DM}; pg8::StaticOrder S; S.init(M, N, C.G, bid);
        pg8::EpiScaleBf16<0> E{R1, N, slots, even ? nullptr : GPTR(bf16, C.ws + WS_HALO)};
        pg8::gemm_phase<pg8::EpiScaleBf16<0>, pg8::StaticOrder, true, true>((PG8_LAS unsigned char*)lds, g, S, E, C.tid());
        if (!rep && bid >= 192 && (l == 0 || l + 1 < DEPTH)) { Ctx C3 = C; { unsigned zq = C.z0; asm volatile("" : "+s"(zq)); C3.z0 = zq; } convert_layer(C3, l == 0 ? 0 : l + 1, sm, 192, C.G - 192, 2); }
    } else if (k == 1 && (ON(1) || ON(12) || ON(13) || ON(14) || ON(15))) {
        if (even) { const int xqe_ = bid & 7, xre_ = bid >> 3; const int ve = (C.G != 256) ? bid : (xqe_ < 2 ? xre_ * 2 + xqe_ : 64 + xre_ * 6 + (xqe_ - 2));
                    if (ve < 64) { if (ON(1) || ON(12)) rwkv_chain3_block(C, li, ve & 31, ve >> 5, lds); } else if (rep && LRUPROBE) { for (int tile = bid - 32; tile < M / 64; tile += C.G - 32) lru_pass2_tile(C, tile, sm, true); }
                    else if (!rep && (ON(1) || ON(13))) {
#ifdef MIXE_DELAY
                        { const unsigned long long td0_ = __builtin_amdgcn_s_memrealtime(); while (__builtin_amdgcn_s_memrealtime() - td0_ < (unsigned long long)(MIXE_DELAY) * 100ull) __builtin_amdgcn_s_sleep(16); }
#endif
                        for (int tile = ve - 64; tile < M / 64; tile += C.G - 64) lru_pass2_tile(C, tile, sm); __syncthreads(); if (l + 1 < DEPTH) { Ctx C4 = C; { unsigned zq = C.z0; asm volatile("" : "+s"(zq)); C4.z0 = zq; } C4.bid = ve; convert_layer(C4, l + 1, sm, 64, C.G - 64, l == 0 ? 0 : 1); if (CONVPROBE) { __syncthreads(); convert_layer(C, l + 1, sm, 64, C.G - 64); } } } }
        else {
               const int xq_ = bid & 7, xr_ = bid >> 3; const int vb = (C.G != 256) ? bid : (xq_ < 2 ? xr_ * 2 + xq_ : (xq_ < 4 ? 64 + xr_ * 2 + (xq_ - 2) : 128 + xr_ * 4 + (xq_ - 4)));
               if (vb < 64) { if ((ON(1) || ON(14)) && !(rep && (REP_SKIP & 1))) gdn_chain4_block(C, vb & 15, vb >> 4, lds); } else {
                   Ctx C2 = C; { unsigned zq = C.z0; asm volatile("" : "+s"(zq)); C2.z0 = zq; } C2.bid = vb;
                   unsigned* cntA = GPTR(unsigned, C.ws + WS_CTL) + 12288 + 128 * li; unsigned* cntB = cntA + 64;
                   if (!rep) {
                       const int SA = C.G - 64, SB = C.G - 128, NA = 16 * ML_CS, NB = 16 * (SEQ / 64 - ML_CS);
                       const int nA = (NA - (vb - 64) + SA - 1) / SA, nB = vb >= 128 ? (NB - (vb - 128) + SB - 1) / SB : 0;
                       for (int k = 0; k <= nA + nB; ++k) {
                           if (k == nA || k == nA + nB) {
                               asm volatile("s_waitcnt vmcnt(0)" ::: "memory"); __syncthreads();
                               if (C2.tid() == 0) { __builtin_amdgcn_fence(__ATOMIC_RELEASE, "agent"); asm volatile("s_waitcnt vmcnt(0)" ::: "memory");
                                   if (k == nA) (void)__hip_atomic_fetch_add(cntA, 1u, __ATOMIC_RELAXED, __HIP_MEMORY_SCOPE_AGENT);
                                   if (k == nA + nB && vb >= 128) (void)__hip_atomic_fetch_add(cntB, 1u, __ATOMIC_RELAXED, __HIP_MEMORY_SCOPE_AGENT); }
                               if (k == nA + nB) break; }
                           const int j = k < nA ? (vb - 64) + SA * k : (vb - 128) + SB * (k - nA); const int unit = (j & 15) * 64 + (k < nA ? 0 : ML_CS) + (j >> 4);
                           __syncthreads(); Ctx Ci = C; { unsigned zq = C.z0; asm volatile("" : "+s"(zq)); Ci.z0 = zq; } MlRaw R; mlstm_pre3_load(Ci, li, unit, R); mlstm_pre3(Ci, li, unit, lds, R, false); }
                       __syncthreads(); }
                   if (vb < 128) { if ((ON(1) || ON(15)) && !(rep && (REP_SKIP & 2))) { if (!rep) cnt_wait(C2, cntA, (unsigned)(C.G - 64)); mlstm_chain4_block(C2, (vb - 64) & 15, (vb - 64) >> 4, lds, cntB, rep ? 0u : (unsigned)(C.G - 128)); } }
                   else if (!rep && l + 1 < DEPTH) convert_layer(C2, l + 1, sm, 128, C.G - 128, 1); } }
    } else if (k == 2 && (ON(2) || ON(16) || ON(17) || ON(18))) {
        if (even) { if (ON(2) || ON(16)) for (int tile = bid; tile < M / 64; tile += C.G) rwkv_post_tile2(C, li, tile, sm, rep); }
        else { if (ON(2) || ON(17)) odd_post(C, li, rep); }
    } else if (k == 3 && ON(3)) {
        pg8::Gemm g{Y, C.wset(l, WOFF_OUT), M, DM, DM}; pg8::StaticOrder S; S.init(M, DM, C.G, bid);
        pg8::EpiRes E{XB, rep ? GPTR(bf16, C.ws + WS_XB) : XB, slots, rep};
        pg8::gemm_phase<pg8::EpiRes, pg8::StaticOrder, true, true>((PG8_LAS unsigned char*)lds, g, S, E, C.tid());
    } else if (k == 4 && ON(4)) {
        pg8::Gemm g{XB, C.wset(l, WOFF_UP), M, DFF, DM}; pg8::StaticOrder S; S.init(M, DFF, C.G, bid);
        pg8::EpiScaleBf16<1> E{R1, DFF, slots, nullptr, rep ? G3PROBE : 0};
        pg8::gemm_phase<pg8::EpiScaleBf16<1>, pg8::StaticOrder, true, true>((PG8_LAS unsigned char*)lds, g, S, E, C.tid());
    } else if (k == 5 && ON(5)) {
        pg8::Gemm g{R1, C.wset(l, WOFF_DOWN), M, DM, DFF}; pg8::StaticOrder S; S.init(M, DM, C.G, bid);
        pg8::EpiRes E{XB, (l + 1 < DEPTH && !rep) ? XB : GPTR(bf16, C.ws + WS_XB), slots, rep};
        pg8::gemm_phase<pg8::EpiRes, pg8::StaticOrder, true, true>((PG8_LAS unsigned char*)lds, g, S, E, C.tid());
    }
}

#ifndef MK_SINGLE
#define MK_SINGLE 1
#endif
#ifndef REP_SKIP
#define REP_SKIP 0
#endif
#ifndef MK_XCDBAR
#define MK_XCDBAR 1
#endif
constexpr int CW_BAR = 4096;
#define XB_TMO      128
#define XB_XCNT(j)  (256  + 64 * (j))
#define XB_XSUB(j)  (1280 + 64 * (j))
#define XB_XGEN(j)  (2304 + 64 * (j))
#define XB_TOP      3328
#define XB_TOPGEN   3392
#define XCD_BAR_WORDS 3456
#define XB_SPIN_CAP (1u << 18)

__device__ __forceinline__ unsigned xb_ld(unsigned* p)              { return __hip_atomic_load(p, __ATOMIC_RELAXED, __HIP_MEMORY_SCOPE_AGENT); }
__device__ __forceinline__ unsigned xb_add(unsigned* p, unsigned v) { return __hip_atomic_fetch_add(p, v, __ATOMIC_RELAXED, __HIP_MEMORY_SCOPE_AGENT); }
__device__ __forceinline__ unsigned xb_xcc_id() { return (unsigned)__builtin_amdgcn_s_getreg((3 << 11) | 20) & 0xFu; }
#define XB_SPIN(cond, bar) do { unsigned _sp = 0; while (cond) { __builtin_amdgcn_s_sleep(1); \
    if ((++_sp & 255u) == 0u) { if (xb_ld(&(bar)[XB_TMO])) break; if (_sp > XB_SPIN_CAP) { atomicAdd(&(bar)[XB_TMO], 1u); break; } } } } while (0)

struct XcdBarrier {
    unsigned* bar; unsigned x;
    volatile LAS unsigned* st;
};

__device__ __forceinline__ XcdBarrier xcd_barrier_post(unsigned* bar, volatile LAS unsigned* st) {
    XcdBarrier b; b.bar = bar; b.x = xb_xcc_id(); b.st = st;
    if (threadIdx.x == 0) (void)xb_add(&bar[XB_XCNT(b.x)], 1u);
    return b;
}
__device__ __forceinline__ void xcd_barrier_complete(unsigned* bar, unsigned x, unsigned& nloc, unsigned& nx) {
    const unsigned G = gridDim.x * gridDim.y * gridDim.z;
    unsigned sum, cnt, mine, sp = 0u;
    for (;;) {
        sum = 0u; cnt = 0u; mine = 0u;
#pragma unroll
        for (unsigned j = 0; j < 16; ++j) { const unsigned c = xb_ld(&bar[XB_XCNT(j)]); sum += c; cnt += (c > 0u) ? 1u : 0u; mine = (j == x) ? c : mine; }
        if (sum == G) break;
        __builtin_amdgcn_s_sleep(1);
        if ((++sp & 255u) == 0u) { if (xb_ld(&bar[XB_TMO])) break; if (sp > XB_SPIN_CAP) { atomicAdd(&bar[XB_TMO], 1u); break; } }
    }
    nloc = mine > 0u ? mine : 1u; nx = cnt > 0u ? cnt : 1u;
}

__device__ __forceinline__ void xcd_barrier(const XcdBarrier& b, bool lead  ) {
    asm volatile("s_waitcnt vmcnt(0)" ::: "memory");
    __syncthreads();
    if (lead) {
        unsigned* bar = b.bar;
        __builtin_amdgcn_s_waitcnt(0);
        unsigned nloc = b.st[0], nx = b.st[1];
        if (nloc == 0u) { xcd_barrier_complete(bar, b.x, nloc, nx); b.st[0] = nloc; b.st[1] = nx; }
        const unsigned old = xb_add(&bar[XB_XSUB(b.x)], 1u);
        const unsigned gen = old / nloc;
        if (old + 1u == (gen + 1u) * nloc) {
            __builtin_amdgcn_fence(__ATOMIC_RELEASE, "agent");
            asm volatile("s_waitcnt vmcnt(0)" ::: "memory");
            const unsigned og = xb_add(&bar[XB_TOP], 1u);
            const unsigned tg = og / nx;
            if (og + 1u == (tg + 1u) * nx) xb_add(&bar[XB_TOPGEN], 1u);
            else XB_SPIN(xb_ld(&bar[XB_TOPGEN]) == tg, bar);
            __builtin_amdgcn_fence(__ATOMIC_ACQUIRE, "agent");
            xb_add(&bar[XB_XGEN(b.x)], 1u);
            asm volatile("s_waitcnt vmcnt(0)" ::: "memory");
        } else {
            XB_SPIN(xb_ld(&bar[XB_XGEN(b.x)]) == gen, bar);
            __builtin_amdgcn_fence(__ATOMIC_ACQUIRE, "agent");
            asm volatile("s_waitcnt vmcnt(0)" ::: "memory");
        }
    }
    __syncthreads();
}


__global__ void __launch_bounds__(NTHREADS, 2) mega(Args args) {
    extern __shared__ __attribute__((aligned(16))) unsigned char lds[];
    if (threadIdx.x < 36) ((LAS unsigned long long*)((LAS unsigned char*)lds + LDS_TBL_OFF))[threadIdx.x] = (unsigned long long)args.in[threadIdx.x];
#if MK_SINGLE && MK_XCDBAR
    volatile LAS unsigned* bst = (volatile LAS unsigned*)((LAS unsigned char*)lds + (LDS_BYTES - 64));
    if (threadIdx.x < 2) bst[threadIdx.x] = 0u;
    __syncthreads();
    (void)xcd_barrier_post((unsigned*)(args.ws + WS_CTL) + CW_BAR, bst);
#define XBAR_NOW() XcdBarrier{GPTR(unsigned, C.ws + WS_CTL) + CW_BAR, xb_xcc_id(), (volatile LAS unsigned*)((LAS unsigned char*)lds + (LDS_BYTES - 64))}
#endif
    __syncthreads();
    const int wave_s = __builtin_amdgcn_readfirstlane((int)threadIdx.x >> 6);
#ifdef REPEAT_MASK
    for (int ph2 = args.ph_lo * 2; ph2 < args.ph_hi * 2; ++ph2) {
        const int ph = ph2 >> 1; const bool rep = (ph2 & 1) != 0;
        if (rep) { const int l_ = (ph - 1) / 7, k7_ = (ph - 1) % 7; const bool ev_ = (l_ & 1) == 0; const int k_ = (ph == 0 || ph == N_PHASES - 1) ? -1 : (k7_ == 0 ? 0 : (k7_ == 1 ? 6 : k7_ - 1));
                   const int code_ = ph == 0 ? 16 : (k_ < 0 ? -1 : (k_ + (ev_ ? 0 : 8)));
                   if (!(code_ >= 0 && ((REPEAT_MASK >> code_) & 1))) continue; }
#else
    for (int ph = args.ph_lo; ph < args.ph_hi; ++ph) { const bool rep = false;
#endif
        Ctx C;
        int wv_ = wave_s; unsigned z0_ = 0u; asm volatile("" : "+s"(wv_), "+s"(z0_));
        int bx = blockIdx.x, G = gridDim.x; unsigned char* ws = args.ws; float* out = args.out;
        asm volatile("" : "+s"(bx)); asm volatile("" : "+s"(G)); asm volatile("" : "+s"(ws)); asm volatile("" : "+s"(out));
        ws = GPTR(unsigned char, ws); out = GPTR(float, out);
        C.tbl = nullptr; C.out = out; C.ws = ws;
        C.wave = wv_; C.z0 = z0_;
        C.G = G; C.vcu = (G % 8 == 0) ? (bx % 8) * (G / 8) + bx / 8 : bx; C.bid = bx;
        int zoff = 0; asm volatile("" : "+s"(zoff));
#ifndef TP_SIDE
#define TP_SIDE 0
#define TP_SPLIT 32
#endif
#ifndef TP_MULT
#define TP_MULT 1
#endif
#ifndef TP_NODRAIN
#define TP_NODRAIN 0
#endif
#ifdef TIMEPROBE
        const unsigned long long tp0_ = __builtin_amdgcn_s_memrealtime();
#endif
        run_phase(C, ph, lds + zoff, rep);
#ifdef TIMEPROBE
        {   const int l_ = (ph - 1) / 7, k7_ = (ph - 1) % 7; const bool ev_ = (l_ & 1) == 0; const int k_ = (ph == 0 || ph == N_PHASES - 1) ? -1 : (k7_ == 0 ? 0 : (k7_ == 1 ? 6 : k7_ - 1));
            const int code_ = ph == 0 ? 16 : (ph == N_PHASES - 1 ? 17 : (k_ + (ev_ ? 0 : 8)));
            if (((TIMEPROBE >> code_) & 1) && (TP_SIDE == 0 || (TP_SIDE == 1) == (bx < TP_SPLIT))) { if (!TP_NODRAIN) asm volatile("s_waitcnt vmcnt(0) lgkmcnt(0)" ::: "memory"); const unsigned long long tp1_ = __builtin_amdgcn_s_memrealtime(); const unsigned long long dt_ = (tp1_ - tp0_) * TP_MULT;
                while (__builtin_amdgcn_s_memrealtime() - tp1_ < dt_) __builtin_amdgcn_s_sleep(16); } }
#endif
#if MK_SINGLE
#if MK_XCDBAR
        bool lead_; { unsigned zb_ = 0u; asm volatile("" : "+s"(zb_)); lead_ = (wv_ == 0) && (__builtin_amdgcn_mbcnt_hi(~0u, __builtin_amdgcn_mbcnt_lo(~0u, zb_)) == 0u); }
#ifdef REPEAT_MASK
        xcd_barrier(XBAR_NOW(), lead_);
#else
        if (ph + 1 < args.ph_hi) xcd_barrier(XBAR_NOW(), lead_);
#endif
#else
        if (ph + 1 < args.ph_hi) cg::this_grid().sync();
#endif
#endif
    }
#ifdef BARPROBE
    for (int i = 0; i < BARPROBE; ++i) { Ctx C; C.ws = GPTR(unsigned char, args.ws); xcd_barrier(XBAR_NOW(), threadIdx.x == 0); }
#endif
}

extern "C" void kernel_launch(void* const* d_in, const int* in_sizes, int n_in, void* d_out, int out_size, void* d_ws, size_t ws_size, hipStream_t stream) {
    static int grid = 0;
    if (grid == 0) {
        if (n_in != 36 || out_size != M * DM || ws_size < 256 * MiB) { fprintf(stderr, "kernel_launch: unexpected shapes (n_in %d, out %d, ws %zu); nothing launched\n", n_in, out_size, ws_size); grid = -1; return; }
        int dev = 0, cus = 0, per_cu = 0;
        (void)hipGetDevice(&dev); (void)hipDeviceGetAttribute(&cus, hipDeviceAttributeMultiprocessorCount, dev);
        if (hipFuncSetAttribute((const void*)mega, hipFuncAttributeMaxDynamicSharedMemorySize, LDS_BYTES) != hipSuccess) { fprintf(stderr, "kernel_launch: hipFuncSetAttribute failed\n"); grid = -1; return; }
        if (hipOccupancyMaxActiveBlocksPerMultiprocessor(&per_cu, (const void*)mega, NTHREADS, LDS_BYTES) != hipSuccess || per_cu < 1) { fprintf(stderr, "kernel_launch: occupancy query says %d\n", per_cu); per_cu = 1; }
        (void)hipGetLastError();
        grid = cus > 0 ? cus : 256;
        fprintf(stderr, "kernel_launch: cus %d per_cu %d grid %d ws %zu\n", cus, per_cu, grid, ws_size);
    }
    if (grid < 0) return;
    Args a{};
    for (int i = 0; i < 36; ++i) a.in[i] = (const float*)d_in[i];
    a.out = (float*)d_out; a.ws = (unsigned char*)d_ws;
#if MK_SINGLE
    a.ph_lo = 0; a.ph_hi = N_PHASES;
#if MK_XCDBAR
    if (hipMemsetAsync((char*)d_ws + WS_CTL, 0, 65536, stream) != hipSuccess) { fprintf(stderr, "kernel_launch: hipMemsetAsync failed\n"); return; }
    hipLaunchKernelGGL(mega, dim3(grid), dim3(NTHREADS), LDS_BYTES, stream, a);
#else
    void* kargs[] = {&a};
    hipError_t e = hipLaunchCooperativeKernel((const void*)mega, dim3(grid), dim3(NTHREADS), kargs, LDS_BYTES, stream);
    if (e != hipSuccess) fprintf(stderr, "kernel_launch: cooperative launch failed: %s\n", hipGetErrorString(e));
#endif
#else
    for (int ph = 0; ph < N_PHASES; ++ph) {
        a.ph_lo = ph; a.ph_hi = ph + 1;
        hipLaunchKernelGGL(mega, dim3(grid), dim3(NTHREADS), LDS_BYTES, stream, a);
    }
#endif
}
```
